# Optimizing an MI355X kernel written in HIP

```python
import jax, jax.numpy as jnp
from jax import lax
import numpy as np

D_MODEL = 1024
BATCH = 16
SEQ = 4096
DEPTH = 2

MIX_W = 1024
CONV_K = 3
CONV_GROUPS = 8
N_HEADS = 16
HEAD_DIM = 64
N_KV = 4
HPG = N_HEADS // N_KV
KV_W = N_KV * HEAD_DIM
L_CMP = 32
STRIDE_CMP = 16
CMP_HIDDEN = 128
L_SEL = 64
N_SEL_BLOCKS = 16
WINDOW = 512
Q_BLOCK = 16
CHUNK = 128
GM_GROUPS = 8
GM_GW = MIX_W // GM_GROUPS
N_BRANCH = 3
EPS = 1e-6
NEG = -1e30

A_OFF = 0
A_COLS = 4 * MIX_W
B_OFF = A_OFF + A_COLS
B_COLS = 2 * MIX_W + 6 * KV_W + 3 * N_HEADS
C_OFF = B_OFF + B_COLS
C_COLS = 3 * MIX_W
G_OFF = C_OFF + C_COLS
G_COLS = N_BRANCH * D_MODEL
IN_COLS = G_OFF + G_COLS

kernel_name = "hybrid_conv_nsa_gmlp_gated_block"


def rmsnorm(x, g):
    x32 = x.astype(jnp.float32)
    y = x32 * lax.rsqrt(jnp.mean(x32 * x32, axis=-1, keepdims=True) + EPS)
    return y.astype(x.dtype) * g


def layernorm(x, g, b):
    x32 = x.astype(jnp.float32)
    mu = jnp.mean(x32, axis=-1, keepdims=True)
    xc = x32 - mu
    y = xc * lax.rsqrt(jnp.mean(xc * xc, axis=-1, keepdims=True) + EPS)
    return y.astype(x.dtype) * g + b


def masked_softmax(s, mask):
    p = jax.nn.softmax(jnp.where(mask, s, NEG), axis=-1)
    return jnp.where(mask, p, 0.0)


def alibi_slopes():
    i = jnp.arange(1, N_HEADS + 1, dtype=jnp.float32)
    return (2.0 ** (-8.0 * i / N_HEADS)).reshape(N_KV, HPG)


def short_conv_mixer(h, w_in_a, conv_w, conv_b):
    S = h.shape[1]
    b, cg, xin, z = jnp.split(h @ w_in_a, 4, axis=-1)
    y = cg * xin
    yp = jnp.pad(y, ((0, 0), (CONV_K - 1, 0), (0, 0)))
    conv = conv_b + sum(conv_w[k] * yp[:, k:k + S] for k in range(CONV_K))
    return b * conv * jax.nn.silu(z)


def nsa_mixer(h, w_in_b, pos_ck, w_ck1, w_ck2, pos_cv, w_cv1, w_cv2):
    Bsz, S, _ = h.shape
    sizes = [MIX_W] + [KV_W] * 6 + [MIX_W]
    q, kc, vc, ks, vs, kw, vw, z, gl = jnp.split(h @ w_in_b, np.cumsum(sizes).tolist(), axis=-1)

    def heads_kv(t):
        return t.reshape(Bsz, S, N_KV, HEAD_DIM).transpose(0, 2, 1, 3)

    n_cmp = (S - L_CMP) // STRIDE_CMP + 1
    cmp_start = jnp.arange(n_cmp) * STRIDE_CMP
    cmp_end = cmp_start + (L_CMP - 1)
    cmp_idx = cmp_start[:, None] + jnp.arange(L_CMP)[None, :]

    def compress(t, pos, w1, w2):
        blocks = heads_kv(t)[:, :, cmp_idx] + pos
        flat = blocks.reshape(Bsz, N_KV, n_cmp, L_CMP * HEAD_DIM)
        return jax.nn.silu(flat @ w1) @ w2

    k_cmp = compress(kc, pos_ck, w_ck1, w_ck2)
    v_cmp = compress(vc, pos_cv, w_cv1, w_cv2)

    n_sel = S // L_SEL
    k_top = min(N_SEL_BLOCKS, n_sel)
    k_blk = heads_kv(ks).reshape(Bsz, N_KV, n_sel, L_SEL, HEAD_DIM)
    v_blk = heads_kv(vs).reshape(Bsz, N_KV, n_sel, L_SEL, HEAD_DIM)
    sel_ids = jnp.arange(n_sel)
    overlap = ((cmp_start[:, None] <= (sel_ids[None, :] + 1) * L_SEL - 1)
               & (cmp_end[:, None] >= sel_ids[None, :] * L_SEL)).astype(jnp.float32)

    pad = ((0, 0), (0, 0), (WINDOW - 1, 0), (0, 0))
    k_win = jnp.pad(heads_kv(kw), pad)
    v_win = jnp.pad(heads_kv(vw), pad)
    span = Q_BLOCK + WINDOW - 1

    nq = S // Q_BLOCK
    qh = q.reshape(Bsz, nq, Q_BLOCK, N_KV, HPG, HEAD_DIM).transpose(1, 0, 3, 4, 2, 5)
    gh = gl.reshape(Bsz, nq, Q_BLOCK, N_KV, HPG, 3).transpose(1, 0, 3, 4, 2, 5)
    slopes = alibi_slopes()
    scale = HEAD_DIM ** -0.5
    bi = jnp.arange(Bsz)[:, None, None, None]
    gi = jnp.arange(N_KV)[None, :, None, None]

    def block_fn(args):
        ci, qb, gb = args
        t0 = ci * Q_BLOCK
        tq = t0 + jnp.arange(Q_BLOCK)
        d_c = tq[:, None] - cmp_end[None, :]
        s = jnp.einsum('bgnqd,bgkd->bgnqk', qb, k_cmp).astype(jnp.float32) * scale \
            - slopes[:, :, None, None] * d_c.astype(jnp.float32)
        p_cmp = masked_softmax(s, d_c >= 0)
        o_cmp = jnp.einsum('bgnqk,bgkd->bgnqd', p_cmp.astype(v_cmp.dtype), v_cmp)
        imp = jnp.einsum('bgnqk,ks->bgqs', p_cmp, overlap)
        cur = tq // L_SEL
        valid = sel_ids[None, :] * L_SEL <= tq[:, None]
        forced = (sel_ids[None, :] == 0) | (sel_ids[None, :] == cur[:, None]) | (sel_ids[None, :] == cur[:, None] - 1)
        score = jnp.where(forced, jnp.inf, jnp.where(valid, imp, -jnp.inf))
        _, sel = lax.top_k(score, k_top)
        kg = k_blk[bi, gi, sel]
        vg = v_blk[bi, gi, sel]
        spos = sel[..., None] * L_SEL + jnp.arange(L_SEL)
        d_s = (tq[None, None, :, None, None] - spos)[:, :, None]
        s = jnp.einsum('bgnqd,bgqkld->bgnqkl', qb, kg).astype(jnp.float32) * scale \
            - slopes[:, :, None, None, None] * d_s.astype(jnp.float32)
        m = jnp.broadcast_to(d_s >= 0, s.shape)
        flat_shape = (Bsz, N_KV, HPG, Q_BLOCK, k_top * L_SEL)
        p = masked_softmax(s.reshape(flat_shape), m.reshape(flat_shape))
        o_slc = jnp.einsum('bgnqm,bgqmd->bgnqd', p.astype(vg.dtype),
                           vg.reshape(Bsz, N_KV, Q_BLOCK, k_top * L_SEL, HEAD_DIM))
        kwb = lax.dynamic_slice_in_dim(k_win, t0, span, axis=2)
        vwb = lax.dynamic_slice_in_dim(v_win, t0, span, axis=2)
        kpos = t0 - (WINDOW - 1) + jnp.arange(span)
        d_w = tq[:, None] - kpos[None, :]
        m_w = (d_w >= 0) & (d_w < WINDOW) & (kpos[None, :] >= 0)
        s = jnp.einsum('bgnqd,bgkd->bgnqk', qb, kwb).astype(jnp.float32) * scale \
            - slopes[:, :, None, None] * d_w.astype(jnp.float32)
        p = masked_softmax(s, m_w)
        o_win = jnp.einsum('bgnqk,bgkd->bgnqd', p.astype(vwb.dtype), vwb)
        g = jax.nn.sigmoid(gb)
        return g[..., 0:1] * o_cmp + g[..., 1:2] * o_slc + g[..., 2:3] * o_win

    o = lax.map(block_fn, (jnp.arange(nq), qh, gh))
    o = o.transpose(1, 0, 4, 2, 3, 5).reshape(Bsz, S, MIX_W)
    return o * jax.nn.silu(z)


def gmlp_mixer(h, w_in_c, ln_g, ln_b, w_s, b_s):
    Bsz, S, _ = h.shape
    u, v, z = jnp.split(h @ w_in_c, 3, axis=-1)
    u = jax.nn.gelu(u)
    v = layernorm(jax.nn.gelu(v), ln_g, ln_b)
    vr = v.reshape(Bsz, S // CHUNK, CHUNK, GM_GROUPS, GM_GW)
    tril = jnp.tril(jnp.ones((CHUNK, CHUNK), dtype=bool))
    wm = jnp.where(tril, w_s, 0.0)
    sp = jnp.einsum('gij,bnjgc->bnigc', wm, vr) + b_s.T[:, :, None]
    return u * sp.reshape(Bsz, S, MIX_W) * jax.nn.silu(z)


def hybrid_layer(x, c, g_pre, g_post, w_ada, b_ada, w_in, conv_w, conv_b, pos_ck, w_ck1, w_ck2,
                 pos_cv, w_cv1, w_cv2, ln_g, ln_b, w_s, b_s, w_br, w_out):
    shift, scl, gate = jnp.split(jax.nn.silu(c) @ w_ada + b_ada, 3, axis=-1)
    h = rmsnorm(x, g_pre) * (1.0 + scl[:, None]) + shift[:, None]
    ys = (
        short_conv_mixer(h, w_in[:, A_OFF:A_OFF + A_COLS], conv_w, conv_b),
        nsa_mixer(h, w_in[:, B_OFF:B_OFF + B_COLS], pos_ck, w_ck1, w_ck2, pos_cv, w_cv1, w_cv2),
        gmlp_mixer(h, w_in[:, C_OFF:C_OFF + C_COLS], ln_g, ln_b, w_s, b_s),
    )
    merged = None
    for i in range(N_BRANCH):
        g_i = jax.nn.sigmoid(h @ w_in[:, G_OFF + i * D_MODEL:G_OFF + (i + 1) * D_MODEL])
        term = g_i * (ys[i] @ w_br[i])
        merged = term if merged is None else merged + term
    out = rmsnorm(merged @ w_out, g_post)
    return x + gate[:, None] * out


def setup_inputs(seed: int = 0) -> dict:
    key = jax.random.key(seed)
    k = jax.random.split(key, 24)
    nrm = jax.random.normal
    f = jnp.float32
    return {
        "x": nrm(k[0], (BATCH, SEQ, D_MODEL), f),
        "c": nrm(k[1], (BATCH, D_MODEL), f),
        "g_pre": 1.0 + 0.02 * nrm(k[2], (DEPTH, D_MODEL), f),
        "g_post": 1.0 + 0.02 * nrm(k[3], (DEPTH, D_MODEL), f),
        "w_ada": 0.5 * D_MODEL ** -0.5 * nrm(k[4], (DEPTH, D_MODEL, 3 * D_MODEL), f),
        "b_ada": 0.02 * nrm(k[5], (DEPTH, 3 * D_MODEL), f),
        "w_in": D_MODEL ** -0.5 * nrm(k[6], (DEPTH, D_MODEL, IN_COLS), f),
        "conv_w": CONV_K ** -0.5 * nrm(k[7], (DEPTH, CONV_K, MIX_W), f),
        "conv_b": 0.02 * nrm(k[8], (DEPTH, MIX_W), f),
        "pos_ck": 0.02 * nrm(k[9], (DEPTH, L_CMP, HEAD_DIM), f),
        "w_ck1": (L_CMP * HEAD_DIM) ** -0.5 * nrm(k[10], (DEPTH, L_CMP * HEAD_DIM, CMP_HIDDEN), f),
        "w_ck2": CMP_HIDDEN ** -0.5 * nrm(k[11], (DEPTH, CMP_HIDDEN, HEAD_DIM), f),
        "pos_cv": 0.02 * nrm(k[12], (DEPTH, L_CMP, HEAD_DIM), f),
        "w_cv1": (L_CMP * HEAD_DIM) ** -0.5 * nrm(k[13], (DEPTH, L_CMP * HEAD_DIM, CMP_HIDDEN), f),
        "w_cv2": CMP_HIDDEN ** -0.5 * nrm(k[14], (DEPTH, CMP_HIDDEN, HEAD_DIM), f),
        "ln_g": 1.0 + 0.02 * nrm(k[15], (DEPTH, MIX_W), f),
        "ln_b": 0.02 * nrm(k[16], (DEPTH, MIX_W), f),
        "w_s": CHUNK ** -0.5 * nrm(k[17], (DEPTH, GM_GROUPS, CHUNK, CHUNK), f),
        "b_s": 1.0 + 0.02 * nrm(k[18], (DEPTH, GM_GROUPS, CHUNK), f),
        "w_br": MIX_W ** -0.5 * nrm(k[19], (DEPTH, N_BRANCH, MIX_W, D_MODEL), f),
        "w_out": D_MODEL ** -0.5 * nrm(k[20], (DEPTH, D_MODEL, D_MODEL), f),
    }


def reference(x, c, g_pre, g_post, w_ada, b_ada, w_in, conv_w, conv_b, pos_ck, w_ck1, w_ck2,
              pos_cv, w_cv1, w_cv2, ln_g, ln_b, w_s, b_s, w_br, w_out):
    for l in range(DEPTH):
        x = hybrid_layer(x, c, g_pre[l], g_post[l], w_ada[l], b_ada[l], w_in[l], conv_w[l], conv_b[l],
                         pos_ck[l], w_ck1[l], w_ck2[l], pos_cv[l], w_cv1[l], w_cv2[l],
                         ln_g[l], ln_b[l], w_s[l], b_s[l], w_br[l], w_out[l])
    return x
```

```cpp
#include <hip/hip_runtime.h>
#include <hip/hip_cooperative_groups.h>
#include <cstdio>
#include <cstdint>
namespace cg = cooperative_groups;

typedef unsigned short bf16_t;
using bf16x8 = __attribute__((ext_vector_type(8))) short;
using f32x4 = __attribute__((ext_vector_type(4))) float;
using f32x2 = __attribute__((ext_vector_type(2))) float;
using u32x4 = __attribute__((ext_vector_type(4))) uint32_t;
using u32x2 = __attribute__((ext_vector_type(2))) uint32_t;

constexpr int D = 1024, SEQ = 4096, BATCH = 16, DEPTH = 2;
constexpr int IN_COLS = 13872;
constexpr int A_OFF = 0, B_OFF = 4096, C_OFF = 7728, G_OFF = 10800;
constexpr int NT_IN = 109, NP = NT_IN * 128;
constexpr int NB = 4, R = NB * SEQ, NGRP = BATCH / NB;
constexpr int LDK = 40;
constexpr int KS_LD = 72;
constexpr int VT_LD = 68;
constexpr int HS_LD = 136;
constexpr int SMEM_BYTES = 65536 + 16;

constexpr size_t al256(size_t x) { return (x + 255) & ~size_t(255); }
constexpr size_t OFF_WINT = 0;
constexpr size_t OFF_WBRT = al256(OFF_WINT + (size_t)DEPTH * NP * D * 2);
constexpr size_t OFF_WOUTT = al256(OFF_WBRT + (size_t)DEPTH * 3 * D * D * 2);
constexpr size_t OFF_WC1T = al256(OFF_WOUTT + (size_t)DEPTH * D * D * 2);
constexpr size_t OFF_WM = al256(OFF_WC1T + (size_t)DEPTH * 2 * 128 * 2048 * 2);
constexpr size_t OFF_BIAS1 = al256(OFF_WM + (size_t)DEPTH * 8 * 128 * 128 * 2);
constexpr size_t OFF_MOD = al256(OFF_BIAS1 + (size_t)DEPTH * 2 * 8 * 128 * 4);
constexpr size_t OFF_H = al256(OFF_MOD + (size_t)DEPTH * 16 * 3072 * 4);
constexpr size_t SZ_ACT = (size_t)R * 1024 * 2;
constexpr size_t OFF_YAPRE = al256(OFF_H + SZ_ACT);
constexpr size_t OFF_BZA = al256(OFF_YAPRE + SZ_ACT);
constexpr size_t OFF_Q = al256(OFF_BZA + SZ_ACT);
constexpr size_t OFF_ZB = al256(OFF_Q + SZ_ACT);
constexpr size_t OFF_UZ = al256(OFF_ZB + SZ_ACT);
constexpr size_t OFF_GV = al256(OFF_UZ + SZ_ACT);
constexpr size_t OFF_KV = al256(OFF_GV + SZ_ACT);
constexpr size_t OFF_GL = al256(OFF_KV + (size_t)R * 1536 * 2);
constexpr size_t OFF_GATES = al256(OFF_GL + (size_t)R * 48 * 4);
constexpr size_t OFF_YA = al256(OFF_GATES + (size_t)R * 3072 * 2);
constexpr size_t OFF_YB = al256(OFF_YA + SZ_ACT);
constexpr size_t OFF_YC = al256(OFF_YB + SZ_ACT);
constexpr size_t OFF_KCMP = al256(OFF_YC + SZ_ACT);
constexpr size_t OFF_VCMP = al256(OFF_KCMP + (size_t)NB * 4 * 256 * 64 * 2);
constexpr size_t OFF_STATS = al256(OFF_VCMP + (size_t)NB * 4 * 256 * 64 * 2);
constexpr size_t OFF_BAR = al256(OFF_STATS + (size_t)R * 2 * 4);
constexpr size_t WS_END = al256(OFF_BAR + 3456 * 4);

struct Params {
  const float *x, *c, *g_pre, *g_post, *w_ada, *b_ada, *w_in, *conv_w, *conv_b, *pos_ck, *w_ck1, *w_ck2,
      *pos_cv, *w_cv1, *w_cv2, *ln_g, *ln_b, *w_s, *b_s, *w_br, *w_out;
  float* out;
  unsigned char* ws;
};

typedef __bf16 bf16x2_native __attribute__((ext_vector_type(2)));
__device__ __forceinline__ uint32_t pack2(float a, float b) {
  f32x2 v = {a, b};
  return __builtin_bit_cast(uint32_t, __builtin_convertvector(v, bf16x2_native));
}
__device__ __forceinline__ bf16_t f2bf(float f) { return (bf16_t)(pack2(f, f) & 0xffffu); }
__device__ __forceinline__ float bf2f(uint32_t h) { return __uint_as_float(h << 16); }
__device__ __forceinline__ float sigmoid_(float x) { return __builtin_amdgcn_rcpf(1.f + __expf(-x)); }
__device__ __forceinline__ float silu_(float x) { return x * __builtin_amdgcn_rcpf(1.f + __expf(-x)); }
__device__ __forceinline__ float gelu_(float x) {
  float y = 0.7978845608f * (x + 0.044715f * x * x * x);
  return x * __builtin_amdgcn_rcpf(1.f + __expf(-2.f * y));
}
__device__ __forceinline__ f32x4 mfma16(bf16x8 a, bf16x8 b, f32x4 c) {
  return __builtin_amdgcn_mfma_f32_16x16x32_bf16(a, b, c, 0, 0, 0);
}
__device__ __forceinline__ float bperm(float v, int srclane) {
  return __int_as_float(__builtin_amdgcn_ds_bpermute(srclane << 2, __float_as_int(v)));
}
__device__ __forceinline__ float wave_sum(float v, int lane) {
#pragma unroll
  for (int o = 32; o >= 1; o >>= 1) v += bperm(v, lane ^ o);
  return v;
}

__device__ __forceinline__ int opaque_tid() {
  int t = threadIdx.x;
  asm volatile("" : "+v"(t));
  return t;
}

__device__ __forceinline__ int win_colmap(int np) {
  int tile = np >> 7, r = np & 127;
  if (tile < 32) { int wc = r >> 6, t = (r >> 4) & 3, i = r & 15; return A_OFF + t * 1024 + tile * 32 + wc * 16 + i; }
  if (tile < 40) return B_OFF + (np - 32 * 128);
  if (tile < 52) return B_OFF + 1024 + (np - 40 * 128);
  if (tile < 60) return B_OFF + 2560 + (np - 52 * 128);
  if (tile == 60) return r < 48 ? B_OFF + 3584 + r : -1;
  if (tile < 77) { int tb = tile - 61, wc = r >> 6, t = (r >> 4) & 3, i = r & 15; return C_OFF + ((t & 1) ? 2048 : 0) + tb * 64 + wc * 32 + (t >> 1) * 16 + i; }
  if (tile < 85) return C_OFF + 1024 + (np - 77 * 128);
  return G_OFF + (np - 85 * 128);
}

template <bool WIN>
__device__ __forceinline__ void transpose_tile(const float* __restrict__ src, int ld_src, bf16_t* __restrict__ dst, int Kdim, int n0, int k0, float* sm, int tid) {
  const int tx = tid & 63, ty = tid >> 6;
  const int col = WIN ? win_colmap(n0 + tx) : (n0 + tx);
  __syncthreads();
#pragma unroll
  for (int i = 0; i < 16; ++i) {
    int k = ty * 16 + i;
    float v = (col >= 0) ? src[(size_t)(k0 + k) * ld_src + col] : 0.f;
    sm[k * 65 + tx] = v;
  }
  __syncthreads();
#pragma unroll
  for (int i = 0; i < 16; ++i) {
    int n = ty * 16 + i;
    dst[(size_t)(n0 + n) * Kdim + k0 + tx] = f2bf(sm[tx * 65 + n]);
  }
}

__device__ __forceinline__ void phase0(const Params& p, char* smraw) {
  float* smf = (float*)smraw;
  const int bid = blockIdx.x, nblk = gridDim.x, tid = opaque_tid();
  bf16_t* WinT = (bf16_t*)(p.ws + OFF_WINT);
  bf16_t* WbrT = (bf16_t*)(p.ws + OFF_WBRT);
  bf16_t* WoutT = (bf16_t*)(p.ws + OFF_WOUTT);
  bf16_t* Wc1T = (bf16_t*)(p.ws + OFF_WC1T);
  bf16_t* Wm = (bf16_t*)(p.ws + OFF_WM);
  float* bias1 = (float*)(p.ws + OFF_BIAS1);
  float* mod = (float*)(p.ws + OFF_MOD);
  for (int t = bid; t < DEPTH * 218 * 16; t += nblk) {
    int l = t / (218 * 16), r = t % (218 * 16), nt = r >> 4, kt = r & 15;
    transpose_tile<true>(p.w_in + (size_t)l * D * IN_COLS, IN_COLS, WinT + (size_t)l * NP * D, D, nt * 64, kt * 64, smf, tid);
  }
  for (int t = bid; t < DEPTH * 3 * 256; t += nblk) {
    int li = t >> 8, r = t & 255, nt = r >> 4, kt = r & 15;
    transpose_tile<false>(p.w_br + (size_t)li * D * D, D, WbrT + (size_t)li * D * D, D, nt * 64, kt * 64, smf, tid);
  }
  for (int t = bid; t < DEPTH * 256; t += nblk) {
    int l = t >> 8, r = t & 255, nt = r >> 4, kt = r & 15;
    transpose_tile<false>(p.w_out + (size_t)l * D * D, D, WoutT + (size_t)l * D * D, D, nt * 64, kt * 64, smf, tid);
  }
  for (int t = bid; t < DEPTH * 2 * 64; t += nblk) {
    int lk = t >> 6, r = t & 63, nt = r >> 5, kt = r & 31;
    int l = lk >> 1, kv = lk & 1;
    const float* src = (kv ? p.w_cv1 : p.w_ck1) + (size_t)l * 2048 * 128;
    transpose_tile<false>(src, 128, Wc1T + (size_t)lk * 128 * 2048, 2048, nt * 64, kt * 64, smf, tid);
  }
  for (int e = bid * 256 + tid; e < DEPTH * 8 * 128 * 128; e += nblk * 256) {
    int j = e & 127, i = (e >> 7) & 127;
    Wm[e] = (j <= i) ? f2bf(p.w_s[e]) : (bf16_t)0;
  }
  for (int t = bid - 128; t >= 0 && t < DEPTH * 2 * 8; t += nblk) {
    int lk = t >> 3, ks = t & 7, l = lk >> 1, kv = lk & 1;
    const float* pos = (kv ? p.pos_cv : p.pos_ck) + (size_t)l * 2048;
    const float* w1 = (kv ? p.w_cv1 : p.w_ck1) + (size_t)l * 2048 * 128;
    int n = tid & 127, half = tid >> 7;
    float acc = 0.f;
    const int kb = ks * 256 + half * 128;
#pragma unroll 16
    for (int k = kb; k < kb + 128; ++k) acc += pos[k] * w1[(size_t)k * 128 + n];
    __syncthreads();
    smf[tid] = acc;
    __syncthreads();
    if (tid < 128) bias1[t * 128 + tid] = smf[tid] + smf[tid + 128];
  }
  for (int t = nblk - 1 - bid; t < DEPTH * 48; t += nblk) {
    int l = t / 48, ch = t % 48;
    int tx = tid & 63, ty = tid >> 6;
    int col = ch * 64 + tx;
    __syncthreads();
    for (int i = 0; i < 64; ++i) {
      int e = tid + 256 * i;
      smf[(e & 1023) * 16 + (e >> 10)] = silu_(p.c[e]);
    }
    __syncthreads();
    float acc[16];
#pragma unroll
    for (int b = 0; b < 16; ++b) acc[b] = 0.f;
    const float* w = p.w_ada + (size_t)l * D * 3072 + col;
#pragma unroll 8
    for (int k = ty * 256; k < ty * 256 + 256; ++k) {
      float wv = w[(size_t)k * 3072];
      const f32x4 s0 = *(const f32x4*)(smf + k * 16), s1 = *(const f32x4*)(smf + k * 16 + 4), s2 = *(const f32x4*)(smf + k * 16 + 8), s3 = *(const f32x4*)(smf + k * 16 + 12);
#pragma unroll
      for (int b = 0; b < 4; ++b) { acc[b] += s0[b] * wv; acc[4 + b] += s1[b] * wv; acc[8 + b] += s2[b] * wv; acc[12 + b] += s3[b] * wv; }
    }
    __syncthreads();
#pragma unroll
    for (int b = 0; b < 16; ++b) smf[(ty * 16 + b) * 64 + tx] = acc[b];
    __syncthreads();
    if (ty == 0) {
#pragma unroll
      for (int b = 0; b < 16; ++b) {
        float s_ = smf[b * 64 + tx] + smf[(16 + b) * 64 + tx] + smf[(32 + b) * 64 + tx] + smf[(48 + b) * 64 + tx];
        mod[((size_t)l * 16 + b) * 3072 + col] = s_ + p.b_ada[l * 3072 + col];
      }
    }
  }
}

__device__ __forceinline__ void write_h_row(const f32x4 (&xv)[4], float ss, const float* g_pre, const float* modl_b, bf16_t* hrow, int lane) {
  float rs = rsqrtf(ss * (1.f / 1024.f) + 1e-6f);
#pragma unroll
  for (int i = 0; i < 4; ++i) {
    int c = i * 256 + lane * 4;
    f32x4 g = *(const f32x4*)(g_pre + c);
    f32x4 sh = *(const f32x4*)(modl_b + c);
    f32x4 sc = *(const f32x4*)(modl_b + 1024 + c);
    float h0 = xv[i].x * rs * g.x * (1.f + sc.x) + sh.x;
    float h1 = xv[i].y * rs * g.y * (1.f + sc.y) + sh.y;
    float h2 = xv[i].z * rs * g.z * (1.f + sc.z) + sh.z;
    float h3 = xv[i].w * rs * g.w * (1.f + sc.w) + sh.w;
    u32x2 o; o.x = pack2(h0, h1); o.y = pack2(h2, h3);
    *(u32x2*)(hrow + c) = o;
  }
}

__device__ __forceinline__ void phase_h0(const Params& p, int grp_i) {
  const int tid = opaque_tid(); const int lane = tid & 63, w = tid >> 6;
  bf16_t* H = (bf16_t*)(p.ws + OFF_H);
  const float* mod = (const float*)(p.ws + OFF_MOD);
  for (int r = blockIdx.x * 4 + w; r < R; r += gridDim.x * 4) {
    size_t grow = (size_t)grp_i * R + r;
    int b = (int)(grow >> 12);
    const float* xr = p.x + grow * D;
    f32x4 xv[4]; float ss = 0.f;
#pragma unroll
    for (int i = 0; i < 4; ++i) {
      xv[i] = *(const f32x4*)(xr + i * 256 + lane * 4);
      ss += xv[i].x * xv[i].x + xv[i].y * xv[i].y + xv[i].z * xv[i].z + xv[i].w * xv[i].w;
    }
    ss = wave_sum(ss, lane);
    write_h_row(xv, ss, p.g_pre, mod + (size_t)b * 3072, H + (size_t)r * D, lane);
  }
}

__device__ __forceinline__ void phase_final(const Params& p, int grp_i, int l) {
  const int tid = opaque_tid(); const int lane = tid & 63, w = tid >> 6;
  bf16_t* H = (bf16_t*)(p.ws + OFF_H);
  const bf16_t* OP = (const bf16_t*)(p.ws + OFF_YAPRE);
  const float* mod = (const float*)(p.ws + OFF_MOD);
  const float* xin = (l == 0) ? p.x : p.out;
  for (int r = blockIdx.x * 4 + w; r < R; r += gridDim.x * 4) {
    size_t grow = (size_t)grp_i * R + r;
    int b = (int)(grow >> 12);
    const float* xr = xin + grow * D;
    const bf16_t* orow = OP + (size_t)r * D;
    const float* gate = mod + ((size_t)l * 16 + b) * 3072 + 2048;
    const float* gp = p.g_post + l * D;
    f32x4 xv[4], ov[4]; float ss = 0.f;
#pragma unroll
    for (int i = 0; i < 4; ++i) {
      int c = i * 256 + lane * 4;
      xv[i] = *(const f32x4*)(xr + c);
      u32x2 u = *(const u32x2*)(orow + c);
      ov[i].x = bf2f(u.x & 0xffffu); ov[i].y = bf2f(u.x >> 16); ov[i].z = bf2f(u.y & 0xffffu); ov[i].w = bf2f(u.y >> 16);
      ss += ov[i].x * ov[i].x + ov[i].y * ov[i].y + ov[i].z * ov[i].z + ov[i].w * ov[i].w;
    }
    ss = wave_sum(ss, lane);
    float rs = rsqrtf(ss * (1.f / 1024.f) + 1e-6f);
    float ss2 = 0.f;
#pragma unroll
    for (int i = 0; i < 4; ++i) {
      int c = i * 256 + lane * 4;
      f32x4 g = *(const f32x4*)(gp + c);
      f32x4 ga = *(const f32x4*)(gate + c);
      xv[i].x += ga.x * (ov[i].x * rs * g.x);
      xv[i].y += ga.y * (ov[i].y * rs * g.y);
      xv[i].z += ga.z * (ov[i].z * rs * g.z);
      xv[i].w += ga.w * (ov[i].w * rs * g.w);
      *(f32x4*)(p.out + grow * D + c) = xv[i];
      ss2 += xv[i].x * xv[i].x + xv[i].y * xv[i].y + xv[i].z * xv[i].z + xv[i].w * xv[i].w;
    }
    if (l == 0) {
      ss2 = wave_sum(ss2, lane);
      write_h_row(xv, ss2, p.g_pre + D, mod + ((size_t)16 + b) * 3072, H + (size_t)r * D, lane);
    }
  }
}

struct StdLoader {
  const bf16_t* base;
  int soff;
  u32x4 r0, r1;
  __device__ __forceinline__ void init(const bf16_t* tile_base, size_t ld, int tid) {
    base = tile_base + (size_t)(tid >> 1) * ld + (tid & 1) * 16;
    soff = (tid >> 1) * LDK + (tid & 1) * 16;
  }
  __device__ __forceinline__ void load(int kt) {
    const bf16_t* q = base + kt * 32;
    r0 = *(const u32x4*)q; r1 = *(const u32x4*)(q + 8);
  }
  __device__ __forceinline__ void store(bf16_t* tile) {
    bf16_t* q = tile + soff;
    *(u32x4*)q = r0; *(u32x4*)(q + 8) = r1;
  }
};

template <class AL, class BL>
__device__ __forceinline__ void gemm_core(f32x4 (&acc)[4][4], AL& al, BL& bl, int nk, bf16_t* sm, int tid) {
  const int lane = tid & 63, w = tid >> 6, wr = w >> 1, wc = w & 1, l15 = lane & 15, grp = lane >> 4;
  al.load(0); bl.load(0);
  __syncthreads();
  al.store(sm); bl.store(sm + 2 * 128 * LDK);
  __syncthreads();
  for (int kt = 0; kt < nk; ++kt) {
    const bf16_t* Ab = sm + (kt & 1) * 128 * LDK;
    const bf16_t* Bb = sm + (2 + (kt & 1)) * 128 * LDK;
    if (kt + 1 < nk) { al.load(kt + 1); bl.load(kt + 1); }
    bf16x8 a[4], b[4];
#pragma unroll
    for (int m = 0; m < 4; ++m) a[m] = *(const bf16x8*)(Ab + (wr * 64 + m * 16 + l15) * LDK + grp * 8);
#pragma unroll
    for (int n = 0; n < 4; ++n) b[n] = *(const bf16x8*)(Bb + (wc * 64 + n * 16 + l15) * LDK + grp * 8);
#pragma unroll
    for (int m = 0; m < 4; ++m)
#pragma unroll
      for (int n = 0; n < 4; ++n) acc[m][n] = mfma16(a[m], b[n], acc[m][n]);
    if (kt + 1 < nk) {
      al.store(sm + ((kt + 1) & 1) * 128 * LDK);
      bl.store(sm + (2 + ((kt + 1) & 1)) * 128 * LDK);
    }
    __syncthreads();
  }
}

struct Regs4 { u32x4 r0, r1, r2, r3; };
struct StdLoader64 {
  typedef Regs4 Regs;
  const bf16_t* base;
  size_t ld32;
  int soff;
  __device__ __forceinline__ void init(const bf16_t* tile_base, size_t ld, int tid) {
    base = tile_base + (size_t)(tid >> 3) * ld + (tid & 7) * 8;
    ld32 = ld * 32;
    soff = (tid >> 3) * 64 + (((tid & 7) ^ ((tid >> 4) & 7)) * 8);
  }
  __device__ __forceinline__ void load(int kt, Regs& r) const {
    const bf16_t* q = base + kt * 64;
    r.r0 = *(const u32x4*)q; r.r1 = *(const u32x4*)(q + ld32); r.r2 = *(const u32x4*)(q + 2 * ld32); r.r3 = *(const u32x4*)(q + 3 * ld32);
  }
  __device__ __forceinline__ void store(bf16_t* tile, const Regs& r) const {
    bf16_t* q = tile + soff;
    *(u32x4*)q = r.r0; *(u32x4*)(q + 2048) = r.r1; *(u32x4*)(q + 4096) = r.r2; *(u32x4*)(q + 6144) = r.r3;
  }
};

template <int NST, class AL, class BL>
__device__ __forceinline__ void gemm_core64(f32x4 (&acc)[4][4], const AL& al, const BL& bl, int nk, bf16_t* sm, int tid) {
  const int lane = tid & 63, w = tid >> 6, wr = w >> 1, wc = w & 1, l15 = lane & 15, grp = lane >> 4;
  constexpr int TILE = 128 * 64;
  const int sw = (l15 >> 1) & 7;
  const int fo0 = l15 * 64 + ((grp ^ sw) * 8), fo1 = l15 * 64 + (((4 + grp) ^ sw) * 8);
  typename AL::Regs ra[NST];
  typename BL::Regs rb[NST];
#pragma unroll
  for (int s_ = 0; s_ < NST; ++s_) { al.load(s_, ra[s_]); bl.load(s_, rb[s_]); }
  __syncthreads();
  al.store(sm, ra[0]); bl.store(sm + 2 * TILE, rb[0]);
  { const int k2 = NST < nk ? NST : nk - 1; al.load(k2, ra[0]); bl.load(k2, rb[0]); }
  __syncthreads();
  for (int kt0 = 0; kt0 < nk; kt0 += NST) {
#pragma unroll
    for (int u = 0; u < NST; ++u) {
      const int kt = kt0 + u;
      const bf16_t* Ab = sm + (kt & 1) * TILE + wr * 64 * 64;
      const bf16_t* Bb = sm + (2 + (kt & 1)) * TILE + wc * 64 * 64;
#pragma unroll
      for (int ks = 0; ks < 2; ++ks) {
        const int fo = ks ? fo1 : fo0;
        bf16x8 a[4], b[4];
#pragma unroll
        for (int m = 0; m < 4; ++m) a[m] = *(const bf16x8*)(Ab + m * 16 * 64 + fo);
#pragma unroll
        for (int n = 0; n < 4; ++n) b[n] = *(const bf16x8*)(Bb + n * 16 * 64 + fo);
#pragma unroll
        for (int m = 0; m < 4; ++m)
#pragma unroll
          for (int n = 0; n < 4; ++n) acc[m][n] = mfma16(b[n], a[m], acc[m][n]);
      }
      al.store(sm + ((kt + 1) & 1) * TILE, ra[(u + 1) % NST]);
      bl.store(sm + (2 + ((kt + 1) & 1)) * TILE, rb[(u + 1) % NST]);
      {
        int k2 = kt + 1 + NST;
        k2 = k2 < nk ? k2 : nk - 1;
        al.load(k2, ra[(u + 1) % NST]); bl.load(k2, rb[(u + 1) % NST]);
      }
      __syncthreads();
    }
  }
}

__device__ __forceinline__ void glds_prefetch0(const bf16_t* Atile, size_t lda, const bf16_t* Btile, size_t ldb, bf16_t* sm, int tid) {
  constexpr int TILE = 128 * 64;
  const int gch = ((tid & 7) ^ ((tid >> 4) & 7)) * 8;
  const bf16_t* ga = Atile + (size_t)(tid >> 3) * lda + gch;
  const bf16_t* gb = Btile + (size_t)(tid >> 3) * ldb + gch;
  const size_t a32 = lda * 32, b32 = ldb * 32;
  bf16_t* lbase = sm + tid * 8;
#pragma unroll
  for (int i_ = 0; i_ < 4; ++i_) {
    __builtin_amdgcn_global_load_lds((const unsigned*)(ga + i_ * a32), (unsigned*)(lbase + i_ * 2048), 16, 0, 0);
    __builtin_amdgcn_global_load_lds((const unsigned*)(gb + i_ * b32), (unsigned*)(lbase + 2 * TILE + i_ * 2048), 16, 0, 0);
  }
}

#define DSR1(dst, base, OFF) asm volatile("ds_read_b128 %0, %1 offset:" #OFF : "=v"(dst) : "v"(base) : "memory")
#define DSR4(arr, base) do { DSR1(arr[0], base, 0); DSR1(arr[1], base, 2048); DSR1(arr[2], base, 4096); DSR1(arr[3], base, 6144); } while (0)
template <bool HOIST>
__device__ __forceinline__ void gemm_core_glds(f32x4 (&acc)[4][4], const bf16_t* Atile, size_t lda, const bf16_t* Btile, size_t ldb,
                                               int nk, bf16_t* sm, int tid) {
  const int lane = tid & 63, w = tid >> 6, wr = w >> 1, wc = w & 1, l15 = lane & 15, grp = lane >> 4;
  constexpr int TILE = 128 * 64;
  const int sw = (l15 >> 1) & 7;
  const int fo0 = l15 * 64 + ((grp ^ sw) * 8), fo1 = l15 * 64 + (((4 + grp) ^ sw) * 8);
  const int gch = ((tid & 7) ^ ((tid >> 4) & 7)) * 8;
  const bf16_t* ga = Atile + (size_t)(tid >> 3) * lda + gch;
  const bf16_t* gb = Btile + (size_t)(tid >> 3) * ldb + gch;
  const size_t a32 = lda * 32, b32 = ldb * 32;
  bf16_t* lbase = sm + tid * 8;
#define GLDS_ISSUE(KT, BUF)                                                                                                            \
  do {                                                                                                                                 \
    _Pragma("unroll") for (int i_ = 0; i_ < 4; ++i_) {                                                                                 \
      __builtin_amdgcn_global_load_lds((const unsigned*)(ga + i_ * a32 + (KT) * 64), (unsigned*)(lbase + (BUF) * TILE + i_ * 2048), 16, 0, 0);       \
      __builtin_amdgcn_global_load_lds((const unsigned*)(gb + i_ * b32 + (KT) * 64), (unsigned*)(lbase + (2 + (BUF)) * TILE + i_ * 2048), 16, 0, 0); \
    }                                                                                                                                  \
  } while (0)
#define GLDS_COMPUTE(BUF)                                                                             \
  do {                                                                                                \
    const bf16_t* Ab = sm + (BUF) * TILE + wr * 64 * 64;                                              \
    const bf16_t* Bb = sm + (2 + (BUF)) * TILE + wc * 64 * 64;                                        \
    if (HOIST) {                                                                                      \
        \
      bf16x8 a0[4], b0[4], a1[4], b1[4];                                                              \
      const unsigned pa0 = (unsigned)(size_t)(Ab + fo0), pb0 = (unsigned)(size_t)(Bb + fo0);          \
      const unsigned pa1 = (unsigned)(size_t)(Ab + fo1), pb1 = (unsigned)(size_t)(Bb + fo1);          \
      DSR4(a0, pa0); DSR4(b0, pb0); DSR4(a1, pa1); DSR4(b1, pb1);                                     \
      asm volatile("s_waitcnt lgkmcnt(8)" : "+v"(a0[0]), "+v"(a0[1]), "+v"(a0[2]), "+v"(a0[3]), "+v"(b0[0]), "+v"(b0[1]), "+v"(b0[2]), "+v"(b0[3]) :: "memory"); \
      _Pragma("unroll") for (int m = 0; m < 4; ++m)                                                   \
        _Pragma("unroll") for (int n = 0; n < 4; ++n) acc[m][n] = mfma16(b0[n], a0[m], acc[m][n]);    \
      __builtin_amdgcn_sched_barrier(0);             \
      asm volatile("s_waitcnt lgkmcnt(0)" : "+v"(a1[0]), "+v"(a1[1]), "+v"(a1[2]), "+v"(a1[3]), "+v"(b1[0]), "+v"(b1[1]), "+v"(b1[2]), "+v"(b1[3]) :: "memory"); \
      _Pragma("unroll") for (int m = 0; m < 4; ++m)                                                   \
        _Pragma("unroll") for (int n = 0; n < 4; ++n) acc[m][n] = mfma16(b1[n], a1[m], acc[m][n]);    \
      __builtin_amdgcn_sched_barrier(0);             \
    } else {                                                                                          \
      _Pragma("unroll") for (int ks = 0; ks < 2; ++ks) {                                              \
        const int fo = ks ? fo1 : fo0;                                                                \
        bf16x8 a[4], b[4];                                                                            \
        _Pragma("unroll") for (int m = 0; m < 4; ++m) a[m] = *(const bf16x8*)(Ab + m * 16 * 64 + fo); \
        _Pragma("unroll") for (int n = 0; n < 4; ++n) b[n] = *(const bf16x8*)(Bb + n * 16 * 64 + fo); \
        _Pragma("unroll") for (int m = 0; m < 4; ++m)                                                 \
          _Pragma("unroll") for (int n = 0; n < 4; ++n) acc[m][n] = mfma16(b[n], a[m], acc[m][n]);     \
      }                                                                                               \
    }                                                                                                 \
  } while (0)
  asm volatile("s_waitcnt vmcnt(0)" ::: "memory");
  __syncthreads();
  for (int kt = 0; kt < nk; kt += 2) {
    GLDS_ISSUE(kt + 1, 1);
    GLDS_COMPUTE(0);
    asm volatile("s_waitcnt vmcnt(0)" ::: "memory");
    __syncthreads();
    if (kt + 2 < nk) GLDS_ISSUE(kt + 2, 0);
    GLDS_COMPUTE(1);
    asm volatile("s_waitcnt vmcnt(0)" ::: "memory");
    __syncthreads();
  }
#undef GLDS_ISSUE
#undef GLDS_COMPUTE
}

__device__ __forceinline__ void gemm_core_glds_cmp(f32x4 (&acc)[4][4], const bf16_t* colptr, int r0, const bf16_t* Btile, size_t ldb,
                                                   int nk, bf16_t* sm, int tid) {
  const int lane = tid & 63, w = tid >> 6, wr = w >> 1, wc = w & 1, l15 = lane & 15, grp = lane >> 4;
  constexpr int TILE = 128 * 64;
  const int sw = (l15 >> 1) & 7;
  const int fo0 = l15 * 64 + ((grp ^ sw) * 8), fo1 = l15 * 64 + (((4 + grp) ^ sw) * 8);
  const int gch = ((tid & 7) ^ ((tid >> 4) & 7)) * 8;
  const bf16_t* gb = Btile + (size_t)(tid >> 3) * ldb + gch;
  const size_t b32 = ldb * 32;
  bf16_t* lbase = sm + tid * 8;
#define CMP_ISSUE(KT, BUF)                                                                                                             \
  do {                                                                                                                                 \
    _Pragma("unroll") for (int i_ = 0; i_ < 4; ++i_) {                                                                                 \
      int tok_ = 16 * (r0 + 32 * i_) + (KT);                                                                                           \
      tok_ = tok_ > (SEQ - 1) ? (SEQ - 1) : tok_;                                                                                      \
      __builtin_amdgcn_global_load_lds((const unsigned*)(colptr + (size_t)tok_ * 1536), (unsigned*)(lbase + (BUF) * TILE + i_ * 2048), 16, 0, 0);     \
      __builtin_amdgcn_global_load_lds((const unsigned*)(gb + i_ * b32 + (KT) * 64), (unsigned*)(lbase + (2 + (BUF)) * TILE + i_ * 2048), 16, 0, 0); \
    }                                                                                                                                  \
  } while (0)
#define CMP_COMPUTE(BUF)                                                                              \
  do {                                                                                                \
    const bf16_t* Ab = sm + (BUF) * TILE + wr * 64 * 64;                                              \
    const bf16_t* Bb = sm + (2 + (BUF)) * TILE + wc * 64 * 64;                                        \
    _Pragma("unroll") for (int ks = 0; ks < 2; ++ks) {                                                \
      const int fo = ks ? fo1 : fo0;                                                                  \
      bf16x8 a[4], b[4];                                                                              \
      _Pragma("unroll") for (int m = 0; m < 4; ++m) a[m] = *(const bf16x8*)(Ab + m * 16 * 64 + fo);   \
      _Pragma("unroll") for (int n = 0; n < 4; ++n) b[n] = *(const bf16x8*)(Bb + n * 16 * 64 + fo);   \
      _Pragma("unroll") for (int m = 0; m < 4; ++m)                                                   \
        _Pragma("unroll") for (int n = 0; n < 4; ++n) acc[m][n] = mfma16(b[n], a[m], acc[m][n]);     \
    }                                                                                                 \
  } while (0)
  __syncthreads();
  CMP_ISSUE(0, 0);
  asm volatile("s_waitcnt vmcnt(0)" ::: "memory");
  __syncthreads();
  for (int kt = 0; kt < nk; kt += 2) {
    CMP_ISSUE(kt + 1, 1);
    CMP_COMPUTE(0);
    asm volatile("s_waitcnt vmcnt(0)" ::: "memory");
    __syncthreads();
    if (kt + 2 < nk) CMP_ISSUE(kt + 2, 0);
    CMP_COMPUTE(1);
    asm volatile("s_waitcnt vmcnt(0)" ::: "memory");
    __syncthreads();
  }
#undef CMP_ISSUE
#undef CMP_COMPUTE
}

__device__ __forceinline__ void zero_acc(f32x4 (&acc)[4][4]) {
#pragma unroll
  for (int m = 0; m < 4; ++m)
#pragma unroll
    for (int n = 0; n < 4; ++n) acc[m][n] = f32x4{0.f, 0.f, 0.f, 0.f};
}

__device__ __forceinline__ void phase_inproj(const Params& p, int l, char* smraw) {
  bf16_t* sm = (bf16_t*)smraw;
  const bf16_t* H = (const bf16_t*)(p.ws + OFF_H);
  const bf16_t* W = (const bf16_t*)(p.ws + OFF_WINT) + (size_t)l * NP * D;
  bf16_t* yApre = (bf16_t*)(p.ws + OFF_YAPRE);
  bf16_t* bzA = (bf16_t*)(p.ws + OFF_BZA);
  bf16_t* qb = (bf16_t*)(p.ws + OFF_Q);
  bf16_t* zb = (bf16_t*)(p.ws + OFF_ZB);
  bf16_t* uz = (bf16_t*)(p.ws + OFF_UZ);
  bf16_t* gv = (bf16_t*)(p.ws + OFF_GV);
  bf16_t* kvb = (bf16_t*)(p.ws + OFF_KV);
  float* glb = (float*)(p.ws + OFF_GL);
  bf16_t* gates = (bf16_t*)(p.ws + OFF_GATES);
  const int tid = opaque_tid(); const int lane = tid & 63, w = tid >> 6, wr = w >> 1, wc = w & 1, l15 = lane & 15, grp = lane >> 4;
  constexpr int MT = R / 128;
  constexpr int NC = (NT_IN + 7) / 8;
  const int nx = gridDim.x >> 3;
  constexpr int CJ_END = (MT / 8) * NC * 64;
  auto cj_valid = [&](int c) { return c < CJ_END && ((c >> 6) % NC) * 8 + ((c & 63) >> 3) < NT_IN; };
  auto cj_next = [&](int c) {
    do { c = ((c & 63) + nx < 64) ? (c + nx) : (((c >> 6) + 8) * 64 + (int)(blockIdx.x >> 3)); } while (c < CJ_END && !cj_valid(c));
    return c;
  };
  int cj = (blockIdx.x & 7) * 64 + (blockIdx.x >> 3);
  if (!cj_valid(cj)) cj = cj_next(cj);
  __syncthreads();
  if (cj < CJ_END) {
    const int cell = cj >> 6, jj = cj & 63;
    glds_prefetch0(H + (size_t)((cell / NC) * 8 + (jj & 7)) * 128 * D, D, W + (size_t)((cell % NC) * 8 + (jj >> 3)) * 128 * D, D, sm, tid);
  }
  while (cj < CJ_END) {
    const int cell = cj >> 6, jj = cj & 63;
    const int nt = (cell % NC) * 8 + (jj >> 3), mt = (cell / NC) * 8 + (jj & 7);
    f32x4 acc[4][4];
    zero_acc(acc);
    gemm_core_glds<true>(acc, H + (size_t)mt * 128 * D, D, W + (size_t)nt * 128 * D, D, D / 64, sm, tid);
    cj = cj_next(cj);
    if (cj < CJ_END) {
      const int cell2 = cj >> 6, jj2 = cj & 63;
      glds_prefetch0(H + (size_t)((cell2 / NC) * 8 + (jj2 & 7)) * 128 * D, D, W + (size_t)((cell2 % NC) * 8 + (jj2 >> 3)) * 128 * D, D, sm, tid);
    }
    const int rbase = mt * 128 + wr * 64 + l15;
    const int c4 = 4 * grp;
#define ST4(PTR, V0, V1, V2, V3) *(u32x2*)(PTR) = u32x2{pack2((V0), (V1)), pack2((V2), (V3))}
    if (nt < 32) {
      const int ch = nt * 32 + wc * 16 + c4;
#pragma unroll
      for (int m = 0; m < 4; ++m) {
        const size_t row = rbase + m * 16;
        ST4(yApre + row * 1024 + ch, acc[m][1][0] * acc[m][2][0], acc[m][1][1] * acc[m][2][1], acc[m][1][2] * acc[m][2][2], acc[m][1][3] * acc[m][2][3]);
        ST4(bzA + row * 1024 + ch, acc[m][0][0] * silu_(acc[m][3][0]), acc[m][0][1] * silu_(acc[m][3][1]), acc[m][0][2] * silu_(acc[m][3][2]), acc[m][0][3] * silu_(acc[m][3][3]));
      }
    } else if (nt < 40) {
      const int cb = (nt - 32) * 128 + wc * 64 + c4;
      const float qs = 0.125f * 1.44269504f;
#pragma unroll
      for (int m = 0; m < 4; ++m)
#pragma unroll
        for (int n = 0; n < 4; ++n)
          ST4(qb + (size_t)(rbase + m * 16) * 1024 + cb + n * 16, acc[m][n][0] * qs, acc[m][n][1] * qs, acc[m][n][2] * qs, acc[m][n][3] * qs);
    } else if (nt < 52) {
      const int cb = (nt - 40) * 128 + wc * 64 + c4;
#pragma unroll
      for (int m = 0; m < 4; ++m)
#pragma unroll
        for (int n = 0; n < 4; ++n)
          ST4(kvb + (size_t)(rbase + m * 16) * 1536 + cb + n * 16, acc[m][n][0], acc[m][n][1], acc[m][n][2], acc[m][n][3]);
    } else if (nt < 60) {
      const int cb = (nt - 52) * 128 + wc * 64 + c4;
#pragma unroll
      for (int m = 0; m < 4; ++m)
#pragma unroll
        for (int n = 0; n < 4; ++n)
          ST4(zb + (size_t)(rbase + m * 16) * 1024 + cb + n * 16, silu_(acc[m][n][0]), silu_(acc[m][n][1]), silu_(acc[m][n][2]), silu_(acc[m][n][3]));
    } else if (nt == 60) {
      if (wc == 0) {
#pragma unroll
        for (int m = 0; m < 4; ++m)
#pragma unroll
          for (int n = 0; n < 3; ++n)
            *(f32x4*)(glb + (size_t)(rbase + m * 16) * 48 + n * 16 + c4) =
                f32x4{sigmoid_(acc[m][n][0]), sigmoid_(acc[m][n][1]), sigmoid_(acc[m][n][2]), sigmoid_(acc[m][n][3])};
      }
    } else if (nt < 77) {
      const int chb = (nt - 61) * 64 + wc * 32 + c4;
#pragma unroll
      for (int m = 0; m < 4; ++m)
#pragma unroll
        for (int pr = 0; pr < 2; ++pr)
          ST4(uz + (size_t)(rbase + m * 16) * 1024 + chb + pr * 16,
              gelu_(acc[m][2 * pr][0]) * silu_(acc[m][2 * pr + 1][0]), gelu_(acc[m][2 * pr][1]) * silu_(acc[m][2 * pr + 1][1]),
              gelu_(acc[m][2 * pr][2]) * silu_(acc[m][2 * pr + 1][2]), gelu_(acc[m][2 * pr][3]) * silu_(acc[m][2 * pr + 1][3]));
    } else if (nt < 85) {
      const int cb = (nt - 77) * 128 + wc * 64 + c4;
#pragma unroll
      for (int m = 0; m < 4; ++m)
#pragma unroll
        for (int n = 0; n < 4; ++n)
          ST4(gv + (size_t)(rbase + m * 16) * 1024 + cb + n * 16, gelu_(acc[m][n][0]), gelu_(acc[m][n][1]), gelu_(acc[m][n][2]), gelu_(acc[m][n][3]));
    } else {
      const int cb = (nt - 85) * 128 + wc * 64 + c4;
#pragma unroll
      for (int m = 0; m < 4; ++m)
#pragma unroll
        for (int n = 0; n < 4; ++n)
          ST4(gates + (size_t)(rbase + m * 16) * 3072 + cb + n * 16, sigmoid_(acc[m][n][0]), sigmoid_(acc[m][n][1]), sigmoid_(acc[m][n][2]), sigmoid_(acc[m][n][3]));
    }
#undef ST4
  }
}

struct CmpALoader {
  const bf16_t* rowptr;
  int r, soff;
  u32x4 r0, r1;
  __device__ __forceinline__ void load(int kt) {
    int tok = 16 * r + (kt >> 1);
    tok = tok > (SEQ - 1) ? (SEQ - 1) : tok;
    const bf16_t* q = rowptr + (size_t)tok * 1536 + (kt & 1) * 32;
    r0 = *(const u32x4*)q; r1 = *(const u32x4*)(q + 8);
  }
  __device__ __forceinline__ void store(bf16_t* tile) {
    bf16_t* q = tile + soff;
    *(u32x4*)q = r0; *(u32x4*)(q + 8) = r1;
  }
};

__device__ __forceinline__ void phase_mix1(const Params& p, int l, char* smraw) {
  const int tid = opaque_tid(); const int lane = tid & 63, w = tid >> 6, l15 = lane & 15, grp = lane >> 4;
  const bf16_t* gv = (const bf16_t*)(p.ws + OFF_GV);
  float* stats = (float*)(p.ws + OFF_STATS);
  constexpr int NCB = 2 * (NB * 4 * 256 / 128);
  const bool split = (int)gridDim.x >= 2 * NCB;
  const int eb = split ? (int)blockIdx.x - NCB : (int)blockIdx.x;
  const int neb = split ? (int)gridDim.x - NCB : (int)gridDim.x;
  for (int r = eb * 4 + w; eb >= 0 && r < R; r += neb * 4) {
    const bf16_t* row = gv + (size_t)r * 1024;
    float v[16]; float s = 0.f;
#pragma unroll
    for (int i = 0; i < 2; ++i) {
      u32x4 u = *(const u32x4*)(row + i * 512 + lane * 8);
      v[i * 8 + 0] = bf2f(u.x & 0xffffu); v[i * 8 + 1] = bf2f(u.x >> 16);
      v[i * 8 + 2] = bf2f(u.y & 0xffffu); v[i * 8 + 3] = bf2f(u.y >> 16);
      v[i * 8 + 4] = bf2f(u.z & 0xffffu); v[i * 8 + 5] = bf2f(u.z >> 16);
      v[i * 8 + 6] = bf2f(u.w & 0xffffu); v[i * 8 + 7] = bf2f(u.w >> 16);
    }
#pragma unroll
    for (int i = 0; i < 16; ++i) s += v[i];
    s = wave_sum(s, lane);
    float mu = s * (1.f / 1024.f);
    float q = 0.f;
#pragma unroll
    for (int i = 0; i < 16; ++i) { float d = v[i] - mu; q += d * d; }
    q = wave_sum(q, lane);
    if (lane == 0) { stats[r * 2] = mu; stats[r * 2 + 1] = rsqrtf(q * (1.f / 1024.f) + 1e-6f); }
  }
  {
    const bf16_t* yApre = (const bf16_t*)(p.ws + OFF_YAPRE);
    const bf16_t* bzA = (const bf16_t*)(p.ws + OFF_BZA);
    bf16_t* yA = (bf16_t*)(p.ws + OFF_YA);
    const float* cw = p.conv_w + (size_t)l * 3 * 1024;
    const float* cb = p.conv_b + (size_t)l * 1024;
    for (int e = eb * 256 + tid; eb >= 0 && e < R * 128; e += neb * 256) {
      int row = e >> 7, c8 = (e & 127) * 8;
      int t = row & (SEQ - 1);
      u32x4 y2 = *(const u32x4*)(yApre + (size_t)row * 1024 + c8);
      u32x4 y1 = (t >= 1) ? *(const u32x4*)(yApre + (size_t)(row - 1) * 1024 + c8) : u32x4{0, 0, 0, 0};
      u32x4 y0 = (t >= 2) ? *(const u32x4*)(yApre + (size_t)(row - 2) * 1024 + c8) : u32x4{0, 0, 0, 0};
      u32x4 bz = *(const u32x4*)(bzA + (size_t)row * 1024 + c8);
      u32x4 o;
#pragma unroll
      for (int i = 0; i < 4; ++i) {
        int c = c8 + i * 2;
        float r0 = cb[c] + cw[c] * bf2f(y0[i] & 0xffffu) + cw[1024 + c] * bf2f(y1[i] & 0xffffu) + cw[2048 + c] * bf2f(y2[i] & 0xffffu);
        float r1 = cb[c + 1] + cw[c + 1] * bf2f(y0[i] >> 16) + cw[1024 + c + 1] * bf2f(y1[i] >> 16) + cw[2048 + c + 1] * bf2f(y2[i] >> 16);
        o[i] = pack2(bf2f(bz[i] & 0xffffu) * r0, bf2f(bz[i] >> 16) * r1);
      }
      *(u32x4*)(yA + (size_t)row * 1024 + c8) = o;
    }
  }
  {
    bf16_t* sm = (bf16_t*)smraw;
    const bf16_t* kvb = (const bf16_t*)(p.ws + OFF_KV);
    const bf16_t* Wc1T = (const bf16_t*)(p.ws + OFF_WC1T);
    const float* bias1 = (const float*)(p.ws + OFF_BIAS1);
    const int wr = w >> 1, wc = w & 1;
    constexpr int MTC = NB * 4 * 256 / 128;
    for (int t = blockIdx.x; t < 2 * MTC; t += gridDim.x) {
      int kv = t / MTC, mt = t % MTC;
      f32x4 acc[4][4];
      zero_acc(acc);
      {
        const int rr = mt * 128 + (tid >> 3);
        const int bl = rr >> 10, g = (rr >> 8) & 3;
        const int gch = ((tid & 7) ^ ((tid >> 4) & 7)) * 8;
        gemm_core_glds_cmp(acc, kvb + (size_t)bl * SEQ * 1536 + kv * 256 + g * 64 + gch, rr & 255,
                           Wc1T + (size_t)(l * 2 + kv) * 128 * 2048, 2048, 2048 / 64, sm, tid);
      }
      bf16_t* Hs = sm;
      bf16_t* W2s = sm + 128 * HS_LD;
      const float* b1 = bias1 + (l * 2 + kv) * 8 * 128;
#pragma unroll
      for (int n = 0; n < 4; ++n) {
        const int col = wc * 64 + n * 16 + 4 * grp;
        f32x4 bb = f32x4{0.f, 0.f, 0.f, 0.f};
#pragma unroll
        for (int ks = 0; ks < 8; ++ks) bb += *(const f32x4*)(b1 + ks * 128 + col);
#pragma unroll
        for (int m = 0; m < 4; ++m)
          *(u32x2*)(Hs + (wr * 64 + m * 16 + l15) * HS_LD + col) =
              u32x2{pack2(silu_(acc[m][n][0] + bb[0]), silu_(acc[m][n][1] + bb[1])), pack2(silu_(acc[m][n][2] + bb[2]), silu_(acc[m][n][3] + bb[3]))};
      }
      const float* w2 = (kv ? p.w_cv2 : p.w_ck2) + (size_t)l * 128 * 64;
      for (int i = 0; i < 32; ++i) {
        int e = tid + 256 * i;
        int j = e >> 6, d = e & 63;
        W2s[d * HS_LD + j] = f2bf(w2[e]);
      }
      __syncthreads();
      f32x4 a2[2][4];
#pragma unroll
      for (int mm = 0; mm < 2; ++mm)
#pragma unroll
        for (int nn = 0; nn < 4; ++nn) a2[mm][nn] = f32x4{0.f, 0.f, 0.f, 0.f};
#pragma unroll
      for (int ks = 0; ks < 4; ++ks) {
        bf16x8 af[2], bfr[4];
#pragma unroll
        for (int mm = 0; mm < 2; ++mm) af[mm] = *(const bf16x8*)(Hs + (w * 32 + mm * 16 + l15) * HS_LD + ks * 32 + grp * 8);
#pragma unroll
        for (int nn = 0; nn < 4; ++nn) bfr[nn] = *(const bf16x8*)(W2s + (nn * 16 + l15) * HS_LD + ks * 32 + grp * 8);
#pragma unroll
        for (int mm = 0; mm < 2; ++mm)
#pragma unroll
          for (int nn = 0; nn < 4; ++nn) a2[mm][nn] = mfma16(af[mm], bfr[nn], a2[mm][nn]);
      }
      bf16_t* outp = (bf16_t*)(p.ws + (kv ? OFF_VCMP : OFF_KCMP));
#pragma unroll
      for (int mm = 0; mm < 2; ++mm)
#pragma unroll
        for (int nn = 0; nn < 4; ++nn)
#pragma unroll
          for (int j = 0; j < 4; ++j) {
            int row = mt * 128 + w * 32 + mm * 16 + 4 * grp + j;
            outp[(size_t)row * 64 + nn * 16 + l15] = f2bf(a2[mm][nn][j]);
          }
      __syncthreads();
    }
  }
}

struct KVRegs { u32x4 k0, k1, v0, v1; };

__device__ __forceinline__ void kv_issue(KVRegs& r, const bf16_t* kbase, const bf16_t* vbase, size_t ld, bool wantV, int tid) {
  const uint32_t row = (uint32_t)tid >> 2, c = ((uint32_t)tid & 3u) * 16u;
  const uint32_t off = (ld == 64 ? row * 64u : row * 1536u) + c;
  const bf16_t* kp = kbase + off;
  r.k0 = *(const u32x4*)kp; r.k1 = *(const u32x4*)(kp + 8);
  if (wantV) {
    const bf16_t* vp = vbase + off;
    r.v0 = *(const u32x4*)vp; r.v1 = *(const u32x4*)(vp + 8);
  }
}
__device__ __forceinline__ void kv_commit(const KVRegs& r, bf16_t* Ks, bf16_t* Vs, bool wantV, int tid) {
  int row = tid >> 2, c = (tid & 3) * 16;
  *(u32x4*)(Ks + row * KS_LD + c) = r.k0;
  *(u32x4*)(Ks + row * KS_LD + c + 8) = r.k1;
  if (wantV) {
    *(u32x4*)(Vs + row * KS_LD + c) = r.v0;
    *(u32x4*)(Vs + row * KS_LD + c + 8) = r.v1;
  }
}

typedef short s16x4 __attribute__((ext_vector_type(4)));
__device__ __forceinline__ s16x4 tr_read(const bf16_t* ptr) {
  return __builtin_amdgcn_ds_read_tr16_b64_v4i16((s16x4 __attribute__((address_space(3)))*)ptr);
}

#define ADSR(dst, base, OFF) asm volatile("ds_read_b128 %0, %1 offset:" #OFF : "=v"(dst) : "v"(base) : "memory")
#define ATRR(dst, base, OFF) asm volatile("ds_read_b64_tr_b16 %0, %1 offset:" #OFF : "=v"(dst) : "v"(base) : "memory")
template <bool MASKED>
__device__ __forceinline__ void attn_block64(const bf16_t* Ks, const bf16_t* Vs, bf16x8 q0, bf16x8 q1, int tq, int kp0, int kpstride,
                                             int maxdist, bool extra_ok, float slope, float& m, float& lsum, f32x4 (&o)[4], int l15, int grp,
                                             const f32x4 (&tb)[4]) {
  const float fst = (float)kpstride;
  const int d0 = tq - kp0 - 4 * grp * kpstride;
  const float base = -slope * (float)d0;
  const unsigned kaddr = (unsigned)(size_t)(Ks + l15 * KS_LD + grp * 8);
  const unsigned vaddr = (unsigned)(size_t)(Vs + (4 * grp + (l15 >> 2)) * KS_LD + 4 * (l15 & 3));
  bf16x8 kf[8];
  ADSR(kf[0], kaddr, 0);    ADSR(kf[1], kaddr, 64);   ADSR(kf[2], kaddr, 2304); ADSR(kf[3], kaddr, 2368);
  ADSR(kf[4], kaddr, 4608); ADSR(kf[5], kaddr, 4672); ADSR(kf[6], kaddr, 6912); ADSR(kf[7], kaddr, 6976);
  f32x4 s[4];
  asm volatile("s_waitcnt lgkmcnt(6)" : "+v"(kf[0]), "+v"(kf[1]) :: "memory");
  s[0] = mfma16(kf[1], q1, mfma16(kf[0], q0, f32x4{0.f, 0.f, 0.f, 0.f}));
  asm volatile("s_waitcnt lgkmcnt(4)" : "+v"(kf[2]), "+v"(kf[3]) :: "memory");
  s[1] = mfma16(kf[3], q1, mfma16(kf[2], q0, f32x4{0.f, 0.f, 0.f, 0.f}));
  asm volatile("s_waitcnt lgkmcnt(2)" : "+v"(kf[4]), "+v"(kf[5]) :: "memory");
  s[2] = mfma16(kf[5], q1, mfma16(kf[4], q0, f32x4{0.f, 0.f, 0.f, 0.f}));
  asm volatile("s_waitcnt lgkmcnt(0)" : "+v"(kf[6]), "+v"(kf[7]) :: "memory");
  s[3] = mfma16(kf[7], q1, mfma16(kf[6], q0, f32x4{0.f, 0.f, 0.f, 0.f}));
  s16x4 vt[16];
  ATRR(vt[0], vaddr, 0);     ATRR(vt[1], vaddr, 2304);  ATRR(vt[2], vaddr, 32);    ATRR(vt[3], vaddr, 2336);
  ATRR(vt[4], vaddr, 64);    ATRR(vt[5], vaddr, 2368);  ATRR(vt[6], vaddr, 96);    ATRR(vt[7], vaddr, 2400);
  ATRR(vt[8], vaddr, 4608);  ATRR(vt[9], vaddr, 6912);  ATRR(vt[10], vaddr, 4640); ATRR(vt[11], vaddr, 6944);
  ATRR(vt[12], vaddr, 4672); ATRR(vt[13], vaddr, 6976); ATRR(vt[14], vaddr, 4704); ATRR(vt[15], vaddr, 7008);
  float cmax = -1e30f;
#pragma unroll
  for (int t = 0; t < 4; ++t)
#pragma unroll
    for (int j = 0; j < 4; ++j) {
      const int ci = t * 16 + j;
      float v = __builtin_fmaf(tb[t][j], fst, s[t][j]);
      if (MASKED) {
        const int dist = d0 - ci * kpstride;
        const bool valid = extra_ok && dist >= 0 && dist < maxdist;
        v = valid ? v : -1e30f;
      }
      s[t][j] = v;
      cmax = fmaxf(cmax, v);
    }
  if (!MASKED) cmax = extra_ok ? cmax : -1e30f;
  if (__ballot(cmax + base > m + 40.f) != 0ull) {
    cmax = (cmax > -1e29f) ? cmax + base : -1e30f;
    cmax = fmaxf(cmax, bperm(cmax, (l15 + 16 * grp) ^ 16));
    cmax = fmaxf(cmax, bperm(cmax, (l15 + 16 * grp) ^ 32));
    const float mnew = fmaxf(m, cmax);
    const float alpha = __builtin_amdgcn_exp2f(m - mnew);
    lsum *= alpha;
#pragma unroll
    for (int dt = 0; dt < 4; ++dt) o[dt] *= alpha;
    m = mnew;
  }
  float psum = 0.f;
  const float mb = m - base;
#pragma unroll
  for (int t = 0; t < 4; ++t)
#pragma unroll
    for (int j = 0; j < 4; ++j) {
      const float v = s[t][j];
      float pe = __builtin_amdgcn_exp2f(v - mb);
      if (MASKED) pe = (v > -1e29f) ? pe : 0.f;
      s[t][j] = pe;
      psum += pe;
    }
  if (!MASKED) psum = extra_ok ? psum : 0.f;
  lsum += psum;
  const uint32_t rowm = (MASKED || extra_ok) ? 0xffffffffu : 0u;
  asm volatile("s_waitcnt lgkmcnt(0)"
               : "+v"(vt[0]), "+v"(vt[1]), "+v"(vt[2]), "+v"(vt[3]), "+v"(vt[4]), "+v"(vt[5]), "+v"(vt[6]), "+v"(vt[7]),
                 "+v"(vt[8]), "+v"(vt[9]), "+v"(vt[10]), "+v"(vt[11]), "+v"(vt[12]), "+v"(vt[13]), "+v"(vt[14]), "+v"(vt[15])
               :: "memory");
#pragma unroll
  for (int sc = 0; sc < 2; ++sc) {
    const bf16x8 pb = __builtin_bit_cast(bf16x8, u32x4{pack2(s[2 * sc][0], s[2 * sc][1]) & rowm, pack2(s[2 * sc][2], s[2 * sc][3]) & rowm,
                                                       pack2(s[2 * sc + 1][0], s[2 * sc + 1][1]) & rowm, pack2(s[2 * sc + 1][2], s[2 * sc + 1][3]) & rowm});
#pragma unroll
    for (int dt = 0; dt < 4; ++dt) {
      const s16x4 vlo = vt[sc * 8 + dt * 2], vhi = vt[sc * 8 + dt * 2 + 1];
      const bf16x8 vf = {vlo[0], vlo[1], vlo[2], vlo[3], vhi[0], vhi[1], vhi[2], vhi[3]};
      o[dt] = mfma16(vf, pb, o[dt]);
    }
  }
}

constexpr int ATT_BUF = 9216 + 9216;

template <class DescF, class ProcF>
__device__ __forceinline__ void kv_stream(int n, DescF desc, ProcF proc, char* smraw, int tid) {
  if (n <= 0) return;
  KVRegs r0, r1;
  const bf16_t *kp, *vp; size_t ld;
  desc(0, kp, vp, ld); kv_issue(r0, kp, vp, ld, true, tid);
  desc(1 < n ? 1 : n - 1, kp, vp, ld); kv_issue(r1, kp, vp, ld, true, tid);
  __syncthreads();
  kv_commit(r0, (bf16_t*)smraw, (bf16_t*)(smraw + 9216), true, tid);
  desc(2 < n ? 2 : n - 1, kp, vp, ld); kv_issue(r0, kp, vp, ld, true, tid);
  __syncthreads();
  for (int e0 = 0; e0 < n; e0 += 2) {
    {
      const int e = e0;
      proc(e, (const bf16_t*)smraw, (const bf16_t*)(smraw + 9216));
      kv_commit(r1, (bf16_t*)(smraw + ATT_BUF), (bf16_t*)(smraw + ATT_BUF + 9216), true, tid);
      desc(e + 3 < n ? e + 3 : n - 1, kp, vp, ld); kv_issue(r1, kp, vp, ld, true, tid);
      __syncthreads();
    }
    {
      const int e = e0 + 1;
      if (e < n) proc(e, (const bf16_t*)(smraw + ATT_BUF), (const bf16_t*)(smraw + ATT_BUF + 9216));
      kv_commit(r0, (bf16_t*)smraw, (bf16_t*)(smraw + 9216), true, tid);
      desc(e + 3 < n ? e + 3 : n - 1, kp, vp, ld); kv_issue(r0, kp, vp, ld, true, tid);
      __syncthreads();
    }
  }
}

__device__ __forceinline__ void attn_unit(const Params& p, char* smraw, int bl, int g, int qb) {
  float* impbuf = (float*)(smraw + 2 * ATT_BUF);
  unsigned long long* selmask = (unsigned long long*)(smraw + 2 * ATT_BUF + 16384);
  int* sellist = (int*)(smraw + 2 * ATT_BUF + 16384 + 128);
  const bf16_t* qbuf = (const bf16_t*)(p.ws + OFF_Q);
  const bf16_t* zbuf = (const bf16_t*)(p.ws + OFF_ZB);
  const bf16_t* kvb = (const bf16_t*)(p.ws + OFF_KV);
  const float* glb = (const float*)(p.ws + OFF_GL);
  bf16_t* yB = (bf16_t*)(p.ws + OFF_YB);
  const int tid = opaque_tid(); const int lane = tid & 63, n = tid >> 6, l15 = lane & 15, grp = lane >> 4;
  const int h = g * 4 + n, t0 = qb * 16, tq = t0 + l15;
  const float slope = exp2f(-0.5f * (float)(h + 1)) * 1.44269504f;
  f32x4 tb[4];
#pragma unroll
  for (int t = 0; t < 4; ++t) tb[t] = f32x4{slope * (float)(16 * t), slope * (float)(16 * t + 1), slope * (float)(16 * t + 2), slope * (float)(16 * t + 3)};
  const size_t rowq = (size_t)bl * SEQ + tq;
  bf16x8 q0, q1;
  {
    const bf16_t* qp = qbuf + rowq * 1024 + h * 64 + grp * 8;
    q0 = *(const bf16x8*)qp; q1 = *(const bf16x8*)(qp + 32);
  }
  const float g0 = glb[rowq * 48 + h * 3 + 0], g1 = glb[rowq * 48 + h * 3 + 1], g2 = glb[rowq * 48 + h * 3 + 2];
  f32x4 otot[4];
#pragma unroll
  for (int dt = 0; dt < 4; ++dt) otot[dt] = f32x4{0.f, 0.f, 0.f, 0.f};
  const size_t seqbase = (size_t)bl * SEQ * 1536 + g * 64;
  const int BIG = 1 << 30;
  const bf16_t* kcb = (const bf16_t*)(p.ws + OFF_KCMP) + (size_t)(bl * 4 + g) * 256 * 64;
  const bf16_t* vcb = (const bf16_t*)(p.ws + OFF_VCMP) + (size_t)(bl * 4 + g) * 256 * 64;
  const bf16_t* kwb = kvb + seqbase + 1024;
  const bf16_t* vwb = kvb + seqbase + 1280;
  const bf16_t* ksb = kvb + seqbase + 512;
  const bf16_t* vsb = kvb + seqbase + 768;

  float m = -1e30f, lsum = 0.f;
  f32x4 o[4];
#pragma unroll
  for (int dt = 0; dt < 4; ++dt) o[dt] = f32x4{0.f, 0.f, 0.f, 0.f};
  float m_c = -1e30f, inv_c = 0.f, prev_rot = 0.f;
  float* myimp = impbuf + n * 1024;
#pragma unroll
  for (int i = 0; i < 16; ++i) myimp[i * 64 + lane] = 0.f;

  int lo = t0 - 511; lo = lo < 0 ? 0 : lo;
  const int wlo = lo >> 6, whi = t0 >> 6, nW = whi - wlo + 1;
  const int nck = (qb + 63) >> 6;
  auto finish = [&](float gate) -> float {
    float lt = lsum + bperm(lsum, lane ^ 16);
    lt += bperm(lt, lane ^ 32);
    const float inv = lt > 0.f ? 1.f / lt : 0.f;
    const float sc_ = gate * inv;
#pragma unroll
    for (int dt = 0; dt < 4; ++dt) { otot[dt] += o[dt] * sc_; o[dt] = f32x4{0.f, 0.f, 0.f, 0.f}; }
    lsum = 0.f;
    return inv;
  };
  kv_stream(nW + 2 * nck,
    [&](int e, const bf16_t*& kp, const bf16_t*& vp, size_t& ld) {
      if (e < nW) { const size_t off = (size_t)(whi - e) * 64 * 1536; kp = kwb + off; vp = vwb + off; ld = 1536; }
      else { const int c = (e < nW + nck) ? (nW + nck - 1 - e) : (e - nW - nck); kp = kcb + c * 4096; vp = vcb + c * 4096; ld = 64; }
    },
    [&](int e, const bf16_t* Ks, const bf16_t* Vt) {
      if (e < nW) {
        const int wb = whi - e;
        if (wb < whi && wb * 64 >= t0 - 496) attn_block64<false>(Ks, Vt, q0, q1, tq, wb * 64, 1, 512, true, slope, m, lsum, o, l15, grp, tb);
        else attn_block64<true>(Ks, Vt, q0, q1, tq, wb * 64, 1, 512, true, slope, m, lsum, o, l15, grp, tb);
        if (e == nW - 1) { (void)finish(g2); m = -1e30f; }
      } else if (e < nW + nck) {
        const int c = nW + nck - 1 - e;
        if (16 * (64 * c + 63) + 31 <= t0) attn_block64<false>(Ks, Vt, q0, q1, tq, 1024 * c + 31, 16, BIG, true, slope, m, lsum, o, l15, grp, tb);
        else attn_block64<true>(Ks, Vt, q0, q1, tq, 1024 * c + 31, 16, BIG, true, slope, m, lsum, o, l15, grp, tb);
        if (e == nW + nck - 1) { inv_c = finish(g0); m_c = m; m = -1e30f; }
      } else {
        const int c = e - nW - nck;
#pragma unroll
        for (int tt = 0; tt < 4; ++tt) {
          const bf16_t* krp = Ks + (tt * 16 + l15) * KS_LD + grp * 8;
          bf16x8 k0 = *(const bf16x8*)krp, k1 = *(const bf16x8*)(krp + 32);
          f32x4 z = f32x4{0.f, 0.f, 0.f, 0.f};
          z = mfma16(k0, q0, z);
          z = mfma16(k1, q1, z);
          float sum4 = 0.f, p3 = 0.f;
#pragma unroll
          for (int j = 0; j < 4; ++j) {
            int kidx = c * 64 + tt * 16 + 4 * grp + j;
            int dist = tq - (16 * kidx + 31);
            float pe = (dist >= 0) ? __builtin_amdgcn_exp2f(z[j] - slope * (float)dist - m_c) * inv_c : 0.f;
            sum4 += pe;
            if (j == 3) p3 = pe;
          }
          float rot = bperm(p3, (lane + 48) & 63);
          float extra = (grp == 0) ? prev_rot : rot;
          myimp[l15 * 64 + (c * 4 + tt) * 4 + grp] = sum4 + extra;
          prev_rot = rot;
        }
      }
    }, smraw, tid);
  if (nck < 4 && grp == 0) myimp[l15 * 64 + nck * 16] = prev_rot;
  __syncthreads();
#pragma unroll 1
  for (int i = 0; i < 4; ++i) {
    int qi = n * 4 + i;
    int tqq = t0 + qi, cur = tqq >> 6, s = lane;
    float imp = impbuf[qi * 64 + s] + impbuf[1024 + qi * 64 + s] + impbuf[2048 + qi * 64 + s] + impbuf[3072 + qi * 64 + s];
    bool forced = (s == 0) || (s == cur) || (s == cur - 1);
    bool valid = s <= cur;
    float score = forced ? __builtin_inff() : (valid ? imp : -__builtin_inff());
    int rank = 0;
#pragma unroll 8
    for (int sp = 0; sp < 64; ++sp) {
      float v = bperm(score, sp);
      rank += ((v > score) || (v == score && sp < s)) ? 1 : 0;
    }
    unsigned long long mk = __ballot((rank < 16) && valid);
    if (lane == 0) selmask[qi] = mk;
  }
  __syncthreads();
  const unsigned long long mymask = selmask[l15];
  unsigned long long U = 0, Uand = ~0ull;
#pragma unroll
  for (int i = 0; i < 16; ++i) { const unsigned long long mk = selmask[i]; U |= mk; Uand &= mk; }
  {
    uint32_t ulo = __builtin_amdgcn_readfirstlane((uint32_t)U), uhi = __builtin_amdgcn_readfirstlane((uint32_t)(U >> 32));
    U = ((unsigned long long)uhi << 32) | ulo;
    ulo = __builtin_amdgcn_readfirstlane((uint32_t)Uand); uhi = __builtin_amdgcn_readfirstlane((uint32_t)(Uand >> 32));
    Uand = ((unsigned long long)uhi << 32) | ulo;
  }
  const int nsel = __popcll(U);
  if (n == 0) {
    if ((U >> lane) & 1ull) sellist[__popcll(U >> lane) - 1] = lane;
  }
  __syncthreads();
  kv_stream(nsel,
    [&](int e, const bf16_t*& kp, const bf16_t*& vp, size_t& ld) {
      const int s = __builtin_amdgcn_readfirstlane(sellist[e]);
      const size_t off = (size_t)s * 64 * 1536; kp = ksb + off; vp = vsb + off; ld = 1536;
    },
    [&](int e, const bf16_t* Ks, const bf16_t* Vt) {
      const int s = __builtin_amdgcn_readfirstlane(sellist[e]);
      const bool ok = (mymask >> s) & 1ull;
      if (s < whi) attn_block64<false>(Ks, Vt, q0, q1, tq, s * 64, 1, BIG, ok, slope, m, lsum, o, l15, grp, tb);
      else attn_block64<true>(Ks, Vt, q0, q1, tq, s * 64, 1, BIG, ok, slope, m, lsum, o, l15, grp, tb);
    }, smraw, tid);
  (void)finish(g1);
#pragma unroll
  for (int dt = 0; dt < 4; ++dt) {
    size_t off = rowq * 1024 + h * 64 + dt * 16 + 4 * grp;
    u32x2 zz = *(const u32x2*)(zbuf + off);
    u32x2 ov;
    ov.x = pack2(otot[dt][0] * bf2f(zz.x & 0xffffu), otot[dt][1] * bf2f(zz.x >> 16));
    ov.y = pack2(otot[dt][2] * bf2f(zz.y & 0xffffu), otot[dt][3] * bf2f(zz.y >> 16));
    *(u32x2*)(yB + off) = ov;
  }
}

struct GmlpBLoader {
  const bf16_t* gvbase;
  const float* stats;
  const float* lg; const float* lb;
  int tid;
  u32x4 r[2]; f32x2 st[2];
  __device__ __forceinline__ void load(int kt) {
#pragma unroll
    for (int i = 0; i < 2; ++i) {
      int v = tid + 256 * i;
      int j = kt * 32 + (v >> 4), c8 = (v & 15) * 8;
      r[i] = *(const u32x4*)(gvbase + (size_t)j * 1024 + c8);
      st[i] = *(const f32x2*)(stats + j * 2);
    }
  }
  __device__ __forceinline__ void store(bf16_t* tile) {
#pragma unroll
    for (int i = 0; i < 2; ++i) {
      int v = tid + 256 * i;
      int jl = v >> 4, c8 = (v & 15) * 8;
      const u32x4 u = r[i];
#pragma unroll
      for (int e = 0; e < 4; ++e) {
        int c = c8 + 2 * e;
        float a = (bf2f(u[e] & 0xffffu) - st[i].x) * st[i].y * lg[c] + lb[c];
        float b = (bf2f(u[e] >> 16) - st[i].x) * st[i].y * lg[c + 1] + lb[c + 1];
        tile[c * LDK + jl] = f2bf(a);
        tile[(c + 1) * LDK + jl] = f2bf(b);
      }
    }
  }
};

__device__ __forceinline__ void gmlp_unit(const Params& p, int l, char* smraw, int bl, int chunk, int g) {
  bf16_t* sm = (bf16_t*)smraw;
  const int tid = opaque_tid(); const int lane = tid & 63, w = tid >> 6, wr = w >> 1, wc = w & 1, l15 = lane & 15, grp = lane >> 4;
  const size_t row0 = (size_t)bl * SEQ + chunk * 128;
  f32x4 acc[4][4];
  zero_acc(acc);
  StdLoader al;
  al.init((const bf16_t*)(p.ws + OFF_WM) + (size_t)(l * 8 + g) * 128 * 128, 128, tid);
  GmlpBLoader bl_;
  bl_.tid = tid;
  bl_.gvbase = (const bf16_t*)(p.ws + OFF_GV) + row0 * 1024 + g * 128;
  bl_.stats = (const float*)(p.ws + OFF_STATS) + row0 * 2;
  bl_.lg = p.ln_g + l * 1024 + g * 128;
  bl_.lb = p.ln_b + l * 1024 + g * 128;
  gemm_core(acc, al, bl_, 4, sm, tid);
  const bf16_t* uz = (const bf16_t*)(p.ws + OFF_UZ);
  bf16_t* yC = (bf16_t*)(p.ws + OFF_YC);
  const float* bs = p.b_s + (size_t)(l * 8 + g) * 128;
#pragma unroll
  for (int m = 0; m < 4; ++m)
#pragma unroll
    for (int j = 0; j < 4; ++j) {
      int i = wr * 64 + m * 16 + 4 * grp + j;
      float bb = bs[i];
#pragma unroll
      for (int n = 0; n < 4; ++n) {
        size_t off = (row0 + i) * 1024 + g * 128 + wc * 64 + n * 16 + l15;
        yC[off] = f2bf(bf2f(uz[off]) * (acc[m][n][j] + bb));
      }
    }
}

__device__ __forceinline__ void phase_mix2(const Params& p, int l, char* smraw, int inst) {
  constexpr int NATT = NB * 4 * 256, NGM = NB * 32 * 8;
  unsigned* ctr = (unsigned*)(p.ws + OFF_BAR) + inst;
  volatile int* slot = (volatile int*)(smraw + 65536 + 8);
  int u = (int)blockIdx.x;
  while (u < NATT + NGM) {
    int un = 0;
    if (threadIdx.x == 0) un = (int)gridDim.x + (int)__hip_atomic_fetch_add(ctr, 1u, __ATOMIC_RELAXED, __HIP_MEMORY_SCOPE_AGENT);
    if (u < NATT) {
      int qb = 255 - (u / (NB * 4)), r = u % (NB * 4);
      attn_unit(p, smraw, r >> 2, r & 3, qb);
    } else {
      int v = u - NATT;
      gmlp_unit(p, l, smraw, v >> 8, (v >> 3) & 31, v & 7);
    }
    __syncthreads();
    if (threadIdx.x == 0) *slot = un;
    __syncthreads();
    u = *slot;
  }
}

__device__ __forceinline__ void phase_merge(const Params& p, int l, char* smraw) {
  bf16_t* sm = (bf16_t*)smraw;
  const bf16_t* WbrT = (const bf16_t*)(p.ws + OFF_WBRT) + (size_t)l * 3 * D * D;
  const bf16_t* gates = (const bf16_t*)(p.ws + OFF_GATES);
  bf16_t* merged = (bf16_t*)(p.ws + OFF_H);
  const int tid = opaque_tid(); const int lane = tid & 63, w = tid >> 6, wr = w >> 1, wc = w & 1, l15 = lane & 15, grp = lane >> 4;
  const int nx = gridDim.x >> 3;
  constexpr int CJ_END = (R / 1024) * 64;
  auto cj_next = [&](int c) { return ((c & 63) + nx < 64) ? (c + nx) : (((c >> 6) + 8) * 64 + (int)(blockIdx.x >> 3)); };
  auto ybuf = [&](int i) { return (const bf16_t*)(p.ws + (i == 0 ? OFF_YA : (i == 1 ? OFF_YB : OFF_YC))); };
  int cj = (blockIdx.x & 7) * 64 + (blockIdx.x >> 3);
  __syncthreads();
  if (cj < CJ_END) glds_prefetch0(ybuf(0) + (size_t)((cj >> 6) * 8 + (cj & 7)) * 128 * D, D, WbrT + (size_t)((cj & 63) >> 3) * 128 * D, D, sm, tid);
  for (; cj < CJ_END; cj = cj_next(cj)) {
    const int nt = (cj & 63) >> 3, mt = (cj >> 6) * 8 + (cj & 7);
    const int rbase = mt * 128 + wr * 64 + l15, cbase = nt * 128 + wc * 64 + 4 * grp;
    f32x4 tot[4][4];
    zero_acc(tot);
#pragma unroll 1
    for (int i = 0; i < 3; ++i) {
      f32x4 acc[4][4];
      zero_acc(acc);
      const bf16_t* Y = ybuf(i);
      gemm_core_glds<false>(acc, Y + (size_t)mt * 128 * D, D, WbrT + (size_t)i * D * D + (size_t)nt * 128 * D, D, D / 64, sm, tid);
      if (i < 2) {
        glds_prefetch0(ybuf(i + 1) + (size_t)mt * 128 * D, D, WbrT + (size_t)(i + 1) * D * D + (size_t)nt * 128 * D, D, sm, tid);
      } else {
        const int c2 = cj_next(cj);
        if (c2 < CJ_END) glds_prefetch0(ybuf(0) + (size_t)((c2 >> 6) * 8 + (c2 & 7)) * 128 * D, D, WbrT + (size_t)((c2 & 63) >> 3) * 128 * D, D, sm, tid);
      }
#pragma unroll
      for (int m = 0; m < 4; ++m)
#pragma unroll
        for (int n = 0; n < 4; ++n) {
          const u32x2 gt = *(const u32x2*)(gates + (size_t)(rbase + m * 16) * 3072 + i * 1024 + cbase + n * 16);
          tot[m][n][0] += bf2f(gt.x & 0xffffu) * acc[m][n][0];
          tot[m][n][1] += bf2f(gt.x >> 16) * acc[m][n][1];
          tot[m][n][2] += bf2f(gt.y & 0xffffu) * acc[m][n][2];
          tot[m][n][3] += bf2f(gt.y >> 16) * acc[m][n][3];
        }
    }
#pragma unroll
    for (int m = 0; m < 4; ++m)
#pragma unroll
      for (int n = 0; n < 4; ++n)
        *(u32x2*)(merged + (size_t)(rbase + m * 16) * 1024 + cbase + n * 16) = u32x2{pack2(tot[m][n][0], tot[m][n][1]), pack2(tot[m][n][2], tot[m][n][3])};
  }
}

__device__ __forceinline__ void phase_outproj(const Params& p, int l, char* smraw) {
  bf16_t* sm = (bf16_t*)smraw;
  const bf16_t* WoutT = (const bf16_t*)(p.ws + OFF_WOUTT) + (size_t)l * D * D;
  const bf16_t* merged = (const bf16_t*)(p.ws + OFF_H);
  bf16_t* opre = (bf16_t*)(p.ws + OFF_YAPRE);
  const int tid = opaque_tid(); const int lane = tid & 63, w = tid >> 6, wr = w >> 1, wc = w & 1, l15 = lane & 15, grp = lane >> 4;
  const int nx = gridDim.x >> 3;
  constexpr int CJ_END = (R / 1024) * 64;
  auto cj_next = [&](int c) { return ((c & 63) + nx < 64) ? (c + nx) : (((c >> 6) + 8) * 64 + (int)(blockIdx.x >> 3)); };
  int cj = (blockIdx.x & 7) * 64 + (blockIdx.x >> 3);
  __syncthreads();
  if (cj < CJ_END) glds_prefetch0(merged + (size_t)((cj >> 6) * 8 + (cj & 7)) * 128 * D, D, WoutT + (size_t)((cj & 63) >> 3) * 128 * D, D, sm, tid);
  for (; cj < CJ_END; cj = cj_next(cj)) {
    const int nt = (cj & 63) >> 3, mt = (cj >> 6) * 8 + (cj & 7);
    f32x4 acc[4][4];
    zero_acc(acc);
    gemm_core_glds<true>(acc, merged + (size_t)mt * 128 * D, D, WoutT + (size_t)nt * 128 * D, D, D / 64, sm, tid);
    {
      const int c2 = cj_next(cj);
      if (c2 < CJ_END) glds_prefetch0(merged + (size_t)((c2 >> 6) * 8 + (c2 & 7)) * 128 * D, D, WoutT + (size_t)((c2 & 63) >> 3) * 128 * D, D, sm, tid);
    }
    const int rbase = mt * 128 + wr * 64 + l15, cbase = nt * 128 + wc * 64 + 4 * grp;
#pragma unroll
    for (int m = 0; m < 4; ++m)
#pragma unroll
      for (int n = 0; n < 4; ++n)
        *(u32x2*)(opre + (size_t)(rbase + m * 16) * 1024 + cbase + n * 16) = u32x2{pack2(acc[m][n][0], acc[m][n][1]), pack2(acc[m][n][2], acc[m][n][3])};
  }
}

#define XB_TMO      128
#define XB_XCNT(j)  (256  + 64 * (j))
#define XB_XSUB(j)  (1280 + 64 * (j))
#define XB_XGEN(j)  (2304 + 64 * (j))
#define XB_TOP      3328
#define XB_TOPGEN   3392
#define XCD_BAR_WORDS 3456
#define XB_SPIN_CAP (1u << 18)
#define LAS __attribute__((address_space(3)))

__device__ __forceinline__ unsigned xb_ld(unsigned* p)              { return __hip_atomic_load(p, __ATOMIC_RELAXED, __HIP_MEMORY_SCOPE_AGENT); }
__device__ __forceinline__ unsigned xb_add(unsigned* p, unsigned v) { return __hip_atomic_fetch_add(p, v, __ATOMIC_RELAXED, __HIP_MEMORY_SCOPE_AGENT); }
__device__ __forceinline__ unsigned xb_xcc_id() { return (unsigned)__builtin_amdgcn_s_getreg((3 << 11) | 20) & 0xFu; }
#define XB_SPIN(cond, bar) do { unsigned _sp = 0; while (cond) { __builtin_amdgcn_s_sleep(1); \
    if ((++_sp & 255u) == 0u) { if (xb_ld(&(bar)[XB_TMO])) break; if (_sp > XB_SPIN_CAP) { atomicAdd(&(bar)[XB_TMO], 1u); break; } } } } while (0)

struct XcdBarrier {
    unsigned* bar; unsigned x;
    volatile LAS unsigned* st;
};

__device__ __forceinline__ XcdBarrier xcd_barrier_post(unsigned* bar, volatile LAS unsigned* st) {
    XcdBarrier b; b.bar = bar; b.x = xb_xcc_id(); b.st = st;
    if (threadIdx.x == 0) (void)xb_add(&bar[XB_XCNT(b.x)], 1u);
    return b;
}
__device__ __forceinline__ void xcd_barrier_complete(unsigned* bar, unsigned x, unsigned& nloc, unsigned& nx) {
    const unsigned G = gridDim.x * gridDim.y * gridDim.z;
    unsigned sum, cnt, mine, sp = 0u;
    for (;;) {
        sum = 0u; cnt = 0u; mine = 0u;
#pragma unroll
        for (unsigned j = 0; j < 16; ++j) { const unsigned c = xb_ld(&bar[XB_XCNT(j)]); sum += c; cnt += (c > 0u) ? 1u : 0u; mine = (j == x) ? c : mine; }
        if (sum == G) break;
        __builtin_amdgcn_s_sleep(1);
        if ((++sp & 255u) == 0u) { if (xb_ld(&bar[XB_TMO])) break; if (sp > XB_SPIN_CAP) { atomicAdd(&bar[XB_TMO], 1u); break; } }
    }
    nloc = mine > 0u ? mine : 1u; nx = cnt > 0u ? cnt : 1u;
}
__device__ __forceinline__ void xcd_barrier(const XcdBarrier& b) {
    asm volatile("s_waitcnt vmcnt(0)" ::: "memory");
    __syncthreads();
    if (threadIdx.x == 0) {
        unsigned* bar = b.bar;
        __builtin_amdgcn_s_waitcnt(0);
        unsigned nloc = b.st[0], nx = b.st[1];
        if (nloc == 0u) { xcd_barrier_complete(bar, b.x, nloc, nx); b.st[0] = nloc; b.st[1] = nx; }
        const unsigned old = xb_add(&bar[XB_XSUB(b.x)], 1u);
        const unsigned gen = old / nloc;
        if (old + 1u == (gen + 1u) * nloc) {
            __builtin_amdgcn_fence(__ATOMIC_RELEASE, "agent");
            asm volatile("s_waitcnt vmcnt(0)" ::: "memory");
            const unsigned og = xb_add(&bar[XB_TOP], 1u);
            const unsigned tg = og / nx;
            if (og + 1u == (tg + 1u) * nx) xb_add(&bar[XB_TOPGEN], 1u);
            else XB_SPIN(xb_ld(&bar[XB_TOPGEN]) == tg, bar);
            __builtin_amdgcn_fence(__ATOMIC_ACQUIRE, "agent");
            xb_add(&bar[XB_XGEN(b.x)], 1u);
            asm volatile("s_waitcnt vmcnt(0)" ::: "memory");
        } else {
            XB_SPIN(xb_ld(&bar[XB_XGEN(b.x)]) == gen, bar);
            __builtin_amdgcn_fence(__ATOMIC_ACQUIRE, "agent");
            asm volatile("s_waitcnt vmcnt(0)" ::: "memory");
        }
    }
    __syncthreads();
}

__global__ void __launch_bounds__(256, 2) hybrid_fwd(Params p) {
  __shared__ __attribute__((aligned(16))) char smraw[SMEM_BYTES];
  cg::grid_group grid = cg::this_grid();
  if (threadIdx.x == 0) *(u32x4*)(smraw + 65536) = u32x4{0u, 0u, 0u, 0u};
  __syncthreads();
  const XcdBarrier xb = xcd_barrier_post((unsigned*)(p.ws + OFF_BAR), (volatile LAS unsigned*)(smraw + 65536));
  phase0(p, smraw);
  grid.sync();
  for (int gi = 0; gi < NGRP; ++gi) {
    phase_h0(p, gi);
    xcd_barrier(xb);
    for (int l = 0; l < DEPTH; ++l) {
      phase_inproj(p, l, smraw);
      xcd_barrier(xb);
      phase_mix1(p, l, smraw);
      xcd_barrier(xb);
      phase_mix2(p, l, smraw, gi * DEPTH + l);
      xcd_barrier(xb);
      phase_merge(p, l, smraw);
      xcd_barrier(xb);
      phase_outproj(p, l, smraw);
      xcd_barrier(xb);
      phase_final(p, gi, l);
      xcd_barrier(xb);
    }
  }
}

extern "C" void kernel_launch(void* const* d_in, const int* in_sizes, int n_in, void* d_out, int out_size, void* d_ws,
                              size_t ws_size, hipStream_t stream) {
  static int grid_blocks = 0;
  if (!grid_blocks) {
    int dev = 0, cus = 0, per_cu = 0;
    hipGetDevice(&dev);
    hipDeviceGetAttribute(&cus, hipDeviceAttributeMultiprocessorCount, dev);
    hipOccupancyMaxActiveBlocksPerMultiprocessor(&per_cu, hybrid_fwd, 256, 0);
    if (per_cu < 1) per_cu = 1;
    if (per_cu > 2) per_cu = 2;
    grid_blocks = cus * per_cu;
    if (ws_size < WS_END) fprintf(stderr, "kernel_launch: workspace too small: %zu < %zu\n", ws_size, (size_t)WS_END);
  }
  Params p{};
  const float** pp = (const float**)&p;
  for (int i = 0; i < 21; ++i) pp[i] = (const float*)d_in[i];
  p.out = (float*)d_out;
  p.ws = (unsigned char*)d_ws;
  (void)hipMemsetAsync((char*)d_ws + OFF_BAR, 0, 3456 * 4, stream);
  void* args[] = {&p};
  hipError_t e = hipLaunchCooperativeKernel((void*)hybrid_fwd, dim3(grid_blocks), dim3(256), args, 0, stream);
  if (e != hipSuccess) fprintf(stderr, "cooperative launch failed: %s (grid %d)\n", hipGetErrorString(e), grid_blocks);
}
```

```cpp
#include <hip/hip_runtime.h>
#include <hip/hip_cooperative_groups.h>
#include <cstdio>
#include <cstdint>
namespace cg = cooperative_groups;

typedef unsigned short bf16_t;
using bf16x8 = __attribute__((ext_vector_type(8))) short;
using f32x4 = __attribute__((ext_vector_type(4))) float;
using f32x2 = __attribute__((ext_vector_type(2))) float;
using u32x4 = __attribute__((ext_vector_type(4))) uint32_t;
using u32x2 = __attribute__((ext_vector_type(2))) uint32_t;

constexpr int D = 1024, SEQ = 4096, BATCH = 16, DEPTH = 2;
constexpr int IN_COLS = 13872;
constexpr int A_OFF = 0, B_OFF = 4096, C_OFF = 7728, G_OFF = 10800;
constexpr int NT_IN = 109, NP = NT_IN * 128;
constexpr int NB = 4, R = NB * SEQ, NGRP = BATCH / NB;
constexpr int LDK = 40;
constexpr int KS_LD = 80;
constexpr int VT_LD = 68;
constexpr int HS_LD = 136;
constexpr int SMEM_BYTES = 65536 + 16;

constexpr size_t al256(size_t x) { return (x + 255) & ~size_t(255); }
constexpr size_t OFF_WINT = 0;
constexpr size_t OFF_WBRT = al256(OFF_WINT + (size_t)DEPTH * NP * D * 2);
constexpr size_t OFF_WOUTT = al256(OFF_WBRT + (size_t)DEPTH * 3 * D * D * 2);
constexpr size_t OFF_WC1T = al256(OFF_WOUTT + (size_t)DEPTH * D * D * 2);
constexpr size_t OFF_WM = al256(OFF_WC1T + (size_t)DEPTH * 2 * 128 * 2048 * 2);
constexpr size_t OFF_BIAS1 = al256(OFF_WM + (size_t)DEPTH * 8 * 128 * 128 * 2);
constexpr size_t OFF_MOD = al256(OFF_BIAS1 + (size_t)DEPTH * 2 * 8 * 128 * 4);
constexpr size_t OFF_H = al256(OFF_MOD + (size_t)DEPTH * 16 * 3072 * 4);
constexpr size_t SZ_ACT = (size_t)R * 1024 * 2;
constexpr size_t OFF_YAPRE = al256(OFF_H + SZ_ACT);
constexpr size_t OFF_BZA = al256(OFF_YAPRE + SZ_ACT);
constexpr size_t OFF_Q = al256(OFF_BZA + SZ_ACT);
constexpr size_t OFF_ZB = al256(OFF_Q + SZ_ACT);
constexpr size_t OFF_UZ = al256(OFF_ZB + SZ_ACT);
constexpr size_t OFF_GV = al256(OFF_UZ + SZ_ACT);
constexpr size_t OFF_KV = al256(OFF_GV + SZ_ACT);
constexpr size_t OFF_GL = al256(OFF_KV + (size_t)R * 1536 * 2);
constexpr size_t OFF_GATES = al256(OFF_GL + (size_t)R * 48 * 4);
constexpr size_t OFF_YA = al256(OFF_GATES + (size_t)R * 3072 * 2);
constexpr size_t OFF_YB = al256(OFF_YA + SZ_ACT);
constexpr size_t OFF_YC = al256(OFF_YB + SZ_ACT);
constexpr size_t OFF_KCMP = al256(OFF_YC + SZ_ACT);
constexpr size_t OFF_VCMP = al256(OFF_KCMP + (size_t)NB * 4 * 256 * 64 * 2);
constexpr size_t OFF_STATS = al256(OFF_VCMP + (size_t)NB * 4 * 256 * 64 * 2);
constexpr size_t OFF_BAR = al256(OFF_STATS + (size_t)R * 2 * 4);
constexpr size_t WS_END = al256(OFF_BAR + 3456 * 4);

struct Params {
  const float *x, *c, *g_pre, *g_post, *w_ada, *b_ada, *w_in, *conv_w, *conv_b, *pos_ck, *w_ck1, *w_ck2,
      *pos_cv, *w_cv1, *w_cv2, *ln_g, *ln_b, *w_s, *b_s, *w_br, *w_out;
  float* out;
  unsigned char* ws;
};

typedef __bf16 bf16x2_native __attribute__((ext_vector_type(2)));
__device__ __forceinline__ uint32_t pack2(float a, float b) {
  f32x2 v = {a, b};
  return __builtin_bit_cast(uint32_t, __builtin_convertvector(v, bf16x2_native));
}
__device__ __forceinline__ bf16_t f2bf(float f) { return (bf16_t)(pack2(f, f) & 0xffffu); }
__device__ __forceinline__ float bf2f(uint32_t h) { return __uint_as_float(h << 16); }
__device__ __forceinline__ float sigmoid_(float x) { return __builtin_amdgcn_rcpf(1.f + __expf(-x)); }
__device__ __forceinline__ float silu_(float x) { return x * __builtin_amdgcn_rcpf(1.f + __expf(-x)); }
__device__ __forceinline__ float gelu_(float x) {
  float y = 0.7978845608f * (x + 0.044715f * x * x * x);
  return x * __builtin_amdgcn_rcpf(1.f + __expf(-2.f * y));
}
__device__ __forceinline__ f32x4 mfma16(bf16x8 a, bf16x8 b, f32x4 c) {
  return __builtin_amdgcn_mfma_f32_16x16x32_bf16(a, b, c, 0, 0, 0);
}
__device__ __forceinline__ float bperm(float v, int srclane) {
  return __int_as_float(__builtin_amdgcn_ds_bpermute(srclane << 2, __float_as_int(v)));
}
__device__ __forceinline__ float wave_sum(float v, int lane) {
#pragma unroll
  for (int o = 32; o >= 1; o >>= 1) v += bperm(v, lane ^ o);
  return v;
}

__device__ __forceinline__ int opaque_tid() {
  int t = threadIdx.x;
  asm volatile("" : "+v"(t));
  return t;
}

__device__ __forceinline__ int win_colmap(int np) {
  int tile = np >> 7, r = np & 127;
  if (tile < 32) { int wc = r >> 6, t = (r >> 4) & 3, i = r & 15; return A_OFF + t * 1024 + tile * 32 + wc * 16 + i; }
  if (tile < 40) return B_OFF + (np - 32 * 128);
  if (tile < 52) return B_OFF + 1024 + (np - 40 * 128);
  if (tile < 60) return B_OFF + 2560 + (np - 52 * 128);
  if (tile == 60) return r < 48 ? B_OFF + 3584 + r : -1;
  if (tile < 77) { int tb = tile - 61, wc = r >> 6, t = (r >> 4) & 3, i = r & 15; return C_OFF + ((t & 1) ? 2048 : 0) + tb * 64 + wc * 32 + (t >> 1) * 16 + i; }
  if (tile < 85) return C_OFF + 1024 + (np - 77 * 128);
  return G_OFF + (np - 85 * 128);
}

template <bool WIN>
__device__ __forceinline__ void transpose_tile(const float* __restrict__ src, int ld_src, bf16_t* __restrict__ dst, int Kdim, int n0, int k0, float* sm, int tid) {
  const int tx = tid & 63, ty = tid >> 6;
  const int col = WIN ? win_colmap(n0 + tx) : (n0 + tx);
  __syncthreads();
#pragma unroll
  for (int i = 0; i < 16; ++i) {
    int k = ty * 16 + i;
    float v = (col >= 0) ? src[(size_t)(k0 + k) * ld_src + col] : 0.f;
    sm[k * 65 + tx] = v;
  }
  __syncthreads();
#pragma unroll
  for (int i = 0; i < 16; ++i) {
    int n = ty * 16 + i;
    dst[(size_t)(n0 + n) * Kdim + k0 + tx] = f2bf(sm[tx * 65 + n]);
  }
}

__device__ __forceinline__ void phase0(const Params& p, char* smraw) {
  float* smf = (float*)smraw;
  const int bid = blockIdx.x, nblk = gridDim.x, tid = opaque_tid();
  bf16_t* WinT = (bf16_t*)(p.ws + OFF_WINT);
  bf16_t* WbrT = (bf16_t*)(p.ws + OFF_WBRT);
  bf16_t* WoutT = (bf16_t*)(p.ws + OFF_WOUTT);
  bf16_t* Wc1T = (bf16_t*)(p.ws + OFF_WC1T);
  bf16_t* Wm = (bf16_t*)(p.ws + OFF_WM);
  float* bias1 = (float*)(p.ws + OFF_BIAS1);
  float* mod = (float*)(p.ws + OFF_MOD);
  for (int t = bid; t < DEPTH * 218 * 16; t += nblk) {
    int l = t / (218 * 16), r = t % (218 * 16), nt = r >> 4, kt = r & 15;
    transpose_tile<true>(p.w_in + (size_t)l * D * IN_COLS, IN_COLS, WinT + (size_t)l * NP * D, D, nt * 64, kt * 64, smf, tid);
  }
  for (int t = bid; t < DEPTH * 3 * 256; t += nblk) {
    int li = t >> 8, r = t & 255, nt = r >> 4, kt = r & 15;
    transpose_tile<false>(p.w_br + (size_t)li * D * D, D, WbrT + (size_t)li * D * D, D, nt * 64, kt * 64, smf, tid);
  }
  for (int t = bid; t < DEPTH * 256; t += nblk) {
    int l = t >> 8, r = t & 255, nt = r >> 4, kt = r & 15;
    transpose_tile<false>(p.w_out + (size_t)l * D * D, D, WoutT + (size_t)l * D * D, D, nt * 64, kt * 64, smf, tid);
  }
  for (int t = bid; t < DEPTH * 2 * 64; t += nblk) {
    int lk = t >> 6, r = t & 63, nt = r >> 5, kt = r & 31;
    int l = lk >> 1, kv = lk & 1;
    const float* src = (kv ? p.w_cv1 : p.w_ck1) + (size_t)l * 2048 * 128;
    transpose_tile<false>(src, 128, Wc1T + (size_t)lk * 128 * 2048, 2048, nt * 64, kt * 64, smf, tid);
  }
  for (int e = bid * 256 + tid; e < DEPTH * 8 * 128 * 128; e += nblk * 256) {
    int j = e & 127, i = (e >> 7) & 127;
    Wm[e] = (j <= i) ? f2bf(p.w_s[e]) : (bf16_t)0;
  }
  for (int t = bid - 128; t >= 0 && t < DEPTH * 2 * 8; t += nblk) {
    int lk = t >> 3, ks = t & 7, l = lk >> 1, kv = lk & 1;
    const float* pos = (kv ? p.pos_cv : p.pos_ck) + (size_t)l * 2048;
    const float* w1 = (kv ? p.w_cv1 : p.w_ck1) + (size_t)l * 2048 * 128;
    int n = tid & 127, half = tid >> 7;
    float acc = 0.f;
    const int kb = ks * 256 + half * 128;
#pragma unroll 16
    for (int k = kb; k < kb + 128; ++k) acc += pos[k] * w1[(size_t)k * 128 + n];
    __syncthreads();
    smf[tid] = acc;
    __syncthreads();
    if (tid < 128) bias1[t * 128 + tid] = smf[tid] + smf[tid + 128];
  }
  for (int t = nblk - 1 - bid; t < DEPTH * 48; t += nblk) {
    int l = t / 48, ch = t % 48;
    int tx = tid & 63, ty = tid >> 6;
    int col = ch * 64 + tx;
    __syncthreads();
    for (int i = 0; i < 64; ++i) {
      int e = tid + 256 * i;
      smf[(e & 1023) * 16 + (e >> 10)] = silu_(p.c[e]);
    }
    __syncthreads();
    float acc[16];
#pragma unroll
    for (int b = 0; b < 16; ++b) acc[b] = 0.f;
    const float* w = p.w_ada + (size_t)l * D * 3072 + col;
#pragma unroll 8
    for (int k = ty * 256; k < ty * 256 + 256; ++k) {
      float wv = w[(size_t)k * 3072];
      const f32x4 s0 = *(const f32x4*)(smf + k * 16), s1 = *(const f32x4*)(smf + k * 16 + 4), s2 = *(const f32x4*)(smf + k * 16 + 8), s3 = *(const f32x4*)(smf + k * 16 + 12);
#pragma unroll
      for (int b = 0; b < 4; ++b) { acc[b] += s0[b] * wv; acc[4 + b] += s1[b] * wv; acc[8 + b] += s2[b] * wv; acc[12 + b] += s3[b] * wv; }
    }
    __syncthreads();
#pragma unroll
    for (int b = 0; b < 16; ++b) smf[(ty * 16 + b) * 64 + tx] = acc[b];
    __syncthreads();
    if (ty == 0) {
#pragma unroll
      for (int b = 0; b < 16; ++b) {
        float s_ = smf[b * 64 + tx] + smf[(16 + b) * 64 + tx] + smf[(32 + b) * 64 + tx] + smf[(48 + b) * 64 + tx];
        mod[((size_t)l * 16 + b) * 3072 + col] = s_ + p.b_ada[l * 3072 + col];
      }
    }
  }
}

__device__ __forceinline__ void write_h_row(const f32x4 (&xv)[4], float ss, const float* g_pre, const float* modl_b, bf16_t* hrow, int lane) {
  float rs = rsqrtf(ss * (1.f / 1024.f) + 1e-6f);
#pragma unroll
  for (int i = 0; i < 4; ++i) {
    int c = i * 256 + lane * 4;
    f32x4 g = *(const f32x4*)(g_pre + c);
    f32x4 sh = *(const f32x4*)(modl_b + c);
    f32x4 sc = *(const f32x4*)(modl_b + 1024 + c);
    float h0 = xv[i].x * rs * g.x * (1.f + sc.x) + sh.x;
    float h1 = xv[i].y * rs * g.y * (1.f + sc.y) + sh.y;
    float h2 = xv[i].z * rs * g.z * (1.f + sc.z) + sh.z;
    float h3 = xv[i].w * rs * g.w * (1.f + sc.w) + sh.w;
    u32x2 o; o.x = pack2(h0, h1); o.y = pack2(h2, h3);
    *(u32x2*)(hrow + c) = o;
  }
}

__device__ __forceinline__ void phase_h0(const Params& p, int grp_i) {
  const int tid = opaque_tid(); const int lane = tid & 63, w = tid >> 6;
  bf16_t* H = (bf16_t*)(p.ws + OFF_H);
  const float* mod = (const float*)(p.ws + OFF_MOD);
  for (int r = blockIdx.x * 4 + w; r < R; r += gridDim.x * 4) {
    size_t grow = (size_t)grp_i * R + r;
    int b = (int)(grow >> 12);
    const float* xr = p.x + grow * D;
    f32x4 xv[4]; float ss = 0.f;
#pragma unroll
    for (int i = 0; i < 4; ++i) {
      xv[i] = *(const f32x4*)(xr + i * 256 + lane * 4);
      ss += xv[i].x * xv[i].x + xv[i].y * xv[i].y + xv[i].z * xv[i].z + xv[i].w * xv[i].w;
    }
    ss = wave_sum(ss, lane);
    write_h_row(xv, ss, p.g_pre, mod + (size_t)b * 3072, H + (size_t)r * D, lane);
  }
}

__device__ __forceinline__ void phase_final(const Params& p, int grp_i, int l) {
  const int tid = opaque_tid(); const int lane = tid & 63, w = tid >> 6;
  bf16_t* H = (bf16_t*)(p.ws + OFF_H);
  const bf16_t* OP = (const bf16_t*)(p.ws + OFF_YAPRE);
  const float* mod = (const float*)(p.ws + OFF_MOD);
  const float* xin = (l == 0) ? p.x : p.out;
  for (int r = blockIdx.x * 4 + w; r < R; r += gridDim.x * 4) {
    size_t grow = (size_t)grp_i * R + r;
    int b = (int)(grow >> 12);
    const float* xr = xin + grow * D;
    const bf16_t* orow = OP + (size_t)r * D;
    const float* gate = mod + ((size_t)l * 16 + b) * 3072 + 2048;
    const float* gp = p.g_post + l * D;
    f32x4 xv[4], ov[4]; float ss = 0.f;
#pragma unroll
    for (int i = 0; i < 4; ++i) {
      int c = i * 256 + lane * 4;
      xv[i] = *(const f32x4*)(xr + c);
      u32x2 u = *(const u32x2*)(orow + c);
      ov[i].x = bf2f(u.x & 0xffffu); ov[i].y = bf2f(u.x >> 16); ov[i].z = bf2f(u.y & 0xffffu); ov[i].w = bf2f(u.y >> 16);
      ss += ov[i].x * ov[i].x + ov[i].y * ov[i].y + ov[i].z * ov[i].z + ov[i].w * ov[i].w;
    }
    ss = wave_sum(ss, lane);
    float rs = rsqrtf(ss * (1.f / 1024.f) + 1e-6f);
    float ss2 = 0.f;
#pragma unroll
    for (int i = 0; i < 4; ++i) {
      int c = i * 256 + lane * 4;
      f32x4 g = *(const f32x4*)(gp + c);
      f32x4 ga = *(const f32x4*)(gate + c);
      xv[i].x += ga.x * (ov[i].x * rs * g.x);
      xv[i].y += ga.y * (ov[i].y * rs * g.y);
      xv[i].z += ga.z * (ov[i].z * rs * g.z);
      xv[i].w += ga.w * (ov[i].w * rs * g.w);
      *(f32x4*)(p.out + grow * D + c) = xv[i];
      ss2 += xv[i].x * xv[i].x + xv[i].y * xv[i].y + xv[i].z * xv[i].z + xv[i].w * xv[i].w;
    }
    if (l == 0) {
      ss2 = wave_sum(ss2, lane);
      write_h_row(xv, ss2, p.g_pre + D, mod + ((size_t)16 + b) * 3072, H + (size_t)r * D, lane);
    }
  }
}

struct StdLoader {
  const bf16_t* base;
  int soff;
  u32x4 r0, r1;
  __device__ __forceinline__ void init(const bf16_t* tile_base, size_t ld, int tid) {
    base = tile_base + (size_t)(tid >> 1) * ld + (tid & 1) * 16;
    soff = (tid >> 1) * LDK + (tid & 1) * 16;
  }
  __device__ __forceinline__ void load(int kt) {
    const bf16_t* q = base + kt * 32;
    r0 = *(const u32x4*)q; r1 = *(const u32x4*)(q + 8);
  }
  __device__ __forceinline__ void store(bf16_t* tile) {
    bf16_t* q = tile + soff;
    *(u32x4*)q = r0; *(u32x4*)(q + 8) = r1;
  }
};

template <class AL, class BL>
__device__ __forceinline__ void gemm_core(f32x4 (&acc)[4][4], AL& al, BL& bl, int nk, bf16_t* sm, int tid) {
  const int lane = tid & 63, w = tid >> 6, wr = w >> 1, wc = w & 1, l15 = lane & 15, grp = lane >> 4;
  al.load(0); bl.load(0);
  __syncthreads();
  al.store(sm); bl.store(sm + 2 * 128 * LDK);
  __syncthreads();
  for (int kt = 0; kt < nk; ++kt) {
    const bf16_t* Ab = sm + (kt & 1) * 128 * LDK;
    const bf16_t* Bb = sm + (2 + (kt & 1)) * 128 * LDK;
    if (kt + 1 < nk) { al.load(kt + 1); bl.load(kt + 1); }
    bf16x8 a[4], b[4];
#pragma unroll
    for (int m = 0; m < 4; ++m) a[m] = *(const bf16x8*)(Ab + (wr * 64 + m * 16 + l15) * LDK + grp * 8);
#pragma unroll
    for (int n = 0; n < 4; ++n) b[n] = *(const bf16x8*)(Bb + (wc * 64 + n * 16 + l15) * LDK + grp * 8);
#pragma unroll
    for (int m = 0; m < 4; ++m)
#pragma unroll
      for (int n = 0; n < 4; ++n) acc[m][n] = mfma16(a[m], b[n], acc[m][n]);
    if (kt + 1 < nk) {
      al.store(sm + ((kt + 1) & 1) * 128 * LDK);
      bl.store(sm + (2 + ((kt + 1) & 1)) * 128 * LDK);
    }
    __syncthreads();
  }
}

struct Regs4 { u32x4 r0, r1, r2, r3; };
struct StdLoader64 {
  typedef Regs4 Regs;
  const bf16_t* base;
  size_t ld32;
  int soff;
  __device__ __forceinline__ void init(const bf16_t* tile_base, size_t ld, int tid) {
    base = tile_base + (size_t)(tid >> 3) * ld + (tid & 7) * 8;
    ld32 = ld * 32;
    soff = (tid >> 3) * 64 + (((tid & 7) ^ ((tid >> 4) & 7)) * 8);
  }
  __device__ __forceinline__ void load(int kt, Regs& r) const {
    const bf16_t* q = base + kt * 64;
    r.r0 = *(const u32x4*)q; r.r1 = *(const u32x4*)(q + ld32); r.r2 = *(const u32x4*)(q + 2 * ld32); r.r3 = *(const u32x4*)(q + 3 * ld32);
  }
  __device__ __forceinline__ void store(bf16_t* tile, const Regs& r) const {
    bf16_t* q = tile + soff;
    *(u32x4*)q = r.r0; *(u32x4*)(q + 2048) = r.r1; *(u32x4*)(q + 4096) = r.r2; *(u32x4*)(q + 6144) = r.r3;
  }
};

template <int NST, class AL, class BL>
__device__ __forceinline__ void gemm_core64(f32x4 (&acc)[4][4], const AL& al, const BL& bl, int nk, bf16_t* sm, int tid) {
  const int lane = tid & 63, w = tid >> 6, wr = w >> 1, wc = w & 1, l15 = lane & 15, grp = lane >> 4;
  constexpr int TILE = 128 * 64;
  const int sw = (l15 >> 1) & 7;
  const int fo0 = l15 * 64 + ((grp ^ sw) * 8), fo1 = l15 * 64 + (((4 + grp) ^ sw) * 8);
  typename AL::Regs ra[NST];
  typename BL::Regs rb[NST];
#pragma unroll
  for (int s_ = 0; s_ < NST; ++s_) { al.load(s_, ra[s_]); bl.load(s_, rb[s_]); }
  __syncthreads();
  al.store(sm, ra[0]); bl.store(sm + 2 * TILE, rb[0]);
  { const int k2 = NST < nk ? NST : nk - 1; al.load(k2, ra[0]); bl.load(k2, rb[0]); }
  __syncthreads();
  for (int kt0 = 0; kt0 < nk; kt0 += NST) {
#pragma unroll
    for (int u = 0; u < NST; ++u) {
      const int kt = kt0 + u;
      const bf16_t* Ab = sm + (kt & 1) * TILE + wr * 64 * 64;
      const bf16_t* Bb = sm + (2 + (kt & 1)) * TILE + wc * 64 * 64;
#pragma unroll
      for (int ks = 0; ks < 2; ++ks) {
        const int fo = ks ? fo1 : fo0;
        bf16x8 a[4], b[4];
#pragma unroll
        for (int m = 0; m < 4; ++m) a[m] = *(const bf16x8*)(Ab + m * 16 * 64 + fo);
#pragma unroll
        for (int n = 0; n < 4; ++n) b[n] = *(const bf16x8*)(Bb + n * 16 * 64 + fo);
#pragma unroll
        for (int m = 0; m < 4; ++m)
#pragma unroll
          for (int n = 0; n < 4; ++n) acc[m][n] = mfma16(b[n], a[m], acc[m][n]);
      }
      al.store(sm + ((kt + 1) & 1) * TILE, ra[(u + 1) % NST]);
      bl.store(sm + (2 + ((kt + 1) & 1)) * TILE, rb[(u + 1) % NST]);
      {
        int k2 = kt + 1 + NST;
        k2 = k2 < nk ? k2 : nk - 1;
        al.load(k2, ra[(u + 1) % NST]); bl.load(k2, rb[(u + 1) % NST]);
      }
      __syncthreads();
    }
  }
}

__device__ __forceinline__ void glds_prefetch0(const bf16_t* Atile, size_t lda, const bf16_t* Btile, size_t ldb, bf16_t* sm, int tid) {
  constexpr int TILE = 128 * 64;
  const int gch = ((tid & 7) ^ ((tid >> 4) & 7)) * 8;
  const bf16_t* ga = Atile + (size_t)(tid >> 3) * lda + gch;
  const bf16_t* gb = Btile + (size_t)(tid >> 3) * ldb + gch;
  const size_t a32 = lda * 32, b32 = ldb * 32;
  bf16_t* lbase = sm + tid * 8;
#pragma unroll
  for (int i_ = 0; i_ < 4; ++i_) {
    __builtin_amdgcn_global_load_lds((const unsigned*)(ga + i_ * a32), (unsigned*)(lbase + i_ * 2048), 16, 0, 0);
    __builtin_amdgcn_global_load_lds((const unsigned*)(gb + i_ * b32), (unsigned*)(lbase + 2 * TILE + i_ * 2048), 16, 0, 0);
  }
}

#define DSR1(dst, base, OFF) asm volatile("ds_read_b128 %0, %1 offset:" #OFF : "=v"(dst) : "v"(base) : "memory")
#define DSR4(arr, base) do { DSR1(arr[0], base, 0); DSR1(arr[1], base, 2048); DSR1(arr[2], base, 4096); DSR1(arr[3], base, 6144); } while (0)
template <bool HOIST>
__device__ __forceinline__ void gemm_core_glds(f32x4 (&acc)[4][4], const bf16_t* Atile, size_t lda, const bf16_t* Btile, size_t ldb,
                                               int nk, bf16_t* sm, int tid) {
  const int lane = tid & 63, w = tid >> 6, wr = w >> 1, wc = w & 1, l15 = lane & 15, grp = lane >> 4;
  constexpr int TILE = 128 * 64;
  const int sw = (l15 >> 1) & 7;
  const int fo0 = l15 * 64 + ((grp ^ sw) * 8), fo1 = l15 * 64 + (((4 + grp) ^ sw) * 8);
  const int gch = ((tid & 7) ^ ((tid >> 4) & 7)) * 8;
  const bf16_t* ga = Atile + (size_t)(tid >> 3) * lda + gch;
  const bf16_t* gb = Btile + (size_t)(tid >> 3) * ldb + gch;
  const size_t a32 = lda * 32, b32 = ldb * 32;
  bf16_t* lbase = sm + tid * 8;
#define GLDS_ISSUE(KT, BUF)                                                                                                            \
  do {                                                                                                                                 \
    _Pragma("unroll") for (int i_ = 0; i_ < 4; ++i_) {                                                                                 \
      __builtin_amdgcn_global_load_lds((const unsigned*)(ga + i_ * a32 + (KT) * 64), (unsigned*)(lbase + (BUF) * TILE + i_ * 2048), 16, 0, 0);       \
      __builtin_amdgcn_global_load_lds((const unsigned*)(gb + i_ * b32 + (KT) * 64), (unsigned*)(lbase + (2 + (BUF)) * TILE + i_ * 2048), 16, 0, 0); \
    }                                                                                                                                  \
  } while (0)
#define GLDS_COMPUTE(BUF)                                                                             \
  do {                                                                                                \
    const bf16_t* Ab = sm + (BUF) * TILE + wr * 64 * 64;                                              \
    const bf16_t* Bb = sm + (2 + (BUF)) * TILE + wc * 64 * 64;                                        \
    if (HOIST) {                                                                                      \
        \
      bf16x8 a0[4], b0[4], a1[4], b1[4];                                                              \
      const unsigned pa0 = (unsigned)(size_t)(Ab + fo0), pb0 = (unsigned)(size_t)(Bb + fo0);          \
      const unsigned pa1 = (unsigned)(size_t)(Ab + fo1), pb1 = (unsigned)(size_t)(Bb + fo1);          \
      DSR4(a0, pa0); DSR4(b0, pb0); DSR4(a1, pa1); DSR4(b1, pb1);                                     \
      asm volatile("s_waitcnt lgkmcnt(8)" : "+v"(a0[0]), "+v"(a0[1]), "+v"(a0[2]), "+v"(a0[3]), "+v"(b0[0]), "+v"(b0[1]), "+v"(b0[2]), "+v"(b0[3]) :: "memory"); \
      _Pragma("unroll") for (int m = 0; m < 4; ++m)                                                   \
        _Pragma("unroll") for (int n = 0; n < 4; ++n) acc[m][n] = mfma16(b0[n], a0[m], acc[m][n]);    \
      __builtin_amdgcn_sched_barrier(0);             \
      asm volatile("s_waitcnt lgkmcnt(0)" : "+v"(a1[0]), "+v"(a1[1]), "+v"(a1[2]), "+v"(a1[3]), "+v"(b1[0]), "+v"(b1[1]), "+v"(b1[2]), "+v"(b1[3]) :: "memory"); \
      _Pragma("unroll") for (int m = 0; m < 4; ++m)                                                   \
        _Pragma("unroll") for (int n = 0; n < 4; ++n) acc[m][n] = mfma16(b1[n], a1[m], acc[m][n]);    \
      __builtin_amdgcn_sched_barrier(0);             \
    } else {                                                                                          \
      _Pragma("unroll") for (int ks = 0; ks < 2; ++ks) {                                              \
        const int fo = ks ? fo1 : fo0;                                                                \
        bf16x8 a[4], b[4];                                                                            \
        _Pragma("unroll") for (int m = 0; m < 4; ++m) a[m] = *(const bf16x8*)(Ab + m * 16 * 64 + fo); \
        _Pragma("unroll") for (int n = 0; n < 4; ++n) b[n] = *(const bf16x8*)(Bb + n * 16 * 64 + fo); \
        _Pragma("unroll") for (int m = 0; m < 4; ++m)                                                 \
          _Pragma("unroll") for (int n = 0; n < 4; ++n) acc[m][n] = mfma16(b[n], a[m], acc[m][n]);     \
      }                                                                                               \
    }                                                                                                 \
  } while (0)
  asm volatile("s_waitcnt vmcnt(0)" ::: "memory");
  __syncthreads();
  for (int kt = 0; kt < nk; kt += 2) {
    GLDS_ISSUE(kt + 1, 1);
    GLDS_COMPUTE(0);
    asm volatile("s_waitcnt vmcnt(0)" ::: "memory");
    __syncthreads();
    if (kt + 2 < nk) GLDS_ISSUE(kt + 2, 0);
    GLDS_COMPUTE(1);
    asm volatile("s_waitcnt vmcnt(0)" ::: "memory");
    __syncthreads();
  }
#undef GLDS_ISSUE
#undef GLDS_COMPUTE
}

__device__ __forceinline__ void gemm_core_glds_cmp(f32x4 (&acc)[4][4], const bf16_t* colptr, int r0, const bf16_t* Btile, size_t ldb,
                                                   int nk, bf16_t* sm, int tid) {
  const int lane = tid & 63, w = tid >> 6, wr = w >> 1, wc = w & 1, l15 = lane & 15, grp = lane >> 4;
  constexpr int TILE = 128 * 64;
  const int sw = (l15 >> 1) & 7;
  const int fo0 = l15 * 64 + ((grp ^ sw) * 8), fo1 = l15 * 64 + (((4 + grp) ^ sw) * 8);
  const int gch = ((tid & 7) ^ ((tid >> 4) & 7)) * 8;
  const bf16_t* gb = Btile + (size_t)(tid >> 3) * ldb + gch;
  const size_t b32 = ldb * 32;
  bf16_t* lbase = sm + tid * 8;
#define CMP_ISSUE(KT, BUF)                                                                                                             \
  do {                                                                                                                                 \
    _Pragma("unroll") for (int i_ = 0; i_ < 4; ++i_) {                                                                                 \
      int tok_ = 16 * (r0 + 32 * i_) + (KT);                                                                                           \
      tok_ = tok_ > (SEQ - 1) ? (SEQ - 1) : tok_;                                                                                      \
      __builtin_amdgcn_global_load_lds((const unsigned*)(colptr + (size_t)tok_ * 1536), (unsigned*)(lbase + (BUF) * TILE + i_ * 2048), 16, 0, 0);     \
      __builtin_amdgcn_global_load_lds((const unsigned*)(gb + i_ * b32 + (KT) * 64), (unsigned*)(lbase + (2 + (BUF)) * TILE + i_ * 2048), 16, 0, 0); \
    }                                                                                                                                  \
  } while (0)
#define CMP_COMPUTE(BUF)                                                                              \
  do {                                                                                                \
    const bf16_t* Ab = sm + (BUF) * TILE + wr * 64 * 64;                                              \
    const bf16_t* Bb = sm + (2 + (BUF)) * TILE + wc * 64 * 64;                                        \
    _Pragma("unroll") for (int ks = 0; ks < 2; ++ks) {                                                \
      const int fo = ks ? fo1 : fo0;                                                                  \
      bf16x8 a[4], b[4];                                                                              \
      _Pragma("unroll") for (int m = 0; m < 4; ++m) a[m] = *(const bf16x8*)(Ab + m * 16 * 64 + fo);   \
      _Pragma("unroll") for (int n = 0; n < 4; ++n) b[n] = *(const bf16x8*)(Bb + n * 16 * 64 + fo);   \
      _Pragma("unroll") for (int m = 0; m < 4; ++m)                                                   \
        _Pragma("unroll") for (int n = 0; n < 4; ++n) acc[m][n] = mfma16(b[n], a[m], acc[m][n]);     \
    }                                                                                                 \
  } while (0)
  __syncthreads();
  CMP_ISSUE(0, 0);
  asm volatile("s_waitcnt vmcnt(0)" ::: "memory");
  __syncthreads();
  for (int kt = 0; kt < nk; kt += 2) {
    CMP_ISSUE(kt + 1, 1);
    CMP_COMPUTE(0);
    asm volatile("s_waitcnt vmcnt(0)" ::: "memory");
    __syncthreads();
    if (kt + 2 < nk) CMP_ISSUE(kt + 2, 0);
    CMP_COMPUTE(1);
    asm volatile("s_waitcnt vmcnt(0)" ::: "memory");
    __syncthreads();
  }
#undef CMP_ISSUE
#undef CMP_COMPUTE
}

__device__ __forceinline__ void zero_acc(f32x4 (&acc)[4][4]) {
#pragma unroll
  for (int m = 0; m < 4; ++m)
#pragma unroll
    for (int n = 0; n < 4; ++n) acc[m][n] = f32x4{0.f, 0.f, 0.f, 0.f};
}

__device__ __forceinline__ void phase_inproj(const Params& p, int l, char* smraw) {
  bf16_t* sm = (bf16_t*)smraw;
  const bf16_t* H = (const bf16_t*)(p.ws + OFF_H);
  const bf16_t* W = (const bf16_t*)(p.ws + OFF_WINT) + (size_t)l * NP * D;
  bf16_t* yApre = (bf16_t*)(p.ws + OFF_YAPRE);
  bf16_t* bzA = (bf16_t*)(p.ws + OFF_BZA);
  bf16_t* qb = (bf16_t*)(p.ws + OFF_Q);
  bf16_t* zb = (bf16_t*)(p.ws + OFF_ZB);
  bf16_t* uz = (bf16_t*)(p.ws + OFF_UZ);
  bf16_t* gv = (bf16_t*)(p.ws + OFF_GV);
  bf16_t* kvb = (bf16_t*)(p.ws + OFF_KV);
  float* glb = (float*)(p.ws + OFF_GL);
  bf16_t* gates = (bf16_t*)(p.ws + OFF_GATES);
  const int tid = opaque_tid(); const int lane = tid & 63, w = tid >> 6, wr = w >> 1, wc = w & 1, l15 = lane & 15, grp = lane >> 4;
  constexpr int MT = R / 128;
  constexpr int NC = (NT_IN + 7) / 8;
  const int nx = gridDim.x >> 3;
  constexpr int CJ_END = (MT / 8) * NC * 64;
  auto cj_valid = [&](int c) { return c < CJ_END && ((c >> 6) % NC) * 8 + ((c & 63) >> 3) < NT_IN; };
  auto cj_next = [&](int c) {
    do { c = ((c & 63) + nx < 64) ? (c + nx) : (((c >> 6) + 8) * 64 + (int)(blockIdx.x >> 3)); } while (c < CJ_END && !cj_valid(c));
    return c;
  };
  int cj = (blockIdx.x & 7) * 64 + (blockIdx.x >> 3);
  if (!cj_valid(cj)) cj = cj_next(cj);
  __syncthreads();
  if (cj < CJ_END) {
    const int cell = cj >> 6, jj = cj & 63;
    glds_prefetch0(H + (size_t)((cell / NC) * 8 + (jj & 7)) * 128 * D, D, W + (size_t)((cell % NC) * 8 + (jj >> 3)) * 128 * D, D, sm, tid);
  }
  while (cj < CJ_END) {
    const int cell = cj >> 6, jj = cj & 63;
    const int nt = (cell % NC) * 8 + (jj >> 3), mt = (cell / NC) * 8 + (jj & 7);
    f32x4 acc[4][4];
    zero_acc(acc);
    gemm_core_glds<true>(acc, H + (size_t)mt * 128 * D, D, W + (size_t)nt * 128 * D, D, D / 64, sm, tid);
    cj = cj_next(cj);
    if (cj < CJ_END) {
      const int cell2 = cj >> 6, jj2 = cj & 63;
      glds_prefetch0(H + (size_t)((cell2 / NC) * 8 + (jj2 & 7)) * 128 * D, D, W + (size_t)((cell2 % NC) * 8 + (jj2 >> 3)) * 128 * D, D, sm, tid);
    }
    const int rbase = mt * 128 + wr * 64 + l15;
    const int c4 = 4 * grp;
#define ST4(PTR, V0, V1, V2, V3) *(u32x2*)(PTR) = u32x2{pack2((V0), (V1)), pack2((V2), (V3))}
    if (nt < 32) {
      const int ch = nt * 32 + wc * 16 + c4;
#pragma unroll
      for (int m = 0; m < 4; ++m) {
        const size_t row = rbase + m * 16;
        ST4(yApre + row * 1024 + ch, acc[m][1][0] * acc[m][2][0], acc[m][1][1] * acc[m][2][1], acc[m][1][2] * acc[m][2][2], acc[m][1][3] * acc[m][2][3]);
        ST4(bzA + row * 1024 + ch, acc[m][0][0] * silu_(acc[m][3][0]), acc[m][0][1] * silu_(acc[m][3][1]), acc[m][0][2] * silu_(acc[m][3][2]), acc[m][0][3] * silu_(acc[m][3][3]));
      }
    } else if (nt < 40) {
      const int cb = (nt - 32) * 128 + wc * 64 + c4;
      const float qs = 0.125f * 1.44269504f;
#pragma unroll
      for (int m = 0; m < 4; ++m)
#pragma unroll
        for (int n = 0; n < 4; ++n)
          ST4(qb + (size_t)(rbase + m * 16) * 1024 + cb + n * 16, acc[m][n][0] * qs, acc[m][n][1] * qs, acc[m][n][2] * qs, acc[m][n][3] * qs);
    } else if (nt < 52) {
      const int cb = (nt - 40) * 128 + wc * 64 + c4;
#pragma unroll
      for (int m = 0; m < 4; ++m)
#pragma unroll
        for (int n = 0; n < 4; ++n)
          ST4(kvb + (size_t)(rbase + m * 16) * 1536 + cb + n * 16, acc[m][n][0], acc[m][n][1], acc[m][n][2], acc[m][n][3]);
    } else if (nt < 60) {
      const int cb = (nt - 52) * 128 + wc * 64 + c4;
#pragma unroll
      for (int m = 0; m < 4; ++m)
#pragma unroll
        for (int n = 0; n < 4; ++n)
          ST4(zb + (size_t)(rbase + m * 16) * 1024 + cb + n * 16, silu_(acc[m][n][0]), silu_(acc[m][n][1]), silu_(acc[m][n][2]), silu_(acc[m][n][3]));
    } else if (nt == 60) {
      if (wc == 0) {
#pragma unroll
        for (int m = 0; m < 4; ++m)
#pragma unroll
          for (int n = 0; n < 3; ++n)
            *(f32x4*)(glb + (size_t)(rbase + m * 16) * 48 + n * 16 + c4) =
                f32x4{sigmoid_(acc[m][n][0]), sigmoid_(acc[m][n][1]), sigmoid_(acc[m][n][2]), sigmoid_(acc[m][n][3])};
      }
    } else if (nt < 77) {
      const int chb = (nt - 61) * 64 + wc * 32 + c4;
#pragma unroll
      for (int m = 0; m < 4; ++m)
#pragma unroll
        for (int pr = 0; pr < 2; ++pr)
          ST4(uz + (size_t)(rbase + m * 16) * 1024 + chb + pr * 16,
              gelu_(acc[m][2 * pr][0]) * silu_(acc[m][2 * pr + 1][0]), gelu_(acc[m][2 * pr][1]) * silu_(acc[m][2 * pr + 1][1]),
              gelu_(acc[m][2 * pr][2]) * silu_(acc[m][2 * pr + 1][2]), gelu_(acc[m][2 * pr][3]) * silu_(acc[m][2 * pr + 1][3]));
    } else if (nt < 85) {
      const int cb = (nt - 77) * 128 + wc * 64 + c4;
#pragma unroll
      for (int m = 0; m < 4; ++m)
#pragma unroll
        for (int n = 0; n < 4; ++n)
          ST4(gv + (size_t)(rbase + m * 16) * 1024 + cb + n * 16, gelu_(acc[m][n][0]), gelu_(acc[m][n][1]), gelu_(acc[m][n][2]), gelu_(acc[m][n][3]));
    } else {
      const int cb = (nt - 85) * 128 + wc * 64 + c4;
#pragma unroll
      for (int m = 0; m < 4; ++m)
#pragma unroll
        for (int n = 0; n < 4; ++n)
          ST4(gates + (size_t)(rbase + m * 16) * 3072 + cb + n * 16, sigmoid_(acc[m][n][0]), sigmoid_(acc[m][n][1]), sigmoid_(acc[m][n][2]), sigmoid_(acc[m][n][3]));
    }
#undef ST4
  }
}

struct CmpALoader {
  const bf16_t* rowptr;
  int r, soff;
  u32x4 r0, r1;
  __device__ __forceinline__ void load(int kt) {
    int tok = 16 * r + (kt >> 1);
    tok = tok > (SEQ - 1) ? (SEQ - 1) : tok;
    const bf16_t* q = rowptr + (size_t)tok * 1536 + (kt & 1) * 32;
    r0 = *(const u32x4*)q; r1 = *(const u32x4*)(q + 8);
  }
  __device__ __forceinline__ void store(bf16_t* tile) {
    bf16_t* q = tile + soff;
    *(u32x4*)q = r0; *(u32x4*)(q + 8) = r1;
  }
};

__device__ __forceinline__ void phase_mix1(const Params& p, int l, char* smraw) {
  const int tid = opaque_tid(); const int lane = tid & 63, w = tid >> 6, l15 = lane & 15, grp = lane >> 4;
  const bf16_t* gv = (const bf16_t*)(p.ws + OFF_GV);
  float* stats = (float*)(p.ws + OFF_STATS);
  constexpr int NCB = 2 * (NB * 4 * 256 / 128);
  const bool split = (int)gridDim.x >= 2 * NCB;
  const int eb = split ? (int)blockIdx.x - NCB : (int)blockIdx.x;
  const int neb = split ? (int)gridDim.x - NCB : (int)gridDim.x;
  for (int r = eb * 4 + w; eb >= 0 && r < R; r += neb * 4) {
    const bf16_t* row = gv + (size_t)r * 1024;
    float v[16]; float s = 0.f;
#pragma unroll
    for (int i = 0; i < 2; ++i) {
      u32x4 u = *(const u32x4*)(row + i * 512 + lane * 8);
      v[i * 8 + 0] = bf2f(u.x & 0xffffu); v[i * 8 + 1] = bf2f(u.x >> 16);
      v[i * 8 + 2] = bf2f(u.y & 0xffffu); v[i * 8 + 3] = bf2f(u.y >> 16);
      v[i * 8 + 4] = bf2f(u.z & 0xffffu); v[i * 8 + 5] = bf2f(u.z >> 16);
      v[i * 8 + 6] = bf2f(u.w & 0xffffu); v[i * 8 + 7] = bf2f(u.w >> 16);
    }
#pragma unroll
    for (int i = 0; i < 16; ++i) s += v[i];
    s = wave_sum(s, lane);
    float mu = s * (1.f / 1024.f);
    float q = 0.f;
#pragma unroll
    for (int i = 0; i < 16; ++i) { float d = v[i] - mu; q += d * d; }
    q = wave_sum(q, lane);
    if (lane == 0) { stats[r * 2] = mu; stats[r * 2 + 1] = rsqrtf(q * (1.f / 1024.f) + 1e-6f); }
  }
  {
    const bf16_t* yApre = (const bf16_t*)(p.ws + OFF_YAPRE);
    const bf16_t* bzA = (const bf16_t*)(p.ws + OFF_BZA);
    bf16_t* yA = (bf16_t*)(p.ws + OFF_YA);
    const float* cw = p.conv_w + (size_t)l * 3 * 1024;
    const float* cb = p.conv_b + (size_t)l * 1024;
    for (int e = eb * 256 + tid; eb >= 0 && e < R * 128; e += neb * 256) {
      int row = e >> 7, c8 = (e & 127) * 8;
      int t = row & (SEQ - 1);
      u32x4 y2 = *(const u32x4*)(yApre + (size_t)row * 1024 + c8);
      u32x4 y1 = (t >= 1) ? *(const u32x4*)(yApre + (size_t)(row - 1) * 1024 + c8) : u32x4{0, 0, 0, 0};
      u32x4 y0 = (t >= 2) ? *(const u32x4*)(yApre + (size_t)(row - 2) * 1024 + c8) : u32x4{0, 0, 0, 0};
      u32x4 bz = *(const u32x4*)(bzA + (size_t)row * 1024 + c8);
      u32x4 o;
#pragma unroll
      for (int i = 0; i < 4; ++i) {
        int c = c8 + i * 2;
        float r0 = cb[c] + cw[c] * bf2f(y0[i] & 0xffffu) + cw[1024 + c] * bf2f(y1[i] & 0xffffu) + cw[2048 + c] * bf2f(y2[i] & 0xffffu);
        float r1 = cb[c + 1] + cw[c + 1] * bf2f(y0[i] >> 16) + cw[1024 + c + 1] * bf2f(y1[i] >> 16) + cw[2048 + c + 1] * bf2f(y2[i] >> 16);
        o[i] = pack2(bf2f(bz[i] & 0xffffu) * r0, bf2f(bz[i] >> 16) * r1);
      }
      *(u32x4*)(yA + (size_t)row * 1024 + c8) = o;
    }
  }
  {
    bf16_t* sm = (bf16_t*)smraw;
    const bf16_t* kvb = (const bf16_t*)(p.ws + OFF_KV);
    const bf16_t* Wc1T = (const bf16_t*)(p.ws + OFF_WC1T);
    const float* bias1 = (const float*)(p.ws + OFF_BIAS1);
    const int wr = w >> 1, wc = w & 1;
    constexpr int MTC = NB * 4 * 256 / 128;
    for (int t = blockIdx.x; t < 2 * MTC; t += gridDim.x) {
      int kv = t / MTC, mt = t % MTC;
      f32x4 acc[4][4];
      zero_acc(acc);
      {
        const int rr = mt * 128 + (tid >> 3);
        const int bl = rr >> 10, g = (rr >> 8) & 3;
        const int gch = ((tid & 7) ^ ((tid >> 4) & 7)) * 8;
        gemm_core_glds_cmp(acc, kvb + (size_t)bl * SEQ * 1536 + kv * 256 + g * 64 + gch, rr & 255,
                           Wc1T + (size_t)(l * 2 + kv) * 128 * 2048, 2048, 2048 / 64, sm, tid);
      }
      bf16_t* Hs = sm;
      bf16_t* W2s = sm + 128 * HS_LD;
      const float* b1 = bias1 + (l * 2 + kv) * 8 * 128;
#pragma unroll
      for (int n = 0; n < 4; ++n) {
        const int col = wc * 64 + n * 16 + 4 * grp;
        f32x4 bb = f32x4{0.f, 0.f, 0.f, 0.f};
#pragma unroll
        for (int ks = 0; ks < 8; ++ks) bb += *(const f32x4*)(b1 + ks * 128 + col);
#pragma unroll
        for (int m = 0; m < 4; ++m)
          *(u32x2*)(Hs + (wr * 64 + m * 16 + l15) * HS_LD + col) =
              u32x2{pack2(silu_(acc[m][n][0] + bb[0]), silu_(acc[m][n][1] + bb[1])), pack2(silu_(acc[m][n][2] + bb[2]), silu_(acc[m][n][3] + bb[3]))};
      }
      const float* w2 = (kv ? p.w_cv2 : p.w_ck2) + (size_t)l * 128 * 64;
      for (int i = 0; i < 32; ++i) {
        int e = tid + 256 * i;
        int j = e >> 6, d = e & 63;
        W2s[d * HS_LD + j] = f2bf(w2[e]);
      }
      __syncthreads();
      f32x4 a2[2][4];
#pragma unroll
      for (int mm = 0; mm < 2; ++mm)
#pragma unroll
        for (int nn = 0; nn < 4; ++nn) a2[mm][nn] = f32x4{0.f, 0.f, 0.f, 0.f};
#pragma unroll
      for (int ks = 0; ks < 4; ++ks) {
        bf16x8 af[2], bfr[4];
#pragma unroll
        for (int mm = 0; mm < 2; ++mm) af[mm] = *(const bf16x8*)(Hs + (w * 32 + mm * 16 + l15) * HS_LD + ks * 32 + grp * 8);
#pragma unroll
        for (int nn = 0; nn < 4; ++nn) bfr[nn] = *(const bf16x8*)(W2s + (nn * 16 + l15) * HS_LD + ks * 32 + grp * 8);
#pragma unroll
        for (int mm = 0; mm < 2; ++mm)
#pragma unroll
          for (int nn = 0; nn < 4; ++nn) a2[mm][nn] = mfma16(af[mm], bfr[nn], a2[mm][nn]);
      }
      bf16_t* outp = (bf16_t*)(p.ws + (kv ? OFF_VCMP : OFF_KCMP));
#pragma unroll
      for (int mm = 0; mm < 2; ++mm)
#pragma unroll
        for (int nn = 0; nn < 4; ++nn)
#pragma unroll
          for (int j = 0; j < 4; ++j) {
            int row = mt * 128 + w * 32 + mm * 16 + 4 * grp + j;
            outp[(size_t)row * 64 + nn * 16 + l15] = f2bf(a2[mm][nn][j]);
          }
      __syncthreads();
    }
  }
}

struct KVRegs { u32x4 k0, k1, v0, v1; };

__device__ __forceinline__ void kv_issue(KVRegs& r, const bf16_t* kbase, const bf16_t* vbase, size_t ld, bool wantV, int tid) {
  const uint32_t row = (uint32_t)tid >> 2, c = ((uint32_t)tid & 3u) * 16u;
  const uint32_t off = (ld == 64 ? row * 64u : row * 1536u) + c;
  const bf16_t* kp = kbase + off;
  r.k0 = *(const u32x4*)kp; r.k1 = *(const u32x4*)(kp + 8);
  if (wantV) {
    const bf16_t* vp = vbase + off;
    r.v0 = *(const u32x4*)vp; r.v1 = *(const u32x4*)(vp + 8);
  }
}
__device__ __forceinline__ void kv_commit(const KVRegs& r, bf16_t* Ks, bf16_t* Vs, bool wantV, int tid) {
  int row = tid >> 2, c = (tid & 3) * 16;
  *(u32x4*)(Ks + row * KS_LD + c) = r.k0;
  *(u32x4*)(Ks + row * KS_LD + c + 8) = r.k1;
  if (wantV) {
    *(u32x4*)(Vs + row * KS_LD + c) = r.v0;
    *(u32x4*)(Vs + row * KS_LD + c + 8) = r.v1;
  }
}

typedef short s16x4 __attribute__((ext_vector_type(4)));
__device__ __forceinline__ s16x4 tr_read(const bf16_t* ptr) {
  return __builtin_amdgcn_ds_read_tr16_b64_v4i16((s16x4 __attribute__((address_space(3)))*)ptr);
}

#define ADSR(dst, base, OFF) asm volatile("ds_read_b128 %0, %1 offset:" #OFF : "=v"(dst) : "v"(base) : "memory")
#define ATRR(dst, base, OFF) asm volatile("ds_read_b64_tr_b16 %0, %1 offset:" #OFF : "=v"(dst) : "v"(base) : "memory")
template <bool MASKED>
__device__ __forceinline__ void attn_block64(const bf16_t* Ks, const bf16_t* Vs, bf16x8 q0, bf16x8 q1, int tq, int kp0, int kpstride,
                                             int maxdist, bool extra_ok, float slope, float& m, float& lsum, f32x4 (&o)[4], int l15, int grp,
                                             const f32x4 (&tb)[4]) {
  const float fst = (float)kpstride;
  const int d0 = tq - kp0 - 4 * grp * kpstride;
  const float base = -slope * (float)d0;
  const unsigned kaddr = (unsigned)(size_t)(Ks + l15 * KS_LD + grp * 8);
  const unsigned vaddr = (unsigned)(size_t)(Vs + (4 * grp + (l15 >> 2)) * KS_LD + 4 * (l15 & 3));
  bf16x8 kf[8];
  ADSR(kf[0], kaddr, 0);    ADSR(kf[1], kaddr, 64);   ADSR(kf[2], kaddr, 2560); ADSR(kf[3], kaddr, 2624);
  ADSR(kf[4], kaddr, 5120); ADSR(kf[5], kaddr, 5184); ADSR(kf[6], kaddr, 7680); ADSR(kf[7], kaddr, 7744);
  f32x4 s[4];
  asm volatile("s_waitcnt lgkmcnt(6)" : "+v"(kf[0]), "+v"(kf[1]) :: "memory");
  s[0] = mfma16(kf[1], q1, mfma16(kf[0], q0, f32x4{0.f, 0.f, 0.f, 0.f}));
  asm volatile("s_waitcnt lgkmcnt(4)" : "+v"(kf[2]), "+v"(kf[3]) :: "memory");
  s[1] = mfma16(kf[3], q1, mfma16(kf[2], q0, f32x4{0.f, 0.f, 0.f, 0.f}));
  asm volatile("s_waitcnt lgkmcnt(2)" : "+v"(kf[4]), "+v"(kf[5]) :: "memory");
  s[2] = mfma16(kf[5], q1, mfma16(kf[4], q0, f32x4{0.f, 0.f, 0.f, 0.f}));
  asm volatile("s_waitcnt lgkmcnt(0)" : "+v"(kf[6]), "+v"(kf[7]) :: "memory");
  s[3] = mfma16(kf[7], q1, mfma16(kf[6], q0, f32x4{0.f, 0.f, 0.f, 0.f}));
  s16x4 vt[16];
  ATRR(vt[0], vaddr, 0);     ATRR(vt[1], vaddr, 2560);  ATRR(vt[2], vaddr, 32);    ATRR(vt[3], vaddr, 2592);
  ATRR(vt[4], vaddr, 64);    ATRR(vt[5], vaddr, 2624);  ATRR(vt[6], vaddr, 96);    ATRR(vt[7], vaddr, 2656);
  ATRR(vt[8], vaddr, 5120);  ATRR(vt[9], vaddr, 7680);  ATRR(vt[10], vaddr, 5152); ATRR(vt[11], vaddr, 7712);
  ATRR(vt[12], vaddr, 5184); ATRR(vt[13], vaddr, 7744); ATRR(vt[14], vaddr, 5216); ATRR(vt[15], vaddr, 7776);
  float cmax = -1e30f;
#pragma unroll
  for (int t = 0; t < 4; ++t)
#pragma unroll
    for (int j = 0; j < 4; ++j) {
      const int ci = t * 16 + j;
      float v = __builtin_fmaf(tb[t][j], fst, s[t][j]);
      if (MASKED) {
        const int dist = d0 - ci * kpstride;
        const bool valid = extra_ok && dist >= 0 && dist < maxdist;
        v = valid ? v : -1e30f;
      }
      s[t][j] = v;
      cmax = fmaxf(cmax, v);
    }
  if (!MASKED) cmax = extra_ok ? cmax : -1e30f;
  if (__ballot(cmax + base > m + 40.f) != 0ull) {
    cmax = (cmax > -1e29f) ? cmax + base : -1e30f;
    cmax = fmaxf(cmax, bperm(cmax, (l15 + 16 * grp) ^ 16));
    cmax = fmaxf(cmax, bperm(cmax, (l15 + 16 * grp) ^ 32));
    const float mnew = fmaxf(m, cmax);
    const float alpha = __builtin_amdgcn_exp2f(m - mnew);
    lsum *= alpha;
#pragma unroll
    for (int dt = 0; dt < 4; ++dt) o[dt] *= alpha;
    m = mnew;
  }
  float psum = 0.f;
  const float mb = m - base;
#pragma unroll
  for (int t = 0; t < 4; ++t)
#pragma unroll
    for (int j = 0; j < 4; ++j) {
      const float v = s[t][j];
      float pe = __builtin_amdgcn_exp2f(v - mb);
      if (MASKED) pe = (v > -1e29f) ? pe : 0.f;
      s[t][j] = pe;
      psum += pe;
    }
  if (!MASKED) psum = extra_ok ? psum : 0.f;
  lsum += psum;
  const uint32_t rowm = (MASKED || extra_ok) ? 0xffffffffu : 0u;
  asm volatile("s_waitcnt lgkmcnt(0)"
               : "+v"(vt[0]), "+v"(vt[1]), "+v"(vt[2]), "+v"(vt[3]), "+v"(vt[4]), "+v"(vt[5]), "+v"(vt[6]), "+v"(vt[7]),
                 "+v"(vt[8]), "+v"(vt[9]), "+v"(vt[10]), "+v"(vt[11]), "+v"(vt[12]), "+v"(vt[13]), "+v"(vt[14]), "+v"(vt[15])
               :: "memory");
#pragma unroll
  for (int sc = 0; sc < 2; ++sc) {
    const bf16x8 pb = __builtin_bit_cast(bf16x8, u32x4{pack2(s[2 * sc][0], s[2 * sc][1]) & rowm, pack2(s[2 * sc][2], s[2 * sc][3]) & rowm,
                                                       pack2(s[2 * sc + 1][0], s[2 * sc + 1][1]) & rowm, pack2(s[2 * sc + 1][2], s[2 * sc + 1][3]) & rowm});
#pragma unroll
    for (int dt = 0; dt < 4; ++dt) {
      const s16x4 vlo = vt[sc * 8 + dt * 2], vhi = vt[sc * 8 + dt * 2 + 1];
      const bf16x8 vf = {vlo[0], vlo[1], vlo[2], vlo[3], vhi[0], vhi[1], vhi[2], vhi[3]};
      o[dt] = mfma16(vf, pb, o[dt]);
    }
  }
}

constexpr int ATT_TILE = 64 * KS_LD * 2;
constexpr int ATT_BUF = 2 * ATT_TILE;

template <class DescF, class ProcF>
__device__ __forceinline__ void kv_stream(int n, DescF desc, ProcF proc, char* smraw, int tid) {
  if (n <= 0) return;
  KVRegs r0, r1;
  const bf16_t *kp, *vp; size_t ld;
  desc(0, kp, vp, ld); kv_issue(r0, kp, vp, ld, true, tid);
  desc(1 < n ? 1 : n - 1, kp, vp, ld); kv_issue(r1, kp, vp, ld, true, tid);
  __syncthreads();
  kv_commit(r0, (bf16_t*)smraw, (bf16_t*)(smraw + ATT_TILE), true, tid);
  desc(2 < n ? 2 : n - 1, kp, vp, ld); kv_issue(r0, kp, vp, ld, true, tid);
  __syncthreads();
  for (int e0 = 0; e0 < n; e0 += 2) {
    {
      const int e = e0;
      proc(e, (const bf16_t*)smraw, (const bf16_t*)(smraw + ATT_TILE));
      kv_commit(r1, (bf16_t*)(smraw + ATT_BUF), (bf16_t*)(smraw + ATT_BUF + ATT_TILE), true, tid);
      desc(e + 3 < n ? e + 3 : n - 1, kp, vp, ld); kv_issue(r1, kp, vp, ld, true, tid);
      __syncthreads();
    }
    {
      const int e = e0 + 1;
      if (e < n) proc(e, (const bf16_t*)(smraw + ATT_BUF), (const bf16_t*)(smraw + ATT_BUF + ATT_TILE));
      kv_commit(r0, (bf16_t*)smraw, (bf16_t*)(smraw + ATT_TILE), true, tid);
      desc(e + 3 < n ? e + 3 : n - 1, kp, vp, ld); kv_issue(r0, kp, vp, ld, true, tid);
      __syncthreads();
    }
  }
}

__device__ __forceinline__ void attn_unit(const Params& p, char* smraw, int bl, int g, int qb) {
  float* impbuf = (float*)(smraw + 2 * ATT_BUF);
  unsigned long long* selmask = (unsigned long long*)(smraw + 2 * ATT_BUF + 16384);
  int* sellist = (int*)(smraw + 2 * ATT_BUF + 16384 + 128);
  const bf16_t* qbuf = (const bf16_t*)(p.ws + OFF_Q);
  const bf16_t* zbuf = (const bf16_t*)(p.ws + OFF_ZB);
  const bf16_t* kvb = (const bf16_t*)(p.ws + OFF_KV);
  const float* glb = (const float*)(p.ws + OFF_GL);
  bf16_t* yB = (bf16_t*)(p.ws + OFF_YB);
  const int tid = opaque_tid(); const int lane = tid & 63, n = tid >> 6, l15 = lane & 15, grp = lane >> 4;
  const int h = g * 4 + n, t0 = qb * 16, tq = t0 + l15;
  const float slope = exp2f(-0.5f * (float)(h + 1)) * 1.44269504f;
  f32x4 tb[4];
#pragma unroll
  for (int t = 0; t < 4; ++t) tb[t] = f32x4{slope * (float)(16 * t), slope * (float)(16 * t + 1), slope * (float)(16 * t + 2), slope * (float)(16 * t + 3)};
  const size_t rowq = (size_t)bl * SEQ + tq;
  bf16x8 q0, q1;
  {
    const bf16_t* qp = qbuf + rowq * 1024 + h * 64 + grp * 8;
    q0 = *(const bf16x8*)qp; q1 = *(const bf16x8*)(qp + 32);
  }
  const float g0 = glb[rowq * 48 + h * 3 + 0], g1 = glb[rowq * 48 + h * 3 + 1], g2 = glb[rowq * 48 + h * 3 + 2];
  f32x4 otot[4];
#pragma unroll
  for (int dt = 0; dt < 4; ++dt) otot[dt] = f32x4{0.f, 0.f, 0.f, 0.f};
  const size_t seqbase = (size_t)bl * SEQ * 1536 + g * 64;
  const int BIG = 1 << 30;
  const bf16_t* kcb = (const bf16_t*)(p.ws + OFF_KCMP) + (size_t)(bl * 4 + g) * 256 * 64;
  const bf16_t* vcb = (const bf16_t*)(p.ws + OFF_VCMP) + (size_t)(bl * 4 + g) * 256 * 64;
  const bf16_t* kwb = kvb + seqbase + 1024;
  const bf16_t* vwb = kvb + seqbase + 1280;
  const bf16_t* ksb = kvb + seqbase + 512;
  const bf16_t* vsb = kvb + seqbase + 768;

  float m = -1e30f, lsum = 0.f;
  f32x4 o[4];
#pragma unroll
  for (int dt = 0; dt < 4; ++dt) o[dt] = f32x4{0.f, 0.f, 0.f, 0.f};
  float m_c = -1e30f, inv_c = 0.f, prev_rot = 0.f;
  float* myimp = impbuf + n * 1024;
#pragma unroll
  for (int i = 0; i < 16; ++i) myimp[i * 64 + lane] = 0.f;

  int lo = t0 - 511; lo = lo < 0 ? 0 : lo;
  const int wlo = lo >> 6, whi = t0 >> 6, nW = whi - wlo + 1;
  const int nck = (qb + 63) >> 6;
  auto finish = [&](float gate) -> float {
    float lt = lsum + bperm(lsum, lane ^ 16);
    lt += bperm(lt, lane ^ 32);
    const float inv = lt > 0.f ? 1.f / lt : 0.f;
    const float sc_ = gate * inv;
#pragma unroll
    for (int dt = 0; dt < 4; ++dt) { otot[dt] += o[dt] * sc_; o[dt] = f32x4{0.f, 0.f, 0.f, 0.f}; }
    lsum = 0.f;
    return inv;
  };
  kv_stream(nW + 2 * nck,
    [&](int e, const bf16_t*& kp, const bf16_t*& vp, size_t& ld) {
      if (e < nW) { const size_t off = (size_t)(whi - e) * 64 * 1536; kp = kwb + off; vp = vwb + off; ld = 1536; }
      else { const int c = (e < nW + nck) ? (nW + nck - 1 - e) : (e - nW - nck); kp = kcb + c * 4096; vp = vcb + c * 4096; ld = 64; }
    },
    [&](int e, const bf16_t* Ks, const bf16_t* Vt) {
      if (e < nW) {
        const int wb = whi - e;
        if (wb < whi && wb * 64 >= t0 - 496) attn_block64<false>(Ks, Vt, q0, q1, tq, wb * 64, 1, 512, true, slope, m, lsum, o, l15, grp, tb);
        else attn_block64<true>(Ks, Vt, q0, q1, tq, wb * 64, 1, 512, true, slope, m, lsum, o, l15, grp, tb);
        if (e == nW - 1) { (void)finish(g2); m = -1e30f; }
      } else if (e < nW + nck) {
        const int c = nW + nck - 1 - e;
        if (16 * (64 * c + 63) + 31 <= t0) attn_block64<false>(Ks, Vt, q0, q1, tq, 1024 * c + 31, 16, BIG, true, slope, m, lsum, o, l15, grp, tb);
        else attn_block64<true>(Ks, Vt, q0, q1, tq, 1024 * c + 31, 16, BIG, true, slope, m, lsum, o, l15, grp, tb);
        if (e == nW + nck - 1) { inv_c = finish(g0); m_c = m; m = -1e30f; }
      } else {
        const int c = e - nW - nck;
#pragma unroll
        for (int tt = 0; tt < 4; ++tt) {
          const bf16_t* krp = Ks + (tt * 16 + l15) * KS_LD + grp * 8;
          bf16x8 k0 = *(const bf16x8*)krp, k1 = *(const bf16x8*)(krp + 32);
          f32x4 z = f32x4{0.f, 0.f, 0.f, 0.f};
          z = mfma16(k0, q0, z);
          z = mfma16(k1, q1, z);
          float sum4 = 0.f, p3 = 0.f;
#pragma unroll
          for (int j = 0; j < 4; ++j) {
            int kidx = c * 64 + tt * 16 + 4 * grp + j;
            int dist = tq - (16 * kidx + 31);
            float pe = (dist >= 0) ? __builtin_amdgcn_exp2f(z[j] - slope * (float)dist - m_c) * inv_c : 0.f;
            sum4 += pe;
            if (j == 3) p3 = pe;
          }
          float rot = bperm(p3, (lane + 48) & 63);
          float extra = (grp == 0) ? prev_rot : rot;
          myimp[l15 * 64 + (c * 4 + tt) * 4 + grp] = sum4 + extra;
          prev_rot = rot;
        }
      }
    }, smraw, tid);
  if (nck < 4 && grp == 0) myimp[l15 * 64 + nck * 16] = prev_rot;
  __syncthreads();
#pragma unroll 1
  for (int i = 0; i < 4; ++i) {
    int qi = n * 4 + i;
    int tqq = t0 + qi, cur = tqq >> 6, s = lane;
    float imp = impbuf[qi * 64 + s] + impbuf[1024 + qi * 64 + s] + impbuf[2048 + qi * 64 + s] + impbuf[3072 + qi * 64 + s];
    bool forced = (s == 0) || (s == cur) || (s == cur - 1);
    bool valid = s <= cur;
    float score = forced ? __builtin_inff() : (valid ? imp : -__builtin_inff());
    int rank = 0;
#pragma unroll 8
    for (int sp = 0; sp < 64; ++sp) {
      float v = bperm(score, sp);
      rank += ((v > score) || (v == score && sp < s)) ? 1 : 0;
    }
    unsigned long long mk = __ballot((rank < 16) && valid);
    if (lane == 0) selmask[qi] = mk;
  }
  __syncthreads();
  const unsigned long long mymask = selmask[l15];
  unsigned long long U = 0, Uand = ~0ull;
#pragma unroll
  for (int i = 0; i < 16; ++i) { const unsigned long long mk = selmask[i]; U |= mk; Uand &= mk; }
  {
    uint32_t ulo = __builtin_amdgcn_readfirstlane((uint32_t)U), uhi = __builtin_amdgcn_readfirstlane((uint32_t)(U >> 32));
    U = ((unsigned long long)uhi << 32) | ulo;
    ulo = __builtin_amdgcn_readfirstlane((uint32_t)Uand); uhi = __builtin_amdgcn_readfirstlane((uint32_t)(Uand >> 32));
    Uand = ((unsigned long long)uhi << 32) | ulo;
  }
  const int nsel = __popcll(U);
  if (n == 0) {
    if ((U >> lane) & 1ull) sellist[__popcll(U >> lane) - 1] = lane;
  }
  __syncthreads();
  kv_stream(nsel,
    [&](int e, const bf16_t*& kp, const bf16_t*& vp, size_t& ld) {
      const int s = __builtin_amdgcn_readfirstlane(sellist[e]);
      const size_t off = (size_t)s * 64 * 1536; kp = ksb + off; vp = vsb + off; ld = 1536;
    },
    [&](int e, const bf16_t* Ks, const bf16_t* Vt) {
      const int s = __builtin_amdgcn_readfirstlane(sellist[e]);
      const bool ok = (mymask >> s) & 1ull;
      if (s < whi) attn_block64<false>(Ks, Vt, q0, q1, tq, s * 64, 1, BIG, ok, slope, m, lsum, o, l15, grp, tb);
      else attn_block64<true>(Ks, Vt, q0, q1, tq, s * 64, 1, BIG, ok, slope, m, lsum, o, l15, grp, tb);
    }, smraw, tid);
  (void)finish(g1);
#pragma unroll
  for (int dt = 0; dt < 4; ++dt) {
    size_t off = rowq * 1024 + h * 64 + dt * 16 + 4 * grp;
    u32x2 zz = *(const u32x2*)(zbuf + off);
    u32x2 ov;
    ov.x = pack2(otot[dt][0] * bf2f(zz.x & 0xffffu), otot[dt][1] * bf2f(zz.x >> 16));
    ov.y = pack2(otot[dt][2] * bf2f(zz.y & 0xffffu), otot[dt][3] * bf2f(zz.y >> 16));
    *(u32x2*)(yB + off) = ov;
  }
}

struct GmlpBLoader {
  const bf16_t* gvbase;
  const float* stats;
  const float* lg; const float* lb;
  int tid;
  u32x4 r[2]; f32x2 st[2];
  __device__ __forceinline__ void load(int kt) {
#pragma unroll
    for (int i = 0; i < 2; ++i) {
      int v = tid + 256 * i;
      int j = kt * 32 + (v >> 4), c8 = (v & 15) * 8;
      r[i] = *(const u32x4*)(gvbase + (size_t)j * 1024 + c8);
      st[i] = *(const f32x2*)(stats + j * 2);
    }
  }
  __device__ __forceinline__ void store(bf16_t* tile) {
#pragma unroll
    for (int i = 0; i < 2; ++i) {
      int v = tid + 256 * i;
      int jl = v >> 4, c8 = (v & 15) * 8;
      const u32x4 u = r[i];
#pragma unroll
      for (int e = 0; e < 4; ++e) {
        int c = c8 + 2 * e;
        float a = (bf2f(u[e] & 0xffffu) - st[i].x) * st[i].y * lg[c] + lb[c];
        float b = (bf2f(u[e] >> 16) - st[i].x) * st[i].y * lg[c + 1] + lb[c + 1];
        tile[c * LDK + jl] = f2bf(a);
        tile[(c + 1) * LDK + jl] = f2bf(b);
      }
    }
  }
};

__device__ __forceinline__ void gmlp_unit(const Params& p, int l, char* smraw, int bl, int chunk, int g) {
  bf16_t* sm = (bf16_t*)smraw;
  const int tid = opaque_tid(); const int lane = tid & 63, w = tid >> 6, wr = w >> 1, wc = w & 1, l15 = lane & 15, grp = lane >> 4;
  const size_t row0 = (size_t)bl * SEQ + chunk * 128;
  f32x4 acc[4][4];
  zero_acc(acc);
  StdLoader al;
  al.init((const bf16_t*)(p.ws + OFF_WM) + (size_t)(l * 8 + g) * 128 * 128, 128, tid);
  GmlpBLoader bl_;
  bl_.tid = tid;
  bl_.gvbase = (const bf16_t*)(p.ws + OFF_GV) + row0 * 1024 + g * 128;
  bl_.stats = (const float*)(p.ws + OFF_STATS) + row0 * 2;
  bl_.lg = p.ln_g + l * 1024 + g * 128;
  bl_.lb = p.ln_b + l * 1024 + g * 128;
  gemm_core(acc, al, bl_, 4, sm, tid);
  const bf16_t* uz = (const bf16_t*)(p.ws + OFF_UZ);
  bf16_t* yC = (bf16_t*)(p.ws + OFF_YC);
  const float* bs = p.b_s + (size_t)(l * 8 + g) * 128;
#pragma unroll
  for (int m = 0; m < 4; ++m)
#pragma unroll
    for (int j = 0; j < 4; ++j) {
      int i = wr * 64 + m * 16 + 4 * grp + j;
      float bb = bs[i];
#pragma unroll
      for (int n = 0; n < 4; ++n) {
        size_t off = (row0 + i) * 1024 + g * 128 + wc * 64 + n * 16 + l15;
        yC[off] = f2bf(bf2f(uz[off]) * (acc[m][n][j] + bb));
      }
    }
}

__device__ __forceinline__ void phase_mix2(const Params& p, int l, char* smraw) {
  constexpr int NATT = NB * 4 * 256, NGM = NB * 32 * 8;
  for (int u = blockIdx.x; u < NATT + NGM; u += gridDim.x) {
    if (u < NATT) {
      int qb = 255 - (u / (NB * 4)), r = u % (NB * 4);
      attn_unit(p, smraw, r >> 2, r & 3, qb);
    } else {
      int v = u - NATT;
      gmlp_unit(p, l, smraw, v >> 8, (v >> 3) & 31, v & 7);
    }
  }
}

__device__ __forceinline__ void phase_merge(const Params& p, int l, char* smraw) {
  bf16_t* sm = (bf16_t*)smraw;
  const bf16_t* WbrT = (const bf16_t*)(p.ws + OFF_WBRT) + (size_t)l * 3 * D * D;
  const bf16_t* gates = (const bf16_t*)(p.ws + OFF_GATES);
  bf16_t* merged = (bf16_t*)(p.ws + OFF_H);
  const int tid = opaque_tid(); const int lane = tid & 63, w = tid >> 6, wr = w >> 1, wc = w & 1, l15 = lane & 15, grp = lane >> 4;
  const int nx = gridDim.x >> 3;
  constexpr int CJ_END = (R / 1024) * 64;
  auto cj_next = [&](int c) { return ((c & 63) + nx < 64) ? (c + nx) : (((c >> 6) + 8) * 64 + (int)(blockIdx.x >> 3)); };
  auto ybuf = [&](int i) { return (const bf16_t*)(p.ws + (i == 0 ? OFF_YA : (i == 1 ? OFF_YB : OFF_YC))); };
  int cj = (blockIdx.x & 7) * 64 + (blockIdx.x >> 3);
  __syncthreads();
  if (cj < CJ_END) glds_prefetch0(ybuf(0) + (size_t)((cj >> 6) * 8 + (cj & 7)) * 128 * D, D, WbrT + (size_t)((cj & 63) >> 3) * 128 * D, D, sm, tid);
  for (; cj < CJ_END; cj = cj_next(cj)) {
    const int nt = (cj & 63) >> 3, mt = (cj >> 6) * 8 + (cj & 7);
    const int rbase = mt * 128 + wr * 64 + l15, cbase = nt * 128 + wc * 64 + 4 * grp;
    f32x4 tot[4][4];
    zero_acc(tot);
#pragma unroll 1
    for (int i = 0; i < 3; ++i) {
      f32x4 acc[4][4];
      zero_acc(acc);
      const bf16_t* Y = ybuf(i);
      gemm_core_glds<false>(acc, Y + (size_t)mt * 128 * D, D, WbrT + (size_t)i * D * D + (size_t)nt * 128 * D, D, D / 64, sm, tid);
      if (i < 2) {
        glds_prefetch0(ybuf(i + 1) + (size_t)mt * 128 * D, D, WbrT + (size_t)(i + 1) * D * D + (size_t)nt * 128 * D, D, sm, tid);
      } else {
        const int c2 = cj_next(cj);
        if (c2 < CJ_END) glds_prefetch0(ybuf(0) + (size_t)((c2 >> 6) * 8 + (c2 & 7)) * 128 * D, D, WbrT + (size_t)((c2 & 63) >> 3) * 128 * D, D, sm, tid);
      }
#pragma unroll
      for (int m = 0; m < 4; ++m)
#pragma unroll
        for (int n = 0; n < 4; ++n) {
          const u32x2 gt = *(const u32x2*)(gates + (size_t)(rbase + m * 16) * 3072 + i * 1024 + cbase + n * 16);
          tot[m][n][0] += bf2f(gt.x & 0xffffu) * acc[m][n][0];
          tot[m][n][1] += bf2f(gt.x >> 16) * acc[m][n][1];
          tot[m][n][2] += bf2f(gt.y & 0xffffu) * acc[m][n][2];
          tot[m][n][3] += bf2f(gt.y >> 16) * acc[m][n][3];
        }
    }
#pragma unroll
    for (int m = 0; m < 4; ++m)
#pragma unroll
      for (int n = 0; n < 4; ++n)
        *(u32x2*)(merged + (size_t)(rbase + m * 16) * 1024 + cbase + n * 16) = u32x2{pack2(tot[m][n][0], tot[m][n][1]), pack2(tot[m][n][2], tot[m][n][3])};
  }
}

__device__ __forceinline__ void phase_outproj(const Params& p, int l, char* smraw) {
  bf16_t* sm = (bf16_t*)smraw;
  const bf16_t* WoutT = (const bf16_t*)(p.ws + OFF_WOUTT) + (size_t)l * D * D;
  const bf16_t* merged = (const bf16_t*)(p.ws + OFF_H);
  bf16_t* opre = (bf16_t*)(p.ws + OFF_YAPRE);
  const int tid = opaque_tid(); const int lane = tid & 63, w = tid >> 6, wr = w >> 1, wc = w & 1, l15 = lane & 15, grp = lane >> 4;
  const int nx = gridDim.x >> 3;
  constexpr int CJ_END = (R / 1024) * 64;
  auto cj_next = [&](int c) { return ((c & 63) + nx < 64) ? (c + nx) : (((c >> 6) + 8) * 64 + (int)(blockIdx.x >> 3)); };
  int cj = (blockIdx.x & 7) * 64 + (blockIdx.x >> 3);
  __syncthreads();
  if (cj < CJ_END) glds_prefetch0(merged + (size_t)((cj >> 6) * 8 + (cj & 7)) * 128 * D, D, WoutT + (size_t)((cj & 63) >> 3) * 128 * D, D, sm, tid);
  for (; cj < CJ_END; cj = cj_next(cj)) {
    const int nt = (cj & 63) >> 3, mt = (cj >> 6) * 8 + (cj & 7);
    f32x4 acc[4][4];
    zero_acc(acc);
    gemm_core_glds<true>(acc, merged + (size_t)mt * 128 * D, D, WoutT + (size_t)nt * 128 * D, D, D / 64, sm, tid);
    {
      const int c2 = cj_next(cj);
      if (c2 < CJ_END) glds_prefetch0(merged + (size_t)((c2 >> 6) * 8 + (c2 & 7)) * 128 * D, D, WoutT + (size_t)((c2 & 63) >> 3) * 128 * D, D, sm, tid);
    }
    const int rbase = mt * 128 + wr * 64 + l15, cbase = nt * 128 + wc * 64 + 4 * grp;
#pragma unroll
    for (int m = 0; m < 4; ++m)
#pragma unroll
      for (int n = 0; n < 4; ++n)
        *(u32x2*)(opre + (size_t)(rbase + m * 16) * 1024 + cbase + n * 16) = u32x2{pack2(acc[m][n][0], acc[m][n][1]), pack2(acc[m][n][2], acc[m][n][3])};
  }
}

#define XB_TMO      128
#define XB_XCNT(j)  (256  + 64 * (j))
#define XB_XSUB(j)  (1280 + 64 * (j))
#define XB_XGEN(j)  (2304 + 64 * (j))
#define XB_TOP      3328
#define XB_TOPGEN   3392
#define XCD_BAR_WORDS 3456
#define XB_SPIN_CAP (1u << 18)
#define LAS __attribute__((address_space(3)))

__device__ __forceinline__ unsigned xb_ld(unsigned* p)              { return __hip_atomic_load(p, __ATOMIC_RELAXED, __HIP_MEMORY_SCOPE_AGENT); }
__device__ __forceinline__ unsigned xb_add(unsigned* p, unsigned v) { return __hip_atomic_fetch_add(p, v, __ATOMIC_RELAXED, __HIP_MEMORY_SCOPE_AGENT); }
__device__ __forceinline__ unsigned xb_xcc_id() { return (unsigned)__builtin_amdgcn_s_getreg((3 << 11) | 20) & 0xFu; }
#define XB_SPIN(cond, bar) do { unsigned _sp = 0; while (cond) { __builtin_amdgcn_s_sleep(1); \
    if ((++_sp & 255u) == 0u) { if (xb_ld(&(bar)[XB_TMO])) break; if (_sp > XB_SPIN_CAP) { atomicAdd(&(bar)[XB_TMO], 1u); break; } } } } while (0)

struct XcdBarrier {
    unsigned* bar; unsigned x;
    volatile LAS unsigned* st;
};

__device__ __forceinline__ XcdBarrier xcd_barrier_post(unsigned* bar, volatile LAS unsigned* st) {
    XcdBarrier b; b.bar = bar; b.x = xb_xcc_id(); b.st = st;
    if (threadIdx.x == 0) (void)xb_add(&bar[XB_XCNT(b.x)], 1u);
    return b;
}
__device__ __forceinline__ void xcd_barrier_complete(unsigned* bar, unsigned x, unsigned& nloc, unsigned& nx) {
    const unsigned G = gridDim.x * gridDim.y * gridDim.z;
    unsigned sum, cnt, mine, sp = 0u;
    for (;;) {
        sum = 0u; cnt = 0u; mine = 0u;
#pragma unroll
        for (unsigned j = 0; j < 16; ++j) { const unsigned c = xb_ld(&bar[XB_XCNT(j)]); sum += c; cnt += (c > 0u) ? 1u : 0u; mine = (j == x) ? c : mine; }
        if (sum == G) break;
        __builtin_amdgcn_s_sleep(1);
        if ((++sp & 255u) == 0u) { if (xb_ld(&bar[XB_TMO])) break; if (sp > XB_SPIN_CAP) { atomicAdd(&bar[XB_TMO], 1u); break; } }
    }
    nloc = mine > 0u ? mine : 1u; nx = cnt > 0u ? cnt : 1u;
}
__device__ __forceinline__ void xcd_barrier(const XcdBarrier& b) {
    asm volatile("s_waitcnt vmcnt(0)" ::: "memory");
    __syncthreads();
    if (threadIdx.x == 0) {
        unsigned* bar = b.bar;
        __builtin_amdgcn_s_waitcnt(0);
        unsigned nloc = b.st[0], nx = b.st[1];
        if (nloc == 0u) { xcd_barrier_complete(bar, b.x, nloc, nx); b.st[0] = nloc; b.st[1] = nx; }
        const unsigned old = xb_add(&bar[XB_XSUB(b.x)], 1u);
        const unsigned gen = old / nloc;
        if (old + 1u == (gen + 1u) * nloc) {
            __builtin_amdgcn_fence(__ATOMIC_RELEASE, "agent");
            asm volatile("s_waitcnt vmcnt(0)" ::: "memory");
            const unsigned og = xb_add(&bar[XB_TOP], 1u);
            const unsigned tg = og / nx;
            if (og + 1u == (tg + 1u) * nx) xb_add(&bar[XB_TOPGEN], 1u);
            else XB_SPIN(xb_ld(&bar[XB_TOPGEN]) == tg, bar);
            __builtin_amdgcn_fence(__ATOMIC_ACQUIRE, "agent");
            xb_add(&bar[XB_XGEN(b.x)], 1u);
            asm volatile("s_waitcnt vmcnt(0)" ::: "memory");
        } else {
            XB_SPIN(xb_ld(&bar[XB_XGEN(b.x)]) == gen, bar);
            __builtin_amdgcn_fence(__ATOMIC_ACQUIRE, "agent");
            asm volatile("s_waitcnt vmcnt(0)" ::: "memory");
        }
    }
    __syncthreads();
}

__global__ void __launch_bounds__(256, 2) hybrid_fwd(Params p) {
  __shared__ __attribute__((aligned(16))) char smraw[SMEM_BYTES];
  cg::grid_group grid = cg::this_grid();
  if (threadIdx.x == 0) *(u32x4*)(smraw + 65536) = u32x4{0u, 0u, 0u, 0u};
  __syncthreads();
  const XcdBarrier xb = xcd_barrier_post((unsigned*)(p.ws + OFF_BAR), (volatile LAS unsigned*)(smraw + 65536));
  phase0(p, smraw);
  grid.sync();
  for (int gi = 0; gi < NGRP; ++gi) {
    phase_h0(p, gi);
    xcd_barrier(xb);
    for (int l = 0; l < DEPTH; ++l) {
      phase_inproj(p, l, smraw);
      xcd_barrier(xb);
      phase_mix1(p, l, smraw);
      xcd_barrier(xb);
      phase_mix2(p, l, smraw);
      xcd_barrier(xb);
      phase_merge(p, l, smraw);
      xcd_barrier(xb);
      phase_outproj(p, l, smraw);
      xcd_barrier(xb);
      phase_final(p, gi, l);
      xcd_barrier(xb);
    }
  }
}

extern "C" void kernel_launch(void* const* d_in, const int* in_sizes, int n_in, void* d_out, int out_size, void* d_ws,
                              size_t ws_size, hipStream_t stream) {
  static int grid_blocks = 0;
  if (!grid_blocks) {
    int dev = 0, cus = 0, per_cu = 0;
    hipGetDevice(&dev);
    hipDeviceGetAttribute(&cus, hipDeviceAttributeMultiprocessorCount, dev);
    hipOccupancyMaxActiveBlocksPerMultiprocessor(&per_cu, hybrid_fwd, 256, 0);
    if (per_cu < 1) per_cu = 1;
    if (per_cu > 2) per_cu = 2;
    grid_blocks = cus * per_cu;
    if (ws_size < WS_END) fprintf(stderr, "kernel_launch: workspace too small: %zu < %zu\n", ws_size, (size_t)WS_END);
  }
  Params p{};
  const float** pp = (const float**)&p;
  for (int i = 0; i < 21; ++i) pp[i] = (const float*)d_in[i];
  p.out = (float*)d_out;
  p.ws = (unsigned char*)d_ws;
  (void)hipMemsetAsync((char*)d_ws + OFF_BAR, 0, 3456 * 4, stream);
  void* args[] = {&p};
  hipError_t e = hipLaunchCooperativeKernel((void*)hybrid_fwd, dim3(grid_blocks), dim3(256), args, 0, stream);
  if (e != hipSuccess) fprintf(stderr, "cooperative launch failed: %s (grid %d)\n", hipGetErrorString(e), grid_blocks);
}
```

```cpp
#include <hip/hip_runtime.h>
#include <hip/hip_cooperative_groups.h>
#include <cstdio>
#include <cstdint>
namespace cg = cooperative_groups;

typedef unsigned short bf16_t;
using bf16x8 = __attribute__((ext_vector_type(8))) short;
using f32x4 = __attribute__((ext_vector_type(4))) float;
using f32x2 = __attribute__((ext_vector_type(2))) float;
using u32x4 = __attribute__((ext_vector_type(4))) uint32_t;
using u32x2 = __attribute__((ext_vector_type(2))) uint32_t;

constexpr int D = 1024, SEQ = 4096, BATCH = 16, DEPTH = 2;
constexpr int IN_COLS = 13872;
constexpr int A_OFF = 0, B_OFF = 4096, C_OFF = 7728, G_OFF = 10800;
constexpr int NT_IN = 109, NP = NT_IN * 128;
constexpr int NB = 4, R = NB * SEQ, NGRP = BATCH / NB;
constexpr int LDK = 40;
constexpr int KS_LD = 80;
constexpr int VT_LD = 68;
constexpr int HS_LD = 136;
constexpr int SMEM_BYTES = 65536 + 16;

constexpr size_t al256(size_t x) { return (x + 255) & ~size_t(255); }
constexpr size_t OFF_WINT = 0;
constexpr size_t OFF_WBRT = al256(OFF_WINT + (size_t)DEPTH * NP * D * 2);
constexpr size_t OFF_WOUTT = al256(OFF_WBRT + (size_t)DEPTH * 3 * D * D * 2);
constexpr size_t OFF_WC1T = al256(OFF_WOUTT + (size_t)DEPTH * D * D * 2);
constexpr size_t OFF_WM = al256(OFF_WC1T + (size_t)DEPTH * 2 * 128 * 2048 * 2);
constexpr size_t OFF_BIAS1 = al256(OFF_WM + (size_t)DEPTH * 8 * 128 * 128 * 2);
constexpr size_t OFF_MOD = al256(OFF_BIAS1 + (size_t)DEPTH * 2 * 8 * 128 * 4);
constexpr size_t OFF_H = al256(OFF_MOD + (size_t)DEPTH * 16 * 3072 * 4);
constexpr size_t SZ_ACT = (size_t)R * 1024 * 2;
constexpr size_t OFF_YAPRE = al256(OFF_H + SZ_ACT);
constexpr size_t OFF_BZA = al256(OFF_YAPRE + SZ_ACT);
constexpr size_t OFF_Q = al256(OFF_BZA + SZ_ACT);
constexpr size_t OFF_ZB = al256(OFF_Q + SZ_ACT);
constexpr size_t OFF_UZ = al256(OFF_ZB + SZ_ACT);
constexpr size_t OFF_GV = al256(OFF_UZ + SZ_ACT);
constexpr size_t OFF_KV = al256(OFF_GV + SZ_ACT);
constexpr size_t OFF_GL = al256(OFF_KV + (size_t)R * 1536 * 2);
constexpr size_t OFF_GATES = al256(OFF_GL + (size_t)R * 48 * 4);
constexpr size_t OFF_YA = al256(OFF_GATES + (size_t)R * 3072 * 2);
constexpr size_t OFF_YB = al256(OFF_YA + SZ_ACT);
constexpr size_t OFF_YC = al256(OFF_YB + SZ_ACT);
constexpr size_t OFF_KCMP = al256(OFF_YC + SZ_ACT);
constexpr size_t OFF_VCMP = al256(OFF_KCMP + (size_t)NB * 4 * 256 * 64 * 2);
constexpr size_t OFF_STATS = al256(OFF_VCMP + (size_t)NB * 4 * 256 * 64 * 2);
constexpr size_t OFF_BAR = al256(OFF_STATS + (size_t)R * 2 * 4);
constexpr size_t WS_END = al256(OFF_BAR + 3456 * 4);

struct Params {
  const float *x, *c, *g_pre, *g_post, *w_ada, *b_ada, *w_in, *conv_w, *conv_b, *pos_ck, *w_ck1, *w_ck2,
      *pos_cv, *w_cv1, *w_cv2, *ln_g, *ln_b, *w_s, *b_s, *w_br, *w_out;
  float* out;
  unsigned char* ws;
};

typedef __bf16 bf16x2_native __attribute__((ext_vector_type(2)));
__device__ __forceinline__ uint32_t pack2(float a, float b) {
  f32x2 v = {a, b};
  return __builtin_bit_cast(uint32_t, __builtin_convertvector(v, bf16x2_native));
}
__device__ __forceinline__ bf16_t f2bf(float f) { return (bf16_t)(pack2(f, f) & 0xffffu); }
__device__ __forceinline__ float bf2f(uint32_t h) { return __uint_as_float(h << 16); }
__device__ __forceinline__ float sigmoid_(float x) { return __builtin_amdgcn_rcpf(1.f + __expf(-x)); }
__device__ __forceinline__ float silu_(float x) { return x * __builtin_amdgcn_rcpf(1.f + __expf(-x)); }
__device__ __forceinline__ float gelu_(float x) {
  float y = 0.7978845608f * (x + 0.044715f * x * x * x);
  return x * __builtin_amdgcn_rcpf(1.f + __expf(-2.f * y));
}
__device__ __forceinline__ f32x4 mfma16(bf16x8 a, bf16x8 b, f32x4 c) {
  return __builtin_amdgcn_mfma_f32_16x16x32_bf16(a, b, c, 0, 0, 0);
}
__device__ __forceinline__ float bperm(float v, int srclane) {
  return __int_as_float(__builtin_amdgcn_ds_bpermute(srclane << 2, __float_as_int(v)));
}
__device__ __forceinline__ float wave_sum(float v, int lane) {
#pragma unroll
  for (int o = 32; o >= 1; o >>= 1) v += bperm(v, lane ^ o);
  return v;
}

__device__ __forceinline__ int opaque_tid() {
  int t = threadIdx.x;
  asm volatile("" : "+v"(t));
  return t;
}

__device__ __forceinline__ int win_colmap(int np) {
  int tile = np >> 7, r = np & 127;
  if (tile < 32) { int wc = r >> 6, t = (r >> 4) & 3, i = r & 15; return A_OFF + t * 1024 + tile * 32 + wc * 16 + i; }
  if (tile < 40) return B_OFF + (np - 32 * 128);
  if (tile < 52) return B_OFF + 1024 + (np - 40 * 128);
  if (tile < 60) return B_OFF + 2560 + (np - 52 * 128);
  if (tile == 60) return r < 48 ? B_OFF + 3584 + r : -1;
  if (tile < 77) { int tb = tile - 61, wc = r >> 6, t = (r >> 4) & 3, i = r & 15; return C_OFF + ((t & 1) ? 2048 : 0) + tb * 64 + wc * 32 + (t >> 1) * 16 + i; }
  if (tile < 85) return C_OFF + 1024 + (np - 77 * 128);
  return G_OFF + (np - 85 * 128);
}

template <bool WIN>
__device__ __forceinline__ void transpose_tile(const float* __restrict__ src, int ld_src, bf16_t* __restrict__ dst, int Kdim, int n0, int k0, float* sm, int tid) {
  const int tx = tid & 63, ty = tid >> 6;
  const int col = WIN ? win_colmap(n0 + tx) : (n0 + tx);
  __syncthreads();
#pragma unroll
  for (int i = 0; i < 16; ++i) {
    int k = ty * 16 + i;
    float v = (col >= 0) ? src[(size_t)(k0 + k) * ld_src + col] : 0.f;
    sm[k * 65 + tx] = v;
  }
  __syncthreads();
#pragma unroll
  for (int i = 0; i < 16; ++i) {
    int n = ty * 16 + i;
    dst[(size_t)(n0 + n) * Kdim + k0 + tx] = f2bf(sm[tx * 65 + n]);
  }
}

__device__ __forceinline__ void phase0(const Params& p, char* smraw) {
  float* smf = (float*)smraw;
  const int bid = blockIdx.x, nblk = gridDim.x, tid = opaque_tid();
  bf16_t* WinT = (bf16_t*)(p.ws + OFF_WINT);
  bf16_t* WbrT = (bf16_t*)(p.ws + OFF_WBRT);
  bf16_t* WoutT = (bf16_t*)(p.ws + OFF_WOUTT);
  bf16_t* Wc1T = (bf16_t*)(p.ws + OFF_WC1T);
  bf16_t* Wm = (bf16_t*)(p.ws + OFF_WM);
  float* bias1 = (float*)(p.ws + OFF_BIAS1);
  float* mod = (float*)(p.ws + OFF_MOD);
  for (int t = bid; t < DEPTH * 218 * 16; t += nblk) {
    int l = t / (218 * 16), r = t % (218 * 16), nt = r >> 4, kt = r & 15;
    transpose_tile<true>(p.w_in + (size_t)l * D * IN_COLS, IN_COLS, WinT + (size_t)l * NP * D, D, nt * 64, kt * 64, smf, tid);
  }
  for (int t = bid; t < DEPTH * 3 * 256; t += nblk) {
    int li = t >> 8, r = t & 255, nt = r >> 4, kt = r & 15;
    transpose_tile<false>(p.w_br + (size_t)li * D * D, D, WbrT + (size_t)li * D * D, D, nt * 64, kt * 64, smf, tid);
  }
  for (int t = bid; t < DEPTH * 256; t += nblk) {
    int l = t >> 8, r = t & 255, nt = r >> 4, kt = r & 15;
    transpose_tile<false>(p.w_out + (size_t)l * D * D, D, WoutT + (size_t)l * D * D, D, nt * 64, kt * 64, smf, tid);
  }
  for (int t = bid; t < DEPTH * 2 * 64; t += nblk) {
    int lk = t >> 6, r = t & 63, nt = r >> 5, kt = r & 31;
    int l = lk >> 1, kv = lk & 1;
    const float* src = (kv ? p.w_cv1 : p.w_ck1) + (size_t)l * 2048 * 128;
    transpose_tile<false>(src, 128, Wc1T + (size_t)lk * 128 * 2048, 2048, nt * 64, kt * 64, smf, tid);
  }
  for (int e = bid * 256 + tid; e < DEPTH * 8 * 128 * 128; e += nblk * 256) {
    int j = e & 127, i = (e >> 7) & 127;
    Wm[e] = (j <= i) ? f2bf(p.w_s[e]) : (bf16_t)0;
  }
  for (int t = bid - 128; t >= 0 && t < DEPTH * 2 * 8; t += nblk) {
    int lk = t >> 3, ks = t & 7, l = lk >> 1, kv = lk & 1;
    const float* pos = (kv ? p.pos_cv : p.pos_ck) + (size_t)l * 2048;
    const float* w1 = (kv ? p.w_cv1 : p.w_ck1) + (size_t)l * 2048 * 128;
    int n = tid & 127, half = tid >> 7;
    float acc = 0.f;
    const int kb = ks * 256 + half * 128;
#pragma unroll 16
    for (int k = kb; k < kb + 128; ++k) acc += pos[k] * w1[(size_t)k * 128 + n];
    __syncthreads();
    smf[tid] = acc;
    __syncthreads();
    if (tid < 128) bias1[t * 128 + tid] = smf[tid] + smf[tid + 128];
  }
  for (int t = nblk - 1 - bid; t < DEPTH * 48; t += nblk) {
    int l = t / 48, ch = t % 48;
    int tx = tid & 63, ty = tid >> 6;
    int col = ch * 64 + tx;
    __syncthreads();
    for (int i = 0; i < 64; ++i) {
      int e = tid + 256 * i;
      smf[(e & 1023) * 16 + (e >> 10)] = silu_(p.c[e]);
    }
    __syncthreads();
    float acc[16];
#pragma unroll
    for (int b = 0; b < 16; ++b) acc[b] = 0.f;
    const float* w = p.w_ada + (size_t)l * D * 3072 + col;
#pragma unroll 8
    for (int k = ty * 256; k < ty * 256 + 256; ++k) {
      float wv = w[(size_t)k * 3072];
      const f32x4 s0 = *(const f32x4*)(smf + k * 16), s1 = *(const f32x4*)(smf + k * 16 + 4), s2 = *(const f32x4*)(smf + k * 16 + 8), s3 = *(const f32x4*)(smf + k * 16 + 12);
#pragma unroll
      for (int b = 0; b < 4; ++b) { acc[b] += s0[b] * wv; acc[4 + b] += s1[b] * wv; acc[8 + b] += s2[b] * wv; acc[12 + b] += s3[b] * wv; }
    }
    __syncthreads();
#pragma unroll
    for (int b = 0; b < 16; ++b) smf[(ty * 16 + b) * 64 + tx] = acc[b];
    __syncthreads();
    if (ty == 0) {
#pragma unroll
      for (int b = 0; b < 16; ++b) {
        float s_ = smf[b * 64 + tx] + smf[(16 + b) * 64 + tx] + smf[(32 + b) * 64 + tx] + smf[(48 + b) * 64 + tx];
        mod[((size_t)l * 16 + b) * 3072 + col] = s_ + p.b_ada[l * 3072 + col];
      }
    }
  }
}

__device__ __forceinline__ void write_h_row(const f32x4 (&xv)[4], float ss, const float* g_pre, const float* modl_b, bf16_t* hrow, int lane) {
  float rs = rsqrtf(ss * (1.f / 1024.f) + 1e-6f);
#pragma unroll
  for (int i = 0; i < 4; ++i) {
    int c = i * 256 + lane * 4;
    f32x4 g = *(const f32x4*)(g_pre + c);
    f32x4 sh = *(const f32x4*)(modl_b + c);
    f32x4 sc = *(const f32x4*)(modl_b + 1024 + c);
    float h0 = xv[i].x * rs * g.x * (1.f + sc.x) + sh.x;
    float h1 = xv[i].y * rs * g.y * (1.f + sc.y) + sh.y;
    float h2 = xv[i].z * rs * g.z * (1.f + sc.z) + sh.z;
    float h3 = xv[i].w * rs * g.w * (1.f + sc.w) + sh.w;
    u32x2 o; o.x = pack2(h0, h1); o.y = pack2(h2, h3);
    *(u32x2*)(hrow + c) = o;
  }
}

__device__ __forceinline__ void phase_h0(const Params& p, int grp_i) {
  const int tid = opaque_tid(); const int lane = tid & 63, w = tid >> 6;
  bf16_t* H = (bf16_t*)(p.ws + OFF_H);
  const float* mod = (const float*)(p.ws + OFF_MOD);
  for (int r = blockIdx.x * 4 + w; r < R; r += gridDim.x * 4) {
    size_t grow = (size_t)grp_i * R + r;
    int b = (int)(grow >> 12);
    const float* xr = p.x + grow * D;
    f32x4 xv[4]; float ss = 0.f;
#pragma unroll
    for (int i = 0; i < 4; ++i) {
      xv[i] = *(const f32x4*)(xr + i * 256 + lane * 4);
      ss += xv[i].x * xv[i].x + xv[i].y * xv[i].y + xv[i].z * xv[i].z + xv[i].w * xv[i].w;
    }
    ss = wave_sum(ss, lane);
    write_h_row(xv, ss, p.g_pre, mod + (size_t)b * 3072, H + (size_t)r * D, lane);
  }
}

__device__ __forceinline__ void phase_final(const Params& p, int grp_i, int l) {
  const int tid = opaque_tid(); const int lane = tid & 63, w = tid >> 6;
  bf16_t* H = (bf16_t*)(p.ws + OFF_H);
  const bf16_t* OP = (const bf16_t*)(p.ws + OFF_YAPRE);
  const float* mod = (const float*)(p.ws + OFF_MOD);
  const float* xin = (l == 0) ? p.x : p.out;
  for (int r = blockIdx.x * 4 + w; r < R; r += gridDim.x * 4) {
    size_t grow = (size_t)grp_i * R + r;
    int b = (int)(grow >> 12);
    const float* xr = xin + grow * D;
    const bf16_t* orow = OP + (size_t)r * D;
    const float* gate = mod + ((size_t)l * 16 + b) * 3072 + 2048;
    const float* gp = p.g_post + l * D;
    f32x4 xv[4], ov[4]; float ss = 0.f;
#pragma unroll
    for (int i = 0; i < 4; ++i) {
      int c = i * 256 + lane * 4;
      xv[i] = *(const f32x4*)(xr + c);
      u32x2 u = *(const u32x2*)(orow + c);
      ov[i].x = bf2f(u.x & 0xffffu); ov[i].y = bf2f(u.x >> 16); ov[i].z = bf2f(u.y & 0xffffu); ov[i].w = bf2f(u.y >> 16);
      ss += ov[i].x * ov[i].x + ov[i].y * ov[i].y + ov[i].z * ov[i].z + ov[i].w * ov[i].w;
    }
    ss = wave_sum(ss, lane);
    float rs = rsqrtf(ss * (1.f / 1024.f) + 1e-6f);
    float ss2 = 0.f;
#pragma unroll
    for (int i = 0; i < 4; ++i) {
      int c = i * 256 + lane * 4;
      f32x4 g = *(const f32x4*)(gp + c);
      f32x4 ga = *(const f32x4*)(gate + c);
      xv[i].x += ga.x * (ov[i].x * rs * g.x);
      xv[i].y += ga.y * (ov[i].y * rs * g.y);
      xv[i].z += ga.z * (ov[i].z * rs * g.z);
      xv[i].w += ga.w * (ov[i].w * rs * g.w);
      *(f32x4*)(p.out + grow * D + c) = xv[i];
      ss2 += xv[i].x * xv[i].x + xv[i].y * xv[i].y + xv[i].z * xv[i].z + xv[i].w * xv[i].w;
    }
    if (l == 0) {
      ss2 = wave_sum(ss2, lane);
      write_h_row(xv, ss2, p.g_pre + D, mod + ((size_t)16 + b) * 3072, H + (size_t)r * D, lane);
    }
  }
}

struct StdLoader {
  const bf16_t* base;
  int soff;
  u32x4 r0, r1;
  __device__ __forceinline__ void init(const bf16_t* tile_base, size_t ld, int tid) {
    base = tile_base + (size_t)(tid >> 1) * ld + (tid & 1) * 16;
    soff = (tid >> 1) * LDK + (tid & 1) * 16;
  }
  __device__ __forceinline__ void load(int kt) {
    const bf16_t* q = base + kt * 32;
    r0 = *(const u32x4*)q; r1 = *(const u32x4*)(q + 8);
  }
  __device__ __forceinline__ void store(bf16_t* tile) {
    bf16_t* q = tile + soff;
    *(u32x4*)q = r0; *(u32x4*)(q + 8) = r1;
  }
};

template <class AL, class BL>
__device__ __forceinline__ void gemm_core(f32x4 (&acc)[4][4], AL& al, BL& bl, int nk, bf16_t* sm, int tid) {
  const int lane = tid & 63, w = tid >> 6, wr = w >> 1, wc = w & 1, l15 = lane & 15, grp = lane >> 4;
  al.load(0); bl.load(0);
  __syncthreads();
  al.store(sm); bl.store(sm + 2 * 128 * LDK);
  __syncthreads();
  for (int kt = 0; kt < nk; ++kt) {
    const bf16_t* Ab = sm + (kt & 1) * 128 * LDK;
    const bf16_t* Bb = sm + (2 + (kt & 1)) * 128 * LDK;
    if (kt + 1 < nk) { al.load(kt + 1); bl.load(kt + 1); }
    bf16x8 a[4], b[4];
#pragma unroll
    for (int m = 0; m < 4; ++m) a[m] = *(const bf16x8*)(Ab + (wr * 64 + m * 16 + l15) * LDK + grp * 8);
#pragma unroll
    for (int n = 0; n < 4; ++n) b[n] = *(const bf16x8*)(Bb + (wc * 64 + n * 16 + l15) * LDK + grp * 8);
#pragma unroll
    for (int m = 0; m < 4; ++m)
#pragma unroll
      for (int n = 0; n < 4; ++n) acc[m][n] = mfma16(a[m], b[n], acc[m][n]);
    if (kt + 1 < nk) {
      al.store(sm + ((kt + 1) & 1) * 128 * LDK);
      bl.store(sm + (2 + ((kt + 1) & 1)) * 128 * LDK);
    }
    __syncthreads();
  }
}

struct Regs4 { u32x4 r0, r1, r2, r3; };
struct StdLoader64 {
  typedef Regs4 Regs;
  const bf16_t* base;
  size_t ld32;
  int soff;
  __device__ __forceinline__ void init(const bf16_t* tile_base, size_t ld, int tid) {
    base = tile_base + (size_t)(tid >> 3) * ld + (tid & 7) * 8;
    ld32 = ld * 32;
    soff = (tid >> 3) * 64 + (((tid & 7) ^ ((tid >> 4) & 7)) * 8);
  }
  __device__ __forceinline__ void load(int kt, Regs& r) const {
    const bf16_t* q = base + kt * 64;
    r.r0 = *(const u32x4*)q; r.r1 = *(const u32x4*)(q + ld32); r.r2 = *(const u32x4*)(q + 2 * ld32); r.r3 = *(const u32x4*)(q + 3 * ld32);
  }
  __device__ __forceinline__ void store(bf16_t* tile, const Regs& r) const {
    bf16_t* q = tile + soff;
    *(u32x4*)q = r.r0; *(u32x4*)(q + 2048) = r.r1; *(u32x4*)(q + 4096) = r.r2; *(u32x4*)(q + 6144) = r.r3;
  }
};

template <int NST, class AL, class BL>
__device__ __forceinline__ void gemm_core64(f32x4 (&acc)[4][4], const AL& al, const BL& bl, int nk, bf16_t* sm, int tid) {
  const int lane = tid & 63, w = tid >> 6, wr = w >> 1, wc = w & 1, l15 = lane & 15, grp = lane >> 4;
  constexpr int TILE = 128 * 64;
  const int sw = (l15 >> 1) & 7;
  const int fo0 = l15 * 64 + ((grp ^ sw) * 8), fo1 = l15 * 64 + (((4 + grp) ^ sw) * 8);
  typename AL::Regs ra[NST];
  typename BL::Regs rb[NST];
#pragma unroll
  for (int s_ = 0; s_ < NST; ++s_) { al.load(s_, ra[s_]); bl.load(s_, rb[s_]); }
  __syncthreads();
  al.store(sm, ra[0]); bl.store(sm + 2 * TILE, rb[0]);
  { const int k2 = NST < nk ? NST : nk - 1; al.load(k2, ra[0]); bl.load(k2, rb[0]); }
  __syncthreads();
  for (int kt0 = 0; kt0 < nk; kt0 += NST) {
#pragma unroll
    for (int u = 0; u < NST; ++u) {
      const int kt = kt0 + u;
      const bf16_t* Ab = sm + (kt & 1) * TILE + wr * 64 * 64;
      const bf16_t* Bb = sm + (2 + (kt & 1)) * TILE + wc * 64 * 64;
#pragma unroll
      for (int ks = 0; ks < 2; ++ks) {
        const int fo = ks ? fo1 : fo0;
        bf16x8 a[4], b[4];
#pragma unroll
        for (int m = 0; m < 4; ++m) a[m] = *(const bf16x8*)(Ab + m * 16 * 64 + fo);
#pragma unroll
        for (int n = 0; n < 4; ++n) b[n] = *(const bf16x8*)(Bb + n * 16 * 64 + fo);
#pragma unroll
        for (int m = 0; m < 4; ++m)
#pragma unroll
          for (int n = 0; n < 4; ++n) acc[m][n] = mfma16(b[n], a[m], acc[m][n]);
      }
      al.store(sm + ((kt + 1) & 1) * TILE, ra[(u + 1) % NST]);
      bl.store(sm + (2 + ((kt + 1) & 1)) * TILE, rb[(u + 1) % NST]);
      {
        int k2 = kt + 1 + NST;
        k2 = k2 < nk ? k2 : nk - 1;
        al.load(k2, ra[(u + 1) % NST]); bl.load(k2, rb[(u + 1) % NST]);
      }
      __syncthreads();
    }
  }
}

__device__ __forceinline__ void glds_prefetch0(const bf16_t* Atile, size_t lda, const bf16_t* Btile, size_t ldb, bf16_t* sm, int tid) {
  constexpr int TILE = 128 * 64;
  const int gch = ((tid & 7) ^ ((tid >> 4) & 7)) * 8;
  const bf16_t* ga = Atile + (size_t)(tid >> 3) * lda + gch;
  const bf16_t* gb = Btile + (size_t)(tid >> 3) * ldb + gch;
  const size_t a32 = lda * 32, b32 = ldb * 32;
  bf16_t* lbase = sm + tid * 8;
#pragma unroll
  for (int i_ = 0; i_ < 4; ++i_) {
    __builtin_amdgcn_global_load_lds((const unsigned*)(ga + i_ * a32), (unsigned*)(lbase + i_ * 2048), 16, 0, 0);
    __builtin_amdgcn_global_load_lds((const unsigned*)(gb + i_ * b32), (unsigned*)(lbase + 2 * TILE + i_ * 2048), 16, 0, 0);
  }
}

#define DSR1(dst, base, OFF) asm volatile("ds_read_b128 %0, %1 offset:" #OFF : "=v"(dst) : "v"(base) : "memory")
#define DSR4(arr, base) do { DSR1(arr[0], base, 0); DSR1(arr[1], base, 2048); DSR1(arr[2], base, 4096); DSR1(arr[3], base, 6144); } while (0)
template <bool HOIST>
__device__ __forceinline__ void gemm_core_glds(f32x4 (&acc)[4][4], const bf16_t* Atile, size_t lda, const bf16_t* Btile, size_t ldb,
                                               int nk, bf16_t* sm, int tid) {
  const int lane = tid & 63, w = tid >> 6, wr = w >> 1, wc = w & 1, l15 = lane & 15, grp = lane >> 4;
  constexpr int TILE = 128 * 64;
  const int sw = (l15 >> 1) & 7;
  const int fo0 = l15 * 64 + ((grp ^ sw) * 8), fo1 = l15 * 64 + (((4 + grp) ^ sw) * 8);
  const int gch = ((tid & 7) ^ ((tid >> 4) & 7)) * 8;
  const bf16_t* ga = Atile + (size_t)(tid >> 3) * lda + gch;
  const bf16_t* gb = Btile + (size_t)(tid >> 3) * ldb + gch;
  const size_t a32 = lda * 32, b32 = ldb * 32;
  bf16_t* lbase = sm + tid * 8;
#define GLDS_ISSUE(KT, BUF)                                                                                                            \
  do {                                                                                                                                 \
    _Pragma("unroll") for (int i_ = 0; i_ < 4; ++i_) {                                                                                 \
      __builtin_amdgcn_global_load_lds((const unsigned*)(ga + i_ * a32 + (KT) * 64), (unsigned*)(lbase + (BUF) * TILE + i_ * 2048), 16, 0, 0);       \
      __builtin_amdgcn_global_load_lds((const unsigned*)(gb + i_ * b32 + (KT) * 64), (unsigned*)(lbase + (2 + (BUF)) * TILE + i_ * 2048), 16, 0, 0); \
    }                                                                                                                                  \
  } while (0)
#define GLDS_COMPUTE(BUF)                                                                             \
  do {                                                                                                \
    const bf16_t* Ab = sm + (BUF) * TILE + wr * 64 * 64;                                              \
    const bf16_t* Bb = sm + (2 + (BUF)) * TILE + wc * 64 * 64;                                        \
    if (HOIST) {                                                                                      \
        \
      bf16x8 a0[4], b0[4], a1[4], b1[4];                                                              \
      const unsigned pa0 = (unsigned)(size_t)(Ab + fo0), pb0 = (unsigned)(size_t)(Bb + fo0);          \
      const unsigned pa1 = (unsigned)(size_t)(Ab + fo1), pb1 = (unsigned)(size_t)(Bb + fo1);          \
      DSR4(a0, pa0); DSR4(b0, pb0); DSR4(a1, pa1); DSR4(b1, pb1);                                     \
      asm volatile("s_waitcnt lgkmcnt(8)" : "+v"(a0[0]), "+v"(a0[1]), "+v"(a0[2]), "+v"(a0[3]), "+v"(b0[0]), "+v"(b0[1]), "+v"(b0[2]), "+v"(b0[3]) :: "memory"); \
      _Pragma("unroll") for (int m = 0; m < 4; ++m)                                                   \
        _Pragma("unroll") for (int n = 0; n < 4; ++n) acc[m][n] = mfma16(b0[n], a0[m], acc[m][n]);    \
      __builtin_amdgcn_sched_barrier(0);             \
      asm volatile("s_waitcnt lgkmcnt(0)" : "+v"(a1[0]), "+v"(a1[1]), "+v"(a1[2]), "+v"(a1[3]), "+v"(b1[0]), "+v"(b1[1]), "+v"(b1[2]), "+v"(b1[3]) :: "memory"); \
      _Pragma("unroll") for (int m = 0; m < 4; ++m)                                                   \
        _Pragma("unroll") for (int n = 0; n < 4; ++n) acc[m][n] = mfma16(b1[n], a1[m], acc[m][n]);    \
      __builtin_amdgcn_sched_barrier(0);             \
    } else {                                                                                          \
      _Pragma("unroll") for (int ks = 0; ks < 2; ++ks) {                                              \
        const int fo = ks ? fo1 : fo0;                                                                \
        bf16x8 a[4], b[4];                                                                            \
        _Pragma("unroll") for (int m = 0; m < 4; ++m) a[m] = *(const bf16x8*)(Ab + m * 16 * 64 + fo); \
        _Pragma("unroll") for (int n = 0; n < 4; ++n) b[n] = *(const bf16x8*)(Bb + n * 16 * 64 + fo); \
        _Pragma("unroll") for (int m = 0; m < 4; ++m)                                                 \
          _Pragma("unroll") for (int n = 0; n < 4; ++n) acc[m][n] = mfma16(b[n], a[m], acc[m][n]);     \
      }                                                                                               \
    }                                                                                                 \
  } while (0)
  asm volatile("s_waitcnt vmcnt(0)" ::: "memory");
  __syncthreads();
  for (int kt = 0; kt < nk; kt += 2) {
    GLDS_ISSUE(kt + 1, 1);
    GLDS_COMPUTE(0);
    asm volatile("s_waitcnt vmcnt(0)" ::: "memory");
    __syncthreads();
    if (kt + 2 < nk) GLDS_ISSUE(kt + 2, 0);
    GLDS_COMPUTE(1);
    asm volatile("s_waitcnt vmcnt(0)" ::: "memory");
    __syncthreads();
  }
#undef GLDS_ISSUE
#undef GLDS_COMPUTE
}

__device__ __forceinline__ void gemm_core_glds_cmp(f32x4 (&acc)[4][4], const bf16_t* colptr, int r0, const bf16_t* Btile, size_t ldb,
                                                   int nk, bf16_t* sm, int tid) {
  const int lane = tid & 63, w = tid >> 6, wr = w >> 1, wc = w & 1, l15 = lane & 15, grp = lane >> 4;
  constexpr int TILE = 128 * 64;
  const int sw = (l15 >> 1) & 7;
  const int fo0 = l15 * 64 + ((grp ^ sw) * 8), fo1 = l15 * 64 + (((4 + grp) ^ sw) * 8);
  const int gch = ((tid & 7) ^ ((tid >> 4) & 7)) * 8;
  const bf16_t* gb = Btile + (size_t)(tid >> 3) * ldb + gch;
  const size_t b32 = ldb * 32;
  bf16_t* lbase = sm + tid * 8;
#define CMP_ISSUE(KT, BUF)                                                                                                             \
  do {                                                                                                                                 \
    _Pragma("unroll") for (int i_ = 0; i_ < 4; ++i_) {                                                                                 \
      int tok_ = 16 * (r0 + 32 * i_) + (KT);                                                                                           \
      tok_ = tok_ > (SEQ - 1) ? (SEQ - 1) : tok_;                                                                                      \
      __builtin_amdgcn_global_load_lds((const unsigned*)(colptr + (size_t)tok_ * 1536), (unsigned*)(lbase + (BUF) * TILE + i_ * 2048), 16, 0, 0);     \
      __builtin_amdgcn_global_load_lds((const unsigned*)(gb + i_ * b32 + (KT) * 64), (unsigned*)(lbase + (2 + (BUF)) * TILE + i_ * 2048), 16, 0, 0); \
    }                                                                                                                                  \
  } while (0)
#define CMP_COMPUTE(BUF)                                                                              \
  do {                                                                                                \
    const bf16_t* Ab = sm + (BUF) * TILE + wr * 64 * 64;                                              \
    const bf16_t* Bb = sm + (2 + (BUF)) * TILE + wc * 64 * 64;                                        \
    _Pragma("unroll") for (int ks = 0; ks < 2; ++ks) {                                                \
      const int fo = ks ? fo1 : fo0;                                                                  \
      bf16x8 a[4], b[4];                                                                              \
      _Pragma("unroll") for (int m = 0; m < 4; ++m) a[m] = *(const bf16x8*)(Ab + m * 16 * 64 + fo);   \
      _Pragma("unroll") for (int n = 0; n < 4; ++n) b[n] = *(const bf16x8*)(Bb + n * 16 * 64 + fo);   \
      _Pragma("unroll") for (int m = 0; m < 4; ++m)                                                   \
        _Pragma("unroll") for (int n = 0; n < 4; ++n) acc[m][n] = mfma16(b[n], a[m], acc[m][n]);     \
    }                                                                                                 \
  } while (0)
  __syncthreads();
  CMP_ISSUE(0, 0);
  asm volatile("s_waitcnt vmcnt(0)" ::: "memory");
  __syncthreads();
  for (int kt = 0; kt < nk; kt += 2) {
    CMP_ISSUE(kt + 1, 1);
    CMP_COMPUTE(0);
    asm volatile("s_waitcnt vmcnt(0)" ::: "memory");
    __syncthreads();
    if (kt + 2 < nk) CMP_ISSUE(kt + 2, 0);
    CMP_COMPUTE(1);
    asm volatile("s_waitcnt vmcnt(0)" ::: "memory");
    __syncthreads();
  }
#undef CMP_ISSUE
#undef CMP_COMPUTE
}

__device__ __forceinline__ void zero_acc(f32x4 (&acc)[4][4]) {
#pragma unroll
  for (int m = 0; m < 4; ++m)
#pragma unroll
    for (int n = 0; n < 4; ++n) acc[m][n] = f32x4{0.f, 0.f, 0.f, 0.f};
}

__device__ __forceinline__ void phase_inproj(const Params& p, int l, char* smraw) {
  bf16_t* sm = (bf16_t*)smraw;
  const bf16_t* H = (const bf16_t*)(p.ws + OFF_H);
  const bf16_t* W = (const bf16_t*)(p.ws + OFF_WINT) + (size_t)l * NP * D;
  bf16_t* yApre = (bf16_t*)(p.ws + OFF_YAPRE);
  bf16_t* bzA = (bf16_t*)(p.ws + OFF_BZA);
  bf16_t* qb = (bf16_t*)(p.ws + OFF_Q);
  bf16_t* zb = (bf16_t*)(p.ws + OFF_ZB);
  bf16_t* uz = (bf16_t*)(p.ws + OFF_UZ);
  bf16_t* gv = (bf16_t*)(p.ws + OFF_GV);
  bf16_t* kvb = (bf16_t*)(p.ws + OFF_KV);
  float* glb = (float*)(p.ws + OFF_GL);
  bf16_t* gates = (bf16_t*)(p.ws + OFF_GATES);
  const int tid = opaque_tid(); const int lane = tid & 63, w = tid >> 6, wr = w >> 1, wc = w & 1, l15 = lane & 15, grp = lane >> 4;
  constexpr int MT = R / 128;
  constexpr int NC = (NT_IN + 7) / 8;
  const int nx = gridDim.x >> 3;
  constexpr int CJ_END = (MT / 8) * NC * 64;
  auto cj_valid = [&](int c) { return c < CJ_END && ((c >> 6) % NC) * 8 + ((c & 63) >> 3) < NT_IN; };
  auto cj_next = [&](int c) {
    do { c = ((c & 63) + nx < 64) ? (c + nx) : (((c >> 6) + 8) * 64 + (int)(blockIdx.x >> 3)); } while (c < CJ_END && !cj_valid(c));
    return c;
  };
  int cj = (blockIdx.x & 7) * 64 + (blockIdx.x >> 3);
  if (!cj_valid(cj)) cj = cj_next(cj);
  __syncthreads();
  if (cj < CJ_END) {
    const int cell = cj >> 6, jj = cj & 63;
    glds_prefetch0(H + (size_t)((cell / NC) * 8 + (jj & 7)) * 128 * D, D, W + (size_t)((cell % NC) * 8 + (jj >> 3)) * 128 * D, D, sm, tid);
  }
  while (cj < CJ_END) {
    const int cell = cj >> 6, jj = cj & 63;
    const int nt = (cell % NC) * 8 + (jj >> 3), mt = (cell / NC) * 8 + (jj & 7);
    f32x4 acc[4][4];
    zero_acc(acc);
    gemm_core_glds<true>(acc, H + (size_t)mt * 128 * D, D, W + (size_t)nt * 128 * D, D, D / 64, sm, tid);
    cj = cj_next(cj);
    if (cj < CJ_END) {
      const int cell2 = cj >> 6, jj2 = cj & 63;
      glds_prefetch0(H + (size_t)((cell2 / NC) * 8 + (jj2 & 7)) * 128 * D, D, W + (size_t)((cell2 % NC) * 8 + (jj2 >> 3)) * 128 * D, D, sm, tid);
    }
    const int rbase = mt * 128 + wr * 64 + l15;
    const int c4 = 4 * grp;
#define ST4(PTR, V0, V1, V2, V3) *(u32x2*)(PTR) = u32x2{pack2((V0), (V1)), pack2((V2), (V3))}
    if (nt < 32) {
      const int ch = nt * 32 + wc * 16 + c4;
#pragma unroll
      for (int m = 0; m < 4; ++m) {
        const size_t row = rbase + m * 16;
        ST4(yApre + row * 1024 + ch, acc[m][1][0] * acc[m][2][0], acc[m][1][1] * acc[m][2][1], acc[m][1][2] * acc[m][2][2], acc[m][1][3] * acc[m][2][3]);
        ST4(bzA + row * 1024 + ch, acc[m][0][0] * silu_(acc[m][3][0]), acc[m][0][1] * silu_(acc[m][3][1]), acc[m][0][2] * silu_(acc[m][3][2]), acc[m][0][3] * silu_(acc[m][3][3]));
      }
    } else if (nt < 40) {
      const int cb = (nt - 32) * 128 + wc * 64 + c4;
      const float qs = 0.125f * 1.44269504f;
#pragma unroll
      for (int m = 0; m < 4; ++m)
#pragma unroll
        for (int n = 0; n < 4; ++n)
          ST4(qb + (size_t)(rbase + m * 16) * 1024 + cb + n * 16, acc[m][n][0] * qs, acc[m][n][1] * qs, acc[m][n][2] * qs, acc[m][n][3] * qs);
    } else if (nt < 52) {
      const int cb = (nt - 40) * 128 + wc * 64 + c4;
#pragma unroll
      for (int m = 0; m < 4; ++m)
#pragma unroll
        for (int n = 0; n < 4; ++n)
          ST4(kvb + (size_t)(rbase + m * 16) * 1536 + cb + n * 16, acc[m][n][0], acc[m][n][1], acc[m][n][2], acc[m][n][3]);
    } else if (nt < 60) {
      const int cb = (nt - 52) * 128 + wc * 64 + c4;
#pragma unroll
      for (int m = 0; m < 4; ++m)
#pragma unroll
        for (int n = 0; n < 4; ++n)
          ST4(zb + (size_t)(rbase + m * 16) * 1024 + cb + n * 16, silu_(acc[m][n][0]), silu_(acc[m][n][1]), silu_(acc[m][n][2]), silu_(acc[m][n][3]));
    } else if (nt == 60) {
      if (wc == 0) {
#pragma unroll
        for (int m = 0; m < 4; ++m)
#pragma unroll
          for (int n = 0; n < 3; ++n)
            *(f32x4*)(glb + (size_t)(rbase + m * 16) * 48 + n * 16 + c4) =
                f32x4{sigmoid_(acc[m][n][0]), sigmoid_(acc[m][n][1]), sigmoid_(acc[m][n][2]), sigmoid_(acc[m][n][3])};
      }
    } else if (nt < 77) {
      const int chb = (nt - 61) * 64 + wc * 32 + c4;
#pragma unroll
      for (int m = 0; m < 4; ++m)
#pragma unroll
        for (int pr = 0; pr < 2; ++pr)
          ST4(uz + (size_t)(rbase + m * 16) * 1024 + chb + pr * 16,
              gelu_(acc[m][2 * pr][0]) * silu_(acc[m][2 * pr + 1][0]), gelu_(acc[m][2 * pr][1]) * silu_(acc[m][2 * pr + 1][1]),
              gelu_(acc[m][2 * pr][2]) * silu_(acc[m][2 * pr + 1][2]), gelu_(acc[m][2 * pr][3]) * silu_(acc[m][2 * pr + 1][3]));
    } else if (nt < 85) {
      const int cb = (nt - 77) * 128 + wc * 64 + c4;
#pragma unroll
      for (int m = 0; m < 4; ++m)
#pragma unroll
        for (int n = 0; n < 4; ++n)
          ST4(gv + (size_t)(rbase + m * 16) * 1024 + cb + n * 16, gelu_(acc[m][n][0]), gelu_(acc[m][n][1]), gelu_(acc[m][n][2]), gelu_(acc[m][n][3]));
    } else {
      const int cb = (nt - 85) * 128 + wc * 64 + c4;
#pragma unroll
      for (int m = 0; m < 4; ++m)
#pragma unroll
        for (int n = 0; n < 4; ++n)
          ST4(gates + (size_t)(rbase + m * 16) * 3072 + cb + n * 16, sigmoid_(acc[m][n][0]), sigmoid_(acc[m][n][1]), sigmoid_(acc[m][n][2]), sigmoid_(acc[m][n][3]));
    }
#undef ST4
  }
}

struct CmpALoader {
  const bf16_t* rowptr;
  int r, soff;
  u32x4 r0, r1;
  __device__ __forceinline__ void load(int kt) {
    int tok = 16 * r + (kt >> 1);
    tok = tok > (SEQ - 1) ? (SEQ - 1) : tok;
    const bf16_t* q = rowptr + (size_t)tok * 1536 + (kt & 1) * 32;
    r0 = *(const u32x4*)q; r1 = *(const u32x4*)(q + 8);
  }
  __device__ __forceinline__ void store(bf16_t* tile) {
    bf16_t* q = tile + soff;
    *(u32x4*)q = r0; *(u32x4*)(q + 8) = r1;
  }
};

__device__ __forceinline__ void phase_mix1(const Params& p, int l, char* smraw) {
  const int tid = opaque_tid(); const int lane = tid & 63, w = tid >> 6, l15 = lane & 15, grp = lane >> 4;
  const bf16_t* gv = (const bf16_t*)(p.ws + OFF_GV);
  float* stats = (float*)(p.ws + OFF_STATS);
  constexpr int NCB = 2 * (NB * 4 * 256 / 128);
  const bool split = (int)gridDim.x >= 2 * NCB;
  const int eb = split ? (int)blockIdx.x - NCB : (int)blockIdx.x;
  const int neb = split ? (int)gridDim.x - NCB : (int)gridDim.x;
  for (int r = eb * 4 + w; eb >= 0 && r < R; r += neb * 4) {
    const bf16_t* row = gv + (size_t)r * 1024;
    float v[16]; float s = 0.f;
#pragma unroll
    for (int i = 0; i < 2; ++i) {
      u32x4 u = *(const u32x4*)(row + i * 512 + lane * 8);
      v[i * 8 + 0] = bf2f(u.x & 0xffffu); v[i * 8 + 1] = bf2f(u.x >> 16);
      v[i * 8 + 2] = bf2f(u.y & 0xffffu); v[i * 8 + 3] = bf2f(u.y >> 16);
      v[i * 8 + 4] = bf2f(u.z & 0xffffu); v[i * 8 + 5] = bf2f(u.z >> 16);
      v[i * 8 + 6] = bf2f(u.w & 0xffffu); v[i * 8 + 7] = bf2f(u.w >> 16);
    }
#pragma unroll
    for (int i = 0; i < 16; ++i) s += v[i];
    s = wave_sum(s, lane);
    float mu = s * (1.f / 1024.f);
    float q = 0.f;
#pragma unroll
    for (int i = 0; i < 16; ++i) { float d = v[i] - mu; q += d * d; }
    q = wave_sum(q, lane);
    if (lane == 0) { stats[r * 2] = mu; stats[r * 2 + 1] = rsqrtf(q * (1.f / 1024.f) + 1e-6f); }
  }
  {
    const bf16_t* yApre = (const bf16_t*)(p.ws + OFF_YAPRE);
    const bf16_t* bzA = (const bf16_t*)(p.ws + OFF_BZA);
    bf16_t* yA = (bf16_t*)(p.ws + OFF_YA);
    const float* cw = p.conv_w + (size_t)l * 3 * 1024;
    const float* cb = p.conv_b + (size_t)l * 1024;
    for (int e = eb * 256 + tid; eb >= 0 && e < R * 128; e += neb * 256) {
      int row = e >> 7, c8 = (e & 127) * 8;
      int t = row & (SEQ - 1);
      u32x4 y2 = *(const u32x4*)(yApre + (size_t)row * 1024 + c8);
      u32x4 y1 = (t >= 1) ? *(const u32x4*)(yApre + (size_t)(row - 1) * 1024 + c8) : u32x4{0, 0, 0, 0};
      u32x4 y0 = (t >= 2) ? *(const u32x4*)(yApre + (size_t)(row - 2) * 1024 + c8) : u32x4{0, 0, 0, 0};
      u32x4 bz = *(const u32x4*)(bzA + (size_t)row * 1024 + c8);
      u32x4 o;
#pragma unroll
      for (int i = 0; i < 4; ++i) {
        int c = c8 + i * 2;
        float r0 = cb[c] + cw[c] * bf2f(y0[i] & 0xffffu) + cw[1024 + c] * bf2f(y1[i] & 0xffffu) + cw[2048 + c] * bf2f(y2[i] & 0xffffu);
        float r1 = cb[c + 1] + cw[c + 1] * bf2f(y0[i] >> 16) + cw[1024 + c + 1] * bf2f(y1[i] >> 16) + cw[2048 + c + 1] * bf2f(y2[i] >> 16);
        o[i] = pack2(bf2f(bz[i] & 0xffffu) * r0, bf2f(bz[i] >> 16) * r1);
      }
      *(u32x4*)(yA + (size_t)row * 1024 + c8) = o;
    }
  }
  {
    bf16_t* sm = (bf16_t*)smraw;
    const bf16_t* kvb = (const bf16_t*)(p.ws + OFF_KV);
    const bf16_t* Wc1T = (const bf16_t*)(p.ws + OFF_WC1T);
    const float* bias1 = (const float*)(p.ws + OFF_BIAS1);
    const int wr = w >> 1, wc = w & 1;
    constexpr int MTC = NB * 4 * 256 / 128;
    for (int t = blockIdx.x; t < 2 * MTC; t += gridDim.x) {
      int kv = t / MTC, mt = t % MTC;
      f32x4 acc[4][4];
      zero_acc(acc);
      {
        const int rr = mt * 128 + (tid >> 3);
        const int bl = rr >> 10, g = (rr >> 8) & 3;
        const int gch = ((tid & 7) ^ ((tid >> 4) & 7)) * 8;
        gemm_core_glds_cmp(acc, kvb + (size_t)bl * SEQ * 1536 + kv * 256 + g * 64 + gch, rr & 255,
                           Wc1T + (size_t)(l * 2 + kv) * 128 * 2048, 2048, 2048 / 64, sm, tid);
      }
      bf16_t* Hs = sm;
      bf16_t* W2s = sm + 128 * HS_LD;
      const float* b1 = bias1 + (l * 2 + kv) * 8 * 128;
#pragma unroll
      for (int n = 0; n < 4; ++n) {
        const int col = wc * 64 + n * 16 + 4 * grp;
        f32x4 bb = f32x4{0.f, 0.f, 0.f, 0.f};
#pragma unroll
        for (int ks = 0; ks < 8; ++ks) bb += *(const f32x4*)(b1 + ks * 128 + col);
#pragma unroll
        for (int m = 0; m < 4; ++m)
          *(u32x2*)(Hs + (wr * 64 + m * 16 + l15) * HS_LD + col) =
              u32x2{pack2(silu_(acc[m][n][0] + bb[0]), silu_(acc[m][n][1] + bb[1])), pack2(silu_(acc[m][n][2] + bb[2]), silu_(acc[m][n][3] + bb[3]))};
      }
      const float* w2 = (kv ? p.w_cv2 : p.w_ck2) + (size_t)l * 128 * 64;
      for (int i = 0; i < 32; ++i) {
        int e = tid + 256 * i;
        int j = e >> 6, d = e & 63;
        W2s[d * HS_LD + j] = f2bf(w2[e]);
      }
      __syncthreads();
      f32x4 a2[2][4];
#pragma unroll
      for (int mm = 0; mm < 2; ++mm)
#pragma unroll
        for (int nn = 0; nn < 4; ++nn) a2[mm][nn] = f32x4{0.f, 0.f, 0.f, 0.f};
#pragma unroll
      for (int ks = 0; ks < 4; ++ks) {
        bf16x8 af[2], bfr[4];
#pragma unroll
        for (int mm = 0; mm < 2; ++mm) af[mm] = *(const bf16x8*)(Hs + (w * 32 + mm * 16 + l15) * HS_LD + ks * 32 + grp * 8);
#pragma unroll
        for (int nn = 0; nn < 4; ++nn) bfr[nn] = *(const bf16x8*)(W2s + (nn * 16 + l15) * HS_LD + ks * 32 + grp * 8);
#pragma unroll
        for (int mm = 0; mm < 2; ++mm)
#pragma unroll
          for (int nn = 0; nn < 4; ++nn) a2[mm][nn] = mfma16(af[mm], bfr[nn], a2[mm][nn]);
      }
      bf16_t* outp = (bf16_t*)(p.ws + (kv ? OFF_VCMP : OFF_KCMP));
#pragma unroll
      for (int mm = 0; mm < 2; ++mm)
#pragma unroll
        for (int nn = 0; nn < 4; ++nn)
#pragma unroll
          for (int j = 0; j < 4; ++j) {
            int row = mt * 128 + w * 32 + mm * 16 + 4 * grp + j;
            outp[(size_t)row * 64 + nn * 16 + l15] = f2bf(a2[mm][nn][j]);
          }
      __syncthreads();
    }
  }
}

struct KVRegs { u32x4 k0, k1, v0, v1; };

__device__ __forceinline__ void kv_issue(KVRegs& r, const bf16_t* kbase, const bf16_t* vbase, size_t ld, bool wantV, int tid) {
  const uint32_t row = (uint32_t)tid >> 3, c = ((uint32_t)tid & 7u) * 8u;
  const uint32_t ldu = (ld == 64 ? 64u : 1536u);
  const uint32_t off = row * ldu + c;
  const bf16_t* kp = kbase + off;
  r.k0 = *(const u32x4*)kp; r.k1 = *(const u32x4*)(kp + 32u * ldu);
  if (wantV) {
    const bf16_t* vp = vbase + off;
    r.v0 = *(const u32x4*)vp; r.v1 = *(const u32x4*)(vp + 32u * ldu);
  }
}
__device__ __forceinline__ void kv_commit(const KVRegs& r, bf16_t* Ks, bf16_t* Vs, bool wantV, int tid) {
  int row = tid >> 3, c = (tid & 7) * 8;
  *(u32x4*)(Ks + row * KS_LD + c) = r.k0;
  *(u32x4*)(Ks + (row + 32) * KS_LD + c) = r.k1;
  if (wantV) {
    *(u32x4*)(Vs + row * KS_LD + c) = r.v0;
    *(u32x4*)(Vs + (row + 32) * KS_LD + c) = r.v1;
  }
}

typedef short s16x4 __attribute__((ext_vector_type(4)));
__device__ __forceinline__ s16x4 tr_read(const bf16_t* ptr) {
  return __builtin_amdgcn_ds_read_tr16_b64_v4i16((s16x4 __attribute__((address_space(3)))*)ptr);
}

#define ADSR(dst, base, OFF) asm volatile("ds_read_b128 %0, %1 offset:" #OFF : "=v"(dst) : "v"(base) : "memory")
#define ATRR(dst, base, OFF) asm volatile("ds_read_b64_tr_b16 %0, %1 offset:" #OFF : "=v"(dst) : "v"(base) : "memory")
template <bool MASKED>
__device__ __forceinline__ void attn_block64(const bf16_t* Ks, const bf16_t* Vs, bf16x8 q0, bf16x8 q1, int tq, int kp0, int kpstride,
                                             int maxdist, bool extra_ok, float slope, float& m, float& lsum, f32x4 (&o)[4], int l15, int grp,
                                             const f32x4 (&tb)[4]) {
  const float fst = (float)kpstride;
  const int d0 = tq - kp0 - 4 * grp * kpstride;
  const float base = -slope * (float)d0;
  const unsigned kaddr = (unsigned)(size_t)(Ks + l15 * KS_LD + grp * 8);
  const unsigned vaddr = (unsigned)(size_t)(Vs + (4 * grp + (l15 >> 2)) * KS_LD + 4 * (l15 & 3));
  bf16x8 kf[8];
  ADSR(kf[0], kaddr, 0);    ADSR(kf[1], kaddr, 64);   ADSR(kf[2], kaddr, 2560); ADSR(kf[3], kaddr, 2624);
  ADSR(kf[4], kaddr, 5120); ADSR(kf[5], kaddr, 5184); ADSR(kf[6], kaddr, 7680); ADSR(kf[7], kaddr, 7744);
  f32x4 s[4];
  asm volatile("s_waitcnt lgkmcnt(6)" : "+v"(kf[0]), "+v"(kf[1]) :: "memory");
  s[0] = mfma16(kf[1], q1, mfma16(kf[0], q0, f32x4{0.f, 0.f, 0.f, 0.f}));
  asm volatile("s_waitcnt lgkmcnt(4)" : "+v"(kf[2]), "+v"(kf[3]) :: "memory");
  s[1] = mfma16(kf[3], q1, mfma16(kf[2], q0, f32x4{0.f, 0.f, 0.f, 0.f}));
  asm volatile("s_waitcnt lgkmcnt(2)" : "+v"(kf[4]), "+v"(kf[5]) :: "memory");
  s[2] = mfma16(kf[5], q1, mfma16(kf[4], q0, f32x4{0.f, 0.f, 0.f, 0.f}));
  asm volatile("s_waitcnt lgkmcnt(0)" : "+v"(kf[6]), "+v"(kf[7]) :: "memory");
  s[3] = mfma16(kf[7], q1, mfma16(kf[6], q0, f32x4{0.f, 0.f, 0.f, 0.f}));
  s16x4 vt[16];
  ATRR(vt[0], vaddr, 0);     ATRR(vt[1], vaddr, 2560);  ATRR(vt[2], vaddr, 32);    ATRR(vt[3], vaddr, 2592);
  ATRR(vt[4], vaddr, 64);    ATRR(vt[5], vaddr, 2624);  ATRR(vt[6], vaddr, 96);    ATRR(vt[7], vaddr, 2656);
  ATRR(vt[8], vaddr, 5120);  ATRR(vt[9], vaddr, 7680);  ATRR(vt[10], vaddr, 5152); ATRR(vt[11], vaddr, 7712);
  ATRR(vt[12], vaddr, 5184); ATRR(vt[13], vaddr, 7744); ATRR(vt[14], vaddr, 5216); ATRR(vt[15], vaddr, 7776);
  float cmax = -1e30f;
#pragma unroll
  for (int t = 0; t < 4; ++t)
#pragma unroll
    for (int j = 0; j < 4; ++j) {
      const int ci = t * 16 + j;
      float v = __builtin_fmaf(tb[t][j], fst, s[t][j]);
      if (MASKED) {
        const int dist = d0 - ci * kpstride;
        const bool valid = extra_ok && dist >= 0 && dist < maxdist;
        v = valid ? v : -1e30f;
      }
      s[t][j] = v;
      cmax = fmaxf(cmax, v);
    }
  if (!MASKED) cmax = extra_ok ? cmax : -1e30f;
  if (__ballot(cmax + base > m + 40.f) != 0ull) {
    cmax = (cmax > -1e29f) ? cmax + base : -1e30f;
    cmax = fmaxf(cmax, bperm(cmax, (l15 + 16 * grp) ^ 16));
    cmax = fmaxf(cmax, bperm(cmax, (l15 + 16 * grp) ^ 32));
    const float mnew = fmaxf(m, cmax);
    const float alpha = __builtin_amdgcn_exp2f(m - mnew);
    lsum *= alpha;
#pragma unroll
    for (int dt = 0; dt < 4; ++dt) o[dt] *= alpha;
    m = mnew;
  }
  float psum = 0.f;
  const float mb = m - base;
#pragma unroll
  for (int t = 0; t < 4; ++t)
#pragma unroll
    for (int j = 0; j < 4; ++j) {
      const float v = s[t][j];
      float pe = __builtin_amdgcn_exp2f(v - mb);
      if (MASKED) pe = (v > -1e29f) ? pe : 0.f;
      s[t][j] = pe;
      psum += pe;
    }
  if (!MASKED) psum = extra_ok ? psum : 0.f;
  lsum += psum;
  const uint32_t rowm = (MASKED || extra_ok) ? 0xffffffffu : 0u;
  asm volatile("s_waitcnt lgkmcnt(0)"
               : "+v"(vt[0]), "+v"(vt[1]), "+v"(vt[2]), "+v"(vt[3]), "+v"(vt[4]), "+v"(vt[5]), "+v"(vt[6]), "+v"(vt[7]),
                 "+v"(vt[8]), "+v"(vt[9]), "+v"(vt[10]), "+v"(vt[11]), "+v"(vt[12]), "+v"(vt[13]), "+v"(vt[14]), "+v"(vt[15])
               :: "memory");
#pragma unroll
  for (int sc = 0; sc < 2; ++sc) {
    const bf16x8 pb = __builtin_bit_cast(bf16x8, u32x4{pack2(s[2 * sc][0], s[2 * sc][1]) & rowm, pack2(s[2 * sc][2], s[2 * sc][3]) & rowm,
                                                       pack2(s[2 * sc + 1][0], s[2 * sc + 1][1]) & rowm, pack2(s[2 * sc + 1][2], s[2 * sc + 1][3]) & rowm});
#pragma unroll
    for (int dt = 0; dt < 4; ++dt) {
      const s16x4 vlo = vt[sc * 8 + dt * 2], vhi = vt[sc * 8 + dt * 2 + 1];
      const bf16x8 vf = {vlo[0], vlo[1], vlo[2], vlo[3], vhi[0], vhi[1], vhi[2], vhi[3]};
      o[dt] = mfma16(vf, pb, o[dt]);
    }
  }
}

constexpr int ATT_TILE = 64 * KS_LD * 2;
constexpr int ATT_BUF = 2 * ATT_TILE;

template <class DescF, class ProcF>
__device__ __forceinline__ void kv_stream(int n, DescF desc, ProcF proc, char* smraw, int tid) {
  if (n <= 0) return;
  KVRegs r0, r1;
  const bf16_t *kp, *vp; size_t ld;
  desc(0, kp, vp, ld); kv_issue(r0, kp, vp, ld, true, tid);
  desc(1 < n ? 1 : n - 1, kp, vp, ld); kv_issue(r1, kp, vp, ld, true, tid);
  __syncthreads();
  kv_commit(r0, (bf16_t*)smraw, (bf16_t*)(smraw + ATT_TILE), true, tid);
  desc(2 < n ? 2 : n - 1, kp, vp, ld); kv_issue(r0, kp, vp, ld, true, tid);
  __syncthreads();
  for (int e0 = 0; e0 < n; e0 += 2) {
    {
      const int e = e0;
      proc(e, (const bf16_t*)smraw, (const bf16_t*)(smraw + ATT_TILE));
      kv_commit(r1, (bf16_t*)(smraw + ATT_BUF), (bf16_t*)(smraw + ATT_BUF + ATT_TILE), true, tid);
      desc(e + 3 < n ? e + 3 : n - 1, kp, vp, ld); kv_issue(r1, kp, vp, ld, true, tid);
      __syncthreads();
    }
    {
      const int e = e0 + 1;
      if (e < n) proc(e, (const bf16_t*)(smraw + ATT_BUF), (const bf16_t*)(smraw + ATT_BUF + ATT_TILE));
      kv_commit(r0, (bf16_t*)smraw, (bf16_t*)(smraw + ATT_TILE), true, tid);
      desc(e + 3 < n ? e + 3 : n - 1, kp, vp, ld); kv_issue(r0, kp, vp, ld, true, tid);
      __syncthreads();
    }
  }
}

__device__ __forceinline__ void attn_unit(const Params& p, char* smraw, int bl, int g, int qb) {
  float* impbuf = (float*)(smraw + 2 * ATT_BUF);
  unsigned long long* selmask = (unsigned long long*)(smraw + 2 * ATT_BUF + 16640);
  int* sellist = (int*)(smraw + 2 * ATT_BUF + 16640 + 128);
  const bf16_t* qbuf = (const bf16_t*)(p.ws + OFF_Q);
  const bf16_t* zbuf = (const bf16_t*)(p.ws + OFF_ZB);
  const bf16_t* kvb = (const bf16_t*)(p.ws + OFF_KV);
  const float* glb = (const float*)(p.ws + OFF_GL);
  bf16_t* yB = (bf16_t*)(p.ws + OFF_YB);
  const int tid = opaque_tid(); const int lane = tid & 63, n = tid >> 6, l15 = lane & 15, grp = lane >> 4;
  const int h = g * 4 + n, t0 = qb * 16, tq = t0 + l15;
  const float slope = exp2f(-0.5f * (float)(h + 1)) * 1.44269504f;
  f32x4 tb[4];
#pragma unroll
  for (int t = 0; t < 4; ++t) tb[t] = f32x4{slope * (float)(16 * t), slope * (float)(16 * t + 1), slope * (float)(16 * t + 2), slope * (float)(16 * t + 3)};
  const size_t rowq = (size_t)bl * SEQ + tq;
  bf16x8 q0, q1;
  {
    const bf16_t* qp = qbuf + rowq * 1024 + h * 64 + grp * 8;
    q0 = *(const bf16x8*)qp; q1 = *(const bf16x8*)(qp + 32);
  }
  const float g0 = glb[rowq * 48 + h * 3 + 0], g1 = glb[rowq * 48 + h * 3 + 1], g2 = glb[rowq * 48 + h * 3 + 2];
  f32x4 otot[4];
#pragma unroll
  for (int dt = 0; dt < 4; ++dt) otot[dt] = f32x4{0.f, 0.f, 0.f, 0.f};
  const size_t seqbase = (size_t)bl * SEQ * 1536 + g * 64;
  const int BIG = 1 << 30;
  const bf16_t* kcb = (const bf16_t*)(p.ws + OFF_KCMP) + (size_t)(bl * 4 + g) * 256 * 64;
  const bf16_t* vcb = (const bf16_t*)(p.ws + OFF_VCMP) + (size_t)(bl * 4 + g) * 256 * 64;
  const bf16_t* kwb = kvb + seqbase + 1024;
  const bf16_t* vwb = kvb + seqbase + 1280;
  const bf16_t* ksb = kvb + seqbase + 512;
  const bf16_t* vsb = kvb + seqbase + 768;

  float m = -1e30f, lsum = 0.f;
  f32x4 o[4];
#pragma unroll
  for (int dt = 0; dt < 4; ++dt) o[dt] = f32x4{0.f, 0.f, 0.f, 0.f};
  float m_c = -1e30f, inv_c = 0.f, prev_rot = 0.f;
  float* myimp = impbuf + n * 1040;
#pragma unroll
  for (int i = 0; i < 16; ++i) myimp[i * 65 + lane] = 0.f;

  int lo = t0 - 511; lo = lo < 0 ? 0 : lo;
  const int wlo = lo >> 6, whi = t0 >> 6, nW = whi - wlo + 1;
  const int nck = (qb + 63) >> 6;
  auto finish = [&](float gate) -> float {
    float lt = lsum + bperm(lsum, lane ^ 16);
    lt += bperm(lt, lane ^ 32);
    const float inv = lt > 0.f ? 1.f / lt : 0.f;
    const float sc_ = gate * inv;
#pragma unroll
    for (int dt = 0; dt < 4; ++dt) { otot[dt] += o[dt] * sc_; o[dt] = f32x4{0.f, 0.f, 0.f, 0.f}; }
    lsum = 0.f;
    return inv;
  };
  kv_stream(nW + 2 * nck,
    [&](int e, const bf16_t*& kp, const bf16_t*& vp, size_t& ld) {
      if (e < nW) { const size_t off = (size_t)(whi - e) * 64 * 1536; kp = kwb + off; vp = vwb + off; ld = 1536; }
      else { const int c = (e < nW + nck) ? (nW + nck - 1 - e) : (e - nW - nck); kp = kcb + c * 4096; vp = vcb + c * 4096; ld = 64; }
    },
    [&](int e, const bf16_t* Ks, const bf16_t* Vt) {
      if (e < nW) {
        const int wb = whi - e;
        if (wb < whi && wb * 64 >= t0 - 496) attn_block64<false>(Ks, Vt, q0, q1, tq, wb * 64, 1, 512, true, slope, m, lsum, o, l15, grp, tb);
        else attn_block64<true>(Ks, Vt, q0, q1, tq, wb * 64, 1, 512, true, slope, m, lsum, o, l15, grp, tb);
        if (e == nW - 1) { (void)finish(g2); m = -1e30f; }
      } else if (e < nW + nck) {
        const int c = nW + nck - 1 - e;
        if (16 * (64 * c + 63) + 31 <= t0) attn_block64<false>(Ks, Vt, q0, q1, tq, 1024 * c + 31, 16, BIG, true, slope, m, lsum, o, l15, grp, tb);
        else attn_block64<true>(Ks, Vt, q0, q1, tq, 1024 * c + 31, 16, BIG, true, slope, m, lsum, o, l15, grp, tb);
        if (e == nW + nck - 1) { inv_c = finish(g0); m_c = m; m = -1e30f; }
      } else {
        const int c = e - nW - nck;
#pragma unroll
        for (int tt = 0; tt < 4; ++tt) {
          const bf16_t* krp = Ks + (tt * 16 + l15) * KS_LD + grp * 8;
          bf16x8 k0 = *(const bf16x8*)krp, k1 = *(const bf16x8*)(krp + 32);
          f32x4 z = f32x4{0.f, 0.f, 0.f, 0.f};
          z = mfma16(k0, q0, z);
          z = mfma16(k1, q1, z);
          float sum4 = 0.f, p3 = 0.f;
#pragma unroll
          for (int j = 0; j < 4; ++j) {
            int kidx = c * 64 + tt * 16 + 4 * grp + j;
            int dist = tq - (16 * kidx + 31);
            float pe = (dist >= 0) ? __builtin_amdgcn_exp2f(z[j] - slope * (float)dist - m_c) * inv_c : 0.f;
            sum4 += pe;
            if (j == 3) p3 = pe;
          }
          float rot = bperm(p3, (lane + 48) & 63);
          float extra = (grp == 0) ? prev_rot : rot;
          myimp[l15 * 65 + (c * 4 + tt) * 4 + grp] = sum4 + extra;
          prev_rot = rot;
        }
      }
    }, smraw, tid);
  if (nck < 4 && grp == 0) myimp[l15 * 65 + nck * 16] = prev_rot;
  __syncthreads();
#pragma unroll 1
  for (int i = 0; i < 4; ++i) {
    int qi = n * 4 + i;
    int tqq = t0 + qi, cur = tqq >> 6, s = lane;
    float imp = impbuf[qi * 65 + s] + impbuf[1040 + qi * 65 + s] + impbuf[2080 + qi * 65 + s] + impbuf[3120 + qi * 65 + s];
    bool forced = (s == 0) || (s == cur) || (s == cur - 1);
    bool valid = s <= cur;
    float score = forced ? __builtin_inff() : (valid ? imp : -__builtin_inff());
    int rank = 0;
#pragma unroll 8
    for (int sp = 0; sp < 64; ++sp) {
      float v = bperm(score, sp);
      rank += ((v > score) || (v == score && sp < s)) ? 1 : 0;
    }
    unsigned long long mk = __ballot((rank < 16) && valid);
    if (lane == 0) selmask[qi] = mk;
  }
  __syncthreads();
  const unsigned long long mymask = selmask[l15];
  unsigned long long U = 0, Uand = ~0ull;
#pragma unroll
  for (int i = 0; i < 16; ++i) { const unsigned long long mk = selmask[i]; U |= mk; Uand &= mk; }
  {
    uint32_t ulo = __builtin_amdgcn_readfirstlane((uint32_t)U), uhi = __builtin_amdgcn_readfirstlane((uint32_t)(U >> 32));
    U = ((unsigned long long)uhi << 32) | ulo;
    ulo = __builtin_amdgcn_readfirstlane((uint32_t)Uand); uhi = __builtin_amdgcn_readfirstlane((uint32_t)(Uand >> 32));
    Uand = ((unsigned long long)uhi << 32) | ulo;
  }
  const int nsel = __popcll(U);
  if (n == 0) {
    if ((U >> lane) & 1ull) sellist[__popcll(U >> lane) - 1] = lane;
  }
  __syncthreads();
  kv_stream(nsel,
    [&](int e, const bf16_t*& kp, const bf16_t*& vp, size_t& ld) {
      const int s = __builtin_amdgcn_readfirstlane(sellist[e]);
      const size_t off = (size_t)s * 64 * 1536; kp = ksb + off; vp = vsb + off; ld = 1536;
    },
    [&](int e, const bf16_t* Ks, const bf16_t* Vt) {
      const int s = __builtin_amdgcn_readfirstlane(sellist[e]);
      const bool ok = (mymask >> s) & 1ull;
      if (s < whi) attn_block64<false>(Ks, Vt, q0, q1, tq, s * 64, 1, BIG, ok, slope, m, lsum, o, l15, grp, tb);
      else attn_block64<true>(Ks, Vt, q0, q1, tq, s * 64, 1, BIG, ok, slope, m, lsum, o, l15, grp, tb);
    }, smraw, tid);
  (void)finish(g1);
#pragma unroll
  for (int dt = 0; dt < 4; ++dt) {
    size_t off = rowq * 1024 + h * 64 + dt * 16 + 4 * grp;
    u32x2 zz = *(const u32x2*)(zbuf + off);
    u32x2 ov;
    ov.x = pack2(otot[dt][0] * bf2f(zz.x & 0xffffu), otot[dt][1] * bf2f(zz.x >> 16));
    ov.y = pack2(otot[dt][2] * bf2f(zz.y & 0xffffu), otot[dt][3] * bf2f(zz.y >> 16));
    *(u32x2*)(yB + off) = ov;
  }
}

struct GmlpBLoader {
  const bf16_t* gvbase;
  const float* stats;
  const float* lg; const float* lb;
  int tid;
  u32x4 r[2]; f32x2 st[2];
  __device__ __forceinline__ void load(int kt) {
#pragma unroll
    for (int i = 0; i < 2; ++i) {
      int v = tid + 256 * i;
      int j = kt * 32 + (v >> 4), c8 = (v & 15) * 8;
      r[i] = *(const u32x4*)(gvbase + (size_t)j * 1024 + c8);
      st[i] = *(const f32x2*)(stats + j * 2);
    }
  }
  __device__ __forceinline__ void store(bf16_t* tile) {
#pragma unroll
    for (int i = 0; i < 2; ++i) {
      int v = tid + 256 * i;
      int jl = v >> 4, c8 = (v & 15) * 8;
      const u32x4 u = r[i];
#pragma unroll
      for (int e = 0; e < 4; ++e) {
        int c = c8 + 2 * e;
        float a = (bf2f(u[e] & 0xffffu) - st[i].x) * st[i].y * lg[c] + lb[c];
        float b = (bf2f(u[e] >> 16) - st[i].x) * st[i].y * lg[c + 1] + lb[c + 1];
        tile[c * LDK + jl] = f2bf(a);
        tile[(c + 1) * LDK + jl] = f2bf(b);
      }
    }
  }
};

__device__ __forceinline__ void gmlp_unit(const Params& p, int l, char* smraw, int bl, int chunk, int g) {
  bf16_t* sm = (bf16_t*)smraw;
  const int tid = opaque_tid(); const int lane = tid & 63, w = tid >> 6, wr = w >> 1, wc = w & 1, l15 = lane & 15, grp = lane >> 4;
  const size_t row0 = (size_t)bl * SEQ + chunk * 128;
  f32x4 acc[4][4];
  zero_acc(acc);
  StdLoader al;
  al.init((const bf16_t*)(p.ws + OFF_WM) + (size_t)(l * 8 + g) * 128 * 128, 128, tid);
  GmlpBLoader bl_;
  bl_.tid = tid;
  bl_.gvbase = (const bf16_t*)(p.ws + OFF_GV) + row0 * 1024 + g * 128;
  bl_.stats = (const float*)(p.ws + OFF_STATS) + row0 * 2;
  bl_.lg = p.ln_g + l * 1024 + g * 128;
  bl_.lb = p.ln_b + l * 1024 + g * 128;
  gemm_core(acc, al, bl_, 4, sm, tid);
  const bf16_t* uz = (const bf16_t*)(p.ws + OFF_UZ);
  bf16_t* yC = (bf16_t*)(p.ws + OFF_YC);
  const float* bs = p.b_s + (size_t)(l * 8 + g) * 128;
#pragma unroll
  for (int m = 0; m < 4; ++m)
#pragma unroll
    for (int j = 0; j < 4; ++j) {
      int i = wr * 64 + m * 16 + 4 * grp + j;
      float bb = bs[i];
#pragma unroll
      for (int n = 0; n < 4; ++n) {
        size_t off = (row0 + i) * 1024 + g * 128 + wc * 64 + n * 16 + l15;
        yC[off] = f2bf(bf2f(uz[off]) * (acc[m][n][j] + bb));
      }
    }
}

__device__ __forceinline__ void phase_mix2(const Params& p, int l, char* smraw) {
  constexpr int NATT = NB * 4 * 256, NGM = NB * 32 * 8;
  for (int u = blockIdx.x; u < NATT + NGM; u += gridDim.x) {
    if (u < NATT) {
      int qb = 255 - (u / (NB * 4)), r = u % (NB * 4);
      attn_unit(p, smraw, r >> 2, r & 3, qb);
    } else {
      int v = u - NATT;
      gmlp_unit(p, l, smraw, v >> 8, (v >> 3) & 31, v & 7);
    }
  }
}

__device__ __forceinline__ void phase_merge(const Params& p, int l, char* smraw) {
  bf16_t* sm = (bf16_t*)smraw;
  const bf16_t* WbrT = (const bf16_t*)(p.ws + OFF_WBRT) + (size_t)l * 3 * D * D;
  const bf16_t* gates = (const bf16_t*)(p.ws + OFF_GATES);
  bf16_t* merged = (bf16_t*)(p.ws + OFF_H);
  const int tid = opaque_tid(); const int lane = tid & 63, w = tid >> 6, wr = w >> 1, wc = w & 1, l15 = lane & 15, grp = lane >> 4;
  const int nx = gridDim.x >> 3;
  constexpr int CJ_END = (R / 1024) * 64;
  auto cj_next = [&](int c) { return ((c & 63) + nx < 64) ? (c + nx) : (((c >> 6) + 8) * 64 + (int)(blockIdx.x >> 3)); };
  auto ybuf = [&](int i) { return (const bf16_t*)(p.ws + (i == 0 ? OFF_YA : (i == 1 ? OFF_YB : OFF_YC))); };
  int cj = (blockIdx.x & 7) * 64 + (blockIdx.x >> 3);
  __syncthreads();
  if (cj < CJ_END) glds_prefetch0(ybuf(0) + (size_t)((cj >> 6) * 8 + (cj & 7)) * 128 * D, D, WbrT + (size_t)((cj & 63) >> 3) * 128 * D, D, sm, tid);
  for (; cj < CJ_END; cj = cj_next(cj)) {
    const int nt = (cj & 63) >> 3, mt = (cj >> 6) * 8 + (cj & 7);
    const int rbase = mt * 128 + wr * 64 + l15, cbase = nt * 128 + wc * 64 + 4 * grp;
    f32x4 tot[4][4];
    zero_acc(tot);
#pragma unroll 1
    for (int i = 0; i < 3; ++i) {
      f32x4 acc[4][4];
      zero_acc(acc);
      const bf16_t* Y = ybuf(i);
      gemm_core_glds<false>(acc, Y + (size_t)mt * 128 * D, D, WbrT + (size_t)i * D * D + (size_t)nt * 128 * D, D, D / 64, sm, tid);
      if (i < 2) {
        glds_prefetch0(ybuf(i + 1) + (size_t)mt * 128 * D, D, WbrT + (size_t)(i + 1) * D * D + (size_t)nt * 128 * D, D, sm, tid);
      } else {
        const int c2 = cj_next(cj);
        if (c2 < CJ_END) glds_prefetch0(ybuf(0) + (size_t)((c2 >> 6) * 8 + (c2 & 7)) * 128 * D, D, WbrT + (size_t)((c2 & 63) >> 3) * 128 * D, D, sm, tid);
      }
#pragma unroll
      for (int m = 0; m < 4; ++m)
#pragma unroll
        for (int n = 0; n < 4; ++n) {
          const u32x2 gt = *(const u32x2*)(gates + (size_t)(rbase + m * 16) * 3072 + i * 1024 + cbase + n * 16);
          tot[m][n][0] += bf2f(gt.x & 0xffffu) * acc[m][n][0];
          tot[m][n][1] += bf2f(gt.x >> 16) * acc[m][n][1];
          tot[m][n][2] += bf2f(gt.y & 0xffffu) * acc[m][n][2];
          tot[m][n][3] += bf2f(gt.y >> 16) * acc[m][n][3];
        }
    }
#pragma unroll
    for (int m = 0; m < 4; ++m)
#pragma unroll
      for (int n = 0; n < 4; ++n)
        *(u32x2*)(merged + (size_t)(rbase + m * 16) * 1024 + cbase + n * 16) = u32x2{pack2(tot[m][n][0], tot[m][n][1]), pack2(tot[m][n][2], tot[m][n][3])};
  }
}

__device__ __forceinline__ void phase_outproj(const Params& p, int l, char* smraw) {
  bf16_t* sm = (bf16_t*)smraw;
  const bf16_t* WoutT = (const bf16_t*)(p.ws + OFF_WOUTT) + (size_t)l * D * D;
  const bf16_t* merged = (const bf16_t*)(p.ws + OFF_H);
  bf16_t* opre = (bf16_t*)(p.ws + OFF_YAPRE);
  const int tid = opaque_tid(); const int lane = tid & 63, w = tid >> 6, wr = w >> 1, wc = w & 1, l15 = lane & 15, grp = lane >> 4;
  const int nx = gridDim.x >> 3;
  constexpr int CJ_END = (R / 1024) * 64;
  auto cj_next = [&](int c) { return ((c & 63) + nx < 64) ? (c + nx) : (((c >> 6) + 8) * 64 + (int)(blockIdx.x >> 3)); };
  int cj = (blockIdx.x & 7) * 64 + (blockIdx.x >> 3);
  __syncthreads();
  if (cj < CJ_END) glds_prefetch0(merged + (size_t)((cj >> 6) * 8 + (cj & 7)) * 128 * D, D, WoutT + (size_t)((cj & 63) >> 3) * 128 * D, D, sm, tid);
  for (; cj < CJ_END; cj = cj_next(cj)) {
    const int nt = (cj & 63) >> 3, mt = (cj >> 6) * 8 + (cj & 7);
    f32x4 acc[4][4];
    zero_acc(acc);
    gemm_core_glds<true>(acc, merged + (size_t)mt * 128 * D, D, WoutT + (size_t)nt * 128 * D, D, D / 64, sm, tid);
    {
      const int c2 = cj_next(cj);
      if (c2 < CJ_END) glds_prefetch0(merged + (size_t)((c2 >> 6) * 8 + (c2 & 7)) * 128 * D, D, WoutT + (size_t)((c2 & 63) >> 3) * 128 * D, D, sm, tid);
    }
    const int rbase = mt * 128 + wr * 64 + l15, cbase = nt * 128 + wc * 64 + 4 * grp;
#pragma unroll
    for (int m = 0; m < 4; ++m)
#pragma unroll
      for (int n = 0; n < 4; ++n)
        *(u32x2*)(opre + (size_t)(rbase + m * 16) * 1024 + cbase + n * 16) = u32x2{pack2(acc[m][n][0], acc[m][n][1]), pack2(acc[m][n][2], acc[m][n][3])};
  }
}

#define XB_TMO      128
#define XB_XCNT(j)  (256  + 64 * (j))
#define XB_XSUB(j)  (1280 + 64 * (j))
#define XB_XGEN(j)  (2304 + 64 * (j))
#define XB_TOP      3328
#define XB_TOPGEN   3392
#define XCD_BAR_WORDS 3456
#define XB_SPIN_CAP (1u << 18)
#define LAS __attribute__((address_space(3)))

__device__ __forceinline__ unsigned xb_ld(unsigned* p)              { return __hip_atomic_load(p, __ATOMIC_RELAXED, __HIP_MEMORY_SCOPE_AGENT); }
__device__ __forceinline__ unsigned xb_add(unsigned* p, unsigned v) { return __hip_atomic_fetch_add(p, v, __ATOMIC_RELAXED, __HIP_MEMORY_SCOPE_AGENT); }
__device__ __forceinline__ unsigned xb_xcc_id() { return (unsigned)__builtin_amdgcn_s_getreg((3 << 11) | 20) & 0xFu; }
#define XB_SPIN(cond, bar) do { unsigned _sp = 0; while (cond) { __builtin_amdgcn_s_sleep(1); \
    if ((++_sp & 255u) == 0u) { if (xb_ld(&(bar)[XB_TMO])) break; if (_sp > XB_SPIN_CAP) { atomicAdd(&(bar)[XB_TMO], 1u); break; } } } } while (0)

struct XcdBarrier {
    unsigned* bar; unsigned x;
    volatile LAS unsigned* st;
};

__device__ __forceinline__ XcdBarrier xcd_barrier_post(unsigned* bar, volatile LAS unsigned* st) {
    XcdBarrier b; b.bar = bar; b.x = xb_xcc_id(); b.st = st;
    if (threadIdx.x == 0) (void)xb_add(&bar[XB_XCNT(b.x)], 1u);
    return b;
}
__device__ __forceinline__ void xcd_barrier_complete(unsigned* bar, unsigned x, unsigned& nloc, unsigned& nx) {
    const unsigned G = gridDim.x * gridDim.y * gridDim.z;
    unsigned sum, cnt, mine, sp = 0u;
    for (;;) {
        sum = 0u; cnt = 0u; mine = 0u;
#pragma unroll
        for (unsigned j = 0; j < 16; ++j) { const unsigned c = xb_ld(&bar[XB_XCNT(j)]); sum += c; cnt += (c > 0u) ? 1u : 0u; mine = (j == x) ? c : mine; }
        if (sum == G) break;
        __builtin_amdgcn_s_sleep(1);
        if ((++sp & 255u) == 0u) { if (xb_ld(&bar[XB_TMO])) break; if (sp > XB_SPIN_CAP) { atomicAdd(&bar[XB_TMO], 1u); break; } }
    }
    nloc = mine > 0u ? mine : 1u; nx = cnt > 0u ? cnt : 1u;
}
__device__ __forceinline__ void xcd_barrier(const XcdBarrier& b) {
    asm volatile("s_waitcnt vmcnt(0)" ::: "memory");
    __syncthreads();
    if (threadIdx.x == 0) {
        unsigned* bar = b.bar;
        __builtin_amdgcn_s_waitcnt(0);
        unsigned nloc = b.st[0], nx = b.st[1];
        if (nloc == 0u) { xcd_barrier_complete(bar, b.x, nloc, nx); b.st[0] = nloc; b.st[1] = nx; }
        const unsigned old = xb_add(&bar[XB_XSUB(b.x)], 1u);
        const unsigned gen = old / nloc;
        if (old + 1u == (gen + 1u) * nloc) {
            __builtin_amdgcn_fence(__ATOMIC_RELEASE, "agent");
            asm volatile("s_waitcnt vmcnt(0)" ::: "memory");
            const unsigned og = xb_add(&bar[XB_TOP], 1u);
            const unsigned tg = og / nx;
            if (og + 1u == (tg + 1u) * nx) xb_add(&bar[XB_TOPGEN], 1u);
            else XB_SPIN(xb_ld(&bar[XB_TOPGEN]) == tg, bar);
            __builtin_amdgcn_fence(__ATOMIC_ACQUIRE, "agent");
            xb_add(&bar[XB_XGEN(b.x)], 1u);
            asm volatile("s_waitcnt vmcnt(0)" ::: "memory");
        } else {
            XB_SPIN(xb_ld(&bar[XB_XGEN(b.x)]) == gen, bar);
            __builtin_amdgcn_fence(__ATOMIC_ACQUIRE, "agent");
            asm volatile("s_waitcnt vmcnt(0)" ::: "memory");
        }
    }
    __syncthreads();
}

__global__ void __launch_bounds__(256, 2) hybrid_fwd(Params p) {
  __shared__ __attribute__((aligned(16))) char smraw[SMEM_BYTES];
  cg::grid_group grid = cg::this_grid();
  if (threadIdx.x == 0) *(u32x4*)(smraw + 65536) = u32x4{0u, 0u, 0u, 0u};
  __syncthreads();
  const XcdBarrier xb = xcd_barrier_post((unsigned*)(p.ws + OFF_BAR), (volatile LAS unsigned*)(smraw + 65536));
  phase0(p, smraw);
  grid.sync();
  for (int gi = 0; gi < NGRP; ++gi) {
    phase_h0(p, gi);
    xcd_barrier(xb);
    for (int l = 0; l < DEPTH; ++l) {
      phase_inproj(p, l, smraw);
      xcd_barrier(xb);
      phase_mix1(p, l, smraw);
      xcd_barrier(xb);
      phase_mix2(p, l, smraw);
      xcd_barrier(xb);
      phase_merge(p, l, smraw);
      xcd_barrier(xb);
      phase_outproj(p, l, smraw);
      xcd_barrier(xb);
      phase_final(p, gi, l);
      xcd_barrier(xb);
    }
  }
}

extern "C" void kernel_launch(void* const* d_in, const int* in_sizes, int n_in, void* d_out, int out_size, void* d_ws,
                              size_t ws_size, hipStream_t stream) {
  static int grid_blocks = 0;
  if (!grid_blocks) {
    int dev = 0, cus = 0, per_cu = 0;
    hipGetDevice(&dev);
    hipDeviceGetAttribute(&cus, hipDeviceAttributeMultiprocessorCount, dev);
    hipOccupancyMaxActiveBlocksPerMultiprocessor(&per_cu, hybrid_fwd, 256, 0);
    if (per_cu < 1) per_cu = 1;
    if (per_cu > 2) per_cu = 2;
    grid_blocks = cus * per_cu;
    if (ws_size < WS_END) fprintf(stderr, "kernel_launch: workspace too small: %zu < %zu\n", ws_size, (size_t)WS_END);
  }
  Params p{};
  const float** pp = (const float**)&p;
  for (int i = 0; i < 21; ++i) pp[i] = (const float*)d_in[i];
  p.out = (float*)d_out;
  p.ws = (unsigned char*)d_ws;
  (void)hipMemsetAsync((char*)d_ws + OFF_BAR, 0, 3456 * 4, stream);
  void* args[] = {&p};
  hipError_t e = hipLaunchCooperativeKernel((void*)hybrid_fwd, dim3(grid_blocks), dim3(256), args, 0, stream);
  if (e != hipSuccess) fprintf(stderr, "cooperative launch failed: %s (grid %d)\n", hipGetErrorString(e), grid_blocks);
}
```

```cpp
#include <hip/hip_runtime.h>
#include <hip/hip_cooperative_groups.h>
#include <cstdio>
#include <cstdint>
namespace cg = cooperative_groups;

typedef unsigned short bf16_t;
using bf16x8 = __attribute__((ext_vector_type(8))) short;
using f32x4 = __attribute__((ext_vector_type(4))) float;
using f32x2 = __attribute__((ext_vector_type(2))) float;
using u32x4 = __attribute__((ext_vector_type(4))) uint32_t;
using u32x2 = __attribute__((ext_vector_type(2))) uint32_t;

constexpr int D = 1024, SEQ = 4096, BATCH = 16, DEPTH = 2;
constexpr int IN_COLS = 13872;
constexpr int A_OFF = 0, B_OFF = 4096, C_OFF = 7728, G_OFF = 10800;
constexpr int NT_IN = 109, NP = NT_IN * 128;
constexpr int NB = 4, R = NB * SEQ, NGRP = BATCH / NB;
constexpr int LDK = 40;
constexpr int KS_LD = 80;
constexpr int VT_LD = 68;
constexpr int HS_LD = 136;
constexpr int SMEM_BYTES = 65536 + 16;

constexpr size_t al256(size_t x) { return (x + 255) & ~size_t(255); }
constexpr size_t OFF_WINT = 0;
constexpr size_t OFF_WBRT = al256(OFF_WINT + (size_t)DEPTH * NP * D * 2);
constexpr size_t OFF_WOUTT = al256(OFF_WBRT + (size_t)DEPTH * 3 * D * D * 2);
constexpr size_t OFF_WC1T = al256(OFF_WOUTT + (size_t)DEPTH * D * D * 2);
constexpr size_t OFF_WM = al256(OFF_WC1T + (size_t)DEPTH * 2 * 128 * 2048 * 2);
constexpr size_t OFF_BIAS1 = al256(OFF_WM + (size_t)DEPTH * 8 * 128 * 128 * 2);
constexpr size_t OFF_MOD = al256(OFF_BIAS1 + (size_t)DEPTH * 2 * 8 * 128 * 4);
constexpr size_t OFF_H = al256(OFF_MOD + (size_t)DEPTH * 16 * 3072 * 4);
constexpr size_t SZ_ACT = (size_t)R * 1024 * 2;
constexpr size_t OFF_YAPRE = al256(OFF_H + SZ_ACT);
constexpr size_t OFF_BZA = al256(OFF_YAPRE + SZ_ACT);
constexpr size_t OFF_Q = al256(OFF_BZA + SZ_ACT);
constexpr size_t OFF_ZB = al256(OFF_Q + SZ_ACT);
constexpr size_t OFF_UZ = al256(OFF_ZB + SZ_ACT);
constexpr size_t OFF_GV = al256(OFF_UZ + SZ_ACT);
constexpr size_t OFF_KV = al256(OFF_GV + SZ_ACT);
constexpr size_t OFF_GL = al256(OFF_KV + (size_t)R * 1536 * 2);
constexpr size_t OFF_GATES = al256(OFF_GL + (size_t)R * 48 * 4);
constexpr size_t OFF_YA = al256(OFF_GATES + (size_t)R * 3072 * 2);
constexpr size_t OFF_YB = al256(OFF_YA + SZ_ACT);
constexpr size_t OFF_YC = al256(OFF_YB + SZ_ACT);
constexpr size_t OFF_KCMP = al256(OFF_YC + SZ_ACT);
constexpr size_t OFF_VCMP = al256(OFF_KCMP + (size_t)NB * 4 * 256 * 64 * 2);
constexpr size_t OFF_STATS = al256(OFF_VCMP + (size_t)NB * 4 * 256 * 64 * 2);
constexpr size_t OFF_BAR = al256(OFF_STATS + (size_t)R * 2 * 4);
constexpr size_t WS_END = al256(OFF_BAR + 3456 * 4);

struct Params {
  const float *x, *c, *g_pre, *g_post, *w_ada, *b_ada, *w_in, *conv_w, *conv_b, *pos_ck, *w_ck1, *w_ck2,
      *pos_cv, *w_cv1, *w_cv2, *ln_g, *ln_b, *w_s, *b_s, *w_br, *w_out;
  float* out;
  unsigned char* ws;
};

typedef __bf16 bf16x2_native __attribute__((ext_vector_type(2)));
__device__ __forceinline__ uint32_t pack2(float a, float b) {
  f32x2 v = {a, b};
  return __builtin_bit_cast(uint32_t, __builtin_convertvector(v, bf16x2_native));
}
__device__ __forceinline__ bf16_t f2bf(float f) { return (bf16_t)(pack2(f, f) & 0xffffu); }
__device__ __forceinline__ float bf2f(uint32_t h) { return __uint_as_float(h << 16); }
__device__ __forceinline__ float sigmoid_(float x) { return __builtin_amdgcn_rcpf(1.f + __expf(-x)); }
__device__ __forceinline__ float silu_(float x) { return x * __builtin_amdgcn_rcpf(1.f + __expf(-x)); }
__device__ __forceinline__ float gelu_(float x) {
  float y = 0.7978845608f * (x + 0.044715f * x * x * x);
  return x * __builtin_amdgcn_rcpf(1.f + __expf(-2.f * y));
}
__device__ __forceinline__ f32x4 mfma16(bf16x8 a, bf16x8 b, f32x4 c) {
  return __builtin_amdgcn_mfma_f32_16x16x32_bf16(a, b, c, 0, 0, 0);
}
__device__ __forceinline__ float bperm(float v, int srclane) {
  return __int_as_float(__builtin_amdgcn_ds_bpermute(srclane << 2, __float_as_int(v)));
}
__device__ __forceinline__ float wave_sum(float v, int lane) {
#pragma unroll
  for (int o = 32; o >= 1; o >>= 1) v += bperm(v, lane ^ o);
  return v;
}

__device__ __forceinline__ int opaque_tid() {
  int t = threadIdx.x;
  asm volatile("" : "+v"(t));
  return t;
}

__device__ __forceinline__ int win_colmap(int np) {
  int tile = np >> 7, r = np & 127;
  if (tile < 32) { int wc = r >> 6, t = (r >> 4) & 3, i = r & 15; return A_OFF + t * 1024 + tile * 32 + wc * 16 + i; }
  if (tile < 40) return B_OFF + (np - 32 * 128);
  if (tile < 52) return B_OFF + 1024 + (np - 40 * 128);
  if (tile < 60) return B_OFF + 2560 + (np - 52 * 128);
  if (tile == 60) return r < 48 ? B_OFF + 3584 + r : -1;
  if (tile < 77) { int tb = tile - 61, wc = r >> 6, t = (r >> 4) & 3, i = r & 15; return C_OFF + ((t & 1) ? 2048 : 0) + tb * 64 + wc * 32 + (t >> 1) * 16 + i; }
  if (tile < 85) return C_OFF + 1024 + (np - 77 * 128);
  return G_OFF + (np - 85 * 128);
}

template <bool WIN>
__device__ __forceinline__ void transpose_tile(const float* __restrict__ src, int ld_src, bf16_t* __restrict__ dst, int Kdim, int n0, int k0, float* sm, int tid) {
  const int tx = tid & 63, ty = tid >> 6;
  const int col = WIN ? win_colmap(n0 + tx) : (n0 + tx);
  __syncthreads();
#pragma unroll
  for (int i = 0; i < 16; ++i) {
    int k = ty * 16 + i;
    float v = (col >= 0) ? src[(size_t)(k0 + k) * ld_src + col] : 0.f;
    sm[k * 65 + tx] = v;
  }
  __syncthreads();
#pragma unroll
  for (int i = 0; i < 16; ++i) {
    int n = ty * 16 + i;
    dst[(size_t)(n0 + n) * Kdim + k0 + tx] = f2bf(sm[tx * 65 + n]);
  }
}

__device__ __forceinline__ void phase0(const Params& p, char* smraw) {
  float* smf = (float*)smraw;
  const int bid = blockIdx.x, nblk = gridDim.x, tid = opaque_tid();
  bf16_t* WinT = (bf16_t*)(p.ws + OFF_WINT);
  bf16_t* WbrT = (bf16_t*)(p.ws + OFF_WBRT);
  bf16_t* WoutT = (bf16_t*)(p.ws + OFF_WOUTT);
  bf16_t* Wc1T = (bf16_t*)(p.ws + OFF_WC1T);
  bf16_t* Wm = (bf16_t*)(p.ws + OFF_WM);
  float* bias1 = (float*)(p.ws + OFF_BIAS1);
  float* mod = (float*)(p.ws + OFF_MOD);
  for (int t = bid; t < DEPTH * 218 * 16; t += nblk) {
    int l = t / (218 * 16), r = t % (218 * 16), nt = r >> 4, kt = r & 15;
    transpose_tile<true>(p.w_in + (size_t)l * D * IN_COLS, IN_COLS, WinT + (size_t)l * NP * D, D, nt * 64, kt * 64, smf, tid);
  }
  for (int t = bid; t < DEPTH * 3 * 256; t += nblk) {
    int li = t >> 8, r = t & 255, nt = r >> 4, kt = r & 15;
    transpose_tile<false>(p.w_br + (size_t)li * D * D, D, WbrT + (size_t)li * D * D, D, nt * 64, kt * 64, smf, tid);
  }
  for (int t = bid; t < DEPTH * 256; t += nblk) {
    int l = t >> 8, r = t & 255, nt = r >> 4, kt = r & 15;
    transpose_tile<false>(p.w_out + (size_t)l * D * D, D, WoutT + (size_t)l * D * D, D, nt * 64, kt * 64, smf, tid);
  }
  for (int t = bid; t < DEPTH * 2 * 64; t += nblk) {
    int lk = t >> 6, r = t & 63, nt = r >> 5, kt = r & 31;
    int l = lk >> 1, kv = lk & 1;
    const float* src = (kv ? p.w_cv1 : p.w_ck1) + (size_t)l * 2048 * 128;
    transpose_tile<false>(src, 128, Wc1T + (size_t)lk * 128 * 2048, 2048, nt * 64, kt * 64, smf, tid);
  }
  for (int e = bid * 256 + tid; e < DEPTH * 8 * 128 * 128; e += nblk * 256) {
    int j = e & 127, i = (e >> 7) & 127;
    Wm[e] = (j <= i) ? f2bf(p.w_s[e]) : (bf16_t)0;
  }
  for (int t = bid - 128; t >= 0 && t < DEPTH * 2 * 8; t += nblk) {
    int lk = t >> 3, ks = t & 7, l = lk >> 1, kv = lk & 1;
    const float* pos = (kv ? p.pos_cv : p.pos_ck) + (size_t)l * 2048;
    const float* w1 = (kv ? p.w_cv1 : p.w_ck1) + (size_t)l * 2048 * 128;
    int n = tid & 127, half = tid >> 7;
    float acc = 0.f;
    const int kb = ks * 256 + half * 128;
#pragma unroll 16
    for (int k = kb; k < kb + 128; ++k) acc += pos[k] * w1[(size_t)k * 128 + n];
    __syncthreads();
    smf[tid] = acc;
    __syncthreads();
    if (tid < 128) bias1[t * 128 + tid] = smf[tid] + smf[tid + 128];
  }
  for (int t = nblk - 1 - bid; t < DEPTH * 48; t += nblk) {
    int l = t / 48, ch = t % 48;
    int tx = tid & 63, ty = tid >> 6;
    int col = ch * 64 + tx;
    __syncthreads();
    for (int i = 0; i < 64; ++i) {
      int e = tid + 256 * i;
      smf[(e & 1023) * 16 + (e >> 10)] = silu_(p.c[e]);
    }
    __syncthreads();
    float acc[16];
#pragma unroll
    for (int b = 0; b < 16; ++b) acc[b] = 0.f;
    const float* w = p.w_ada + (size_t)l * D * 3072 + col;
#pragma unroll 8
    for (int k = ty * 256; k < ty * 256 + 256; ++k) {
      float wv = w[(size_t)k * 3072];
      const f32x4 s0 = *(const f32x4*)(smf + k * 16), s1 = *(const f32x4*)(smf + k * 16 + 4), s2 = *(const f32x4*)(smf + k * 16 + 8), s3 = *(const f32x4*)(smf + k * 16 + 12);
#pragma unroll
      for (int b = 0; b < 4; ++b) { acc[b] += s0[b] * wv; acc[4 + b] += s1[b] * wv; acc[8 + b] += s2[b] * wv; acc[12 + b] += s3[b] * wv; }
    }
    __syncthreads();
#pragma unroll
    for (int b = 0; b < 16; ++b) smf[(ty * 16 + b) * 64 + tx] = acc[b];
    __syncthreads();
    if (ty == 0) {
#pragma unroll
      for (int b = 0; b < 16; ++b) {
        float s_ = smf[b * 64 + tx] + smf[(16 + b) * 64 + tx] + smf[(32 + b) * 64 + tx] + smf[(48 + b) * 64 + tx];
        mod[((size_t)l * 16 + b) * 3072 + col] = s_ + p.b_ada[l * 3072 + col];
      }
    }
  }
}

__device__ __forceinline__ void write_h_row(const f32x4 (&xv)[4], float ss, const float* g_pre, const float* modl_b, bf16_t* hrow, int lane) {
  float rs = rsqrtf(ss * (1.f / 1024.f) + 1e-6f);
#pragma unroll
  for (int i = 0; i < 4; ++i) {
    int c = i * 256 + lane * 4;
    f32x4 g = *(const f32x4*)(g_pre + c);
    f32x4 sh = *(const f32x4*)(modl_b + c);
    f32x4 sc = *(const f32x4*)(modl_b + 1024 + c);
    float h0 = xv[i].x * rs * g.x * (1.f + sc.x) + sh.x;
    float h1 = xv[i].y * rs * g.y * (1.f + sc.y) + sh.y;
    float h2 = xv[i].z * rs * g.z * (1.f + sc.z) + sh.z;
    float h3 = xv[i].w * rs * g.w * (1.f + sc.w) + sh.w;
    u32x2 o; o.x = pack2(h0, h1); o.y = pack2(h2, h3);
    *(u32x2*)(hrow + c) = o;
  }
}

__device__ __forceinline__ void phase_h0(const Params& p, int grp_i) {
  const int tid = opaque_tid(); const int lane = tid & 63, w = tid >> 6;
  bf16_t* H = (bf16_t*)(p.ws + OFF_H);
  const float* mod = (const float*)(p.ws + OFF_MOD);
  for (int r = blockIdx.x * 4 + w; r < R; r += gridDim.x * 4) {
    size_t grow = (size_t)grp_i * R + r;
    int b = (int)(grow >> 12);
    const float* xr = p.x + grow * D;
    f32x4 xv[4]; float ss = 0.f;
#pragma unroll
    for (int i = 0; i < 4; ++i) {
      xv[i] = *(const f32x4*)(xr + i * 256 + lane * 4);
      ss += xv[i].x * xv[i].x + xv[i].y * xv[i].y + xv[i].z * xv[i].z + xv[i].w * xv[i].w;
    }
    ss = wave_sum(ss, lane);
    write_h_row(xv, ss, p.g_pre, mod + (size_t)b * 3072, H + (size_t)r * D, lane);
  }
}

__device__ __forceinline__ void phase_final(const Params& p, int grp_i, int l) {
  const int tid = opaque_tid(); const int lane = tid & 63, w = tid >> 6;
  bf16_t* H = (bf16_t*)(p.ws + OFF_H);
  const bf16_t* OP = (const bf16_t*)(p.ws + OFF_YAPRE);
  const float* mod = (const float*)(p.ws + OFF_MOD);
  const float* xin = (l == 0) ? p.x : p.out;
  for (int r = blockIdx.x * 4 + w; r < R; r += gridDim.x * 4) {
    size_t grow = (size_t)grp_i * R + r;
    int b = (int)(grow >> 12);
    const float* xr = xin + grow * D;
    const bf16_t* orow = OP + (size_t)r * D;
    const float* gate = mod + ((size_t)l * 16 + b) * 3072 + 2048;
    const float* gp = p.g_post + l * D;
    f32x4 xv[4], ov[4]; float ss = 0.f;
#pragma unroll
    for (int i = 0; i < 4; ++i) {
      int c = i * 256 + lane * 4;
      xv[i] = *(const f32x4*)(xr + c);
      u32x2 u = *(const u32x2*)(orow + c);
      ov[i].x = bf2f(u.x & 0xffffu); ov[i].y = bf2f(u.x >> 16); ov[i].z = bf2f(u.y & 0xffffu); ov[i].w = bf2f(u.y >> 16);
      ss += ov[i].x * ov[i].x + ov[i].y * ov[i].y + ov[i].z * ov[i].z + ov[i].w * ov[i].w;
    }
    ss = wave_sum(ss, lane);
    float rs = rsqrtf(ss * (1.f / 1024.f) + 1e-6f);
    float ss2 = 0.f;
#pragma unroll
    for (int i = 0; i < 4; ++i) {
      int c = i * 256 + lane * 4;
      f32x4 g = *(const f32x4*)(gp + c);
      f32x4 ga = *(const f32x4*)(gate + c);
      xv[i].x += ga.x * (ov[i].x * rs * g.x);
      xv[i].y += ga.y * (ov[i].y * rs * g.y);
      xv[i].z += ga.z * (ov[i].z * rs * g.z);
      xv[i].w += ga.w * (ov[i].w * rs * g.w);
      *(f32x4*)(p.out + grow * D + c) = xv[i];
      ss2 += xv[i].x * xv[i].x + xv[i].y * xv[i].y + xv[i].z * xv[i].z + xv[i].w * xv[i].w;
    }
    if (l == 0) {
      ss2 = wave_sum(ss2, lane);
      write_h_row(xv, ss2, p.g_pre + D, mod + ((size_t)16 + b) * 3072, H + (size_t)r * D, lane);
    }
  }
}

struct StdLoader {
  const bf16_t* base;
  int soff;
  u32x4 r0, r1;
  __device__ __forceinline__ void init(const bf16_t* tile_base, size_t ld, int tid) {
    base = tile_base + (size_t)(tid >> 1) * ld + (tid & 1) * 16;
    soff = (tid >> 1) * LDK + (tid & 1) * 16;
  }
  __device__ __forceinline__ void load(int kt) {
    const bf16_t* q = base + kt * 32;
    r0 = *(const u32x4*)q; r1 = *(const u32x4*)(q + 8);
  }
  __device__ __forceinline__ void store(bf16_t* tile) {
    bf16_t* q = tile + soff;
    *(u32x4*)q = r0; *(u32x4*)(q + 8) = r1;
  }
};

template <class AL, class BL>
__device__ __forceinline__ void gemm_core(f32x4 (&acc)[4][4], AL& al, BL& bl, int nk, bf16_t* sm, int tid) {
  const int lane = tid & 63, w = tid >> 6, wr = w >> 1, wc = w & 1, l15 = lane & 15, grp = lane >> 4;
  al.load(0); bl.load(0);
  __syncthreads();
  al.store(sm); bl.store(sm + 2 * 128 * LDK);
  __syncthreads();
  for (int kt = 0; kt < nk; ++kt) {
    const bf16_t* Ab = sm + (kt & 1) * 128 * LDK;
    const bf16_t* Bb = sm + (2 + (kt & 1)) * 128 * LDK;
    if (kt + 1 < nk) { al.load(kt + 1); bl.load(kt + 1); }
    bf16x8 a[4], b[4];
#pragma unroll
    for (int m = 0; m < 4; ++m) a[m] = *(const bf16x8*)(Ab + (wr * 64 + m * 16 + l15) * LDK + grp * 8);
#pragma unroll
    for (int n = 0; n < 4; ++n) b[n] = *(const bf16x8*)(Bb + (wc * 64 + n * 16 + l15) * LDK + grp * 8);
#pragma unroll
    for (int m = 0; m < 4; ++m)
#pragma unroll
      for (int n = 0; n < 4; ++n) acc[m][n] = mfma16(a[m], b[n], acc[m][n]);
    if (kt + 1 < nk) {
      al.store(sm + ((kt + 1) & 1) * 128 * LDK);
      bl.store(sm + (2 + ((kt + 1) & 1)) * 128 * LDK);
    }
    __syncthreads();
  }
}

struct Regs4 { u32x4 r0, r1, r2, r3; };
struct StdLoader64 {
  typedef Regs4 Regs;
  const bf16_t* base;
  size_t ld32;
  int soff;
  __device__ __forceinline__ void init(const bf16_t* tile_base, size_t ld, int tid) {
    base = tile_base + (size_t)(tid >> 3) * ld + (tid & 7) * 8;
    ld32 = ld * 32;
    soff = (tid >> 3) * 64 + (((tid & 7) ^ ((tid >> 4) & 7)) * 8);
  }
  __device__ __forceinline__ void load(int kt, Regs& r) const {
    const bf16_t* q = base + kt * 64;
    r.r0 = *(const u32x4*)q; r.r1 = *(const u32x4*)(q + ld32); r.r2 = *(const u32x4*)(q + 2 * ld32); r.r3 = *(const u32x4*)(q + 3 * ld32);
  }
  __device__ __forceinline__ void store(bf16_t* tile, const Regs& r) const {
    bf16_t* q = tile + soff;
    *(u32x4*)q = r.r0; *(u32x4*)(q + 2048) = r.r1; *(u32x4*)(q + 4096) = r.r2; *(u32x4*)(q + 6144) = r.r3;
  }
};

template <int NST, class AL, class BL>
__device__ __forceinline__ void gemm_core64(f32x4 (&acc)[4][4], const AL& al, const BL& bl, int nk, bf16_t* sm, int tid) {
  const int lane = tid & 63, w = tid >> 6, wr = w >> 1, wc = w & 1, l15 = lane & 15, grp = lane >> 4;
  constexpr int TILE = 128 * 64;
  const int sw = (l15 >> 1) & 7;
  const int fo0 = l15 * 64 + ((grp ^ sw) * 8), fo1 = l15 * 64 + (((4 + grp) ^ sw) * 8);
  typename AL::Regs ra[NST];
  typename BL::Regs rb[NST];
#pragma unroll
  for (int s_ = 0; s_ < NST; ++s_) { al.load(s_, ra[s_]); bl.load(s_, rb[s_]); }
  __syncthreads();
  al.store(sm, ra[0]); bl.store(sm + 2 * TILE, rb[0]);
  { const int k2 = NST < nk ? NST : nk - 1; al.load(k2, ra[0]); bl.load(k2, rb[0]); }
  __syncthreads();
  for (int kt0 = 0; kt0 < nk; kt0 += NST) {
#pragma unroll
    for (int u = 0; u < NST; ++u) {
      const int kt = kt0 + u;
      const bf16_t* Ab = sm + (kt & 1) * TILE + wr * 64 * 64;
      const bf16_t* Bb = sm + (2 + (kt & 1)) * TILE + wc * 64 * 64;
#pragma unroll
      for (int ks = 0; ks < 2; ++ks) {
        const int fo = ks ? fo1 : fo0;
        bf16x8 a[4], b[4];
#pragma unroll
        for (int m = 0; m < 4; ++m) a[m] = *(const bf16x8*)(Ab + m * 16 * 64 + fo);
#pragma unroll
        for (int n = 0; n < 4; ++n) b[n] = *(const bf16x8*)(Bb + n * 16 * 64 + fo);
#pragma unroll
        for (int m = 0; m < 4; ++m)
#pragma unroll
          for (int n = 0; n < 4; ++n) acc[m][n] = mfma16(b[n], a[m], acc[m][n]);
      }
      al.store(sm + ((kt + 1) & 1) * TILE, ra[(u + 1) % NST]);
      bl.store(sm + (2 + ((kt + 1) & 1)) * TILE, rb[(u + 1) % NST]);
      {
        int k2 = kt + 1 + NST;
        k2 = k2 < nk ? k2 : nk - 1;
        al.load(k2, ra[(u + 1) % NST]); bl.load(k2, rb[(u + 1) % NST]);
      }
      __syncthreads();
    }
  }
}

__device__ __forceinline__ void glds_prefetch0(const bf16_t* Atile, size_t lda, const bf16_t* Btile, size_t ldb, bf16_t* sm, int tid) {
  constexpr int TILE = 128 * 64;
  const int gch = ((tid & 7) ^ ((tid >> 4) & 7)) * 8;
  const bf16_t* ga = Atile + (size_t)(tid >> 3) * lda + gch;
  const bf16_t* gb = Btile + (size_t)(tid >> 3) * ldb + gch;
  const size_t a32 = lda * 32, b32 = ldb * 32;
  bf16_t* lbase = sm + tid * 8;
#pragma unroll
  for (int i_ = 0; i_ < 4; ++i_) {
    __builtin_amdgcn_global_load_lds((const unsigned*)(ga + i_ * a32), (unsigned*)(lbase + i_ * 2048), 16, 0, 0);
    __builtin_amdgcn_global_load_lds((const unsigned*)(gb + i_ * b32), (unsigned*)(lbase + 2 * TILE + i_ * 2048), 16, 0, 0);
  }
}

#define DSR1(dst, base, OFF) asm volatile("ds_read_b128 %0, %1 offset:" #OFF : "=v"(dst) : "v"(base) : "memory")
#define DSR4(arr, base) do { DSR1(arr[0], base, 0); DSR1(arr[1], base, 2048); DSR1(arr[2], base, 4096); DSR1(arr[3], base, 6144); } while (0)
template <bool HOIST>
__device__ __forceinline__ void gemm_core_glds(f32x4 (&acc)[4][4], const bf16_t* Atile, size_t lda, const bf16_t* Btile, size_t ldb,
                                               int nk, bf16_t* sm, int tid) {
  const int lane = tid & 63, w = tid >> 6, wr = w >> 1, wc = w & 1, l15 = lane & 15, grp = lane >> 4;
  constexpr int TILE = 128 * 64;
  const int sw = (l15 >> 1) & 7;
  const int fo0 = l15 * 64 + ((grp ^ sw) * 8), fo1 = l15 * 64 + (((4 + grp) ^ sw) * 8);
  const int gch = ((tid & 7) ^ ((tid >> 4) & 7)) * 8;
  const bf16_t* ga = Atile + (size_t)(tid >> 3) * lda + gch;
  const bf16_t* gb = Btile + (size_t)(tid >> 3) * ldb + gch;
  const size_t a32 = lda * 32, b32 = ldb * 32;
  bf16_t* lbase = sm + tid * 8;
#define GLDS_ISSUE(KT, BUF)                                                                                                            \
  do {                                                                                                                                 \
    _Pragma("unroll") for (int i_ = 0; i_ < 4; ++i_) {                                                                                 \
      __builtin_amdgcn_global_load_lds((const unsigned*)(ga + i_ * a32 + (KT) * 64), (unsigned*)(lbase + (BUF) * TILE + i_ * 2048), 16, 0, 0);       \
      __builtin_amdgcn_global_load_lds((const unsigned*)(gb + i_ * b32 + (KT) * 64), (unsigned*)(lbase + (2 + (BUF)) * TILE + i_ * 2048), 16, 0, 0); \
    }                                                                                                                                  \
  } while (0)
#define GLDS_COMPUTE(BUF)                                                                             \
  do {                                                                                                \
    const bf16_t* Ab = sm + (BUF) * TILE + wr * 64 * 64;                                              \
    const bf16_t* Bb = sm + (2 + (BUF)) * TILE + wc * 64 * 64;                                        \
    if (HOIST) {                                                                                      \
        \
      bf16x8 a0[4], b0[4], a1[4], b1[4];                                                              \
      const unsigned pa0 = (unsigned)(size_t)(Ab + fo0), pb0 = (unsigned)(size_t)(Bb + fo0);          \
      const unsigned pa1 = (unsigned)(size_t)(Ab + fo1), pb1 = (unsigned)(size_t)(Bb + fo1);          \
      DSR4(a0, pa0); DSR4(b0, pb0); DSR4(a1, pa1); DSR4(b1, pb1);                                     \
      asm volatile("s_waitcnt lgkmcnt(8)" : "+v"(a0[0]), "+v"(a0[1]), "+v"(a0[2]), "+v"(a0[3]), "+v"(b0[0]), "+v"(b0[1]), "+v"(b0[2]), "+v"(b0[3]) :: "memory"); \
      _Pragma("unroll") for (int m = 0; m < 4; ++m)                                                   \
        _Pragma("unroll") for (int n = 0; n < 4; ++n) acc[m][n] = mfma16(b0[n], a0[m], acc[m][n]);    \
      __builtin_amdgcn_sched_barrier(0);             \
      asm volatile("s_waitcnt lgkmcnt(0)" : "+v"(a1[0]), "+v"(a1[1]), "+v"(a1[2]), "+v"(a1[3]), "+v"(b1[0]), "+v"(b1[1]), "+v"(b1[2]), "+v"(b1[3]) :: "memory"); \
      _Pragma("unroll") for (int m = 0; m < 4; ++m)                                                   \
        _Pragma("unroll") for (int n = 0; n < 4; ++n) acc[m][n] = mfma16(b1[n], a1[m], acc[m][n]);    \
      __builtin_amdgcn_sched_barrier(0);             \
    } else {                                                                                          \
      _Pragma("unroll") for (int ks = 0; ks < 2; ++ks) {                                              \
        const int fo = ks ? fo1 : fo0;                                                                \
        bf16x8 a[4], b[4];                                                                            \
        _Pragma("unroll") for (int m = 0; m < 4; ++m) a[m] = *(const bf16x8*)(Ab + m * 16 * 64 + fo); \
        _Pragma("unroll") for (int n = 0; n < 4; ++n) b[n] = *(const bf16x8*)(Bb + n * 16 * 64 + fo); \
        _Pragma("unroll") for (int m = 0; m < 4; ++m)                                                 \
          _Pragma("unroll") for (int n = 0; n < 4; ++n) acc[m][n] = mfma16(b[n], a[m], acc[m][n]);     \
      }                                                                                               \
    }                                                                                                 \
  } while (0)
  asm volatile("s_waitcnt vmcnt(0)" ::: "memory");
  __syncthreads();
  for (int kt = 0; kt < nk; kt += 2) {
    GLDS_ISSUE(kt + 1, 1);
    GLDS_COMPUTE(0);
    asm volatile("s_waitcnt vmcnt(0)" ::: "memory");
    __syncthreads();
    if (kt + 2 < nk) GLDS_ISSUE(kt + 2, 0);
    GLDS_COMPUTE(1);
    asm volatile("s_waitcnt vmcnt(0)" ::: "memory");
    __syncthreads();
  }
#undef GLDS_ISSUE
#undef GLDS_COMPUTE
}

__device__ __forceinline__ void gemm_core_glds_cmp(f32x4 (&acc)[4][4], const bf16_t* colptr, int r0, const bf16_t* Btile, size_t ldb,
                                                   int nk, bf16_t* sm, int tid) {
  const int lane = tid & 63, w = tid >> 6, wr = w >> 1, wc = w & 1, l15 = lane & 15, grp = lane >> 4;
  constexpr int TILE = 128 * 64;
  const int sw = (l15 >> 1) & 7;
  const int fo0 = l15 * 64 + ((grp ^ sw) * 8), fo1 = l15 * 64 + (((4 + grp) ^ sw) * 8);
  const int gch = ((tid & 7) ^ ((tid >> 4) & 7)) * 8;
  const bf16_t* gb = Btile + (size_t)(tid >> 3) * ldb + gch;
  const size_t b32 = ldb * 32;
  bf16_t* lbase = sm + tid * 8;
#define CMP_ISSUE(KT, BUF)                                                                                                             \
  do {                                                                                                                                 \
    _Pragma("unroll") for (int i_ = 0; i_ < 4; ++i_) {                                                                                 \
      int tok_ = 16 * (r0 + 32 * i_) + (KT);                                                                                           \
      tok_ = tok_ > (SEQ - 1) ? (SEQ - 1) : tok_;                                                                                      \
      __builtin_amdgcn_global_load_lds((const unsigned*)(colptr + (size_t)tok_ * 1536), (unsigned*)(lbase + (BUF) * TILE + i_ * 2048), 16, 0, 0);     \
      __builtin_amdgcn_global_load_lds((const unsigned*)(gb + i_ * b32 + (KT) * 64), (unsigned*)(lbase + (2 + (BUF)) * TILE + i_ * 2048), 16, 0, 0); \
    }                                                                                                                                  \
  } while (0)
#define CMP_COMPUTE(BUF)                                                                              \
  do {                                                                                                \
    const bf16_t* Ab = sm + (BUF) * TILE + wr * 64 * 64;                                              \
    const bf16_t* Bb = sm + (2 + (BUF)) * TILE + wc * 64 * 64;                                        \
    _Pragma("unroll") for (int ks = 0; ks < 2; ++ks) {                                                \
      const int fo = ks ? fo1 : fo0;                                                                  \
      bf16x8 a[4], b[4];                                                                              \
      _Pragma("unroll") for (int m = 0; m < 4; ++m) a[m] = *(const bf16x8*)(Ab + m * 16 * 64 + fo);   \
      _Pragma("unroll") for (int n = 0; n < 4; ++n) b[n] = *(const bf16x8*)(Bb + n * 16 * 64 + fo);   \
      _Pragma("unroll") for (int m = 0; m < 4; ++m)                                                   \
        _Pragma("unroll") for (int n = 0; n < 4; ++n) acc[m][n] = mfma16(b[n], a[m], acc[m][n]);     \
    }                                                                                                 \
  } while (0)
  __syncthreads();
  CMP_ISSUE(0, 0);
  asm volatile("s_waitcnt vmcnt(0)" ::: "memory");
  __syncthreads();
  for (int kt = 0; kt < nk; kt += 2) {
    CMP_ISSUE(kt + 1, 1);
    CMP_COMPUTE(0);
    asm volatile("s_waitcnt vmcnt(0)" ::: "memory");
    __syncthreads();
    if (kt + 2 < nk) CMP_ISSUE(kt + 2, 0);
    CMP_COMPUTE(1);
    asm volatile("s_waitcnt vmcnt(0)" ::: "memory");
    __syncthreads();
  }
#undef CMP_ISSUE
#undef CMP_COMPUTE
}

__device__ __forceinline__ void zero_acc(f32x4 (&acc)[4][4]) {
#pragma unroll
  for (int m = 0; m < 4; ++m)
#pragma unroll
    for (int n = 0; n < 4; ++n) acc[m][n] = f32x4{0.f, 0.f, 0.f, 0.f};
}

__device__ __forceinline__ void phase_inproj(const Params& p, int l, char* smraw) {
  bf16_t* sm = (bf16_t*)smraw;
  const bf16_t* H = (const bf16_t*)(p.ws + OFF_H);
  const bf16_t* W = (const bf16_t*)(p.ws + OFF_WINT) + (size_t)l * NP * D;
  bf16_t* yApre = (bf16_t*)(p.ws + OFF_YAPRE);
  bf16_t* bzA = (bf16_t*)(p.ws + OFF_BZA);
  bf16_t* qb = (bf16_t*)(p.ws + OFF_Q);
  bf16_t* zb = (bf16_t*)(p.ws + OFF_ZB);
  bf16_t* uz = (bf16_t*)(p.ws + OFF_UZ);
  bf16_t* gv = (bf16_t*)(p.ws + OFF_GV);
  bf16_t* kvb = (bf16_t*)(p.ws + OFF_KV);
  float* glb = (float*)(p.ws + OFF_GL);
  bf16_t* gates = (bf16_t*)(p.ws + OFF_GATES);
  const int tid = opaque_tid(); const int lane = tid & 63, w = tid >> 6, wr = w >> 1, wc = w & 1, l15 = lane & 15, grp = lane >> 4;
  constexpr int MT = R / 128;
  constexpr int NC = (NT_IN + 7) / 8;
  const int nx = gridDim.x >> 3;
  constexpr int CJ_END = (MT / 8) * NC * 64;
  auto cj_valid = [&](int c) { return c < CJ_END && ((c >> 6) % NC) * 8 + ((c & 63) >> 3) < NT_IN; };
  auto cj_next = [&](int c) {
    do { c = ((c & 63) + nx < 64) ? (c + nx) : (((c >> 6) + 8) * 64 + (int)(blockIdx.x >> 3)); } while (c < CJ_END && !cj_valid(c));
    return c;
  };
  int cj = (blockIdx.x & 7) * 64 + (blockIdx.x >> 3);
  if (!cj_valid(cj)) cj = cj_next(cj);
  __syncthreads();
  if (cj < CJ_END) {
    const int cell = cj >> 6, jj = cj & 63;
    glds_prefetch0(H + (size_t)((cell / NC) * 8 + (jj & 7)) * 128 * D, D, W + (size_t)((cell % NC) * 8 + (jj >> 3)) * 128 * D, D, sm, tid);
  }
  while (cj < CJ_END) {
    const int cell = cj >> 6, jj = cj & 63;
    const int nt = (cell % NC) * 8 + (jj >> 3), mt = (cell / NC) * 8 + (jj & 7);
    f32x4 acc[4][4];
    zero_acc(acc);
    gemm_core_glds<true>(acc, H + (size_t)mt * 128 * D, D, W + (size_t)nt * 128 * D, D, D / 64, sm, tid);
    cj = cj_next(cj);
    if (cj < CJ_END) {
      const int cell2 = cj >> 6, jj2 = cj & 63;
      glds_prefetch0(H + (size_t)((cell2 / NC) * 8 + (jj2 & 7)) * 128 * D, D, W + (size_t)((cell2 % NC) * 8 + (jj2 >> 3)) * 128 * D, D, sm, tid);
    }
    const int rbase = mt * 128 + wr * 64 + l15;
    const int c4 = 4 * grp;
#define ST4(PTR, V0, V1, V2, V3) *(u32x2*)(PTR) = u32x2{pack2((V0), (V1)), pack2((V2), (V3))}
    if (nt < 32) {
      const int ch = nt * 32 + wc * 16 + c4;
#pragma unroll
      for (int m = 0; m < 4; ++m) {
        const size_t row = rbase + m * 16;
        ST4(yApre + row * 1024 + ch, acc[m][1][0] * acc[m][2][0], acc[m][1][1] * acc[m][2][1], acc[m][1][2] * acc[m][2][2], acc[m][1][3] * acc[m][2][3]);
        ST4(bzA + row * 1024 + ch, acc[m][0][0] * silu_(acc[m][3][0]), acc[m][0][1] * silu_(acc[m][3][1]), acc[m][0][2] * silu_(acc[m][3][2]), acc[m][0][3] * silu_(acc[m][3][3]));
      }
    } else if (nt < 40) {
      const int cb = (nt - 32) * 128 + wc * 64 + c4;
      const float qs = 0.125f * 1.44269504f;
#pragma unroll
      for (int m = 0; m < 4; ++m)
#pragma unroll
        for (int n = 0; n < 4; ++n)
          ST4(qb + (size_t)(rbase + m * 16) * 1024 + cb + n * 16, acc[m][n][0] * qs, acc[m][n][1] * qs, acc[m][n][2] * qs, acc[m][n][3] * qs);
    } else if (nt < 52) {
      const int cb = (nt - 40) * 128 + wc * 64 + c4;
#pragma unroll
      for (int m = 0; m < 4; ++m)
#pragma unroll
        for (int n = 0; n < 4; ++n)
          ST4(kvb + (size_t)(rbase + m * 16) * 1536 + cb + n * 16, acc[m][n][0], acc[m][n][1], acc[m][n][2], acc[m][n][3]);
    } else if (nt < 60) {
      const int cb = (nt - 52) * 128 + wc * 64 + c4;
#pragma unroll
      for (int m = 0; m < 4; ++m)
#pragma unroll
        for (int n = 0; n < 4; ++n)
          ST4(zb + (size_t)(rbase + m * 16) * 1024 + cb + n * 16, silu_(acc[m][n][0]), silu_(acc[m][n][1]), silu_(acc[m][n][2]), silu_(acc[m][n][3]));
    } else if (nt == 60) {
      if (wc == 0) {
#pragma unroll
        for (int m = 0; m < 4; ++m)
#pragma unroll
          for (int n = 0; n < 3; ++n)
            *(f32x4*)(glb + (size_t)(rbase + m * 16) * 48 + n * 16 + c4) =
                f32x4{sigmoid_(acc[m][n][0]), sigmoid_(acc[m][n][1]), sigmoid_(acc[m][n][2]), sigmoid_(acc[m][n][3])};
      }
    } else if (nt < 77) {
      const int chb = (nt - 61) * 64 + wc * 32 + c4;
#pragma unroll
      for (int m = 0; m < 4; ++m)
#pragma unroll
        for (int pr = 0; pr < 2; ++pr)
          ST4(uz + (size_t)(rbase + m * 16) * 1024 + chb + pr * 16,
              gelu_(acc[m][2 * pr][0]) * silu_(acc[m][2 * pr + 1][0]), gelu_(acc[m][2 * pr][1]) * silu_(acc[m][2 * pr + 1][1]),
              gelu_(acc[m][2 * pr][2]) * silu_(acc[m][2 * pr + 1][2]), gelu_(acc[m][2 * pr][3]) * silu_(acc[m][2 * pr + 1][3]));
    } else if (nt < 85) {
      const int cb = (nt - 77) * 128 + wc * 64 + c4;
#pragma unroll
      for (int m = 0; m < 4; ++m)
#pragma unroll
        for (int n = 0; n < 4; ++n)
          ST4(gv + (size_t)(rbase + m * 16) * 1024 + cb + n * 16, gelu_(acc[m][n][0]), gelu_(acc[m][n][1]), gelu_(acc[m][n][2]), gelu_(acc[m][n][3]));
    } else {
      const int cb = (nt - 85) * 128 + wc * 64 + c4;
#pragma unroll
      for (int m = 0; m < 4; ++m)
#pragma unroll
        for (int n = 0; n < 4; ++n)
          ST4(gates + (size_t)(rbase + m * 16) * 3072 + cb + n * 16, sigmoid_(acc[m][n][0]), sigmoid_(acc[m][n][1]), sigmoid_(acc[m][n][2]), sigmoid_(acc[m][n][3]));
    }
#undef ST4
  }
}

struct CmpALoader {
  const bf16_t* rowptr;
  int r, soff;
  u32x4 r0, r1;
  __device__ __forceinline__ void load(int kt) {
    int tok = 16 * r + (kt >> 1);
    tok = tok > (SEQ - 1) ? (SEQ - 1) : tok;
    const bf16_t* q = rowptr + (size_t)tok * 1536 + (kt & 1) * 32;
    r0 = *(const u32x4*)q; r1 = *(const u32x4*)(q + 8);
  }
  __device__ __forceinline__ void store(bf16_t* tile) {
    bf16_t* q = tile + soff;
    *(u32x4*)q = r0; *(u32x4*)(q + 8) = r1;
  }
};

__device__ __forceinline__ void phase_mix1(const Params& p, int l, char* smraw) {
  const int tid = opaque_tid(); const int lane = tid & 63, w = tid >> 6, l15 = lane & 15, grp = lane >> 4;
  const bf16_t* gv = (const bf16_t*)(p.ws + OFF_GV);
  float* stats = (float*)(p.ws + OFF_STATS);
  constexpr int NCB = 2 * (NB * 4 * 256 / 128);
  const bool split = (int)gridDim.x >= 2 * NCB;
  const int eb = split ? (int)blockIdx.x - NCB : (int)blockIdx.x;
  const int neb = split ? (int)gridDim.x - NCB : (int)gridDim.x;
  for (int r = eb * 4 + w; eb >= 0 && r < R; r += neb * 4) {
    const bf16_t* row = gv + (size_t)r * 1024;
    float v[16]; float s = 0.f;
#pragma unroll
    for (int i = 0; i < 2; ++i) {
      u32x4 u = *(const u32x4*)(row + i * 512 + lane * 8);
      v[i * 8 + 0] = bf2f(u.x & 0xffffu); v[i * 8 + 1] = bf2f(u.x >> 16);
      v[i * 8 + 2] = bf2f(u.y & 0xffffu); v[i * 8 + 3] = bf2f(u.y >> 16);
      v[i * 8 + 4] = bf2f(u.z & 0xffffu); v[i * 8 + 5] = bf2f(u.z >> 16);
      v[i * 8 + 6] = bf2f(u.w & 0xffffu); v[i * 8 + 7] = bf2f(u.w >> 16);
    }
#pragma unroll
    for (int i = 0; i < 16; ++i) s += v[i];
    s = wave_sum(s, lane);
    float mu = s * (1.f / 1024.f);
    float q = 0.f;
#pragma unroll
    for (int i = 0; i < 16; ++i) { float d = v[i] - mu; q += d * d; }
    q = wave_sum(q, lane);
    if (lane == 0) { stats[r * 2] = mu; stats[r * 2 + 1] = rsqrtf(q * (1.f / 1024.f) + 1e-6f); }
  }
  {
    const bf16_t* yApre = (const bf16_t*)(p.ws + OFF_YAPRE);
    const bf16_t* bzA = (const bf16_t*)(p.ws + OFF_BZA);
    bf16_t* yA = (bf16_t*)(p.ws + OFF_YA);
    const float* cw = p.conv_w + (size_t)l * 3 * 1024;
    const float* cb = p.conv_b + (size_t)l * 1024;
    for (int e = eb * 256 + tid; eb >= 0 && e < R * 128; e += neb * 256) {
      int row = e >> 7, c8 = (e & 127) * 8;
      int t = row & (SEQ - 1);
      u32x4 y2 = *(const u32x4*)(yApre + (size_t)row * 1024 + c8);
      u32x4 y1 = (t >= 1) ? *(const u32x4*)(yApre + (size_t)(row - 1) * 1024 + c8) : u32x4{0, 0, 0, 0};
      u32x4 y0 = (t >= 2) ? *(const u32x4*)(yApre + (size_t)(row - 2) * 1024 + c8) : u32x4{0, 0, 0, 0};
      u32x4 bz = *(const u32x4*)(bzA + (size_t)row * 1024 + c8);
      u32x4 o;
#pragma unroll
      for (int i = 0; i < 4; ++i) {
        int c = c8 + i * 2;
        float r0 = cb[c] + cw[c] * bf2f(y0[i] & 0xffffu) + cw[1024 + c] * bf2f(y1[i] & 0xffffu) + cw[2048 + c] * bf2f(y2[i] & 0xffffu);
        float r1 = cb[c + 1] + cw[c + 1] * bf2f(y0[i] >> 16) + cw[1024 + c + 1] * bf2f(y1[i] >> 16) + cw[2048 + c + 1] * bf2f(y2[i] >> 16);
        o[i] = pack2(bf2f(bz[i] & 0xffffu) * r0, bf2f(bz[i] >> 16) * r1);
      }
      *(u32x4*)(yA + (size_t)row * 1024 + c8) = o;
    }
  }
  {
    bf16_t* sm = (bf16_t*)smraw;
    const bf16_t* kvb = (const bf16_t*)(p.ws + OFF_KV);
    const bf16_t* Wc1T = (const bf16_t*)(p.ws + OFF_WC1T);
    const float* bias1 = (const float*)(p.ws + OFF_BIAS1);
    const int wr = w >> 1, wc = w & 1;
    constexpr int MTC = NB * 4 * 256 / 128;
    for (int t = blockIdx.x; t < 2 * MTC; t += gridDim.x) {
      int kv = t / MTC, mt = t % MTC;
      f32x4 acc[4][4];
      zero_acc(acc);
      {
        const int rr = mt * 128 + (tid >> 3);
        const int bl = rr >> 10, g = (rr >> 8) & 3;
        const int gch = ((tid & 7) ^ ((tid >> 4) & 7)) * 8;
        gemm_core_glds_cmp(acc, kvb + (size_t)bl * SEQ * 1536 + kv * 256 + g * 64 + gch, rr & 255,
                           Wc1T + (size_t)(l * 2 + kv) * 128 * 2048, 2048, 2048 / 64, sm, tid);
      }
      bf16_t* Hs = sm;
      bf16_t* W2s = sm + 128 * HS_LD;
      const float* b1 = bias1 + (l * 2 + kv) * 8 * 128;
#pragma unroll
      for (int n = 0; n < 4; ++n) {
        const int col = wc * 64 + n * 16 + 4 * grp;
        f32x4 bb = f32x4{0.f, 0.f, 0.f, 0.f};
#pragma unroll
        for (int ks = 0; ks < 8; ++ks) bb += *(const f32x4*)(b1 + ks * 128 + col);
#pragma unroll
        for (int m = 0; m < 4; ++m)
          *(u32x2*)(Hs + (wr * 64 + m * 16 + l15) * HS_LD + col) =
              u32x2{pack2(silu_(acc[m][n][0] + bb[0]), silu_(acc[m][n][1] + bb[1])), pack2(silu_(acc[m][n][2] + bb[2]), silu_(acc[m][n][3] + bb[3]))};
      }
      const float* w2 = (kv ? p.w_cv2 : p.w_ck2) + (size_t)l * 128 * 64;
      for (int i = 0; i < 32; ++i) {
        int e = tid + 256 * i;
        int j = e >> 6, d = e & 63;
        W2s[d * HS_LD + j] = f2bf(w2[e]);
      }
      __syncthreads();
      f32x4 a2[2][4];
#pragma unroll
      for (int mm = 0; mm < 2; ++mm)
#pragma unroll
        for (int nn = 0; nn < 4; ++nn) a2[mm][nn] = f32x4{0.f, 0.f, 0.f, 0.f};
#pragma unroll
      for (int ks = 0; ks < 4; ++ks) {
        bf16x8 af[2], bfr[4];
#pragma unroll
        for (int mm = 0; mm < 2; ++mm) af[mm] = *(const bf16x8*)(Hs + (w * 32 + mm * 16 + l15) * HS_LD + ks * 32 + grp * 8);
#pragma unroll
        for (int nn = 0; nn < 4; ++nn) bfr[nn] = *(const bf16x8*)(W2s + (nn * 16 + l15) * HS_LD + ks * 32 + grp * 8);
#pragma unroll
        for (int mm = 0; mm < 2; ++mm)
#pragma unroll
          for (int nn = 0; nn < 4; ++nn) a2[mm][nn] = mfma16(af[mm], bfr[nn], a2[mm][nn]);
      }
      bf16_t* outp = (bf16_t*)(p.ws + (kv ? OFF_VCMP : OFF_KCMP));
#pragma unroll
      for (int mm = 0; mm < 2; ++mm)
#pragma unroll
        for (int nn = 0; nn < 4; ++nn)
#pragma unroll
          for (int j = 0; j < 4; ++j) {
            int row = mt * 128 + w * 32 + mm * 16 + 4 * grp + j;
            outp[(size_t)row * 64 + nn * 16 + l15] = f2bf(a2[mm][nn][j]);
          }
      __syncthreads();
    }
  }
}

struct KVRegs { u32x4 k0, k1, v0, v1; };

__device__ __forceinline__ void kv_issue(KVRegs& r, const bf16_t* kbase, const bf16_t* vbase, size_t ld, bool wantV, int tid) {
  const uint32_t row = (uint32_t)tid >> 3, c = ((uint32_t)tid & 7u) * 8u;
  const uint32_t ldu = (ld == 64 ? 64u : 1536u);
  const uint32_t off = row * ldu + c;
  const bf16_t* kp = kbase + off;
  r.k0 = *(const u32x4*)kp; r.k1 = *(const u32x4*)(kp + 32u * ldu);
  if (wantV) {
    const bf16_t* vp = vbase + off;
    r.v0 = *(const u32x4*)vp; r.v1 = *(const u32x4*)(vp + 32u * ldu);
  }
}
__device__ __forceinline__ void kv_commit(const KVRegs& r, bf16_t* Ks, bf16_t* Vs, bool wantV, int tid) {
  int row = tid >> 3, c = (tid & 7) * 8;
  *(u32x4*)(Ks + row * KS_LD + c) = r.k0;
  *(u32x4*)(Ks + (row + 32) * KS_LD + c) = r.k1;
  if (wantV) {
    *(u32x4*)(Vs + row * KS_LD + c) = r.v0;
    *(u32x4*)(Vs + (row + 32) * KS_LD + c) = r.v1;
  }
}

typedef short s16x4 __attribute__((ext_vector_type(4)));
__device__ __forceinline__ s16x4 tr_read(const bf16_t* ptr) {
  return __builtin_amdgcn_ds_read_tr16_b64_v4i16((s16x4 __attribute__((address_space(3)))*)ptr);
}

#define ADSR(dst, base, OFF) asm volatile("ds_read_b128 %0, %1 offset:" #OFF : "=v"(dst) : "v"(base) : "memory")
#define ATRR(dst, base, OFF) asm volatile("ds_read_b64_tr_b16 %0, %1 offset:" #OFF : "=v"(dst) : "v"(base) : "memory")
template <bool MASKED>
__device__ __forceinline__ void attn_block64(const bf16_t* Ks, const bf16_t* Vs, bf16x8 q0, bf16x8 q1, int tq, int kp0, int kpstride,
                                             int maxdist, bool extra_ok, float slope, float& m, float& lsum, f32x4 (&o)[4], int l15, int grp,
                                             const f32x4 (&tb)[4]) {
  const float fst = (float)kpstride;
  const int d0 = tq - kp0 - 4 * grp * kpstride;
  const float base = -slope * (float)d0;
  const unsigned kaddr = (unsigned)(size_t)(Ks + l15 * KS_LD + grp * 8);
  const unsigned vaddr = (unsigned)(size_t)(Vs + (4 * grp + (l15 >> 2)) * KS_LD + 4 * (l15 & 3));
  bf16x8 kf[8];
  ADSR(kf[0], kaddr, 0);    ADSR(kf[1], kaddr, 64);   ADSR(kf[2], kaddr, 2560); ADSR(kf[3], kaddr, 2624);
  ADSR(kf[4], kaddr, 5120); ADSR(kf[5], kaddr, 5184); ADSR(kf[6], kaddr, 7680); ADSR(kf[7], kaddr, 7744);
  f32x4 s[4];
  asm volatile("s_waitcnt lgkmcnt(6)" : "+v"(kf[0]), "+v"(kf[1]) :: "memory");
  s[0] = mfma16(kf[1], q1, mfma16(kf[0], q0, f32x4{0.f, 0.f, 0.f, 0.f}));
  asm volatile("s_waitcnt lgkmcnt(4)" : "+v"(kf[2]), "+v"(kf[3]) :: "memory");
  s[1] = mfma16(kf[3], q1, mfma16(kf[2], q0, f32x4{0.f, 0.f, 0.f, 0.f}));
  asm volatile("s_waitcnt lgkmcnt(2)" : "+v"(kf[4]), "+v"(kf[5]) :: "memory");
  s[2] = mfma16(kf[5], q1, mfma16(kf[4], q0, f32x4{0.f, 0.f, 0.f, 0.f}));
  asm volatile("s_waitcnt lgkmcnt(0)" : "+v"(kf[6]), "+v"(kf[7]) :: "memory");
  s[3] = mfma16(kf[7], q1, mfma16(kf[6], q0, f32x4{0.f, 0.f, 0.f, 0.f}));
  s16x4 vt[16];
  ATRR(vt[0], vaddr, 0);     ATRR(vt[1], vaddr, 2560);  ATRR(vt[2], vaddr, 32);    ATRR(vt[3], vaddr, 2592);
  ATRR(vt[4], vaddr, 64);    ATRR(vt[5], vaddr, 2624);  ATRR(vt[6], vaddr, 96);    ATRR(vt[7], vaddr, 2656);
  ATRR(vt[8], vaddr, 5120);  ATRR(vt[9], vaddr, 7680);  ATRR(vt[10], vaddr, 5152); ATRR(vt[11], vaddr, 7712);
  ATRR(vt[12], vaddr, 5184); ATRR(vt[13], vaddr, 7744); ATRR(vt[14], vaddr, 5216); ATRR(vt[15], vaddr, 7776);
  float cmax = -1e30f;
#pragma unroll
  for (int t = 0; t < 4; ++t)
#pragma unroll
    for (int j = 0; j < 4; ++j) {
      const int ci = t * 16 + j;
      float v = __builtin_fmaf(tb[t][j], fst, s[t][j]);
      if (MASKED) {
        const int dist = d0 - ci * kpstride;
        const bool valid = extra_ok && dist >= 0 && dist < maxdist;
        v = valid ? v : -1e30f;
      }
      s[t][j] = v;
      cmax = fmaxf(cmax, v);
    }
  if (!MASKED) cmax = extra_ok ? cmax : -1e30f;
  if (__ballot(cmax + base > m + 40.f) != 0ull) {
    cmax = (cmax > -1e29f) ? cmax + base : -1e30f;
    cmax = fmaxf(cmax, bperm(cmax, (l15 + 16 * grp) ^ 16));
    cmax = fmaxf(cmax, bperm(cmax, (l15 + 16 * grp) ^ 32));
    const float mnew = fmaxf(m, cmax);
    const float alpha = __builtin_amdgcn_exp2f(m - mnew);
    lsum *= alpha;
#pragma unroll
    for (int dt = 0; dt < 4; ++dt) o[dt] *= alpha;
    m = mnew;
  }
  float psum = 0.f;
  const float mb = m - base;
#pragma unroll
  for (int t = 0; t < 4; ++t)
#pragma unroll
    for (int j = 0; j < 4; ++j) {
      const float v = s[t][j];
      float pe = __builtin_amdgcn_exp2f(v - mb);
      if (MASKED) pe = (v > -1e29f) ? pe : 0.f;
      s[t][j] = pe;
      psum += pe;
    }
  if (!MASKED) psum = extra_ok ? psum : 0.f;
  lsum += psum;
  const uint32_t rowm = (MASKED || extra_ok) ? 0xffffffffu : 0u;
  asm volatile("s_waitcnt lgkmcnt(0)"
               : "+v"(vt[0]), "+v"(vt[1]), "+v"(vt[2]), "+v"(vt[3]), "+v"(vt[4]), "+v"(vt[5]), "+v"(vt[6]), "+v"(vt[7]),
                 "+v"(vt[8]), "+v"(vt[9]), "+v"(vt[10]), "+v"(vt[11]), "+v"(vt[12]), "+v"(vt[13]), "+v"(vt[14]), "+v"(vt[15])
               :: "memory");
#pragma unroll
  for (int sc = 0; sc < 2; ++sc) {
    const bf16x8 pb = __builtin_bit_cast(bf16x8, u32x4{pack2(s[2 * sc][0], s[2 * sc][1]) & rowm, pack2(s[2 * sc][2], s[2 * sc][3]) & rowm,
                                                       pack2(s[2 * sc + 1][0], s[2 * sc + 1][1]) & rowm, pack2(s[2 * sc + 1][2], s[2 * sc + 1][3]) & rowm});
#pragma unroll
    for (int dt = 0; dt < 4; ++dt) {
      const s16x4 vlo = vt[sc * 8 + dt * 2], vhi = vt[sc * 8 + dt * 2 + 1];
      const bf16x8 vf = {vlo[0], vlo[1], vlo[2], vlo[3], vhi[0], vhi[1], vhi[2], vhi[3]};
      o[dt] = mfma16(vf, pb, o[dt]);
    }
  }
}

constexpr int ATT_TILE = 64 * KS_LD * 2;
constexpr int ATT_BUF = 2 * ATT_TILE;

template <class DescF, class ProcF>
__device__ __forceinline__ void kv_stream(int n, DescF desc, ProcF proc, char* smraw, int tid) {
  if (n <= 0) return;
  KVRegs r0, r1;
  const bf16_t *kp, *vp; size_t ld;
  desc(0, kp, vp, ld); kv_issue(r0, kp, vp, ld, true, tid);
  desc(1 < n ? 1 : n - 1, kp, vp, ld); kv_issue(r1, kp, vp, ld, true, tid);
  __syncthreads();
  kv_commit(r0, (bf16_t*)smraw, (bf16_t*)(smraw + ATT_TILE), true, tid);
  desc(2 < n ? 2 : n - 1, kp, vp, ld); kv_issue(r0, kp, vp, ld, true, tid);
  __syncthreads();
  for (int e0 = 0; e0 < n; e0 += 2) {
    {
      const int e = e0;
      proc(e, (const bf16_t*)smraw, (const bf16_t*)(smraw + ATT_TILE));
      kv_commit(r1, (bf16_t*)(smraw + ATT_BUF), (bf16_t*)(smraw + ATT_BUF + ATT_TILE), true, tid);
      desc(e + 3 < n ? e + 3 : n - 1, kp, vp, ld); kv_issue(r1, kp, vp, ld, true, tid);
      __syncthreads();
    }
    {
      const int e = e0 + 1;
      if (e < n) proc(e, (const bf16_t*)(smraw + ATT_BUF), (const bf16_t*)(smraw + ATT_BUF + ATT_TILE));
      kv_commit(r0, (bf16_t*)smraw, (bf16_t*)(smraw + ATT_TILE), true, tid);
      desc(e + 3 < n ? e + 3 : n - 1, kp, vp, ld); kv_issue(r0, kp, vp, ld, true, tid);
      __syncthreads();
    }
  }
}

__device__ __forceinline__ void attn_unit(const Params& p, char* smraw, int bl, int g, int qb) {
  float* impbuf = (float*)(smraw + 2 * ATT_BUF);
  unsigned long long* selmask = (unsigned long long*)(smraw + 2 * ATT_BUF + 16640);
  int* sellist = (int*)(smraw + 2 * ATT_BUF + 16640 + 128);
  const bf16_t* qbuf = (const bf16_t*)(p.ws + OFF_Q);
  const bf16_t* zbuf = (const bf16_t*)(p.ws + OFF_ZB);
  const bf16_t* kvb = (const bf16_t*)(p.ws + OFF_KV);
  const float* glb = (const float*)(p.ws + OFF_GL);
  bf16_t* yB = (bf16_t*)(p.ws + OFF_YB);
  const int tid = opaque_tid(); const int lane = tid & 63, n = tid >> 6, l15 = lane & 15, grp = lane >> 4;
  const int h = g * 4 + n, t0 = qb * 16, tq = t0 + l15;
  const float slope = exp2f(-0.5f * (float)(h + 1)) * 1.44269504f;
  f32x4 tb[4];
#pragma unroll
  for (int t = 0; t < 4; ++t) tb[t] = f32x4{slope * (float)(16 * t), slope * (float)(16 * t + 1), slope * (float)(16 * t + 2), slope * (float)(16 * t + 3)};
  const size_t rowq = (size_t)bl * SEQ + tq;
  bf16x8 q0, q1;
  {
    const bf16_t* qp = qbuf + rowq * 1024 + h * 64 + grp * 8;
    q0 = *(const bf16x8*)qp; q1 = *(const bf16x8*)(qp + 32);
  }
  const float g0 = glb[rowq * 48 + h * 3 + 0], g1 = glb[rowq * 48 + h * 3 + 1], g2 = glb[rowq * 48 + h * 3 + 2];
  f32x4 otot[4];
#pragma unroll
  for (int dt = 0; dt < 4; ++dt) otot[dt] = f32x4{0.f, 0.f, 0.f, 0.f};
  const size_t seqbase = (size_t)bl * SEQ * 1536 + g * 64;
  const int BIG = 1 << 30;
  const bf16_t* kcb = (const bf16_t*)(p.ws + OFF_KCMP) + (size_t)(bl * 4 + g) * 256 * 64;
  const bf16_t* vcb = (const bf16_t*)(p.ws + OFF_VCMP) + (size_t)(bl * 4 + g) * 256 * 64;
  const bf16_t* kwb = kvb + seqbase + 1024;
  const bf16_t* vwb = kvb + seqbase + 1280;
  const bf16_t* ksb = kvb + seqbase + 512;
  const bf16_t* vsb = kvb + seqbase + 768;

  float m = -1e30f, lsum = 0.f;
  f32x4 o[4];
#pragma unroll
  for (int dt = 0; dt < 4; ++dt) o[dt] = f32x4{0.f, 0.f, 0.f, 0.f};
  float m_c = -1e30f, inv_c = 0.f, prev_rot = 0.f;
  float* myimp = impbuf + n * 1040;
#pragma unroll
  for (int i = 0; i < 16; ++i) myimp[i * 65 + lane] = 0.f;

  int lo = t0 - 511; lo = lo < 0 ? 0 : lo;
  const int wlo = lo >> 6, whi = t0 >> 6, nW = whi - wlo + 1;
  const int nck = (qb + 63) >> 6;
  auto finish = [&](float gate) -> float {
    float lt = lsum + bperm(lsum, lane ^ 16);
    lt += bperm(lt, lane ^ 32);
    const float inv = lt > 0.f ? 1.f / lt : 0.f;
    const float sc_ = gate * inv;
#pragma unroll
    for (int dt = 0; dt < 4; ++dt) { otot[dt] += o[dt] * sc_; o[dt] = f32x4{0.f, 0.f, 0.f, 0.f}; }
    lsum = 0.f;
    return inv;
  };
  kv_stream(nW + 2 * nck,
    [&](int e, const bf16_t*& kp, const bf16_t*& vp, size_t& ld) {
      if (e < nW) { const size_t off = (size_t)(whi - e) * 64 * 1536; kp = kwb + off; vp = vwb + off; ld = 1536; }
      else { const int c = (e < nW + nck) ? (nW + nck - 1 - e) : (e - nW - nck); kp = kcb + c * 4096; vp = vcb + c * 4096; ld = 64; }
    },
    [&](int e, const bf16_t* Ks, const bf16_t* Vt) {
      if (e < nW) {
        const int wb = whi - e;
        if (wb < whi && wb * 64 >= t0 - 496) attn_block64<false>(Ks, Vt, q0, q1, tq, wb * 64, 1, 512, true, slope, m, lsum, o, l15, grp, tb);
        else attn_block64<true>(Ks, Vt, q0, q1, tq, wb * 64, 1, 512, true, slope, m, lsum, o, l15, grp, tb);
        if (e == nW - 1) { (void)finish(g2); m = -1e30f; }
      } else if (e < nW + nck) {
        const int c = nW + nck - 1 - e;
        if (16 * (64 * c + 63) + 31 <= t0) attn_block64<false>(Ks, Vt, q0, q1, tq, 1024 * c + 31, 16, BIG, true, slope, m, lsum, o, l15, grp, tb);
        else attn_block64<true>(Ks, Vt, q0, q1, tq, 1024 * c + 31, 16, BIG, true, slope, m, lsum, o, l15, grp, tb);
        if (e == nW + nck - 1) { inv_c = finish(g0); m_c = m; m = -1e30f; }
      } else {
        const int c = e - nW - nck;
#pragma unroll
        for (int tt = 0; tt < 4; ++tt) {
          const bf16_t* krp = Ks + (tt * 16 + l15) * KS_LD + grp * 8;
          bf16x8 k0 = *(const bf16x8*)krp, k1 = *(const bf16x8*)(krp + 32);
          f32x4 z = f32x4{0.f, 0.f, 0.f, 0.f};
          z = mfma16(k0, q0, z);
          z = mfma16(k1, q1, z);
          float sum4 = 0.f, p3 = 0.f;
#pragma unroll
          for (int j = 0; j < 4; ++j) {
            int kidx = c * 64 + tt * 16 + 4 * grp + j;
            int dist = tq - (16 * kidx + 31);
            float pe = (dist >= 0) ? __builtin_amdgcn_exp2f(z[j] - slope * (float)dist - m_c) * inv_c : 0.f;
            sum4 += pe;
            if (j == 3) p3 = pe;
          }
          float rot = bperm(p3, (lane + 48) & 63);
          float extra = (grp == 0) ? prev_rot : rot;
          myimp[l15 * 65 + (c * 4 + tt) * 4 + grp] = sum4 + extra;
          prev_rot = rot;
        }
      }
    }, smraw, tid);
  if (nck < 4 && grp == 0) myimp[l15 * 65 + nck * 16] = prev_rot;
  __syncthreads();
#pragma unroll 1
  for (int i = 0; i < 4; ++i) {
    int qi = n * 4 + i;
    const int cur = t0 >> 6, s = lane;
    float imp = impbuf[qi * 65 + s] + impbuf[1040 + qi * 65 + s] + impbuf[2080 + qi * 65 + s] + impbuf[3120 + qi * 65 + s];
    bool forced = (s == 0) || (s == cur) || (s == cur - 1);
    bool valid = s <= cur;
    float score = forced ? __builtin_inff() : (valid ? imp : -__builtin_inff());
    unsigned long long mk;
    if (cur < 16) {
      mk = __ballot(valid);
    } else {
      int rank = 0;
      const int sbits = __float_as_int(score);
#pragma unroll 4
      for (int sp = 0; sp <= cur; ++sp) {
        const float v = __int_as_float(__builtin_amdgcn_readlane(sbits, sp));
        rank += (v > score) ? 1 : 0;
        rank += (v == score && sp < s) ? 1 : 0;
      }
      mk = __ballot((rank < 16) && valid);
    }
    if (lane == 0) selmask[qi] = mk;
  }
  __syncthreads();
  const unsigned long long mymask = selmask[l15];
  unsigned long long U = 0, Uand = ~0ull;
#pragma unroll
  for (int i = 0; i < 16; ++i) { const unsigned long long mk = selmask[i]; U |= mk; Uand &= mk; }
  {
    uint32_t ulo = __builtin_amdgcn_readfirstlane((uint32_t)U), uhi = __builtin_amdgcn_readfirstlane((uint32_t)(U >> 32));
    U = ((unsigned long long)uhi << 32) | ulo;
    ulo = __builtin_amdgcn_readfirstlane((uint32_t)Uand); uhi = __builtin_amdgcn_readfirstlane((uint32_t)(Uand >> 32));
    Uand = ((unsigned long long)uhi << 32) | ulo;
  }
  const int nsel = __popcll(U);
  if (n == 0) {
    if ((U >> lane) & 1ull) sellist[__popcll(U >> lane) - 1] = lane;
  }
  __syncthreads();
  kv_stream(nsel,
    [&](int e, const bf16_t*& kp, const bf16_t*& vp, size_t& ld) {
      const int s = __builtin_amdgcn_readfirstlane(sellist[e]);
      const size_t off = (size_t)s * 64 * 1536; kp = ksb + off; vp = vsb + off; ld = 1536;
    },
    [&](int e, const bf16_t* Ks, const bf16_t* Vt) {
      const int s = __builtin_amdgcn_readfirstlane(sellist[e]);
      const bool ok = (mymask >> s) & 1ull;
      if (s < whi) attn_block64<false>(Ks, Vt, q0, q1, tq, s * 64, 1, BIG, ok, slope, m, lsum, o, l15, grp, tb);
      else attn_block64<true>(Ks, Vt, q0, q1, tq, s * 64, 1, BIG, ok, slope, m, lsum, o, l15, grp, tb);
    }, smraw, tid);
  (void)finish(g1);
#pragma unroll
  for (int dt = 0; dt < 4; ++dt) {
    size_t off = rowq * 1024 + h * 64 + dt * 16 + 4 * grp;
    u32x2 zz = *(const u32x2*)(zbuf + off);
    u32x2 ov;
    ov.x = pack2(otot[dt][0] * bf2f(zz.x & 0xffffu), otot[dt][1] * bf2f(zz.x >> 16));
    ov.y = pack2(otot[dt][2] * bf2f(zz.y & 0xffffu), otot[dt][3] * bf2f(zz.y >> 16));
    *(u32x2*)(yB + off) = ov;
  }
}

struct GmlpBLoader {
  const bf16_t* gvbase;
  const float* stats;
  const float* lg; const float* lb;
  int tid;
  u32x4 r[2]; f32x2 st[2];
  __device__ __forceinline__ void load(int kt) {
#pragma unroll
    for (int i = 0; i < 2; ++i) {
      int v = tid + 256 * i;
      int j = kt * 32 + (v >> 4), c8 = (v & 15) * 8;
      r[i] = *(const u32x4*)(gvbase + (size_t)j * 1024 + c8);
      st[i] = *(const f32x2*)(stats + j * 2);
    }
  }
  __device__ __forceinline__ void store(bf16_t* tile) {
#pragma unroll
    for (int i = 0; i < 2; ++i) {
      int v = tid + 256 * i;
      int jl = v >> 4, c8 = (v & 15) * 8;
      const u32x4 u = r[i];
#pragma unroll
      for (int e = 0; e < 4; ++e) {
        int c = c8 + 2 * e;
        float a = (bf2f(u[e] & 0xffffu) - st[i].x) * st[i].y * lg[c] + lb[c];
        float b = (bf2f(u[e] >> 16) - st[i].x) * st[i].y * lg[c + 1] + lb[c + 1];
        tile[c * LDK + jl] = f2bf(a);
        tile[(c + 1) * LDK + jl] = f2bf(b);
      }
    }
  }
};

__device__ __forceinline__ void gmlp_unit(const Params& p, int l, char* smraw, int bl, int chunk, int g) {
  bf16_t* sm = (bf16_t*)smraw;
  const int tid = opaque_tid(); const int lane = tid & 63, w = tid >> 6, wr = w >> 1, wc = w & 1, l15 = lane & 15, grp = lane >> 4;
  const size_t row0 = (size_t)bl * SEQ + chunk * 128;
  f32x4 acc[4][4];
  zero_acc(acc);
  StdLoader al;
  al.init((const bf16_t*)(p.ws + OFF_WM) + (size_t)(l * 8 + g) * 128 * 128, 128, tid);
  GmlpBLoader bl_;
  bl_.tid = tid;
  bl_.gvbase = (const bf16_t*)(p.ws + OFF_GV) + row0 * 1024 + g * 128;
  bl_.stats = (const float*)(p.ws + OFF_STATS) + row0 * 2;
  bl_.lg = p.ln_g + l * 1024 + g * 128;
  bl_.lb = p.ln_b + l * 1024 + g * 128;
  gemm_core(acc, al, bl_, 4, sm, tid);
  const bf16_t* uz = (const bf16_t*)(p.ws + OFF_UZ);
  bf16_t* yC = (bf16_t*)(p.ws + OFF_YC);
  const float* bs = p.b_s + (size_t)(l * 8 + g) * 128;
#pragma unroll
  for (int m = 0; m < 4; ++m)
#pragma unroll
    for (int j = 0; j < 4; ++j) {
      int i = wr * 64 + m * 16 + 4 * grp + j;
      float bb = bs[i];
#pragma unroll
      for (int n = 0; n < 4; ++n) {
        size_t off = (row0 + i) * 1024 + g * 128 + wc * 64 + n * 16 + l15;
        yC[off] = f2bf(bf2f(uz[off]) * (acc[m][n][j] + bb));
      }
    }
}

__device__ __forceinline__ void phase_mix2(const Params& p, int l, char* smraw) {
  constexpr int NATT = NB * 4 * 256, NGM = NB * 32 * 8;
  for (int u = blockIdx.x; u < NATT + NGM; u += gridDim.x) {
    if (u < NATT) {
      int qb = 255 - (u / (NB * 4)), r = u % (NB * 4);
      attn_unit(p, smraw, r >> 2, r & 3, qb);
    } else {
      int v = u - NATT;
      gmlp_unit(p, l, smraw, v >> 8, (v >> 3) & 31, v & 7);
    }
  }
}

__device__ __forceinline__ void phase_merge(const Params& p, int l, char* smraw) {
  bf16_t* sm = (bf16_t*)smraw;
  const bf16_t* WbrT = (const bf16_t*)(p.ws + OFF_WBRT) + (size_t)l * 3 * D * D;
  const bf16_t* gates = (const bf16_t*)(p.ws + OFF_GATES);
  bf16_t* merged = (bf16_t*)(p.ws + OFF_H);
  const int tid = opaque_tid(); const int lane = tid & 63, w = tid >> 6, wr = w >> 1, wc = w & 1, l15 = lane & 15, grp = lane >> 4;
  const int nx = gridDim.x >> 3;
  constexpr int CJ_END = (R / 1024) * 64;
  auto cj_next = [&](int c) { return ((c & 63) + nx < 64) ? (c + nx) : (((c >> 6) + 8) * 64 + (int)(blockIdx.x >> 3)); };
  auto ybuf = [&](int i) { return (const bf16_t*)(p.ws + (i == 0 ? OFF_YA : (i == 1 ? OFF_YB : OFF_YC))); };
  int cj = (blockIdx.x & 7) * 64 + (blockIdx.x >> 3);
  __syncthreads();
  if (cj < CJ_END) glds_prefetch0(ybuf(0) + (size_t)((cj >> 6) * 8 + (cj & 7)) * 128 * D, D, WbrT + (size_t)((cj & 63) >> 3) * 128 * D, D, sm, tid);
  for (; cj < CJ_END; cj = cj_next(cj)) {
    const int nt = (cj & 63) >> 3, mt = (cj >> 6) * 8 + (cj & 7);
    const int rbase = mt * 128 + wr * 64 + l15, cbase = nt * 128 + wc * 64 + 4 * grp;
    f32x4 tot[4][4];
    zero_acc(tot);
#pragma unroll 1
    for (int i = 0; i < 3; ++i) {
      f32x4 acc[4][4];
      zero_acc(acc);
      const bf16_t* Y = ybuf(i);
      gemm_core_glds<false>(acc, Y + (size_t)mt * 128 * D, D, WbrT + (size_t)i * D * D + (size_t)nt * 128 * D, D, D / 64, sm, tid);
      if (i < 2) {
        glds_prefetch0(ybuf(i + 1) + (size_t)mt * 128 * D, D, WbrT + (size_t)(i + 1) * D * D + (size_t)nt * 128 * D, D, sm, tid);
      } else {
        const int c2 = cj_next(cj);
        if (c2 < CJ_END) glds_prefetch0(ybuf(0) + (size_t)((c2 >> 6) * 8 + (c2 & 7)) * 128 * D, D, WbrT + (size_t)((c2 & 63) >> 3) * 128 * D, D, sm, tid);
      }
#pragma unroll
      for (int m = 0; m < 4; ++m)
#pragma unroll
        for (int n = 0; n < 4; ++n) {
          const u32x2 gt = *(const u32x2*)(gates + (size_t)(rbase + m * 16) * 3072 + i * 1024 + cbase + n * 16);
          tot[m][n][0] += bf2f(gt.x & 0xffffu) * acc[m][n][0];
          tot[m][n][1] += bf2f(gt.x >> 16) * acc[m][n][1];
          tot[m][n][2] += bf2f(gt.y & 0xffffu) * acc[m][n][2];
          tot[m][n][3] += bf2f(gt.y >> 16) * acc[m][n][3];
        }
    }
#pragma unroll
    for (int m = 0; m < 4; ++m)
#pragma unroll
      for (int n = 0; n < 4; ++n)
        *(u32x2*)(merged + (size_t)(rbase + m * 16) * 1024 + cbase + n * 16) = u32x2{pack2(tot[m][n][0], tot[m][n][1]), pack2(tot[m][n][2], tot[m][n][3])};
  }
}

__device__ __forceinline__ void phase_outproj(const Params& p, int l, char* smraw) {
  bf16_t* sm = (bf16_t*)smraw;
  const bf16_t* WoutT = (const bf16_t*)(p.ws + OFF_WOUTT) + (size_t)l * D * D;
  const bf16_t* merged = (const bf16_t*)(p.ws + OFF_H);
  bf16_t* opre = (bf16_t*)(p.ws + OFF_YAPRE);
  const int tid = opaque_tid(); const int lane = tid & 63, w = tid >> 6, wr = w >> 1, wc = w & 1, l15 = lane & 15, grp = lane >> 4;
  const int nx = gridDim.x >> 3;
  constexpr int CJ_END = (R / 1024) * 64;
  auto cj_next = [&](int c) { return ((c & 63) + nx < 64) ? (c + nx) : (((c >> 6) + 8) * 64 + (int)(blockIdx.x >> 3)); };
  int cj = (blockIdx.x & 7) * 64 + (blockIdx.x >> 3);
  __syncthreads();
  if (cj < CJ_END) glds_prefetch0(merged + (size_t)((cj >> 6) * 8 + (cj & 7)) * 128 * D, D, WoutT + (size_t)((cj & 63) >> 3) * 128 * D, D, sm, tid);
  for (; cj < CJ_END; cj = cj_next(cj)) {
    const int nt = (cj & 63) >> 3, mt = (cj >> 6) * 8 + (cj & 7);
    f32x4 acc[4][4];
    zero_acc(acc);
    gemm_core_glds<true>(acc, merged + (size_t)mt * 128 * D, D, WoutT + (size_t)nt * 128 * D, D, D / 64, sm, tid);
    {
      const int c2 = cj_next(cj);
      if (c2 < CJ_END) glds_prefetch0(merged + (size_t)((c2 >> 6) * 8 + (c2 & 7)) * 128 * D, D, WoutT + (size_t)((c2 & 63) >> 3) * 128 * D, D, sm, tid);
    }
    const int rbase = mt * 128 + wr * 64 + l15, cbase = nt * 128 + wc * 64 + 4 * grp;
#pragma unroll
    for (int m = 0; m < 4; ++m)
#pragma unroll
      for (int n = 0; n < 4; ++n)
        *(u32x2*)(opre + (size_t)(rbase + m * 16) * 1024 + cbase + n * 16) = u32x2{pack2(acc[m][n][0], acc[m][n][1]), pack2(acc[m][n][2], acc[m][n][3])};
  }
}

#define XB_TMO      128
#define XB_XCNT(j)  (256  + 64 * (j))
#define XB_XSUB(j)  (1280 + 64 * (j))
#define XB_XGEN(j)  (2304 + 64 * (j))
#define XB_TOP      3328
#define XB_TOPGEN   3392
#define XCD_BAR_WORDS 3456
#define XB_SPIN_CAP (1u << 18)
#define LAS __attribute__((address_space(3)))

__device__ __forceinline__ unsigned xb_ld(unsigned* p)              { return __hip_atomic_load(p, __ATOMIC_RELAXED, __HIP_MEMORY_SCOPE_AGENT); }
__device__ __forceinline__ unsigned xb_add(unsigned* p, unsigned v) { return __hip_atomic_fetch_add(p, v, __ATOMIC_RELAXED, __HIP_MEMORY_SCOPE_AGENT); }
__device__ __forceinline__ unsigned xb_xcc_id() { return (unsigned)__builtin_amdgcn_s_getreg((3 << 11) | 20) & 0xFu; }
#define XB_SPIN(cond, bar) do { unsigned _sp = 0; while (cond) { __builtin_amdgcn_s_sleep(1); \
    if ((++_sp & 255u) == 0u) { if (xb_ld(&(bar)[XB_TMO])) break; if (_sp > XB_SPIN_CAP) { atomicAdd(&(bar)[XB_TMO], 1u); break; } } } } while (0)

struct XcdBarrier {
    unsigned* bar; unsigned x;
    volatile LAS unsigned* st;
};

__device__ __forceinline__ XcdBarrier xcd_barrier_post(unsigned* bar, volatile LAS unsigned* st) {
    XcdBarrier b; b.bar = bar; b.x = xb_xcc_id(); b.st = st;
    if (threadIdx.x == 0) (void)xb_add(&bar[XB_XCNT(b.x)], 1u);
    return b;
}
__device__ __forceinline__ void xcd_barrier_complete(unsigned* bar, unsigned x, unsigned& nloc, unsigned& nx) {
    const unsigned G = gridDim.x * gridDim.y * gridDim.z;
    unsigned sum, cnt, mine, sp = 0u;
    for (;;) {
        sum = 0u; cnt = 0u; mine = 0u;
#pragma unroll
        for (unsigned j = 0; j < 16; ++j) { const unsigned c = xb_ld(&bar[XB_XCNT(j)]); sum += c; cnt += (c > 0u) ? 1u : 0u; mine = (j == x) ? c : mine; }
        if (sum == G) break;
        __builtin_amdgcn_s_sleep(1);
        if ((++sp & 255u) == 0u) { if (xb_ld(&bar[XB_TMO])) break; if (sp > XB_SPIN_CAP) { atomicAdd(&bar[XB_TMO], 1u); break; } }
    }
    nloc = mine > 0u ? mine : 1u; nx = cnt > 0u ? cnt : 1u;
}
__device__ __forceinline__ void xcd_barrier(const XcdBarrier& b) {
    asm volatile("s_waitcnt vmcnt(0)" ::: "memory");
    __syncthreads();
    if (threadIdx.x == 0) {
        unsigned* bar = b.bar;
        __builtin_amdgcn_s_waitcnt(0);
        unsigned nloc = b.st[0], nx = b.st[1];
        if (nloc == 0u) { xcd_barrier_complete(bar, b.x, nloc, nx); b.st[0] = nloc; b.st[1] = nx; }
        const unsigned old = xb_add(&bar[XB_XSUB(b.x)], 1u);
        const unsigned gen = old / nloc;
        if (old + 1u == (gen + 1u) * nloc) {
            __builtin_amdgcn_fence(__ATOMIC_RELEASE, "agent");
            asm volatile("s_waitcnt vmcnt(0)" ::: "memory");
            const unsigned og = xb_add(&bar[XB_TOP], 1u);
            const unsigned tg = og / nx;
            if (og + 1u == (tg + 1u) * nx) xb_add(&bar[XB_TOPGEN], 1u);
            else XB_SPIN(xb_ld(&bar[XB_TOPGEN]) == tg, bar);
            __builtin_amdgcn_fence(__ATOMIC_ACQUIRE, "agent");
            xb_add(&bar[XB_XGEN(b.x)], 1u);
            asm volatile("s_waitcnt vmcnt(0)" ::: "memory");
        } else {
            XB_SPIN(xb_ld(&bar[XB_XGEN(b.x)]) == gen, bar);
            __builtin_amdgcn_fence(__ATOMIC_ACQUIRE, "agent");
            asm volatile("s_waitcnt vmcnt(0)" ::: "memory");
        }
    }
    __syncthreads();
}

__global__ void __launch_bounds__(256, 2) hybrid_fwd(Params p) {
  __shared__ __attribute__((aligned(16))) char smraw[SMEM_BYTES];
  cg::grid_group grid = cg::this_grid();
  if (threadIdx.x == 0) *(u32x4*)(smraw + 65536) = u32x4{0u, 0u, 0u, 0u};
  __syncthreads();
  const XcdBarrier xb = xcd_barrier_post((unsigned*)(p.ws + OFF_BAR), (volatile LAS unsigned*)(smraw + 65536));
  phase0(p, smraw);
  grid.sync();
  for (int gi = 0; gi < NGRP; ++gi) {
    phase_h0(p, gi);
    xcd_barrier(xb);
    for (int l = 0; l < DEPTH; ++l) {
      phase_inproj(p, l, smraw);
      xcd_barrier(xb);
      phase_mix1(p, l, smraw);
      xcd_barrier(xb);
      phase_mix2(p, l, smraw);
      xcd_barrier(xb);
      phase_merge(p, l, smraw);
      xcd_barrier(xb);
      phase_outproj(p, l, smraw);
      xcd_barrier(xb);
      phase_final(p, gi, l);
      xcd_barrier(xb);
    }
  }
}

extern "C" void kernel_launch(void* const* d_in, const int* in_sizes, int n_in, void* d_out, int out_size, void* d_ws,
                              size_t ws_size, hipStream_t stream) {
  static int grid_blocks = 0;
  if (!grid_blocks) {
    int dev = 0, cus = 0, per_cu = 0;
    hipGetDevice(&dev);
    hipDeviceGetAttribute(&cus, hipDeviceAttributeMultiprocessorCount, dev);
    hipOccupancyMaxActiveBlocksPerMultiprocessor(&per_cu, hybrid_fwd, 256, 0);
    if (per_cu < 1) per_cu = 1;
    if (per_cu > 2) per_cu = 2;
    grid_blocks = cus * per_cu;
    if (ws_size < WS_END) fprintf(stderr, "kernel_launch: workspace too small: %zu < %zu\n", ws_size, (size_t)WS_END);
  }
  Params p{};
  const float** pp = (const float**)&p;
  for (int i = 0; i < 21; ++i) pp[i] = (const float*)d_in[i];
  p.out = (float*)d_out;
  p.ws = (unsigned char*)d_ws;
  (void)hipMemsetAsync((char*)d_ws + OFF_BAR, 0, 3456 * 4, stream);
  void* args[] = {&p};
  hipError_t e = hipLaunchCooperativeKernel((void*)hybrid_fwd, dim3(grid_blocks), dim3(256), args, 0, stream);
  if (e != hipSuccess) fprintf(stderr, "cooperative launch failed: %s (grid %d)\n", hipGetErrorString(e), grid_blocks);
}
```

```cpp
#include <hip/hip_runtime.h>
#include <hip/hip_cooperative_groups.h>
#include <cstdio>
#include <cstdint>
namespace cg = cooperative_groups;

typedef unsigned short bf16_t;
using bf16x8 = __attribute__((ext_vector_type(8))) short;
using f32x4 = __attribute__((ext_vector_type(4))) float;
using f32x2 = __attribute__((ext_vector_type(2))) float;
using u32x4 = __attribute__((ext_vector_type(4))) uint32_t;
using u32x2 = __attribute__((ext_vector_type(2))) uint32_t;

constexpr int D = 1024, SEQ = 4096, BATCH = 16, DEPTH = 2;
constexpr int IN_COLS = 13872;
constexpr int A_OFF = 0, B_OFF = 4096, C_OFF = 7728, G_OFF = 10800;
constexpr int NT_IN = 109, NP = NT_IN * 128;
constexpr int NB = 4, R = NB * SEQ, NGRP = BATCH / NB;
constexpr int LDK = 40;
constexpr int KS_LD = 80;
constexpr int VT_LD = 68;
constexpr int HS_LD = 136;
constexpr int SMEM_BYTES = 65536 + 16;

constexpr size_t al256(size_t x) { return (x + 255) & ~size_t(255); }
constexpr size_t OFF_WINT = 0;
constexpr size_t OFF_WBRT = al256(OFF_WINT + (size_t)DEPTH * NP * D * 2);
constexpr size_t OFF_WOUTT = al256(OFF_WBRT + (size_t)DEPTH * 3 * D * D * 2);
constexpr size_t OFF_WC1T = al256(OFF_WOUTT + (size_t)DEPTH * D * D * 2);
constexpr size_t OFF_WM = al256(OFF_WC1T + (size_t)DEPTH * 2 * 128 * 2048 * 2);
constexpr size_t OFF_BIAS1 = al256(OFF_WM + (size_t)DEPTH * 8 * 128 * 128 * 2);
constexpr size_t OFF_MOD = al256(OFF_BIAS1 + (size_t)DEPTH * 2 * 8 * 128 * 4);
constexpr size_t OFF_H = al256(OFF_MOD + (size_t)DEPTH * 16 * 3072 * 4);
constexpr size_t SZ_ACT = (size_t)R * 1024 * 2;
constexpr size_t OFF_YAPRE = al256(OFF_H + SZ_ACT);
constexpr size_t OFF_BZA = al256(OFF_YAPRE + SZ_ACT);
constexpr size_t OFF_Q = al256(OFF_BZA + SZ_ACT);
constexpr size_t OFF_ZB = al256(OFF_Q + SZ_ACT);
constexpr size_t OFF_UZ = al256(OFF_ZB + SZ_ACT);
constexpr size_t OFF_GV = al256(OFF_UZ + SZ_ACT);
constexpr size_t OFF_KV = al256(OFF_GV + SZ_ACT);
constexpr size_t OFF_GL = al256(OFF_KV + (size_t)R * 1536 * 2);
constexpr size_t OFF_GATES = al256(OFF_GL + (size_t)R * 48 * 4);
constexpr size_t OFF_YA = al256(OFF_GATES + (size_t)R * 3072 * 2);
constexpr size_t OFF_YB = al256(OFF_YA + SZ_ACT);
constexpr size_t OFF_YC = al256(OFF_YB + SZ_ACT);
constexpr size_t OFF_KCMP = al256(OFF_YC + SZ_ACT);
constexpr size_t OFF_VCMP = al256(OFF_KCMP + (size_t)NB * 4 * 256 * 64 * 2);
constexpr size_t OFF_STATS = al256(OFF_VCMP + (size_t)NB * 4 * 256 * 64 * 2);
constexpr size_t OFF_BAR = al256(OFF_STATS + (size_t)R * 2 * 4);
constexpr size_t WS_END = al256(OFF_BAR + 3456 * 4);

struct Params {
  const float *x, *c, *g_pre, *g_post, *w_ada, *b_ada, *w_in, *conv_w, *conv_b, *pos_ck, *w_ck1, *w_ck2,
      *pos_cv, *w_cv1, *w_cv2, *ln_g, *ln_b, *w_s, *b_s, *w_br, *w_out;
  float* out;
  unsigned char* ws;
};

typedef __bf16 bf16x2_native __attribute__((ext_vector_type(2)));
__device__ __forceinline__ uint32_t pack2(float a, float b) {
  f32x2 v = {a, b};
  return __builtin_bit_cast(uint32_t, __builtin_convertvector(v, bf16x2_native));
}
__device__ __forceinline__ bf16_t f2bf(float f) { return (bf16_t)(pack2(f, f) & 0xffffu); }
__device__ __forceinline__ float bf2f(uint32_t h) { return __uint_as_float(h << 16); }
__device__ __forceinline__ float sigmoid_(float x) { return __builtin_amdgcn_rcpf(1.f + __expf(-x)); }
__device__ __forceinline__ float silu_(float x) { return x * __builtin_amdgcn_rcpf(1.f + __expf(-x)); }
__device__ __forceinline__ float gelu_(float x) {
  float y = 0.7978845608f * (x + 0.044715f * x * x * x);
  return x * __builtin_amdgcn_rcpf(1.f + __expf(-2.f * y));
}
__device__ __forceinline__ f32x4 mfma16(bf16x8 a, bf16x8 b, f32x4 c) {
  return __builtin_amdgcn_mfma_f32_16x16x32_bf16(a, b, c, 0, 0, 0);
}
__device__ __forceinline__ float bperm(float v, int srclane) {
  return __int_as_float(__builtin_amdgcn_ds_bpermute(srclane << 2, __float_as_int(v)));
}
__device__ __forceinline__ float wave_sum(float v, int lane) {
#pragma unroll
  for (int o = 32; o >= 1; o >>= 1) v += bperm(v, lane ^ o);
  return v;
}

__device__ __forceinline__ int opaque_tid() {
  int t = threadIdx.x;
  asm volatile("" : "+v"(t));
  return t;
}

__device__ __forceinline__ int win_colmap(int np) {
  int tile = np >> 7, r = np & 127;
  if (tile < 32) { int wc = r >> 6, t = (r >> 4) & 3, i = r & 15; return A_OFF + t * 1024 + tile * 32 + wc * 16 + i; }
  if (tile < 40) return B_OFF + (np - 32 * 128);
  if (tile < 52) return B_OFF + 1024 + (np - 40 * 128);
  if (tile < 60) return B_OFF + 2560 + (np - 52 * 128);
  if (tile == 60) return r < 48 ? B_OFF + 3584 + r : -1;
  if (tile < 77) { int tb = tile - 61, wc = r >> 6, t = (r >> 4) & 3, i = r & 15; return C_OFF + ((t & 1) ? 2048 : 0) + tb * 64 + wc * 32 + (t >> 1) * 16 + i; }
  if (tile < 85) return C_OFF + 1024 + (np - 77 * 128);
  return G_OFF + (np - 85 * 128);
}

template <bool WIN>
__device__ __forceinline__ void transpose_tile(const float* __restrict__ src, int ld_src, bf16_t* __restrict__ dst, int Kdim, int n0, int k0, float* sm, int tid) {
  const int tx = tid & 63, ty = tid >> 6;
  const int col = WIN ? win_colmap(n0 + tx) : (n0 + tx);
  __syncthreads();
#pragma unroll
  for (int i = 0; i < 16; ++i) {
    int k = ty * 16 + i;
    float v = (col >= 0) ? src[(size_t)(k0 + k) * ld_src + col] : 0.f;
    sm[k * 65 + tx] = v;
  }
  __syncthreads();
#pragma unroll
  for (int i = 0; i < 16; ++i) {
    int n = ty * 16 + i;
    dst[(size_t)(n0 + n) * Kdim + k0 + tx] = f2bf(sm[tx * 65 + n]);
  }
}

__device__ __forceinline__ void phase0(const Params& p, char* smraw) {
  float* smf = (float*)smraw;
  const int bid = blockIdx.x, nblk = gridDim.x, tid = opaque_tid();
  bf16_t* WinT = (bf16_t*)(p.ws + OFF_WINT);
  bf16_t* WbrT = (bf16_t*)(p.ws + OFF_WBRT);
  bf16_t* WoutT = (bf16_t*)(p.ws + OFF_WOUTT);
  bf16_t* Wc1T = (bf16_t*)(p.ws + OFF_WC1T);
  bf16_t* Wm = (bf16_t*)(p.ws + OFF_WM);
  float* bias1 = (float*)(p.ws + OFF_BIAS1);
  float* mod = (float*)(p.ws + OFF_MOD);
  for (int t = bid; t < DEPTH * 218 * 16; t += nblk) {
    int l = t / (218 * 16), r = t % (218 * 16), nt = r >> 4, kt = r & 15;
    transpose_tile<true>(p.w_in + (size_t)l * D * IN_COLS, IN_COLS, WinT + (size_t)l * NP * D, D, nt * 64, kt * 64, smf, tid);
  }
  for (int t = bid; t < DEPTH * 3 * 256; t += nblk) {
    int li = t >> 8, r = t & 255, nt = r >> 4, kt = r & 15;
    transpose_tile<false>(p.w_br + (size_t)li * D * D, D, WbrT + (size_t)li * D * D, D, nt * 64, kt * 64, smf, tid);
  }
  for (int t = bid; t < DEPTH * 256; t += nblk) {
    int l = t >> 8, r = t & 255, nt = r >> 4, kt = r & 15;
    transpose_tile<false>(p.w_out + (size_t)l * D * D, D, WoutT + (size_t)l * D * D, D, nt * 64, kt * 64, smf, tid);
  }
  for (int t = bid; t < DEPTH * 2 * 64; t += nblk) {
    int lk = t >> 6, r = t & 63, nt = r >> 5, kt = r & 31;
    int l = lk >> 1, kv = lk & 1;
    const float* src = (kv ? p.w_cv1 : p.w_ck1) + (size_t)l * 2048 * 128;
    transpose_tile<false>(src, 128, Wc1T + (size_t)lk * 128 * 2048, 2048, nt * 64, kt * 64, smf, tid);
  }
  for (int e = bid * 256 + tid; e < DEPTH * 8 * 128 * 128; e += nblk * 256) {
    int j = e & 127, i = (e >> 7) & 127;
    Wm[e] = (j <= i) ? f2bf(p.w_s[e]) : (bf16_t)0;
  }
  for (int t = bid - 128; t >= 0 && t < DEPTH * 2 * 8; t += nblk) {
    int lk = t >> 3, ks = t & 7, l = lk >> 1, kv = lk & 1;
    const float* pos = (kv ? p.pos_cv : p.pos_ck) + (size_t)l * 2048;
    const float* w1 = (kv ? p.w_cv1 : p.w_ck1) + (size_t)l * 2048 * 128;
    int n = tid & 127, half = tid >> 7;
    float acc = 0.f;
    const int kb = ks * 256 + half * 128;
#pragma unroll 16
    for (int k = kb; k < kb + 128; ++k) acc += pos[k] * w1[(size_t)k * 128 + n];
    __syncthreads();
    smf[tid] = acc;
    __syncthreads();
    if (tid < 128) bias1[t * 128 + tid] = smf[tid] + smf[tid + 128];
  }
  for (int t = nblk - 1 - bid; t < DEPTH * 48; t += nblk) {
    int l = t / 48, ch = t % 48;
    int tx = tid & 63, ty = tid >> 6;
    int col = ch * 64 + tx;
    __syncthreads();
    for (int i = 0; i < 64; ++i) {
      int e = tid + 256 * i;
      smf[(e & 1023) * 16 + (e >> 10)] = silu_(p.c[e]);
    }
    __syncthreads();
    float acc[16];
#pragma unroll
    for (int b = 0; b < 16; ++b) acc[b] = 0.f;
    const float* w = p.w_ada + (size_t)l * D * 3072 + col;
#pragma unroll 8
    for (int k = ty * 256; k < ty * 256 + 256; ++k) {
      float wv = w[(size_t)k * 3072];
      const f32x4 s0 = *(const f32x4*)(smf + k * 16), s1 = *(const f32x4*)(smf + k * 16 + 4), s2 = *(const f32x4*)(smf + k * 16 + 8), s3 = *(const f32x4*)(smf + k * 16 + 12);
#pragma unroll
      for (int b = 0; b < 4; ++b) { acc[b] += s0[b] * wv; acc[4 + b] += s1[b] * wv; acc[8 + b] += s2[b] * wv; acc[12 + b] += s3[b] * wv; }
    }
    __syncthreads();
#pragma unroll
    for (int b = 0; b < 16; ++b) smf[(ty * 16 + b) * 64 + tx] = acc[b];
    __syncthreads();
    if (ty == 0) {
#pragma unroll
      for (int b = 0; b < 16; ++b) {
        float s_ = smf[b * 64 + tx] + smf[(16 + b) * 64 + tx] + smf[(32 + b) * 64 + tx] + smf[(48 + b) * 64 + tx];
        mod[((size_t)l * 16 + b) * 3072 + col] = s_ + p.b_ada[l * 3072 + col];
      }
    }
  }
}

__device__ __forceinline__ void write_h_row(const f32x4 (&xv)[4], float ss, const float* g_pre, const float* modl_b, bf16_t* hrow, int lane) {
  float rs = rsqrtf(ss * (1.f / 1024.f) + 1e-6f);
#pragma unroll
  for (int i = 0; i < 4; ++i) {
    int c = i * 256 + lane * 4;
    f32x4 g = *(const f32x4*)(g_pre + c);
    f32x4 sh = *(const f32x4*)(modl_b + c);
    f32x4 sc = *(const f32x4*)(modl_b + 1024 + c);
    float h0 = xv[i].x * rs * g.x * (1.f + sc.x) + sh.x;
    float h1 = xv[i].y * rs * g.y * (1.f + sc.y) + sh.y;
    float h2 = xv[i].z * rs * g.z * (1.f + sc.z) + sh.z;
    float h3 = xv[i].w * rs * g.w * (1.f + sc.w) + sh.w;
    u32x2 o; o.x = pack2(h0, h1); o.y = pack2(h2, h3);
    *(u32x2*)(hrow + c) = o;
  }
}

__device__ __forceinline__ void phase_h0(const Params& p, int grp_i) {
  const int tid = opaque_tid(); const int lane = tid & 63, w = tid >> 6;
  bf16_t* H = (bf16_t*)(p.ws + OFF_H);
  const float* mod = (const float*)(p.ws + OFF_MOD);
  for (int r = blockIdx.x * 4 + w; r < R; r += gridDim.x * 4) {
    size_t grow = (size_t)grp_i * R + r;
    int b = (int)(grow >> 12);
    const float* xr = p.x + grow * D;
    f32x4 xv[4]; float ss = 0.f;
#pragma unroll
    for (int i = 0; i < 4; ++i) {
      xv[i] = *(const f32x4*)(xr + i * 256 + lane * 4);
      ss += xv[i].x * xv[i].x + xv[i].y * xv[i].y + xv[i].z * xv[i].z + xv[i].w * xv[i].w;
    }
    ss = wave_sum(ss, lane);
    write_h_row(xv, ss, p.g_pre, mod + (size_t)b * 3072, H + (size_t)r * D, lane);
  }
}

__device__ __forceinline__ void phase_final(const Params& p, int grp_i, int l) {
  const int tid = opaque_tid(); const int lane = tid & 63, w = tid >> 6;
  bf16_t* H = (bf16_t*)(p.ws + OFF_H);
  const bf16_t* OP = (const bf16_t*)(p.ws + OFF_YAPRE);
  const float* mod = (const float*)(p.ws + OFF_MOD);
  const float* xin = (l == 0) ? p.x : p.out;
  for (int r = blockIdx.x * 4 + w; r < R; r += gridDim.x * 4) {
    size_t grow = (size_t)grp_i * R + r;
    int b = (int)(grow >> 12);
    const float* xr = xin + grow * D;
    const bf16_t* orow = OP + (size_t)r * D;
    const float* gate = mod + ((size_t)l * 16 + b) * 3072 + 2048;
    const float* gp = p.g_post + l * D;
    f32x4 xv[4], ov[4]; float ss = 0.f;
#pragma unroll
    for (int i = 0; i < 4; ++i) {
      int c = i * 256 + lane * 4;
      xv[i] = *(const f32x4*)(xr + c);
      u32x2 u = *(const u32x2*)(orow + c);
      ov[i].x = bf2f(u.x & 0xffffu); ov[i].y = bf2f(u.x >> 16); ov[i].z = bf2f(u.y & 0xffffu); ov[i].w = bf2f(u.y >> 16);
      ss += ov[i].x * ov[i].x + ov[i].y * ov[i].y + ov[i].z * ov[i].z + ov[i].w * ov[i].w;
    }
    ss = wave_sum(ss, lane);
    float rs = rsqrtf(ss * (1.f / 1024.f) + 1e-6f);
    float ss2 = 0.f;
#pragma unroll
    for (int i = 0; i < 4; ++i) {
      int c = i * 256 + lane * 4;
      f32x4 g = *(const f32x4*)(gp + c);
      f32x4 ga = *(const f32x4*)(gate + c);
      xv[i].x += ga.x * (ov[i].x * rs * g.x);
      xv[i].y += ga.y * (ov[i].y * rs * g.y);
      xv[i].z += ga.z * (ov[i].z * rs * g.z);
      xv[i].w += ga.w * (ov[i].w * rs * g.w);
      *(f32x4*)(p.out + grow * D + c) = xv[i];
      ss2 += xv[i].x * xv[i].x + xv[i].y * xv[i].y + xv[i].z * xv[i].z + xv[i].w * xv[i].w;
    }
    if (l == 0) {
      ss2 = wave_sum(ss2, lane);
      write_h_row(xv, ss2, p.g_pre + D, mod + ((size_t)16 + b) * 3072, H + (size_t)r * D, lane);
    }
  }
}

struct StdLoader {
  const bf16_t* base;
  int soff;
  u32x4 r0, r1;
  __device__ __forceinline__ void init(const bf16_t* tile_base, size_t ld, int tid) {
    base = tile_base + (size_t)(tid >> 1) * ld + (tid & 1) * 16;
    soff = (tid >> 1) * LDK + (tid & 1) * 16;
  }
  __device__ __forceinline__ void load(int kt) {
    const bf16_t* q = base + kt * 32;
    r0 = *(const u32x4*)q; r1 = *(const u32x4*)(q + 8);
  }
  __device__ __forceinline__ void store(bf16_t* tile) {
    bf16_t* q = tile + soff;
    *(u32x4*)q = r0; *(u32x4*)(q + 8) = r1;
  }
};

template <class AL, class BL>
__device__ __forceinline__ void gemm_core(f32x4 (&acc)[4][4], AL& al, BL& bl, int nk, bf16_t* sm, int tid) {
  const int lane = tid & 63, w = tid >> 6, wr = w >> 1, wc = w & 1, l15 = lane & 15, grp = lane >> 4;
  al.load(0); bl.load(0);
  __syncthreads();
  al.store(sm); bl.store(sm + 2 * 128 * LDK);
  __syncthreads();
  for (int kt = 0; kt < nk; ++kt) {
    const bf16_t* Ab = sm + (kt & 1) * 128 * LDK;
    const bf16_t* Bb = sm + (2 + (kt & 1)) * 128 * LDK;
    if (kt + 1 < nk) { al.load(kt + 1); bl.load(kt + 1); }
    bf16x8 a[4], b[4];
#pragma unroll
    for (int m = 0; m < 4; ++m) a[m] = *(const bf16x8*)(Ab + (wr * 64 + m * 16 + l15) * LDK + grp * 8);
#pragma unroll
    for (int n = 0; n < 4; ++n) b[n] = *(const bf16x8*)(Bb + (wc * 64 + n * 16 + l15) * LDK + grp * 8);
#pragma unroll
    for (int m = 0; m < 4; ++m)
#pragma unroll
      for (int n = 0; n < 4; ++n) acc[m][n] = mfma16(a[m], b[n], acc[m][n]);
    if (kt + 1 < nk) {
      al.store(sm + ((kt + 1) & 1) * 128 * LDK);
      bl.store(sm + (2 + ((kt + 1) & 1)) * 128 * LDK);
    }
    __syncthreads();
  }
}

struct Regs4 { u32x4 r0, r1, r2, r3; };
struct StdLoader64 {
  typedef Regs4 Regs;
  const bf16_t* base;
  size_t ld32;
  int soff;
  __device__ __forceinline__ void init(const bf16_t* tile_base, size_t ld, int tid) {
    base = tile_base + (size_t)(tid >> 3) * ld + (tid & 7) * 8;
    ld32 = ld * 32;
    soff = (tid >> 3) * 64 + (((tid & 7) ^ ((tid >> 4) & 7)) * 8);
  }
  __device__ __forceinline__ void load(int kt, Regs& r) const {
    const bf16_t* q = base + kt * 64;
    r.r0 = *(const u32x4*)q; r.r1 = *(const u32x4*)(q + ld32); r.r2 = *(const u32x4*)(q + 2 * ld32); r.r3 = *(const u32x4*)(q + 3 * ld32);
  }
  __device__ __forceinline__ void store(bf16_t* tile, const Regs& r) const {
    bf16_t* q = tile + soff;
    *(u32x4*)q = r.r0; *(u32x4*)(q + 2048) = r.r1; *(u32x4*)(q + 4096) = r.r2; *(u32x4*)(q + 6144) = r.r3;
  }
};

template <int NST, class AL, class BL>
__device__ __forceinline__ void gemm_core64(f32x4 (&acc)[4][4], const AL& al, const BL& bl, int nk, bf16_t* sm, int tid) {
  const int lane = tid & 63, w = tid >> 6, wr = w >> 1, wc = w & 1, l15 = lane & 15, grp = lane >> 4;
  constexpr int TILE = 128 * 64;
  const int sw = (l15 >> 1) & 7;
  const int fo0 = l15 * 64 + ((grp ^ sw) * 8), fo1 = l15 * 64 + (((4 + grp) ^ sw) * 8);
  typename AL::Regs ra[NST];
  typename BL::Regs rb[NST];
#pragma unroll
  for (int s_ = 0; s_ < NST; ++s_) { al.load(s_, ra[s_]); bl.load(s_, rb[s_]); }
  __syncthreads();
  al.store(sm, ra[0]); bl.store(sm + 2 * TILE, rb[0]);
  { const int k2 = NST < nk ? NST : nk - 1; al.load(k2, ra[0]); bl.load(k2, rb[0]); }
  __syncthreads();
  for (int kt0 = 0; kt0 < nk; kt0 += NST) {
#pragma unroll
    for (int u = 0; u < NST; ++u) {
      const int kt = kt0 + u;
      const bf16_t* Ab = sm + (kt & 1) * TILE + wr * 64 * 64;
      const bf16_t* Bb = sm + (2 + (kt & 1)) * TILE + wc * 64 * 64;
#pragma unroll
      for (int ks = 0; ks < 2; ++ks) {
        const int fo = ks ? fo1 : fo0;
        bf16x8 a[4], b[4];
#pragma unroll
        for (int m = 0; m < 4; ++m) a[m] = *(const bf16x8*)(Ab + m * 16 * 64 + fo);
#pragma unroll
        for (int n = 0; n < 4; ++n) b[n] = *(const bf16x8*)(Bb + n * 16 * 64 + fo);
#pragma unroll
        for (int m = 0; m < 4; ++m)
#pragma unroll
          for (int n = 0; n < 4; ++n) acc[m][n] = mfma16(b[n], a[m], acc[m][n]);
      }
      al.store(sm + ((kt + 1) & 1) * TILE, ra[(u + 1) % NST]);
      bl.store(sm + (2 + ((kt + 1) & 1)) * TILE, rb[(u + 1) % NST]);
      {
        int k2 = kt + 1 + NST;
        k2 = k2 < nk ? k2 : nk - 1;
        al.load(k2, ra[(u + 1) % NST]); bl.load(k2, rb[(u + 1) % NST]);
      }
      __syncthreads();
    }
  }
}

__device__ __forceinline__ void glds_prefetch0(const bf16_t* Atile, size_t lda, const bf16_t* Btile, size_t ldb, bf16_t* sm, int tid) {
  constexpr int TILE = 128 * 64;
  const int gch = ((tid & 7) ^ ((tid >> 4) & 7)) * 8;
  const bf16_t* ga = Atile + (size_t)(tid >> 3) * lda + gch;
  const bf16_t* gb = Btile + (size_t)(tid >> 3) * ldb + gch;
  const size_t a32 = lda * 32, b32 = ldb * 32;
  bf16_t* lbase = sm + tid * 8;
#pragma unroll
  for (int i_ = 0; i_ < 4; ++i_) {
    __builtin_amdgcn_global_load_lds((const unsigned*)(ga + i_ * a32), (unsigned*)(lbase + i_ * 2048), 16, 0, 0);
    __builtin_amdgcn_global_load_lds((const unsigned*)(gb + i_ * b32), (unsigned*)(lbase + 2 * TILE + i_ * 2048), 16, 0, 0);
  }
}

#define DSR1(dst, base, OFF) asm volatile("ds_read_b128 %0, %1 offset:" #OFF : "=v"(dst) : "v"(base) : "memory")
#define DSR4(arr, base) do { DSR1(arr[0], base, 0); DSR1(arr[1], base, 2048); DSR1(arr[2], base, 4096); DSR1(arr[3], base, 6144); } while (0)
template <bool HOIST>
__device__ __forceinline__ void gemm_core_glds(f32x4 (&acc)[4][4], const bf16_t* Atile, size_t lda, const bf16_t* Btile, size_t ldb,
                                               int nk, bf16_t* sm, int tid) {
  const int lane = tid & 63, w = tid >> 6, wr = w >> 1, wc = w & 1, l15 = lane & 15, grp = lane >> 4;
  constexpr int TILE = 128 * 64;
  const int sw = (l15 >> 1) & 7;
  const int fo0 = l15 * 64 + ((grp ^ sw) * 8), fo1 = l15 * 64 + (((4 + grp) ^ sw) * 8);
  const int gch = ((tid & 7) ^ ((tid >> 4) & 7)) * 8;
  const bf16_t* ga = Atile + (size_t)(tid >> 3) * lda + gch;
  const bf16_t* gb = Btile + (size_t)(tid >> 3) * ldb + gch;
  const size_t a32 = lda * 32, b32 = ldb * 32;
  bf16_t* lbase = sm + tid * 8;
#define GLDS_ISSUE(KT, BUF)                                                                                                            \
  do {                                                                                                                                 \
    _Pragma("unroll") for (int i_ = 0; i_ < 4; ++i_) {                                                                                 \
      __builtin_amdgcn_global_load_lds((const unsigned*)(ga + i_ * a32 + (KT) * 64), (unsigned*)(lbase + (BUF) * TILE + i_ * 2048), 16, 0, 0);       \
      __builtin_amdgcn_global_load_lds((const unsigned*)(gb + i_ * b32 + (KT) * 64), (unsigned*)(lbase + (2 + (BUF)) * TILE + i_ * 2048), 16, 0, 0); \
    }                                                                                                                                  \
  } while (0)
#define GLDS_COMPUTE(BUF)                                                                             \
  do {                                                                                                \
    const bf16_t* Ab = sm + (BUF) * TILE + wr * 64 * 64;                                              \
    const bf16_t* Bb = sm + (2 + (BUF)) * TILE + wc * 64 * 64;                                        \
    if (HOIST) {                                                                                      \
        \
      bf16x8 a0[4], b0[4], a1[4], b1[4];                                                              \
      const unsigned pa0 = (unsigned)(size_t)(Ab + fo0), pb0 = (unsigned)(size_t)(Bb + fo0);          \
      const unsigned pa1 = (unsigned)(size_t)(Ab + fo1), pb1 = (unsigned)(size_t)(Bb + fo1);          \
      DSR4(a0, pa0); DSR4(b0, pb0); DSR4(a1, pa1); DSR4(b1, pb1);                                     \
      asm volatile("s_waitcnt lgkmcnt(8)" : "+v"(a0[0]), "+v"(a0[1]), "+v"(a0[2]), "+v"(a0[3]), "+v"(b0[0]), "+v"(b0[1]), "+v"(b0[2]), "+v"(b0[3]) :: "memory"); \
      _Pragma("unroll") for (int m = 0; m < 4; ++m)                                                   \
        _Pragma("unroll") for (int n = 0; n < 4; ++n) acc[m][n] = mfma16(b0[n], a0[m], acc[m][n]);    \
      __builtin_amdgcn_sched_barrier(0);             \
      asm volatile("s_waitcnt lgkmcnt(0)" : "+v"(a1[0]), "+v"(a1[1]), "+v"(a1[2]), "+v"(a1[3]), "+v"(b1[0]), "+v"(b1[1]), "+v"(b1[2]), "+v"(b1[3]) :: "memory"); \
      _Pragma("unroll") for (int m = 0; m < 4; ++m)                                                   \
        _Pragma("unroll") for (int n = 0; n < 4; ++n) acc[m][n] = mfma16(b1[n], a1[m], acc[m][n]);    \
      __builtin_amdgcn_sched_barrier(0);             \
    } else {                                                                                          \
      _Pragma("unroll") for (int ks = 0; ks < 2; ++ks) {                                              \
        const int fo = ks ? fo1 : fo0;                                                                \
        bf16x8 a[4], b[4];                                                                            \
        _Pragma("unroll") for (int m = 0; m < 4; ++m) a[m] = *(const bf16x8*)(Ab + m * 16 * 64 + fo); \
        _Pragma("unroll") for (int n = 0; n < 4; ++n) b[n] = *(const bf16x8*)(Bb + n * 16 * 64 + fo); \
        _Pragma("unroll") for (int m = 0; m < 4; ++m)                                                 \
          _Pragma("unroll") for (int n = 0; n < 4; ++n) acc[m][n] = mfma16(b[n], a[m], acc[m][n]);     \
      }                                                                                               \
    }                                                                                                 \
  } while (0)
  asm volatile("s_waitcnt vmcnt(0)" ::: "memory");
  __syncthreads();
  for (int kt = 0; kt < nk; kt += 2) {
    GLDS_ISSUE(kt + 1, 1);
    GLDS_COMPUTE(0);
    asm volatile("s_waitcnt vmcnt(0)" ::: "memory");
    __syncthreads();
    if (kt + 2 < nk) GLDS_ISSUE(kt + 2, 0);
    GLDS_COMPUTE(1);
    asm volatile("s_waitcnt vmcnt(0)" ::: "memory");
    __syncthreads();
  }
#undef GLDS_ISSUE
#undef GLDS_COMPUTE
}

__device__ __forceinline__ void gemm_core_glds_cmp(f32x4 (&acc)[4][4], const bf16_t* colptr, int r0, const bf16_t* Btile, size_t ldb,
                                                   int nk, bf16_t* sm, int tid) {
  const int lane = tid & 63, w = tid >> 6, wr = w >> 1, wc = w & 1, l15 = lane & 15, grp = lane >> 4;
  constexpr int TILE = 128 * 64;
  const int sw = (l15 >> 1) & 7;
  const int fo0 = l15 * 64 + ((grp ^ sw) * 8), fo1 = l15 * 64 + (((4 + grp) ^ sw) * 8);
  const int gch = ((tid & 7) ^ ((tid >> 4) & 7)) * 8;
  const bf16_t* gb = Btile + (size_t)(tid >> 3) * ldb + gch;
  const size_t b32 = ldb * 32;
  bf16_t* lbase = sm + tid * 8;
#define CMP_ISSUE(KT, BUF)                                                                                                             \
  do {                                                                                                                                 \
    _Pragma("unroll") for (int i_ = 0; i_ < 4; ++i_) {                                                                                 \
      int tok_ = 16 * (r0 + 32 * i_) + (KT);                                                                                           \
      tok_ = tok_ > (SEQ - 1) ? (SEQ - 1) : tok_;                                                                                      \
      __builtin_amdgcn_global_load_lds((const unsigned*)(colptr + (size_t)tok_ * 1536), (unsigned*)(lbase + (BUF) * TILE + i_ * 2048), 16, 0, 0);     \
      __builtin_amdgcn_global_load_lds((const unsigned*)(gb + i_ * b32 + (KT) * 64), (unsigned*)(lbase + (2 + (BUF)) * TILE + i_ * 2048), 16, 0, 0); \
    }                                                                                                                                  \
  } while (0)
#define CMP_COMPUTE(BUF)                                                                              \
  do {                                                                                                \
    const bf16_t* Ab = sm + (BUF) * TILE + wr * 64 * 64;                                              \
    const bf16_t* Bb = sm + (2 + (BUF)) * TILE + wc * 64 * 64;                                        \
    _Pragma("unroll") for (int ks = 0; ks < 2; ++ks) {                                                \
      const int fo = ks ? fo1 : fo0;                                                                  \
      bf16x8 a[4], b[4];                                                                              \
      _Pragma("unroll") for (int m = 0; m < 4; ++m) a[m] = *(const bf16x8*)(Ab + m * 16 * 64 + fo);   \
      _Pragma("unroll") for (int n = 0; n < 4; ++n) b[n] = *(const bf16x8*)(Bb + n * 16 * 64 + fo);   \
      _Pragma("unroll") for (int m = 0; m < 4; ++m)                                                   \
        _Pragma("unroll") for (int n = 0; n < 4; ++n) acc[m][n] = mfma16(b[n], a[m], acc[m][n]);     \
    }                                                                                                 \
  } while (0)
  __syncthreads();
  CMP_ISSUE(0, 0);
  asm volatile("s_waitcnt vmcnt(0)" ::: "memory");
  __syncthreads();
  for (int kt = 0; kt < nk; kt += 2) {
    CMP_ISSUE(kt + 1, 1);
    CMP_COMPUTE(0);
    asm volatile("s_waitcnt vmcnt(0)" ::: "memory");
    __syncthreads();
    if (kt + 2 < nk) CMP_ISSUE(kt + 2, 0);
    CMP_COMPUTE(1);
    asm volatile("s_waitcnt vmcnt(0)" ::: "memory");
    __syncthreads();
  }
#undef CMP_ISSUE
#undef CMP_COMPUTE
}

__device__ __forceinline__ void zero_acc(f32x4 (&acc)[4][4]) {
#pragma unroll
  for (int m = 0; m < 4; ++m)
#pragma unroll
    for (int n = 0; n < 4; ++n) acc[m][n] = f32x4{0.f, 0.f, 0.f, 0.f};
}

__device__ __forceinline__ void phase_inproj(const Params& p, int l, char* smraw) {
  bf16_t* sm = (bf16_t*)smraw;
  const bf16_t* H = (const bf16_t*)(p.ws + OFF_H);
  const bf16_t* W = (const bf16_t*)(p.ws + OFF_WINT) + (size_t)l * NP * D;
  bf16_t* yApre = (bf16_t*)(p.ws + OFF_YAPRE);
  bf16_t* bzA = (bf16_t*)(p.ws + OFF_BZA);
  bf16_t* qb = (bf16_t*)(p.ws + OFF_Q);
  bf16_t* zb = (bf16_t*)(p.ws + OFF_ZB);
  bf16_t* uz = (bf16_t*)(p.ws + OFF_UZ);
  bf16_t* gv = (bf16_t*)(p.ws + OFF_GV);
  bf16_t* kvb = (bf16_t*)(p.ws + OFF_KV);
  float* glb = (float*)(p.ws + OFF_GL);
  bf16_t* gates = (bf16_t*)(p.ws + OFF_GATES);
  const int tid = opaque_tid(); const int lane = tid & 63, w = tid >> 6, wr = w >> 1, wc = w & 1, l15 = lane & 15, grp = lane >> 4;
  constexpr int MT = R / 128;
  constexpr int NC = (NT_IN + 7) / 8;
  const int nx = gridDim.x >> 3;
  constexpr int CJ_END = (MT / 8) * NC * 64;
  auto cj_valid = [&](int c) { return c < CJ_END && ((c >> 6) % NC) * 8 + ((c & 63) >> 3) < NT_IN; };
  auto cj_next = [&](int c) {
    do { c = ((c & 63) + nx < 64) ? (c + nx) : (((c >> 6) + 8) * 64 + (int)(blockIdx.x >> 3)); } while (c < CJ_END && !cj_valid(c));
    return c;
  };
  int cj = (blockIdx.x & 7) * 64 + (blockIdx.x >> 3);
  if (!cj_valid(cj)) cj = cj_next(cj);
  __syncthreads();
  if (cj < CJ_END) {
    const int cell = cj >> 6, jj = cj & 63;
    glds_prefetch0(H + (size_t)((cell / NC) * 8 + (jj & 7)) * 128 * D, D, W + (size_t)((cell % NC) * 8 + (jj >> 3)) * 128 * D, D, sm, tid);
  }
  while (cj < CJ_END) {
    const int cell = cj >> 6, jj = cj & 63;
    const int nt = (cell % NC) * 8 + (jj >> 3), mt = (cell / NC) * 8 + (jj & 7);
    f32x4 acc[4][4];
    zero_acc(acc);
    gemm_core_glds<true>(acc, H + (size_t)mt * 128 * D, D, W + (size_t)nt * 128 * D, D, D / 64, sm, tid);
    cj = cj_next(cj);
    if (cj < CJ_END) {
      const int cell2 = cj >> 6, jj2 = cj & 63;
      glds_prefetch0(H + (size_t)((cell2 / NC) * 8 + (jj2 & 7)) * 128 * D, D, W + (size_t)((cell2 % NC) * 8 + (jj2 >> 3)) * 128 * D, D, sm, tid);
    }
    const int rbase = mt * 128 + wr * 64 + l15;
    const int c4 = 4 * grp;
#define ST4(PTR, V0, V1, V2, V3) *(u32x2*)(PTR) = u32x2{pack2((V0), (V1)), pack2((V2), (V3))}
    if (nt < 32) {
      const int ch = nt * 32 + wc * 16 + c4;
#pragma unroll
      for (int m = 0; m < 4; ++m) {
        const size_t row = rbase + m * 16;
        ST4(yApre + row * 1024 + ch, acc[m][1][0] * acc[m][2][0], acc[m][1][1] * acc[m][2][1], acc[m][1][2] * acc[m][2][2], acc[m][1][3] * acc[m][2][3]);
        ST4(bzA + row * 1024 + ch, acc[m][0][0] * silu_(acc[m][3][0]), acc[m][0][1] * silu_(acc[m][3][1]), acc[m][0][2] * silu_(acc[m][3][2]), acc[m][0][3] * silu_(acc[m][3][3]));
      }
    } else if (nt < 40) {
      const int cb = (nt - 32) * 128 + wc * 64 + c4;
      const float qs = 0.125f * 1.44269504f;
#pragma unroll
      for (int m = 0; m < 4; ++m)
#pragma unroll
        for (int n = 0; n < 4; ++n)
          ST4(qb + (size_t)(rbase + m * 16) * 1024 + cb + n * 16, acc[m][n][0] * qs, acc[m][n][1] * qs, acc[m][n][2] * qs, acc[m][n][3] * qs);
    } else if (nt < 52) {
      const int cb = (nt - 40) * 128 + wc * 64 + c4;
#pragma unroll
      for (int m = 0; m < 4; ++m)
#pragma unroll
        for (int n = 0; n < 4; ++n)
          ST4(kvb + (size_t)(rbase + m * 16) * 1536 + cb + n * 16, acc[m][n][0], acc[m][n][1], acc[m][n][2], acc[m][n][3]);
    } else if (nt < 60) {
      const int cb = (nt - 52) * 128 + wc * 64 + c4;
#pragma unroll
      for (int m = 0; m < 4; ++m)
#pragma unroll
        for (int n = 0; n < 4; ++n)
          ST4(zb + (size_t)(rbase + m * 16) * 1024 + cb + n * 16, silu_(acc[m][n][0]), silu_(acc[m][n][1]), silu_(acc[m][n][2]), silu_(acc[m][n][3]));
    } else if (nt == 60) {
      if (wc == 0) {
#pragma unroll
        for (int m = 0; m < 4; ++m)
#pragma unroll
          for (int n = 0; n < 3; ++n)
            *(f32x4*)(glb + (size_t)(rbase + m * 16) * 48 + n * 16 + c4) =
                f32x4{sigmoid_(acc[m][n][0]), sigmoid_(acc[m][n][1]), sigmoid_(acc[m][n][2]), sigmoid_(acc[m][n][3])};
      }
    } else if (nt < 77) {
      const int chb = (nt - 61) * 64 + wc * 32 + c4;
#pragma unroll
      for (int m = 0; m < 4; ++m)
#pragma unroll
        for (int pr = 0; pr < 2; ++pr)
          ST4(uz + (size_t)(rbase + m * 16) * 1024 + chb + pr * 16,
              gelu_(acc[m][2 * pr][0]) * silu_(acc[m][2 * pr + 1][0]), gelu_(acc[m][2 * pr][1]) * silu_(acc[m][2 * pr + 1][1]),
              gelu_(acc[m][2 * pr][2]) * silu_(acc[m][2 * pr + 1][2]), gelu_(acc[m][2 * pr][3]) * silu_(acc[m][2 * pr + 1][3]));
    } else if (nt < 85) {
      const int cb = (nt - 77) * 128 + wc * 64 + c4;
#pragma unroll
      for (int m = 0; m < 4; ++m)
#pragma unroll
        for (int n = 0; n < 4; ++n)
          ST4(gv + (size_t)(rbase + m * 16) * 1024 + cb + n * 16, gelu_(acc[m][n][0]), gelu_(acc[m][n][1]), gelu_(acc[m][n][2]), gelu_(acc[m][n][3]));
    } else {
      const int cb = (nt - 85) * 128 + wc * 64 + c4;
#pragma unroll
      for (int m = 0; m < 4; ++m)
#pragma unroll
        for (int n = 0; n < 4; ++n)
          ST4(gates + (size_t)(rbase + m * 16) * 3072 + cb + n * 16, sigmoid_(acc[m][n][0]), sigmoid_(acc[m][n][1]), sigmoid_(acc[m][n][2]), sigmoid_(acc[m][n][3]));
    }
#undef ST4
  }
}

struct CmpALoader {
  const bf16_t* rowptr;
  int r, soff;
  u32x4 r0, r1;
  __device__ __forceinline__ void load(int kt) {
    int tok = 16 * r + (kt >> 1);
    tok = tok > (SEQ - 1) ? (SEQ - 1) : tok;
    const bf16_t* q = rowptr + (size_t)tok * 1536 + (kt & 1) * 32;
    r0 = *(const u32x4*)q; r1 = *(const u32x4*)(q + 8);
  }
  __device__ __forceinline__ void store(bf16_t* tile) {
    bf16_t* q = tile + soff;
    *(u32x4*)q = r0; *(u32x4*)(q + 8) = r1;
  }
};

__device__ __forceinline__ void phase_mix1(const Params& p, int l, char* smraw) {
  const int tid = opaque_tid(); const int lane = tid & 63, w = tid >> 6, l15 = lane & 15, grp = lane >> 4;
  const bf16_t* gv = (const bf16_t*)(p.ws + OFF_GV);
  float* stats = (float*)(p.ws + OFF_STATS);
  constexpr int NCB = 2 * (NB * 4 * 256 / 128);
  const bool split = (int)gridDim.x >= 2 * NCB;
  const int eb = split ? (int)blockIdx.x - NCB : (int)blockIdx.x;
  const int neb = split ? (int)gridDim.x - NCB : (int)gridDim.x;
  for (int r = eb * 4 + w; eb >= 0 && r < R; r += neb * 4) {
    const bf16_t* row = gv + (size_t)r * 1024;
    float v[16]; float s = 0.f;
#pragma unroll
    for (int i = 0; i < 2; ++i) {
      u32x4 u = *(const u32x4*)(row + i * 512 + lane * 8);
      v[i * 8 + 0] = bf2f(u.x & 0xffffu); v[i * 8 + 1] = bf2f(u.x >> 16);
      v[i * 8 + 2] = bf2f(u.y & 0xffffu); v[i * 8 + 3] = bf2f(u.y >> 16);
      v[i * 8 + 4] = bf2f(u.z & 0xffffu); v[i * 8 + 5] = bf2f(u.z >> 16);
      v[i * 8 + 6] = bf2f(u.w & 0xffffu); v[i * 8 + 7] = bf2f(u.w >> 16);
    }
#pragma unroll
    for (int i = 0; i < 16; ++i) s += v[i];
    s = wave_sum(s, lane);
    float mu = s * (1.f / 1024.f);
    float q = 0.f;
#pragma unroll
    for (int i = 0; i < 16; ++i) { float d = v[i] - mu; q += d * d; }
    q = wave_sum(q, lane);
    if (lane == 0) { stats[r * 2] = mu; stats[r * 2 + 1] = rsqrtf(q * (1.f / 1024.f) + 1e-6f); }
  }
  {
    const bf16_t* yApre = (const bf16_t*)(p.ws + OFF_YAPRE);
    const bf16_t* bzA = (const bf16_t*)(p.ws + OFF_BZA);
    bf16_t* yA = (bf16_t*)(p.ws + OFF_YA);
    const float* cw = p.conv_w + (size_t)l * 3 * 1024;
    const float* cb = p.conv_b + (size_t)l * 1024;
    for (int e = eb * 256 + tid; eb >= 0 && e < R * 128; e += neb * 256) {
      int row = e >> 7, c8 = (e & 127) * 8;
      int t = row & (SEQ - 1);
      u32x4 y2 = *(const u32x4*)(yApre + (size_t)row * 1024 + c8);
      u32x4 y1 = (t >= 1) ? *(const u32x4*)(yApre + (size_t)(row - 1) * 1024 + c8) : u32x4{0, 0, 0, 0};
      u32x4 y0 = (t >= 2) ? *(const u32x4*)(yApre + (size_t)(row - 2) * 1024 + c8) : u32x4{0, 0, 0, 0};
      u32x4 bz = *(const u32x4*)(bzA + (size_t)row * 1024 + c8);
      u32x4 o;
#pragma unroll
      for (int i = 0; i < 4; ++i) {
        int c = c8 + i * 2;
        float r0 = cb[c] + cw[c] * bf2f(y0[i] & 0xffffu) + cw[1024 + c] * bf2f(y1[i] & 0xffffu) + cw[2048 + c] * bf2f(y2[i] & 0xffffu);
        float r1 = cb[c + 1] + cw[c + 1] * bf2f(y0[i] >> 16) + cw[1024 + c + 1] * bf2f(y1[i] >> 16) + cw[2048 + c + 1] * bf2f(y2[i] >> 16);
        o[i] = pack2(bf2f(bz[i] & 0xffffu) * r0, bf2f(bz[i] >> 16) * r1);
      }
      *(u32x4*)(yA + (size_t)row * 1024 + c8) = o;
    }
  }
  {
    bf16_t* sm = (bf16_t*)smraw;
    const bf16_t* kvb = (const bf16_t*)(p.ws + OFF_KV);
    const bf16_t* Wc1T = (const bf16_t*)(p.ws + OFF_WC1T);
    const float* bias1 = (const float*)(p.ws + OFF_BIAS1);
    const int wr = w >> 1, wc = w & 1;
    constexpr int MTC = NB * 4 * 256 / 128;
    for (int t = blockIdx.x; t < 2 * MTC; t += gridDim.x) {
      int kv = t / MTC, mt = t % MTC;
      f32x4 acc[4][4];
      zero_acc(acc);
      {
        const int rr = mt * 128 + (tid >> 3);
        const int bl = rr >> 10, g = (rr >> 8) & 3;
        const int gch = ((tid & 7) ^ ((tid >> 4) & 7)) * 8;
        gemm_core_glds_cmp(acc, kvb + (size_t)bl * SEQ * 1536 + kv * 256 + g * 64 + gch, rr & 255,
                           Wc1T + (size_t)(l * 2 + kv) * 128 * 2048, 2048, 2048 / 64, sm, tid);
      }
      bf16_t* Hs = sm;
      bf16_t* W2s = sm + 128 * HS_LD;
      const float* b1 = bias1 + (l * 2 + kv) * 8 * 128;
#pragma unroll
      for (int n = 0; n < 4; ++n) {
        const int col = wc * 64 + n * 16 + 4 * grp;
        f32x4 bb = f32x4{0.f, 0.f, 0.f, 0.f};
#pragma unroll
        for (int ks = 0; ks < 8; ++ks) bb += *(const f32x4*)(b1 + ks * 128 + col);
#pragma unroll
        for (int m = 0; m < 4; ++m)
          *(u32x2*)(Hs + (wr * 64 + m * 16 + l15) * HS_LD + col) =
              u32x2{pack2(silu_(acc[m][n][0] + bb[0]), silu_(acc[m][n][1] + bb[1])), pack2(silu_(acc[m][n][2] + bb[2]), silu_(acc[m][n][3] + bb[3]))};
      }
      const float* w2 = (kv ? p.w_cv2 : p.w_ck2) + (size_t)l * 128 * 64;
      for (int i = 0; i < 32; ++i) {
        int e = tid + 256 * i;
        int j = e >> 6, d = e & 63;
        W2s[d * HS_LD + j] = f2bf(w2[e]);
      }
      __syncthreads();
      f32x4 a2[2][4];
#pragma unroll
      for (int mm = 0; mm < 2; ++mm)
#pragma unroll
        for (int nn = 0; nn < 4; ++nn) a2[mm][nn] = f32x4{0.f, 0.f, 0.f, 0.f};
#pragma unroll
      for (int ks = 0; ks < 4; ++ks) {
        bf16x8 af[2], bfr[4];
#pragma unroll
        for (int mm = 0; mm < 2; ++mm) af[mm] = *(const bf16x8*)(Hs + (w * 32 + mm * 16 + l15) * HS_LD + ks * 32 + grp * 8);
#pragma unroll
        for (int nn = 0; nn < 4; ++nn) bfr[nn] = *(const bf16x8*)(W2s + (nn * 16 + l15) * HS_LD + ks * 32 + grp * 8);
#pragma unroll
        for (int mm = 0; mm < 2; ++mm)
#pragma unroll
          for (int nn = 0; nn < 4; ++nn) a2[mm][nn] = mfma16(af[mm], bfr[nn], a2[mm][nn]);
      }
      bf16_t* outp = (bf16_t*)(p.ws + (kv ? OFF_VCMP : OFF_KCMP));
#pragma unroll
      for (int mm = 0; mm < 2; ++mm)
#pragma unroll
        for (int nn = 0; nn < 4; ++nn)
#pragma unroll
          for (int j = 0; j < 4; ++j) {
            int row = mt * 128 + w * 32 + mm * 16 + 4 * grp + j;
            outp[(size_t)row * 64 + nn * 16 + l15] = f2bf(a2[mm][nn][j]);
          }
      __syncthreads();
    }
  }
}

struct KVRegs { u32x4 k0, k1, v0, v1; };

__device__ __forceinline__ void kv_issue(KVRegs& r, const bf16_t* kbase, const bf16_t* vbase, size_t ld, bool wantV, int tid) {
  const uint32_t row = (uint32_t)tid >> 3, c = ((uint32_t)tid & 7u) * 8u;
  const uint32_t ldu = (ld == 64 ? 64u : 1536u);
  const uint32_t off = row * ldu + c;
  const bf16_t* kp = kbase + off;
  r.k0 = *(const u32x4*)kp; r.k1 = *(const u32x4*)(kp + 32u * ldu);
  if (wantV) {
    const bf16_t* vp = vbase + off;
    r.v0 = *(const u32x4*)vp; r.v1 = *(const u32x4*)(vp + 32u * ldu);
  }
}
__device__ __forceinline__ void kv_commit(const KVRegs& r, bf16_t* Ks, bf16_t* Vs, bool wantV, int tid) {
  int row = tid >> 3, c = (tid & 7) * 8;
  *(u32x4*)(Ks + row * KS_LD + c) = r.k0;
  *(u32x4*)(Ks + (row + 32) * KS_LD + c) = r.k1;
  if (wantV) {
    *(u32x4*)(Vs + row * KS_LD + c) = r.v0;
    *(u32x4*)(Vs + (row + 32) * KS_LD + c) = r.v1;
  }
}

typedef short s16x4 __attribute__((ext_vector_type(4)));
__device__ __forceinline__ s16x4 tr_read(const bf16_t* ptr) {
  return __builtin_amdgcn_ds_read_tr16_b64_v4i16((s16x4 __attribute__((address_space(3)))*)ptr);
}

#define ADSR(dst, base, OFF) asm volatile("ds_read_b128 %0, %1 offset:" #OFF : "=v"(dst) : "v"(base) : "memory")
#define ATRR(dst, base, OFF) asm volatile("ds_read_b64_tr_b16 %0, %1 offset:" #OFF : "=v"(dst) : "v"(base) : "memory")
template <bool MASKED>
__device__ __forceinline__ void attn_block64(const bf16_t* Ks, const bf16_t* Vs, bf16x8 q0, bf16x8 q1, int tq, int kp0, int kpstride,
                                             int maxdist, bool extra_ok, float slope, float& m, float& lsum, f32x4 (&o)[4], int l15, int grp,
                                             const f32x4 (&tb)[4]) {
  const float fst = (float)kpstride;
  const int d0 = tq - kp0 - 4 * grp * kpstride;
  const float base = -slope * (float)d0;
  const unsigned kaddr = (unsigned)(size_t)(Ks + l15 * KS_LD + grp * 8);
  const unsigned vaddr = (unsigned)(size_t)(Vs + (4 * grp + (l15 >> 2)) * KS_LD + 4 * (l15 & 3));
  bf16x8 kf[8];
  ADSR(kf[0], kaddr, 0);    ADSR(kf[1], kaddr, 64);   ADSR(kf[2], kaddr, 2560); ADSR(kf[3], kaddr, 2624);
  ADSR(kf[4], kaddr, 5120); ADSR(kf[5], kaddr, 5184); ADSR(kf[6], kaddr, 7680); ADSR(kf[7], kaddr, 7744);
  f32x4 s[4];
  asm volatile("s_waitcnt lgkmcnt(6)" : "+v"(kf[0]), "+v"(kf[1]) :: "memory");
  s[0] = mfma16(kf[1], q1, mfma16(kf[0], q0, f32x4{0.f, 0.f, 0.f, 0.f}));
  asm volatile("s_waitcnt lgkmcnt(4)" : "+v"(kf[2]), "+v"(kf[3]) :: "memory");
  s[1] = mfma16(kf[3], q1, mfma16(kf[2], q0, f32x4{0.f, 0.f, 0.f, 0.f}));
  asm volatile("s_waitcnt lgkmcnt(2)" : "+v"(kf[4]), "+v"(kf[5]) :: "memory");
  s[2] = mfma16(kf[5], q1, mfma16(kf[4], q0, f32x4{0.f, 0.f, 0.f, 0.f}));
  asm volatile("s_waitcnt lgkmcnt(0)" : "+v"(kf[6]), "+v"(kf[7]) :: "memory");
  s[3] = mfma16(kf[7], q1, mfma16(kf[6], q0, f32x4{0.f, 0.f, 0.f, 0.f}));
  s16x4 vt[16];
  ATRR(vt[0], vaddr, 0);     ATRR(vt[1], vaddr, 2560);  ATRR(vt[2], vaddr, 32);    ATRR(vt[3], vaddr, 2592);
  ATRR(vt[4], vaddr, 64);    ATRR(vt[5], vaddr, 2624);  ATRR(vt[6], vaddr, 96);    ATRR(vt[7], vaddr, 2656);
  ATRR(vt[8], vaddr, 5120);  ATRR(vt[9], vaddr, 7680);  ATRR(vt[10], vaddr, 5152); ATRR(vt[11], vaddr, 7712);
  ATRR(vt[12], vaddr, 5184); ATRR(vt[13], vaddr, 7744); ATRR(vt[14], vaddr, 5216); ATRR(vt[15], vaddr, 7776);
  float cmax = -1e30f;
#pragma unroll
  for (int t = 0; t < 4; ++t)
#pragma unroll
    for (int j = 0; j < 4; ++j) {
      const int ci = t * 16 + j;
      float v = __builtin_fmaf(tb[t][j], fst, s[t][j]);
      if (MASKED) {
        const int dist = d0 - ci * kpstride;
        const bool valid = extra_ok && dist >= 0 && dist < maxdist;
        v = valid ? v : -1e30f;
      }
      s[t][j] = v;
      cmax = fmaxf(cmax, v);
    }
  if (!MASKED) cmax = extra_ok ? cmax : -1e30f;
  if (__ballot(cmax + base > m + 40.f) != 0ull) {
    cmax = (cmax > -1e29f) ? cmax + base : -1e30f;
    cmax = fmaxf(cmax, bperm(cmax, (l15 + 16 * grp) ^ 16));
    cmax = fmaxf(cmax, bperm(cmax, (l15 + 16 * grp) ^ 32));
    const float mnew = fmaxf(m, cmax);
    const float alpha = __builtin_amdgcn_exp2f(m - mnew);
    lsum *= alpha;
#pragma unroll
    for (int dt = 0; dt < 4; ++dt) o[dt] *= alpha;
    m = mnew;
  }
  float psum = 0.f;
  const float mb = m - base;
#pragma unroll
  for (int t = 0; t < 4; ++t)
#pragma unroll
    for (int j = 0; j < 4; ++j) {
      const float v = s[t][j];
      float pe = __builtin_amdgcn_exp2f(v - mb);
      if (MASKED) pe = (v > -1e29f) ? pe : 0.f;
      s[t][j] = pe;
      psum += pe;
    }
  if (!MASKED) psum = extra_ok ? psum : 0.f;
  lsum += psum;
  const uint32_t rowm = (MASKED || extra_ok) ? 0xffffffffu : 0u;
  asm volatile("s_waitcnt lgkmcnt(0)"
               : "+v"(vt[0]), "+v"(vt[1]), "+v"(vt[2]), "+v"(vt[3]), "+v"(vt[4]), "+v"(vt[5]), "+v"(vt[6]), "+v"(vt[7]),
                 "+v"(vt[8]), "+v"(vt[9]), "+v"(vt[10]), "+v"(vt[11]), "+v"(vt[12]), "+v"(vt[13]), "+v"(vt[14]), "+v"(vt[15])
               :: "memory");
#pragma unroll
  for (int sc = 0; sc < 2; ++sc) {
    const bf16x8 pb = __builtin_bit_cast(bf16x8, u32x4{pack2(s[2 * sc][0], s[2 * sc][1]) & rowm, pack2(s[2 * sc][2], s[2 * sc][3]) & rowm,
                                                       pack2(s[2 * sc + 1][0], s[2 * sc + 1][1]) & rowm, pack2(s[2 * sc + 1][2], s[2 * sc + 1][3]) & rowm});
#pragma unroll
    for (int dt = 0; dt < 4; ++dt) {
      const s16x4 vlo = vt[sc * 8 + dt * 2], vhi = vt[sc * 8 + dt * 2 + 1];
      const bf16x8 vf = {vlo[0], vlo[1], vlo[2], vlo[3], vhi[0], vhi[1], vhi[2], vhi[3]};
      o[dt] = mfma16(vf, pb, o[dt]);
    }
  }
}

constexpr int ATT_TILE = 64 * KS_LD * 2;
constexpr int ATT_BUF = 2 * ATT_TILE;

template <class DescF, class ProcF>
__device__ __forceinline__ void kv_stream(int n, DescF desc, ProcF proc, char* smraw, int tid) {
  if (n <= 0) return;
  KVRegs r0, r1;
  const bf16_t *kp, *vp; size_t ld;
  desc(0, kp, vp, ld); kv_issue(r0, kp, vp, ld, true, tid);
  desc(1 < n ? 1 : n - 1, kp, vp, ld); kv_issue(r1, kp, vp, ld, true, tid);
  __syncthreads();
  kv_commit(r0, (bf16_t*)smraw, (bf16_t*)(smraw + ATT_TILE), true, tid);
  desc(2 < n ? 2 : n - 1, kp, vp, ld); kv_issue(r0, kp, vp, ld, true, tid);
  __syncthreads();
  for (int e0 = 0; e0 < n; e0 += 2) {
    {
      const int e = e0;
      proc(e, (const bf16_t*)smraw, (const bf16_t*)(smraw + ATT_TILE));
      kv_commit(r1, (bf16_t*)(smraw + ATT_BUF), (bf16_t*)(smraw + ATT_BUF + ATT_TILE), true, tid);
      desc(e + 3 < n ? e + 3 : n - 1, kp, vp, ld); kv_issue(r1, kp, vp, ld, true, tid);
      __syncthreads();
    }
    {
      const int e = e0 + 1;
      if (e < n) proc(e, (const bf16_t*)(smraw + ATT_BUF), (const bf16_t*)(smraw + ATT_BUF + ATT_TILE));
      kv_commit(r0, (bf16_t*)smraw, (bf16_t*)(smraw + ATT_TILE), true, tid);
      desc(e + 3 < n ? e + 3 : n - 1, kp, vp, ld); kv_issue(r0, kp, vp, ld, true, tid);
      __syncthreads();
    }
  }
}

__device__ __forceinline__ void attn_unit(const Params& p, char* smraw, int bl, int g, int qb) {
  float* impbuf = (float*)(smraw + 2 * ATT_BUF);
  unsigned long long* selmask = (unsigned long long*)(smraw + 2 * ATT_BUF + 16640);
  int* sellist = (int*)(smraw + 2 * ATT_BUF + 16640 + 128);
  const bf16_t* qbuf = (const bf16_t*)(p.ws + OFF_Q);
  const bf16_t* zbuf = (const bf16_t*)(p.ws + OFF_ZB);
  const bf16_t* kvb = (const bf16_t*)(p.ws + OFF_KV);
  const float* glb = (const float*)(p.ws + OFF_GL);
  bf16_t* yB = (bf16_t*)(p.ws + OFF_YB);
  const int tid = opaque_tid(); const int lane = tid & 63, n = tid >> 6, l15 = lane & 15, grp = lane >> 4;
  const int h = g * 4 + n, t0 = qb * 16, tq = t0 + l15;
  const float slope = exp2f(-0.5f * (float)(h + 1)) * 1.44269504f;
  f32x4 tb[4];
#pragma unroll
  for (int t = 0; t < 4; ++t) tb[t] = f32x4{slope * (float)(16 * t), slope * (float)(16 * t + 1), slope * (float)(16 * t + 2), slope * (float)(16 * t + 3)};
  const size_t rowq = (size_t)bl * SEQ + tq;
  bf16x8 q0, q1;
  {
    const bf16_t* qp = qbuf + rowq * 1024 + h * 64 + grp * 8;
    q0 = *(const bf16x8*)qp; q1 = *(const bf16x8*)(qp + 32);
  }
  const float g0 = glb[rowq * 48 + h * 3 + 0], g1 = glb[rowq * 48 + h * 3 + 1], g2 = glb[rowq * 48 + h * 3 + 2];
  f32x4 otot[4];
#pragma unroll
  for (int dt = 0; dt < 4; ++dt) otot[dt] = f32x4{0.f, 0.f, 0.f, 0.f};
  const size_t seqbase = (size_t)bl * SEQ * 1536 + g * 64;
  const int BIG = 1 << 30;
  const bf16_t* kcb = (const bf16_t*)(p.ws + OFF_KCMP) + (size_t)(bl * 4 + g) * 256 * 64;
  const bf16_t* vcb = (const bf16_t*)(p.ws + OFF_VCMP) + (size_t)(bl * 4 + g) * 256 * 64;
  const bf16_t* kwb = kvb + seqbase + 1024;
  const bf16_t* vwb = kvb + seqbase + 1280;
  const bf16_t* ksb = kvb + seqbase + 512;
  const bf16_t* vsb = kvb + seqbase + 768;

  float m = -1e30f, lsum = 0.f;
  f32x4 o[4];
#pragma unroll
  for (int dt = 0; dt < 4; ++dt) o[dt] = f32x4{0.f, 0.f, 0.f, 0.f};
  float m_c = -1e30f, inv_c = 0.f, prev_rot = 0.f;
  float* myimp = impbuf + n * 1040;
#pragma unroll
  for (int i = 0; i < 16; ++i) myimp[i * 65 + lane] = 0.f;

  int lo = t0 - 511; lo = lo < 0 ? 0 : lo;
  const int wlo = lo >> 6, whi = t0 >> 6, nW = whi - wlo + 1;
  const int nck = (qb + 63) >> 6;
  auto finish = [&](float gate) -> float {
    float lt = lsum + bperm(lsum, lane ^ 16);
    lt += bperm(lt, lane ^ 32);
    const float inv = lt > 0.f ? 1.f / lt : 0.f;
    const float sc_ = gate * inv;
#pragma unroll
    for (int dt = 0; dt < 4; ++dt) { otot[dt] += o[dt] * sc_; o[dt] = f32x4{0.f, 0.f, 0.f, 0.f}; }
    lsum = 0.f;
    return inv;
  };
  kv_stream(nW + 2 * nck,
    [&](int e, const bf16_t*& kp, const bf16_t*& vp, size_t& ld) {
      if (e < nW) { const size_t off = (size_t)(whi - e) * 64 * 1536; kp = kwb + off; vp = vwb + off; ld = 1536; }
      else { const int c = (e < nW + nck) ? (nW + nck - 1 - e) : (e - nW - nck); kp = kcb + c * 4096; vp = vcb + c * 4096; ld = 64; }
    },
    [&](int e, const bf16_t* Ks, const bf16_t* Vt) {
      if (e < nW) {
        const int wb = whi - e;
        if (wb < whi && wb * 64 >= t0 - 496) attn_block64<false>(Ks, Vt, q0, q1, tq, wb * 64, 1, 512, true, slope, m, lsum, o, l15, grp, tb);
        else attn_block64<true>(Ks, Vt, q0, q1, tq, wb * 64, 1, 512, true, slope, m, lsum, o, l15, grp, tb);
        if (e == nW - 1) { (void)finish(g2); m = -1e30f; }
      } else if (e < nW + nck) {
        const int c = nW + nck - 1 - e;
        if (16 * (64 * c + 63) + 31 <= t0) attn_block64<false>(Ks, Vt, q0, q1, tq, 1024 * c + 31, 16, BIG, true, slope, m, lsum, o, l15, grp, tb);
        else attn_block64<true>(Ks, Vt, q0, q1, tq, 1024 * c + 31, 16, BIG, true, slope, m, lsum, o, l15, grp, tb);
        if (e == nW + nck - 1) { inv_c = finish(g0); m_c = m; m = -1e30f; }
      } else {
        const int c = e - nW - nck;
#pragma unroll
        for (int tt = 0; tt < 4; ++tt) {
          const bf16_t* krp = Ks + (tt * 16 + l15) * KS_LD + grp * 8;
          bf16x8 k0 = *(const bf16x8*)krp, k1 = *(const bf16x8*)(krp + 32);
          f32x4 z = f32x4{0.f, 0.f, 0.f, 0.f};
          z = mfma16(k0, q0, z);
          z = mfma16(k1, q1, z);
          float sum4 = 0.f, p3 = 0.f;
#pragma unroll
          for (int j = 0; j < 4; ++j) {
            int kidx = c * 64 + tt * 16 + 4 * grp + j;
            int dist = tq - (16 * kidx + 31);
            float pe = (dist >= 0) ? __builtin_amdgcn_exp2f(z[j] - slope * (float)dist - m_c) * inv_c : 0.f;
            sum4 += pe;
            if (j == 3) p3 = pe;
          }
          float rot = bperm(p3, (lane + 48) & 63);
          float extra = (grp == 0) ? prev_rot : rot;
          myimp[l15 * 65 + (c * 4 + tt) * 4 + grp] = sum4 + extra;
          prev_rot = rot;
        }
      }
    }, smraw, tid);
  if (nck < 4 && grp == 0) myimp[l15 * 65 + nck * 16] = prev_rot;
  __syncthreads();
#pragma unroll 1
  for (int i = 0; i < 4; ++i) {
    int qi = n * 4 + i;
    const int cur = t0 >> 6, s = lane;
    float imp = impbuf[qi * 65 + s] + impbuf[1040 + qi * 65 + s] + impbuf[2080 + qi * 65 + s] + impbuf[3120 + qi * 65 + s];
    bool forced = (s == 0) || (s == cur) || (s == cur - 1);
    bool valid = s <= cur;
    float score = forced ? __builtin_inff() : (valid ? imp : -__builtin_inff());
    unsigned long long mk;
    if (cur < 16) {
      mk = __ballot(valid);
    } else {
      const int key = (int)(((forced ? 0x7F800000u : __float_as_uint(imp)) & 0xFFFFFFC0u) | (unsigned)(63 - s));
      int rank = 0;
#pragma unroll 8
      for (int sp = 0; sp <= cur; ++sp)
        rank += (__builtin_amdgcn_readlane(key, sp) > key) ? 1 : 0;
      mk = __ballot((rank < 16) && valid);
    }
    if (lane == 0) selmask[qi] = mk;
  }
  __syncthreads();
  const unsigned long long mymask = selmask[l15];
  unsigned long long U = 0, Uand = ~0ull;
#pragma unroll
  for (int i = 0; i < 16; ++i) { const unsigned long long mk = selmask[i]; U |= mk; Uand &= mk; }
  {
    uint32_t ulo = __builtin_amdgcn_readfirstlane((uint32_t)U), uhi = __builtin_amdgcn_readfirstlane((uint32_t)(U >> 32));
    U = ((unsigned long long)uhi << 32) | ulo;
    ulo = __builtin_amdgcn_readfirstlane((uint32_t)Uand); uhi = __builtin_amdgcn_readfirstlane((uint32_t)(Uand >> 32));
    Uand = ((unsigned long long)uhi << 32) | ulo;
  }
  const int nsel = __popcll(U);
  if (n == 0) {
    if ((U >> lane) & 1ull) sellist[__popcll(U >> lane) - 1] = lane;
  }
  __syncthreads();
  kv_stream(nsel,
    [&](int e, const bf16_t*& kp, const bf16_t*& vp, size_t& ld) {
      const int s = __builtin_amdgcn_readfirstlane(sellist[e]);
      const size_t off = (size_t)s * 64 * 1536; kp = ksb + off; vp = vsb + off; ld = 1536;
    },
    [&](int e, const bf16_t* Ks, const bf16_t* Vt) {
      const int s = __builtin_amdgcn_readfirstlane(sellist[e]);
      const bool ok = (mymask >> s) & 1ull;
      if (s < whi) attn_block64<false>(Ks, Vt, q0, q1, tq, s * 64, 1, BIG, ok, slope, m, lsum, o, l15, grp, tb);
      else attn_block64<true>(Ks, Vt, q0, q1, tq, s * 64, 1, BIG, ok, slope, m, lsum, o, l15, grp, tb);
    }, smraw, tid);
  (void)finish(g1);
#pragma unroll
  for (int dt = 0; dt < 4; ++dt) {
    size_t off = rowq * 1024 + h * 64 + dt * 16 + 4 * grp;
    u32x2 zz = *(const u32x2*)(zbuf + off);
    u32x2 ov;
    ov.x = pack2(otot[dt][0] * bf2f(zz.x & 0xffffu), otot[dt][1] * bf2f(zz.x >> 16));
    ov.y = pack2(otot[dt][2] * bf2f(zz.y & 0xffffu), otot[dt][3] * bf2f(zz.y >> 16));
    *(u32x2*)(yB + off) = ov;
  }
}

struct GmlpBLoader {
  const bf16_t* gvbase;
  const float* stats;
  const float* lg; const float* lb;
  int tid;
  u32x4 r[2]; f32x2 st[2];
  __device__ __forceinline__ void load(int kt) {
#pragma unroll
    for (int i = 0; i < 2; ++i) {
      int v = tid + 256 * i;
      int j = kt * 32 + (v >> 4), c8 = (v & 15) * 8;
      r[i] = *(const u32x4*)(gvbase + (size_t)j * 1024 + c8);
      st[i] = *(const f32x2*)(stats + j * 2);
    }
  }
  __device__ __forceinline__ void store(bf16_t* tile) {
#pragma unroll
    for (int i = 0; i < 2; ++i) {
      int v = tid + 256 * i;
      int jl = v >> 4, c8 = (v & 15) * 8;
      const u32x4 u = r[i];
#pragma unroll
      for (int e = 0; e < 4; ++e) {
        int c = c8 + 2 * e;
        float a = (bf2f(u[e] & 0xffffu) - st[i].x) * st[i].y * lg[c] + lb[c];
        float b = (bf2f(u[e] >> 16) - st[i].x) * st[i].y * lg[c + 1] + lb[c + 1];
        tile[c * LDK + jl] = f2bf(a);
        tile[(c + 1) * LDK + jl] = f2bf(b);
      }
    }
  }
};

__device__ __forceinline__ void gmlp_unit(const Params& p, int l, char* smraw, int bl, int chunk, int g) {
  bf16_t* sm = (bf16_t*)smraw;
  const int tid = opaque_tid(); const int lane = tid & 63, w = tid >> 6, wr = w >> 1, wc = w & 1, l15 = lane & 15, grp = lane >> 4;
  const size_t row0 = (size_t)bl * SEQ + chunk * 128;
  f32x4 acc[4][4];
  zero_acc(acc);
  StdLoader al;
  al.init((const bf16_t*)(p.ws + OFF_WM) + (size_t)(l * 8 + g) * 128 * 128, 128, tid);
  GmlpBLoader bl_;
  bl_.tid = tid;
  bl_.gvbase = (const bf16_t*)(p.ws + OFF_GV) + row0 * 1024 + g * 128;
  bl_.stats = (const float*)(p.ws + OFF_STATS) + row0 * 2;
  bl_.lg = p.ln_g + l * 1024 + g * 128;
  bl_.lb = p.ln_b + l * 1024 + g * 128;
  gemm_core(acc, al, bl_, 4, sm, tid);
  const bf16_t* uz = (const bf16_t*)(p.ws + OFF_UZ);
  bf16_t* yC = (bf16_t*)(p.ws + OFF_YC);
  const float* bs = p.b_s + (size_t)(l * 8 + g) * 128;
#pragma unroll
  for (int m = 0; m < 4; ++m)
#pragma unroll
    for (int j = 0; j < 4; ++j) {
      int i = wr * 64 + m * 16 + 4 * grp + j;
      float bb = bs[i];
#pragma unroll
      for (int n = 0; n < 4; ++n) {
        size_t off = (row0 + i) * 1024 + g * 128 + wc * 64 + n * 16 + l15;
        yC[off] = f2bf(bf2f(uz[off]) * (acc[m][n][j] + bb));
      }
    }
}

__device__ __forceinline__ void phase_mix2(const Params& p, int l, char* smraw) {
  constexpr int NATT = NB * 4 * 256, NGM = NB * 32 * 8;
  for (int u = blockIdx.x; u < NATT + NGM; u += gridDim.x) {
    if (u < NATT) {
      int qb = 255 - (u / (NB * 4)), r = u % (NB * 4);
      attn_unit(p, smraw, r >> 2, r & 3, qb);
    } else {
      int v = u - NATT;
      gmlp_unit(p, l, smraw, v >> 8, (v >> 3) & 31, v & 7);
    }
  }
}

__device__ __forceinline__ void phase_merge(const Params& p, int l, char* smraw) {
  bf16_t* sm = (bf16_t*)smraw;
  const bf16_t* WbrT = (const bf16_t*)(p.ws + OFF_WBRT) + (size_t)l * 3 * D * D;
  const bf16_t* gates = (const bf16_t*)(p.ws + OFF_GATES);
  bf16_t* merged = (bf16_t*)(p.ws + OFF_H);
  const int tid = opaque_tid(); const int lane = tid & 63, w = tid >> 6, wr = w >> 1, wc = w & 1, l15 = lane & 15, grp = lane >> 4;
  const int nx = gridDim.x >> 3;
  constexpr int CJ_END = (R / 1024) * 64;
  auto cj_next = [&](int c) { return ((c & 63) + nx < 64) ? (c + nx) : (((c >> 6) + 8) * 64 + (int)(blockIdx.x >> 3)); };
  auto ybuf = [&](int i) { return (const bf16_t*)(p.ws + (i == 0 ? OFF_YA : (i == 1 ? OFF_YB : OFF_YC))); };
  int cj = (blockIdx.x & 7) * 64 + (blockIdx.x >> 3);
  __syncthreads();
  if (cj < CJ_END) glds_prefetch0(ybuf(0) + (size_t)((cj >> 6) * 8 + (cj & 7)) * 128 * D, D, WbrT + (size_t)((cj & 63) >> 3) * 128 * D, D, sm, tid);
  for (; cj < CJ_END; cj = cj_next(cj)) {
    const int nt = (cj & 63) >> 3, mt = (cj >> 6) * 8 + (cj & 7);
    const int rbase = mt * 128 + wr * 64 + l15, cbase = nt * 128 + wc * 64 + 4 * grp;
    f32x4 tot[4][4];
    zero_acc(tot);
#pragma unroll 1
    for (int i = 0; i < 3; ++i) {
      f32x4 acc[4][4];
      zero_acc(acc);
      const bf16_t* Y = ybuf(i);
      gemm_core_glds<false>(acc, Y + (size_t)mt * 128 * D, D, WbrT + (size_t)i * D * D + (size_t)nt * 128 * D, D, D / 64, sm, tid);
      if (i < 2) {
        glds_prefetch0(ybuf(i + 1) + (size_t)mt * 128 * D, D, WbrT + (size_t)(i + 1) * D * D + (size_t)nt * 128 * D, D, sm, tid);
      } else {
        const int c2 = cj_next(cj);
        if (c2 < CJ_END) glds_prefetch0(ybuf(0) + (size_t)((c2 >> 6) * 8 + (c2 & 7)) * 128 * D, D, WbrT + (size_t)((c2 & 63) >> 3) * 128 * D, D, sm, tid);
      }
#pragma unroll
      for (int m = 0; m < 4; ++m)
#pragma unroll
        for (int n = 0; n < 4; ++n) {
          const u32x2 gt = *(const u32x2*)(gates + (size_t)(rbase + m * 16) * 3072 + i * 1024 + cbase + n * 16);
          tot[m][n][0] += bf2f(gt.x & 0xffffu) * acc[m][n][0];
          tot[m][n][1] += bf2f(gt.x >> 16) * acc[m][n][1];
          tot[m][n][2] += bf2f(gt.y & 0xffffu) * acc[m][n][2];
          tot[m][n][3] += bf2f(gt.y >> 16) * acc[m][n][3];
        }
    }
#pragma unroll
    for (int m = 0; m < 4; ++m)
#pragma unroll
      for (int n = 0; n < 4; ++n)
        *(u32x2*)(merged + (size_t)(rbase + m * 16) * 1024 + cbase + n * 16) = u32x2{pack2(tot[m][n][0], tot[m][n][1]), pack2(tot[m][n][2], tot[m][n][3])};
  }
}

__device__ __forceinline__ void phase_outproj(const Params& p, int l, char* smraw) {
  bf16_t* sm = (bf16_t*)smraw;
  const bf16_t* WoutT = (const bf16_t*)(p.ws + OFF_WOUTT) + (size_t)l * D * D;
  const bf16_t* merged = (const bf16_t*)(p.ws + OFF_H);
  bf16_t* opre = (bf16_t*)(p.ws + OFF_YAPRE);
  const int tid = opaque_tid(); const int lane = tid & 63, w = tid >> 6, wr = w >> 1, wc = w & 1, l15 = lane & 15, grp = lane >> 4;
  const int nx = gridDim.x >> 3;
  constexpr int CJ_END = (R / 1024) * 64;
  auto cj_next = [&](int c) { return ((c & 63) + nx < 64) ? (c + nx) : (((c >> 6) + 8) * 64 + (int)(blockIdx.x >> 3)); };
  int cj = (blockIdx.x & 7) * 64 + (blockIdx.x >> 3);
  __syncthreads();
  if (cj < CJ_END) glds_prefetch0(merged + (size_t)((cj >> 6) * 8 + (cj & 7)) * 128 * D, D, WoutT + (size_t)((cj & 63) >> 3) * 128 * D, D, sm, tid);
  for (; cj < CJ_END; cj = cj_next(cj)) {
    const int nt = (cj & 63) >> 3, mt = (cj >> 6) * 8 + (cj & 7);
    f32x4 acc[4][4];
    zero_acc(acc);
    gemm_core_glds<true>(acc, merged + (size_t)mt * 128 * D, D, WoutT + (size_t)nt * 128 * D, D, D / 64, sm, tid);
    {
      const int c2 = cj_next(cj);
      if (c2 < CJ_END) glds_prefetch0(merged + (size_t)((c2 >> 6) * 8 + (c2 & 7)) * 128 * D, D, WoutT + (size_t)((c2 & 63) >> 3) * 128 * D, D, sm, tid);
    }
    const int rbase = mt * 128 + wr * 64 + l15, cbase = nt * 128 + wc * 64 + 4 * grp;
#pragma unroll
    for (int m = 0; m < 4; ++m)
#pragma unroll
      for (int n = 0; n < 4; ++n)
        *(u32x2*)(opre + (size_t)(rbase + m * 16) * 1024 + cbase + n * 16) = u32x2{pack2(acc[m][n][0], acc[m][n][1]), pack2(acc[m][n][2], acc[m][n][3])};
  }
}

#define XB_TMO      128
#define XB_XCNT(j)  (256  + 64 * (j))
#define XB_XSUB(j)  (1280 + 64 * (j))
#define XB_XGEN(j)  (2304 + 64 * (j))
#define XB_TOP      3328
#define XB_TOPGEN   3392
#define XCD_BAR_WORDS 3456
#define XB_SPIN_CAP (1u << 18)
#define LAS __attribute__((address_space(3)))

__device__ __forceinline__ unsigned xb_ld(unsigned* p)              { return __hip_atomic_load(p, __ATOMIC_RELAXED, __HIP_MEMORY_SCOPE_AGENT); }
__device__ __forceinline__ unsigned xb_add(unsigned* p, unsigned v) { return __hip_atomic_fetch_add(p, v, __ATOMIC_RELAXED, __HIP_MEMORY_SCOPE_AGENT); }
__device__ __forceinline__ unsigned xb_xcc_id() { return (unsigned)__builtin_amdgcn_s_getreg((3 << 11) | 20) & 0xFu; }
#define XB_SPIN(cond, bar) do { unsigned _sp = 0; while (cond) { __builtin_amdgcn_s_sleep(1); \
    if ((++_sp & 255u) == 0u) { if (xb_ld(&(bar)[XB_TMO])) break; if (_sp > XB_SPIN_CAP) { atomicAdd(&(bar)[XB_TMO], 1u); break; } } } } while (0)

struct XcdBarrier {
    unsigned* bar; unsigned x;
    volatile LAS unsigned* st;
};

__device__ __forceinline__ XcdBarrier xcd_barrier_post(unsigned* bar, volatile LAS unsigned* st) {
    XcdBarrier b; b.bar = bar; b.x = xb_xcc_id(); b.st = st;
    if (threadIdx.x == 0) (void)xb_add(&bar[XB_XCNT(b.x)], 1u);
    return b;
}
__device__ __forceinline__ void xcd_barrier_complete(unsigned* bar, unsigned x, unsigned& nloc, unsigned& nx) {
    const unsigned G = gridDim.x * gridDim.y * gridDim.z;
    unsigned sum, cnt, mine, sp = 0u;
    for (;;) {
        sum = 0u; cnt = 0u; mine = 0u;
#pragma unroll
        for (unsigned j = 0; j < 16; ++j) { const unsigned c = xb_ld(&bar[XB_XCNT(j)]); sum += c; cnt += (c > 0u) ? 1u : 0u; mine = (j == x) ? c : mine; }
        if (sum == G) break;
        __builtin_amdgcn_s_sleep(1);
        if ((++sp & 255u) == 0u) { if (xb_ld(&bar[XB_TMO])) break; if (sp > XB_SPIN_CAP) { atomicAdd(&bar[XB_TMO], 1u); break; } }
    }
    nloc = mine > 0u ? mine : 1u; nx = cnt > 0u ? cnt : 1u;
}
__device__ __forceinline__ void xcd_barrier(const XcdBarrier& b) {
    asm volatile("s_waitcnt vmcnt(0)" ::: "memory");
    __syncthreads();
    if (threadIdx.x == 0) {
        unsigned* bar = b.bar;
        __builtin_amdgcn_s_waitcnt(0);
        unsigned nloc = b.st[0], nx = b.st[1];
        if (nloc == 0u) { xcd_barrier_complete(bar, b.x, nloc, nx); b.st[0] = nloc; b.st[1] = nx; }
        const unsigned old = xb_add(&bar[XB_XSUB(b.x)], 1u);
        const unsigned gen = old / nloc;
        if (old + 1u == (gen + 1u) * nloc) {
            __builtin_amdgcn_fence(__ATOMIC_RELEASE, "agent");
            asm volatile("s_waitcnt vmcnt(0)" ::: "memory");
            const unsigned og = xb_add(&bar[XB_TOP], 1u);
            const unsigned tg = og / nx;
            if (og + 1u == (tg + 1u) * nx) xb_add(&bar[XB_TOPGEN], 1u);
            else XB_SPIN(xb_ld(&bar[XB_TOPGEN]) == tg, bar);
            __builtin_amdgcn_fence(__ATOMIC_ACQUIRE, "agent");
            xb_add(&bar[XB_XGEN(b.x)], 1u);
            asm volatile("s_waitcnt vmcnt(0)" ::: "memory");
        } else {
            XB_SPIN(xb_ld(&bar[XB_XGEN(b.x)]) == gen, bar);
            __builtin_amdgcn_fence(__ATOMIC_ACQUIRE, "agent");
            asm volatile("s_waitcnt vmcnt(0)" ::: "memory");
        }
    }
    __syncthreads();
}

__global__ void __launch_bounds__(256, 2) hybrid_fwd(Params p) {
  __shared__ __attribute__((aligned(16))) char smraw[SMEM_BYTES];
  cg::grid_group grid = cg::this_grid();
  if (threadIdx.x == 0) *(u32x4*)(smraw + 65536) = u32x4{0u, 0u, 0u, 0u};
  __syncthreads();
  const XcdBarrier xb = xcd_barrier_post((unsigned*)(p.ws + OFF_BAR), (volatile LAS unsigned*)(smraw + 65536));
  phase0(p, smraw);
  grid.sync();
  for (int gi = 0; gi < NGRP; ++gi) {
    phase_h0(p, gi);
    xcd_barrier(xb);
    for (int l = 0; l < DEPTH; ++l) {
      phase_inproj(p, l, smraw);
      xcd_barrier(xb);
      phase_mix1(p, l, smraw);
      xcd_barrier(xb);
      phase_mix2(p, l, smraw);
      xcd_barrier(xb);
      phase_merge(p, l, smraw);
      xcd_barrier(xb);
      phase_outproj(p, l, smraw);
      xcd_barrier(xb);
      phase_final(p, gi, l);
      xcd_barrier(xb);
    }
  }
}

extern "C" void kernel_launch(void* const* d_in, const int* in_sizes, int n_in, void* d_out, int out_size, void* d_ws,
                              size_t ws_size, hipStream_t stream) {
  static int grid_blocks = 0;
  if (!grid_blocks) {
    int dev = 0, cus = 0, per_cu = 0;
    hipGetDevice(&dev);
    hipDeviceGetAttribute(&cus, hipDeviceAttributeMultiprocessorCount, dev);
    hipOccupancyMaxActiveBlocksPerMultiprocessor(&per_cu, hybrid_fwd, 256, 0);
    if (per_cu < 1) per_cu = 1;
    if (per_cu > 2) per_cu = 2;
    grid_blocks = cus * per_cu;
    if (ws_size < WS_END) fprintf(stderr, "kernel_launch: workspace too small: %zu < %zu\n", ws_size, (size_t)WS_END);
  }
  Params p{};
  const float** pp = (const float**)&p;
  for (int i = 0; i < 21; ++i) pp[i] = (const float*)d_in[i];
  p.out = (float*)d_out;
  p.ws = (unsigned char*)d_ws;
  (void)hipMemsetAsync((char*)d_ws + OFF_BAR, 0, 3456 * 4, stream);
  void* args[] = {&p};
  hipError_t e = hipLaunchCooperativeKernel((void*)hybrid_fwd, dim3(grid_blocks), dim3(256), args, 0, stream);
  if (e != hipSuccess) fprintf(stderr, "cooperative launch failed: %s (grid %d)\n", hipGetErrorString(e), grid_blocks);
}
```

```cpp
#include <hip/hip_runtime.h>
#include <hip/hip_cooperative_groups.h>
#include <cstdio>
#include <cstdint>
namespace cg = cooperative_groups;

typedef unsigned short bf16_t;
using bf16x8 = __attribute__((ext_vector_type(8))) short;
using f32x4 = __attribute__((ext_vector_type(4))) float;
using f32x2 = __attribute__((ext_vector_type(2))) float;
using u32x4 = __attribute__((ext_vector_type(4))) uint32_t;
using u32x2 = __attribute__((ext_vector_type(2))) uint32_t;

constexpr int D = 1024, SEQ = 4096, BATCH = 16, DEPTH = 2;
constexpr int IN_COLS = 13872;
constexpr int A_OFF = 0, B_OFF = 4096, C_OFF = 7728, G_OFF = 10800;
constexpr int NT_IN = 109, NP = NT_IN * 128;
constexpr int NB = 4, R = NB * SEQ, NGRP = BATCH / NB;
constexpr int LDK = 40;
constexpr int KS_LD = 80;
constexpr int VT_LD = 68;
constexpr int HS_LD = 136;
constexpr int SMEM_BYTES = 65536 + 16;

constexpr size_t al256(size_t x) { return (x + 255) & ~size_t(255); }
constexpr size_t OFF_WINT = 0;
constexpr size_t OFF_WBRT = al256(OFF_WINT + (size_t)DEPTH * NP * D * 2);
constexpr size_t OFF_WOUTT = al256(OFF_WBRT + (size_t)DEPTH * 3 * D * D * 2);
constexpr size_t OFF_WC1T = al256(OFF_WOUTT + (size_t)DEPTH * D * D * 2);
constexpr size_t OFF_WM = al256(OFF_WC1T + (size_t)DEPTH * 2 * 128 * 2048 * 2);
constexpr size_t OFF_BIAS1 = al256(OFF_WM + (size_t)DEPTH * 8 * 128 * 128 * 2);
constexpr size_t OFF_MOD = al256(OFF_BIAS1 + (size_t)DEPTH * 2 * 8 * 128 * 4);
constexpr size_t OFF_H = al256(OFF_MOD + (size_t)DEPTH * 16 * 3072 * 4);
constexpr size_t SZ_ACT = (size_t)R * 1024 * 2;
constexpr size_t OFF_YAPRE = al256(OFF_H + SZ_ACT);
constexpr size_t OFF_BZA = al256(OFF_YAPRE + SZ_ACT);
constexpr size_t OFF_Q = al256(OFF_BZA + SZ_ACT);
constexpr size_t OFF_ZB = al256(OFF_Q + SZ_ACT);
constexpr size_t OFF_UZ = al256(OFF_ZB + SZ_ACT);
constexpr size_t OFF_GV = al256(OFF_UZ + SZ_ACT);
constexpr size_t OFF_KV = al256(OFF_GV + SZ_ACT);
constexpr size_t OFF_GL = al256(OFF_KV + (size_t)R * 1536 * 2);
constexpr size_t OFF_GATES = al256(OFF_GL + (size_t)R * 48 * 4);
constexpr size_t OFF_YA = al256(OFF_GATES + (size_t)R * 3072 * 2);
constexpr size_t OFF_YB = al256(OFF_YA + SZ_ACT);
constexpr size_t OFF_YC = al256(OFF_YB + SZ_ACT);
constexpr size_t OFF_KCMP = al256(OFF_YC + SZ_ACT);
constexpr size_t OFF_VCMP = al256(OFF_KCMP + (size_t)NB * 4 * 256 * 64 * 2);
constexpr size_t OFF_STATS = al256(OFF_VCMP + (size_t)NB * 4 * 256 * 64 * 2);
constexpr size_t OFF_BAR = al256(OFF_STATS + (size_t)R * 2 * 4);
constexpr size_t WS_END = al256(OFF_BAR + 3456 * 4);

struct Params {
  const float *x, *c, *g_pre, *g_post, *w_ada, *b_ada, *w_in, *conv_w, *conv_b, *pos_ck, *w_ck1, *w_ck2,
      *pos_cv, *w_cv1, *w_cv2, *ln_g, *ln_b, *w_s, *b_s, *w_br, *w_out;
  float* out;
  unsigned char* ws;
};

typedef __bf16 bf16x2_native __attribute__((ext_vector_type(2)));
__device__ __forceinline__ uint32_t pack2(float a, float b) {
  f32x2 v = {a, b};
  return __builtin_bit_cast(uint32_t, __builtin_convertvector(v, bf16x2_native));
}
__device__ __forceinline__ bf16_t f2bf(float f) { return (bf16_t)(pack2(f, f) & 0xffffu); }
__device__ __forceinline__ float bf2f(uint32_t h) { return __uint_as_float(h << 16); }
__device__ __forceinline__ float sigmoid_(float x) { return __builtin_amdgcn_rcpf(1.f + __expf(-x)); }
__device__ __forceinline__ float silu_(float x) { return x * __builtin_amdgcn_rcpf(1.f + __expf(-x)); }
__device__ __forceinline__ float gelu_(float x) {
  float y = 0.7978845608f * (x + 0.044715f * x * x * x);
  return x * __builtin_amdgcn_rcpf(1.f + __expf(-2.f * y));
}
__device__ __forceinline__ f32x4 mfma16(bf16x8 a, bf16x8 b, f32x4 c) {
  return __builtin_amdgcn_mfma_f32_16x16x32_bf16(a, b, c, 0, 0, 0);
}
__device__ __forceinline__ float bperm(float v, int srclane) {
  return __int_as_float(__builtin_amdgcn_ds_bpermute(srclane << 2, __float_as_int(v)));
}
__device__ __forceinline__ float wave_sum(float v, int lane) {
#pragma unroll
  for (int o = 32; o >= 1; o >>= 1) v += bperm(v, lane ^ o);
  return v;
}

__device__ __forceinline__ int opaque_tid() {
  int t = threadIdx.x;
  asm volatile("" : "+v"(t));
  return t;
}

__device__ __forceinline__ int win_colmap(int np) {
  int tile = np >> 7, r = np & 127;
  if (tile < 32) { int wc = r >> 6, t = (r >> 4) & 3, i = r & 15; return A_OFF + t * 1024 + tile * 32 + wc * 16 + i; }
  if (tile < 40) return B_OFF + (np - 32 * 128);
  if (tile < 52) return B_OFF + 1024 + (np - 40 * 128);
  if (tile < 60) return B_OFF + 2560 + (np - 52 * 128);
  if (tile == 60) return r < 48 ? B_OFF + 3584 + r : -1;
  if (tile < 77) { int tb = tile - 61, wc = r >> 6, t = (r >> 4) & 3, i = r & 15; return C_OFF + ((t & 1) ? 2048 : 0) + tb * 64 + wc * 32 + (t >> 1) * 16 + i; }
  if (tile < 85) return C_OFF + 1024 + (np - 77 * 128);
  return G_OFF + (np - 85 * 128);
}

template <bool WIN>
__device__ __forceinline__ void transpose_tile(const float* __restrict__ src, int ld_src, bf16_t* __restrict__ dst, int Kdim, int n0, int k0, float* sm, int tid) {
  const int tx = tid & 63, ty = tid >> 6;
  const int col = WIN ? win_colmap(n0 + tx) : (n0 + tx);
  __syncthreads();
#pragma unroll
  for (int i = 0; i < 16; ++i) {
    int k = ty * 16 + i;
    float v = (col >= 0) ? src[(size_t)(k0 + k) * ld_src + col] : 0.f;
    sm[k * 65 + tx] = v;
  }
  __syncthreads();
#pragma unroll
  for (int i = 0; i < 16; ++i) {
    int n = ty * 16 + i;
    dst[(size_t)(n0 + n) * Kdim + k0 + tx] = f2bf(sm[tx * 65 + n]);
  }
}

__device__ __forceinline__ void phase0(const Params& p, char* smraw) {
  float* smf = (float*)smraw;
  const int bid = blockIdx.x, nblk = gridDim.x, tid = opaque_tid();
  bf16_t* WinT = (bf16_t*)(p.ws + OFF_WINT);
  bf16_t* WbrT = (bf16_t*)(p.ws + OFF_WBRT);
  bf16_t* WoutT = (bf16_t*)(p.ws + OFF_WOUTT);
  bf16_t* Wc1T = (bf16_t*)(p.ws + OFF_WC1T);
  bf16_t* Wm = (bf16_t*)(p.ws + OFF_WM);
  float* bias1 = (float*)(p.ws + OFF_BIAS1);
  float* mod = (float*)(p.ws + OFF_MOD);
  for (int t = bid; t < DEPTH * 218 * 16; t += nblk) {
    int l = t / (218 * 16), r = t % (218 * 16), nt = r >> 4, kt = r & 15;
    transpose_tile<true>(p.w_in + (size_t)l * D * IN_COLS, IN_COLS, WinT + (size_t)l * NP * D, D, nt * 64, kt * 64, smf, tid);
  }
  for (int t = bid; t < DEPTH * 3 * 256; t += nblk) {
    int li = t >> 8, r = t & 255, nt = r >> 4, kt = r & 15;
    transpose_tile<false>(p.w_br + (size_t)li * D * D, D, WbrT + (size_t)li * D * D, D, nt * 64, kt * 64, smf, tid);
  }
  for (int t = bid; t < DEPTH * 256; t += nblk) {
    int l = t >> 8, r = t & 255, nt = r >> 4, kt = r & 15;
    transpose_tile<false>(p.w_out + (size_t)l * D * D, D, WoutT + (size_t)l * D * D, D, nt * 64, kt * 64, smf, tid);
  }
  for (int t = bid; t < DEPTH * 2 * 64; t += nblk) {
    int lk = t >> 6, r = t & 63, nt = r >> 5, kt = r & 31;
    int l = lk >> 1, kv = lk & 1;
    const float* src = (kv ? p.w_cv1 : p.w_ck1) + (size_t)l * 2048 * 128;
    transpose_tile<false>(src, 128, Wc1T + (size_t)lk * 128 * 2048, 2048, nt * 64, kt * 64, smf, tid);
  }
  for (int e = bid * 256 + tid; e < DEPTH * 8 * 128 * 128; e += nblk * 256) {
    int j = e & 127, i = (e >> 7) & 127;
    Wm[e] = (j <= i) ? f2bf(p.w_s[e]) : (bf16_t)0;
  }
  for (int t = bid - 128; t >= 0 && t < DEPTH * 2 * 8; t += nblk) {
    int lk = t >> 3, ks = t & 7, l = lk >> 1, kv = lk & 1;
    const float* pos = (kv ? p.pos_cv : p.pos_ck) + (size_t)l * 2048;
    const float* w1 = (kv ? p.w_cv1 : p.w_ck1) + (size_t)l * 2048 * 128;
    int n = tid & 127, half = tid >> 7;
    float acc = 0.f;
    const int kb = ks * 256 + half * 128;
#pragma unroll 16
    for (int k = kb; k < kb + 128; ++k) acc += pos[k] * w1[(size_t)k * 128 + n];
    __syncthreads();
    smf[tid] = acc;
    __syncthreads();
    if (tid < 128) bias1[t * 128 + tid] = smf[tid] + smf[tid + 128];
  }
  for (int t = nblk - 1 - bid; t < DEPTH * 48; t += nblk) {
    int l = t / 48, ch = t % 48;
    int tx = tid & 63, ty = tid >> 6;
    int col = ch * 64 + tx;
    __syncthreads();
    for (int i = 0; i < 64; ++i) {
      int e = tid + 256 * i;
      smf[(e & 1023) * 16 + (e >> 10)] = silu_(p.c[e]);
    }
    __syncthreads();
    float acc[16];
#pragma unroll
    for (int b = 0; b < 16; ++b) acc[b] = 0.f;
    const float* w = p.w_ada + (size_t)l * D * 3072 + col;
#pragma unroll 8
    for (int k = ty * 256; k < ty * 256 + 256; ++k) {
      float wv = w[(size_t)k * 3072];
      const f32x4 s0 = *(const f32x4*)(smf + k * 16), s1 = *(const f32x4*)(smf + k * 16 + 4), s2 = *(const f32x4*)(smf + k * 16 + 8), s3 = *(const f32x4*)(smf + k * 16 + 12);
#pragma unroll
      for (int b = 0; b < 4; ++b) { acc[b] += s0[b] * wv; acc[4 + b] += s1[b] * wv; acc[8 + b] += s2[b] * wv; acc[12 + b] += s3[b] * wv; }
    }
    __syncthreads();
#pragma unroll
    for (int b = 0; b < 16; ++b) smf[(ty * 16 + b) * 64 + tx] = acc[b];
    __syncthreads();
    if (ty == 0) {
#pragma unroll
      for (int b = 0; b < 16; ++b) {
        float s_ = smf[b * 64 + tx] + smf[(16 + b) * 64 + tx] + smf[(32 + b) * 64 + tx] + smf[(48 + b) * 64 + tx];
        mod[((size_t)l * 16 + b) * 3072 + col] = s_ + p.b_ada[l * 3072 + col];
      }
    }
  }
}

__device__ __forceinline__ void write_h_row(const f32x4 (&xv)[4], float ss, const float* g_pre, const float* modl_b, bf16_t* hrow, int lane) {
  float rs = rsqrtf(ss * (1.f / 1024.f) + 1e-6f);
#pragma unroll
  for (int i = 0; i < 4; ++i) {
    int c = i * 256 + lane * 4;
    f32x4 g = *(const f32x4*)(g_pre + c);
    f32x4 sh = *(const f32x4*)(modl_b + c);
    f32x4 sc = *(const f32x4*)(modl_b + 1024 + c);
    float h0 = xv[i].x * rs * g.x * (1.f + sc.x) + sh.x;
    float h1 = xv[i].y * rs * g.y * (1.f + sc.y) + sh.y;
    float h2 = xv[i].z * rs * g.z * (1.f + sc.z) + sh.z;
    float h3 = xv[i].w * rs * g.w * (1.f + sc.w) + sh.w;
    u32x2 o; o.x = pack2(h0, h1); o.y = pack2(h2, h3);
    *(u32x2*)(hrow + c) = o;
  }
}

__device__ __forceinline__ void phase_h0(const Params& p, int grp_i) {
  const int tid = opaque_tid(); const int lane = tid & 63, w = tid >> 6;
  bf16_t* H = (bf16_t*)(p.ws + OFF_H);
  const float* mod = (const float*)(p.ws + OFF_MOD);
  for (int r = blockIdx.x * 4 + w; r < R; r += gridDim.x * 4) {
    size_t grow = (size_t)grp_i * R + r;
    int b = (int)(grow >> 12);
    const float* xr = p.x + grow * D;
    f32x4 xv[4]; float ss = 0.f;
#pragma unroll
    for (int i = 0; i < 4; ++i) {
      xv[i] = *(const f32x4*)(xr + i * 256 + lane * 4);
      ss += xv[i].x * xv[i].x + xv[i].y * xv[i].y + xv[i].z * xv[i].z + xv[i].w * xv[i].w;
    }
    ss = wave_sum(ss, lane);
    write_h_row(xv, ss, p.g_pre, mod + (size_t)b * 3072, H + (size_t)r * D, lane);
  }
}

__device__ __forceinline__ void phase_final(const Params& p, int grp_i, int l) {
  const int tid = opaque_tid(); const int lane = tid & 63, w = tid >> 6;
  bf16_t* H = (bf16_t*)(p.ws + OFF_H);
  const bf16_t* OP = (const bf16_t*)(p.ws + OFF_YAPRE);
  const float* mod = (const float*)(p.ws + OFF_MOD);
  const float* xin = (l == 0) ? p.x : p.out;
  for (int r = blockIdx.x * 4 + w; r < R; r += gridDim.x * 4) {
    size_t grow = (size_t)grp_i * R + r;
    int b = (int)(grow >> 12);
    const float* xr = xin + grow * D;
    const bf16_t* orow = OP + (size_t)r * D;
    const float* gate = mod + ((size_t)l * 16 + b) * 3072 + 2048;
    const float* gp = p.g_post + l * D;
    f32x4 xv[4], ov[4]; float ss = 0.f;
#pragma unroll
    for (int i = 0; i < 4; ++i) {
      int c = i * 256 + lane * 4;
      xv[i] = *(const f32x4*)(xr + c);
      u32x2 u = *(const u32x2*)(orow + c);
      ov[i].x = bf2f(u.x & 0xffffu); ov[i].y = bf2f(u.x >> 16); ov[i].z = bf2f(u.y & 0xffffu); ov[i].w = bf2f(u.y >> 16);
      ss += ov[i].x * ov[i].x + ov[i].y * ov[i].y + ov[i].z * ov[i].z + ov[i].w * ov[i].w;
    }
    ss = wave_sum(ss, lane);
    float rs = rsqrtf(ss * (1.f / 1024.f) + 1e-6f);
    float ss2 = 0.f;
#pragma unroll
    for (int i = 0; i < 4; ++i) {
      int c = i * 256 + lane * 4;
      f32x4 g = *(const f32x4*)(gp + c);
      f32x4 ga = *(const f32x4*)(gate + c);
      xv[i].x += ga.x * (ov[i].x * rs * g.x);
      xv[i].y += ga.y * (ov[i].y * rs * g.y);
      xv[i].z += ga.z * (ov[i].z * rs * g.z);
      xv[i].w += ga.w * (ov[i].w * rs * g.w);
      *(f32x4*)(p.out + grow * D + c) = xv[i];
      ss2 += xv[i].x * xv[i].x + xv[i].y * xv[i].y + xv[i].z * xv[i].z + xv[i].w * xv[i].w;
    }
    if (l == 0) {
      ss2 = wave_sum(ss2, lane);
      write_h_row(xv, ss2, p.g_pre + D, mod + ((size_t)16 + b) * 3072, H + (size_t)r * D, lane);
    }
  }
}

struct StdLoader {
  const bf16_t* base;
  int soff;
  u32x4 r0, r1;
  __device__ __forceinline__ void init(const bf16_t* tile_base, size_t ld, int tid) {
    base = tile_base + (size_t)(tid >> 1) * ld + (tid & 1) * 16;
    soff = (tid >> 1) * LDK + (tid & 1) * 16;
  }
  __device__ __forceinline__ void load(int kt) {
    const bf16_t* q = base + kt * 32;
    r0 = *(const u32x4*)q; r1 = *(const u32x4*)(q + 8);
  }
  __device__ __forceinline__ void store(bf16_t* tile) {
    bf16_t* q = tile + soff;
    *(u32x4*)q = r0; *(u32x4*)(q + 8) = r1;
  }
};

template <class AL, class BL>
__device__ __forceinline__ void gemm_core(f32x4 (&acc)[4][4], AL& al, BL& bl, int nk, bf16_t* sm, int tid) {
  const int lane = tid & 63, w = tid >> 6, wr = w >> 1, wc = w & 1, l15 = lane & 15, grp = lane >> 4;
  al.load(0); bl.load(0);
  __syncthreads();
  al.store(sm); bl.store(sm + 2 * 128 * LDK);
  __syncthreads();
  for (int kt = 0; kt < nk; ++kt) {
    const bf16_t* Ab = sm + (kt & 1) * 128 * LDK;
    const bf16_t* Bb = sm + (2 + (kt & 1)) * 128 * LDK;
    if (kt + 1 < nk) { al.load(kt + 1); bl.load(kt + 1); }
    bf16x8 a[4], b[4];
#pragma unroll
    for (int m = 0; m < 4; ++m) a[m] = *(const bf16x8*)(Ab + (wr * 64 + m * 16 + l15) * LDK + grp * 8);
#pragma unroll
    for (int n = 0; n < 4; ++n) b[n] = *(const bf16x8*)(Bb + (wc * 64 + n * 16 + l15) * LDK + grp * 8);
#pragma unroll
    for (int m = 0; m < 4; ++m)
#pragma unroll
      for (int n = 0; n < 4; ++n) acc[m][n] = mfma16(a[m], b[n], acc[m][n]);
    if (kt + 1 < nk) {
      al.store(sm + ((kt + 1) & 1) * 128 * LDK);
      bl.store(sm + (2 + ((kt + 1) & 1)) * 128 * LDK);
    }
    __syncthreads();
  }
}

struct Regs4 { u32x4 r0, r1, r2, r3; };
struct StdLoader64 {
  typedef Regs4 Regs;
  const bf16_t* base;
  size_t ld32;
  int soff;
  __device__ __forceinline__ void init(const bf16_t* tile_base, size_t ld, int tid) {
    base = tile_base + (size_t)(tid >> 3) * ld + (tid & 7) * 8;
    ld32 = ld * 32;
    soff = (tid >> 3) * 64 + (((tid & 7) ^ ((tid >> 4) & 7)) * 8);
  }
  __device__ __forceinline__ void load(int kt, Regs& r) const {
    const bf16_t* q = base + kt * 64;
    r.r0 = *(const u32x4*)q; r.r1 = *(const u32x4*)(q + ld32); r.r2 = *(const u32x4*)(q + 2 * ld32); r.r3 = *(const u32x4*)(q + 3 * ld32);
  }
  __device__ __forceinline__ void store(bf16_t* tile, const Regs& r) const {
    bf16_t* q = tile + soff;
    *(u32x4*)q = r.r0; *(u32x4*)(q + 2048) = r.r1; *(u32x4*)(q + 4096) = r.r2; *(u32x4*)(q + 6144) = r.r3;
  }
};

template <int NST, class AL, class BL>
__device__ __forceinline__ void gemm_core64(f32x4 (&acc)[4][4], const AL& al, const BL& bl, int nk, bf16_t* sm, int tid) {
  const int lane = tid & 63, w = tid >> 6, wr = w >> 1, wc = w & 1, l15 = lane & 15, grp = lane >> 4;
  constexpr int TILE = 128 * 64;
  const int sw = (l15 >> 1) & 7;
  const int fo0 = l15 * 64 + ((grp ^ sw) * 8), fo1 = l15 * 64 + (((4 + grp) ^ sw) * 8);
  typename AL::Regs ra[NST];
  typename BL::Regs rb[NST];
#pragma unroll
  for (int s_ = 0; s_ < NST; ++s_) { al.load(s_, ra[s_]); bl.load(s_, rb[s_]); }
  __syncthreads();
  al.store(sm, ra[0]); bl.store(sm + 2 * TILE, rb[0]);
  { const int k2 = NST < nk ? NST : nk - 1; al.load(k2, ra[0]); bl.load(k2, rb[0]); }
  __syncthreads();
  for (int kt0 = 0; kt0 < nk; kt0 += NST) {
#pragma unroll
    for (int u = 0; u < NST; ++u) {
      const int kt = kt0 + u;
      const bf16_t* Ab = sm + (kt & 1) * TILE + wr * 64 * 64;
      const bf16_t* Bb = sm + (2 + (kt & 1)) * TILE + wc * 64 * 64;
#pragma unroll
      for (int ks = 0; ks < 2; ++ks) {
        const int fo = ks ? fo1 : fo0;
        bf16x8 a[4], b[4];
#pragma unroll
        for (int m = 0; m < 4; ++m) a[m] = *(const bf16x8*)(Ab + m * 16 * 64 + fo);
#pragma unroll
        for (int n = 0; n < 4; ++n) b[n] = *(const bf16x8*)(Bb + n * 16 * 64 + fo);
#pragma unroll
        for (int m = 0; m < 4; ++m)
#pragma unroll
          for (int n = 0; n < 4; ++n) acc[m][n] = mfma16(b[n], a[m], acc[m][n]);
      }
      al.store(sm + ((kt + 1) & 1) * TILE, ra[(u + 1) % NST]);
      bl.store(sm + (2 + ((kt + 1) & 1)) * TILE, rb[(u + 1) % NST]);
      {
        int k2 = kt + 1 + NST;
        k2 = k2 < nk ? k2 : nk - 1;
        al.load(k2, ra[(u + 1) % NST]); bl.load(k2, rb[(u + 1) % NST]);
      }
      __syncthreads();
    }
  }
}

__device__ __forceinline__ void glds_prefetch0(const bf16_t* Atile, size_t lda, const bf16_t* Btile, size_t ldb, bf16_t* sm, int tid) {
  constexpr int TILE = 128 * 64;
  const int gch = ((tid & 7) ^ ((tid >> 4) & 7)) * 8;
  const bf16_t* ga = Atile + (size_t)(tid >> 3) * lda + gch;
  const bf16_t* gb = Btile + (size_t)(tid >> 3) * ldb + gch;
  const size_t a32 = lda * 32, b32 = ldb * 32;
  bf16_t* lbase = sm + tid * 8;
#pragma unroll
  for (int i_ = 0; i_ < 4; ++i_) {
    __builtin_amdgcn_global_load_lds((const unsigned*)(ga + i_ * a32), (unsigned*)(lbase + i_ * 2048), 16, 0, 0);
    __builtin_amdgcn_global_load_lds((const unsigned*)(gb + i_ * b32), (unsigned*)(lbase + 2 * TILE + i_ * 2048), 16, 0, 0);
  }
}

#define DSR1(dst, base, OFF) asm volatile("ds_read_b128 %0, %1 offset:" #OFF : "=v"(dst) : "v"(base) : "memory")
#define DSR4(arr, base) do { DSR1(arr[0], base, 0); DSR1(arr[1], base, 2048); DSR1(arr[2], base, 4096); DSR1(arr[3], base, 6144); } while (0)
template <bool HOIST>
__device__ __forceinline__ void gemm_core_glds(f32x4 (&acc)[4][4], const bf16_t* Atile, size_t lda, const bf16_t* Btile, size_t ldb,
                                               int nk, bf16_t* sm, int tid) {
  const int lane = tid & 63, w = tid >> 6, wr = w >> 1, wc = w & 1, l15 = lane & 15, grp = lane >> 4;
  constexpr int TILE = 128 * 64;
  const int sw = (l15 >> 1) & 7;
  const int fo0 = l15 * 64 + ((grp ^ sw) * 8), fo1 = l15 * 64 + (((4 + grp) ^ sw) * 8);
  const int gch = ((tid & 7) ^ ((tid >> 4) & 7)) * 8;
  const bf16_t* ga = Atile + (size_t)(tid >> 3) * lda + gch;
  const bf16_t* gb = Btile + (size_t)(tid >> 3) * ldb + gch;
  const size_t a32 = lda * 32, b32 = ldb * 32;
  bf16_t* lbase = sm + tid * 8;
#define GLDS_ISSUE(KT, BUF)                                                                                                            \
  do {                                                                                                                                 \
    _Pragma("unroll") for (int i_ = 0; i_ < 4; ++i_) {                                                                                 \
      __builtin_amdgcn_global_load_lds((const unsigned*)(ga + i_ * a32 + (KT) * 64), (unsigned*)(lbase + (BUF) * TILE + i_ * 2048), 16, 0, 0);       \
      __builtin_amdgcn_global_load_lds((const unsigned*)(gb + i_ * b32 + (KT) * 64), (unsigned*)(lbase + (2 + (BUF)) * TILE + i_ * 2048), 16, 0, 0); \
    }                                                                                                                                  \
  } while (0)
#define GLDS_COMPUTE(BUF)                                                                             \
  do {                                                                                                \
    const bf16_t* Ab = sm + (BUF) * TILE + wr * 64 * 64;                                              \
    const bf16_t* Bb = sm + (2 + (BUF)) * TILE + wc * 64 * 64;                                        \
    if (HOIST) {                                                                                      \
        \
      bf16x8 a0[4], b0[4], a1[4], b1[4];                                                              \
      const unsigned pa0 = (unsigned)(size_t)(Ab + fo0), pb0 = (unsigned)(size_t)(Bb + fo0);          \
      const unsigned pa1 = (unsigned)(size_t)(Ab + fo1), pb1 = (unsigned)(size_t)(Bb + fo1);          \
      DSR4(a0, pa0); DSR4(b0, pb0); DSR4(a1, pa1); DSR4(b1, pb1);                                     \
      asm volatile("s_waitcnt lgkmcnt(8)" : "+v"(a0[0]), "+v"(a0[1]), "+v"(a0[2]), "+v"(a0[3]), "+v"(b0[0]), "+v"(b0[1]), "+v"(b0[2]), "+v"(b0[3]) :: "memory"); \
      _Pragma("unroll") for (int m = 0; m < 4; ++m)                                                   \
        _Pragma("unroll") for (int n = 0; n < 4; ++n) acc[m][n] = mfma16(b0[n], a0[m], acc[m][n]);    \
      __builtin_amdgcn_sched_barrier(0);             \
      asm volatile("s_waitcnt lgkmcnt(0)" : "+v"(a1[0]), "+v"(a1[1]), "+v"(a1[2]), "+v"(a1[3]), "+v"(b1[0]), "+v"(b1[1]), "+v"(b1[2]), "+v"(b1[3]) :: "memory"); \
      _Pragma("unroll") for (int m = 0; m < 4; ++m)                                                   \
        _Pragma("unroll") for (int n = 0; n < 4; ++n) acc[m][n] = mfma16(b1[n], a1[m], acc[m][n]);    \
      __builtin_amdgcn_sched_barrier(0);             \
    } else {                                                                                          \
      _Pragma("unroll") for (int ks = 0; ks < 2; ++ks) {                                              \
        const int fo = ks ? fo1 : fo0;                                                                \
        bf16x8 a[4], b[4];                                                                            \
        _Pragma("unroll") for (int m = 0; m < 4; ++m) a[m] = *(const bf16x8*)(Ab + m * 16 * 64 + fo); \
        _Pragma("unroll") for (int n = 0; n < 4; ++n) b[n] = *(const bf16x8*)(Bb + n * 16 * 64 + fo); \
        _Pragma("unroll") for (int m = 0; m < 4; ++m)                                                 \
          _Pragma("unroll") for (int n = 0; n < 4; ++n) acc[m][n] = mfma16(b[n], a[m], acc[m][n]);     \
      }                                                                                               \
    }                                                                                                 \
  } while (0)
  asm volatile("s_waitcnt vmcnt(0)" ::: "memory");
  __syncthreads();
  for (int kt = 0; kt < nk; kt += 2) {
    GLDS_ISSUE(kt + 1, 1);
    GLDS_COMPUTE(0);
    asm volatile("s_waitcnt vmcnt(0)" ::: "memory");
    __syncthreads();
    if (kt + 2 < nk) GLDS_ISSUE(kt + 2, 0);
    GLDS_COMPUTE(1);
    asm volatile("s_waitcnt vmcnt(0)" ::: "memory");
    __syncthreads();
  }
#undef GLDS_ISSUE
#undef GLDS_COMPUTE
}

__device__ __forceinline__ void gemm_core_glds_cmp(f32x4 (&acc)[4][4], const bf16_t* colptr, int r0, const bf16_t* Btile, size_t ldb,
                                                   int nk, bf16_t* sm, int tid) {
  const int lane = tid & 63, w = tid >> 6, wr = w >> 1, wc = w & 1, l15 = lane & 15, grp = lane >> 4;
  constexpr int TILE = 128 * 64;
  const int sw = (l15 >> 1) & 7;
  const int fo0 = l15 * 64 + ((grp ^ sw) * 8), fo1 = l15 * 64 + (((4 + grp) ^ sw) * 8);
  const int gch = ((tid & 7) ^ ((tid >> 4) & 7)) * 8;
  const bf16_t* gb = Btile + (size_t)(tid >> 3) * ldb + gch;
  const size_t b32 = ldb * 32;
  bf16_t* lbase = sm + tid * 8;
#define CMP_ISSUE(KT, BUF)                                                                                                             \
  do {                                                                                                                                 \
    _Pragma("unroll") for (int i_ = 0; i_ < 4; ++i_) {                                                                                 \
      int tok_ = 16 * (r0 + 32 * i_) + (KT);                                                                                           \
      tok_ = tok_ > (SEQ - 1) ? (SEQ - 1) : tok_;                                                                                      \
      __builtin_amdgcn_global_load_lds((const unsigned*)(colptr + (size_t)tok_ * 1536), (unsigned*)(lbase + (BUF) * TILE + i_ * 2048), 16, 0, 0);     \
      __builtin_amdgcn_global_load_lds((const unsigned*)(gb + i_ * b32 + (KT) * 64), (unsigned*)(lbase + (2 + (BUF)) * TILE + i_ * 2048), 16, 0, 0); \
    }                                                                                                                                  \
  } while (0)
#define CMP_COMPUTE(BUF)                                                                              \
  do {                                                                                                \
    const bf16_t* Ab = sm + (BUF) * TILE + wr * 64 * 64;                                              \
    const bf16_t* Bb = sm + (2 + (BUF)) * TILE + wc * 64 * 64;                                        \
    _Pragma("unroll") for (int ks = 0; ks < 2; ++ks) {                                                \
      const int fo = ks ? fo1 : fo0;                                                                  \
      bf16x8 a[4], b[4];                                                                              \
      _Pragma("unroll") for (int m = 0; m < 4; ++m) a[m] = *(const bf16x8*)(Ab + m * 16 * 64 + fo);   \
      _Pragma("unroll") for (int n = 0; n < 4; ++n) b[n] = *(const bf16x8*)(Bb + n * 16 * 64 + fo);   \
      _Pragma("unroll") for (int m = 0; m < 4; ++m)                                                   \
        _Pragma("unroll") for (int n = 0; n < 4; ++n) acc[m][n] = mfma16(b[n], a[m], acc[m][n]);     \
    }                                                                                                 \
  } while (0)
  __syncthreads();
  CMP_ISSUE(0, 0);
  asm volatile("s_waitcnt vmcnt(0)" ::: "memory");
  __syncthreads();
  for (int kt = 0; kt < nk; kt += 2) {
    CMP_ISSUE(kt + 1, 1);
    CMP_COMPUTE(0);
    asm volatile("s_waitcnt vmcnt(0)" ::: "memory");
    __syncthreads();
    if (kt + 2 < nk) CMP_ISSUE(kt + 2, 0);
    CMP_COMPUTE(1);
    asm volatile("s_waitcnt vmcnt(0)" ::: "memory");
    __syncthreads();
  }
#undef CMP_ISSUE
#undef CMP_COMPUTE
}

__device__ __forceinline__ void zero_acc(f32x4 (&acc)[4][4]) {
#pragma unroll
  for (int m = 0; m < 4; ++m)
#pragma unroll
    for (int n = 0; n < 4; ++n) acc[m][n] = f32x4{0.f, 0.f, 0.f, 0.f};
}

__device__ __forceinline__ void phase_inproj(const Params& p, int l, char* smraw) {
  bf16_t* sm = (bf16_t*)smraw;
  const bf16_t* H = (const bf16_t*)(p.ws + OFF_H);
  const bf16_t* W = (const bf16_t*)(p.ws + OFF_WINT) + (size_t)l * NP * D;
  bf16_t* yApre = (bf16_t*)(p.ws + OFF_YAPRE);
  bf16_t* bzA = (bf16_t*)(p.ws + OFF_BZA);
  bf16_t* qb = (bf16_t*)(p.ws + OFF_Q);
  bf16_t* zb = (bf16_t*)(p.ws + OFF_ZB);
  bf16_t* uz = (bf16_t*)(p.ws + OFF_UZ);
  bf16_t* gv = (bf16_t*)(p.ws + OFF_GV);
  bf16_t* kvb = (bf16_t*)(p.ws + OFF_KV);
  float* glb = (float*)(p.ws + OFF_GL);
  bf16_t* gates = (bf16_t*)(p.ws + OFF_GATES);
  const int tid = opaque_tid(); const int lane = tid & 63, w = tid >> 6, wr = w >> 1, wc = w & 1, l15 = lane & 15, grp = lane >> 4;
  constexpr int MT = R / 128;
  constexpr int NC = (NT_IN + 7) / 8;
  const int nx = gridDim.x >> 3;
  constexpr int CJ_END = (MT / 8) * NC * 64;
  auto cj_valid = [&](int c) { return c < CJ_END && ((c >> 6) % NC) * 8 + ((c & 63) >> 3) < NT_IN; };
  auto cj_next = [&](int c) {
    do { c = ((c & 63) + nx < 64) ? (c + nx) : (((c >> 6) + 8) * 64 + (int)(blockIdx.x >> 3)); } while (c < CJ_END && !cj_valid(c));
    return c;
  };
  int cj = (blockIdx.x & 7) * 64 + (blockIdx.x >> 3);
  if (!cj_valid(cj)) cj = cj_next(cj);
  __syncthreads();
  if (cj < CJ_END) {
    const int cell = cj >> 6, jj = cj & 63;
    glds_prefetch0(H + (size_t)((cell / NC) * 8 + (jj & 7)) * 128 * D, D, W + (size_t)((cell % NC) * 8 + (jj >> 3)) * 128 * D, D, sm, tid);
  }
  while (cj < CJ_END) {
    const int cell = cj >> 6, jj = cj & 63;
    const int nt = (cell % NC) * 8 + (jj >> 3), mt = (cell / NC) * 8 + (jj & 7);
    f32x4 acc[4][4];
    zero_acc(acc);
    gemm_core_glds<true>(acc, H + (size_t)mt * 128 * D, D, W + (size_t)nt * 128 * D, D, D / 64, sm, tid);
    cj = cj_next(cj);
    if (cj < CJ_END) {
      const int cell2 = cj >> 6, jj2 = cj & 63;
      glds_prefetch0(H + (size_t)((cell2 / NC) * 8 + (jj2 & 7)) * 128 * D, D, W + (size_t)((cell2 % NC) * 8 + (jj2 >> 3)) * 128 * D, D, sm, tid);
    }
    const int rbase = mt * 128 + wr * 64 + l15;
    const int c4 = 4 * grp;
#define ST4(PTR, V0, V1, V2, V3) *(u32x2*)(PTR) = u32x2{pack2((V0), (V1)), pack2((V2), (V3))}
    if (nt < 32) {
      const int ch = nt * 32 + wc * 16 + c4;
#pragma unroll
      for (int m = 0; m < 4; ++m) {
        const size_t row = rbase + m * 16;
        ST4(yApre + row * 1024 + ch, acc[m][1][0] * acc[m][2][0], acc[m][1][1] * acc[m][2][1], acc[m][1][2] * acc[m][2][2], acc[m][1][3] * acc[m][2][3]);
        ST4(bzA + row * 1024 + ch, acc[m][0][0] * silu_(acc[m][3][0]), acc[m][0][1] * silu_(acc[m][3][1]), acc[m][0][2] * silu_(acc[m][3][2]), acc[m][0][3] * silu_(acc[m][3][3]));
      }
    } else if (nt < 40) {
      const int cb = (nt - 32) * 128 + wc * 64 + c4;
      const float qs = 0.125f * 1.44269504f;
#pragma unroll
      for (int m = 0; m < 4; ++m)
#pragma unroll
        for (int n = 0; n < 4; ++n)
          ST4(qb + (size_t)(rbase + m * 16) * 1024 + cb + n * 16, acc[m][n][0] * qs, acc[m][n][1] * qs, acc[m][n][2] * qs, acc[m][n][3] * qs);
    } else if (nt < 52) {
      const int cb = (nt - 40) * 128 + wc * 64 + c4;
#pragma unroll
      for (int m = 0; m < 4; ++m)
#pragma unroll
        for (int n = 0; n < 4; ++n)
          ST4(kvb + (size_t)(rbase + m * 16) * 1536 + cb + n * 16, acc[m][n][0], acc[m][n][1], acc[m][n][2], acc[m][n][3]);
    } else if (nt < 60) {
      const int cb = (nt - 52) * 128 + wc * 64 + c4;
#pragma unroll
      for (int m = 0; m < 4; ++m)
#pragma unroll
        for (int n = 0; n < 4; ++n)
          ST4(zb + (size_t)(rbase + m * 16) * 1024 + cb + n * 16, silu_(acc[m][n][0]), silu_(acc[m][n][1]), silu_(acc[m][n][2]), silu_(acc[m][n][3]));
    } else if (nt == 60) {
      if (wc == 0) {
#pragma unroll
        for (int m = 0; m < 4; ++m)
#pragma unroll
          for (int n = 0; n < 3; ++n)
            *(f32x4*)(glb + (size_t)(rbase + m * 16) * 48 + n * 16 + c4) =
                f32x4{sigmoid_(acc[m][n][0]), sigmoid_(acc[m][n][1]), sigmoid_(acc[m][n][2]), sigmoid_(acc[m][n][3])};
      }
    } else if (nt < 77) {
      const int chb = (nt - 61) * 64 + wc * 32 + c4;
#pragma unroll
      for (int m = 0; m < 4; ++m)
#pragma unroll
        for (int pr = 0; pr < 2; ++pr)
          ST4(uz + (size_t)(rbase + m * 16) * 1024 + chb + pr * 16,
              gelu_(acc[m][2 * pr][0]) * silu_(acc[m][2 * pr + 1][0]), gelu_(acc[m][2 * pr][1]) * silu_(acc[m][2 * pr + 1][1]),
              gelu_(acc[m][2 * pr][2]) * silu_(acc[m][2 * pr + 1][2]), gelu_(acc[m][2 * pr][3]) * silu_(acc[m][2 * pr + 1][3]));
    } else if (nt < 85) {
      const int cb = (nt - 77) * 128 + wc * 64 + c4;
#pragma unroll
      for (int m = 0; m < 4; ++m)
#pragma unroll
        for (int n = 0; n < 4; ++n)
          ST4(gv + (size_t)(rbase + m * 16) * 1024 + cb + n * 16, gelu_(acc[m][n][0]), gelu_(acc[m][n][1]), gelu_(acc[m][n][2]), gelu_(acc[m][n][3]));
    } else {
      const int cb = (nt - 85) * 128 + wc * 64 + c4;
#pragma unroll
      for (int m = 0; m < 4; ++m)
#pragma unroll
        for (int n = 0; n < 4; ++n)
          ST4(gates + (size_t)(rbase + m * 16) * 3072 + cb + n * 16, sigmoid_(acc[m][n][0]), sigmoid_(acc[m][n][1]), sigmoid_(acc[m][n][2]), sigmoid_(acc[m][n][3]));
    }
#undef ST4
  }
}

struct CmpALoader {
  const bf16_t* rowptr;
  int r, soff;
  u32x4 r0, r1;
  __device__ __forceinline__ void load(int kt) {
    int tok = 16 * r + (kt >> 1);
    tok = tok > (SEQ - 1) ? (SEQ - 1) : tok;
    const bf16_t* q = rowptr + (size_t)tok * 1536 + (kt & 1) * 32;
    r0 = *(const u32x4*)q; r1 = *(const u32x4*)(q + 8);
  }
  __device__ __forceinline__ void store(bf16_t* tile) {
    bf16_t* q = tile + soff;
    *(u32x4*)q = r0; *(u32x4*)(q + 8) = r1;
  }
};

__device__ __forceinline__ void phase_mix1(const Params& p, int l, char* smraw) {
  const int tid = opaque_tid(); const int lane = tid & 63, w = tid >> 6, l15 = lane & 15, grp = lane >> 4;
  const bf16_t* gv = (const bf16_t*)(p.ws + OFF_GV);
  float* stats = (float*)(p.ws + OFF_STATS);
  constexpr int NCB = 2 * (NB * 4 * 256 / 128);
  const bool split = (int)gridDim.x >= 2 * NCB;
  const int eb = split ? (int)blockIdx.x - NCB : (int)blockIdx.x;
  const int neb = split ? (int)gridDim.x - NCB : (int)gridDim.x;
  for (int r = eb * 4 + w; eb >= 0 && r < R; r += neb * 4) {
    const bf16_t* row = gv + (size_t)r * 1024;
    float v[16]; float s = 0.f;
#pragma unroll
    for (int i = 0; i < 2; ++i) {
      u32x4 u = *(const u32x4*)(row + i * 512 + lane * 8);
      v[i * 8 + 0] = bf2f(u.x & 0xffffu); v[i * 8 + 1] = bf2f(u.x >> 16);
      v[i * 8 + 2] = bf2f(u.y & 0xffffu); v[i * 8 + 3] = bf2f(u.y >> 16);
      v[i * 8 + 4] = bf2f(u.z & 0xffffu); v[i * 8 + 5] = bf2f(u.z >> 16);
      v[i * 8 + 6] = bf2f(u.w & 0xffffu); v[i * 8 + 7] = bf2f(u.w >> 16);
    }
#pragma unroll
    for (int i = 0; i < 16; ++i) s += v[i];
    s = wave_sum(s, lane);
    float mu = s * (1.f / 1024.f);
    float q = 0.f;
#pragma unroll
    for (int i = 0; i < 16; ++i) { float d = v[i] - mu; q += d * d; }
    q = wave_sum(q, lane);
    if (lane == 0) { stats[r * 2] = mu; stats[r * 2 + 1] = rsqrtf(q * (1.f / 1024.f) + 1e-6f); }
  }
  {
    const bf16_t* yApre = (const bf16_t*)(p.ws + OFF_YAPRE);
    const bf16_t* bzA = (const bf16_t*)(p.ws + OFF_BZA);
    bf16_t* yA = (bf16_t*)(p.ws + OFF_YA);
    const float* cw = p.conv_w + (size_t)l * 3 * 1024;
    const float* cb = p.conv_b + (size_t)l * 1024;
    for (int e = eb * 256 + tid; eb >= 0 && e < R * 128; e += neb * 256) {
      int row = e >> 7, c8 = (e & 127) * 8;
      int t = row & (SEQ - 1);
      u32x4 y2 = *(const u32x4*)(yApre + (size_t)row * 1024 + c8);
      u32x4 y1 = (t >= 1) ? *(const u32x4*)(yApre + (size_t)(row - 1) * 1024 + c8) : u32x4{0, 0, 0, 0};
      u32x4 y0 = (t >= 2) ? *(const u32x4*)(yApre + (size_t)(row - 2) * 1024 + c8) : u32x4{0, 0, 0, 0};
      u32x4 bz = *(const u32x4*)(bzA + (size_t)row * 1024 + c8);
      u32x4 o;
#pragma unroll
      for (int i = 0; i < 4; ++i) {
        int c = c8 + i * 2;
        float r0 = cb[c] + cw[c] * bf2f(y0[i] & 0xffffu) + cw[1024 + c] * bf2f(y1[i] & 0xffffu) + cw[2048 + c] * bf2f(y2[i] & 0xffffu);
        float r1 = cb[c + 1] + cw[c + 1] * bf2f(y0[i] >> 16) + cw[1024 + c + 1] * bf2f(y1[i] >> 16) + cw[2048 + c + 1] * bf2f(y2[i] >> 16);
        o[i] = pack2(bf2f(bz[i] & 0xffffu) * r0, bf2f(bz[i] >> 16) * r1);
      }
      *(u32x4*)(yA + (size_t)row * 1024 + c8) = o;
    }
  }
  {
    bf16_t* sm = (bf16_t*)smraw;
    const bf16_t* kvb = (const bf16_t*)(p.ws + OFF_KV);
    const bf16_t* Wc1T = (const bf16_t*)(p.ws + OFF_WC1T);
    const float* bias1 = (const float*)(p.ws + OFF_BIAS1);
    const int wr = w >> 1, wc = w & 1;
    constexpr int MTC = NB * 4 * 256 / 128;
    for (int t = blockIdx.x; t < 2 * MTC; t += gridDim.x) {
      int kv = t / MTC, mt = t % MTC;
      f32x4 acc[4][4];
      zero_acc(acc);
      {
        const int rr = mt * 128 + (tid >> 3);
        const int bl = rr >> 10, g = (rr >> 8) & 3;
        const int gch = ((tid & 7) ^ ((tid >> 4) & 7)) * 8;
        gemm_core_glds_cmp(acc, kvb + (size_t)bl * SEQ * 1536 + kv * 256 + g * 64 + gch, rr & 255,
                           Wc1T + (size_t)(l * 2 + kv) * 128 * 2048, 2048, 2048 / 64, sm, tid);
      }
      bf16_t* Hs = sm;
      bf16_t* W2s = sm + 128 * HS_LD;
      const float* b1 = bias1 + (l * 2 + kv) * 8 * 128;
#pragma unroll
      for (int n = 0; n < 4; ++n) {
        const int col = wc * 64 + n * 16 + 4 * grp;
        f32x4 bb = f32x4{0.f, 0.f, 0.f, 0.f};
#pragma unroll
        for (int ks = 0; ks < 8; ++ks) bb += *(const f32x4*)(b1 + ks * 128 + col);
#pragma unroll
        for (int m = 0; m < 4; ++m)
          *(u32x2*)(Hs + (wr * 64 + m * 16 + l15) * HS_LD + col) =
              u32x2{pack2(silu_(acc[m][n][0] + bb[0]), silu_(acc[m][n][1] + bb[1])), pack2(silu_(acc[m][n][2] + bb[2]), silu_(acc[m][n][3] + bb[3]))};
      }
      const float* w2 = (kv ? p.w_cv2 : p.w_ck2) + (size_t)l * 128 * 64;
      for (int i = 0; i < 32; ++i) {
        int e = tid + 256 * i;
        int j = e >> 6, d = e & 63;
        W2s[d * HS_LD + j] = f2bf(w2[e]);
      }
      __syncthreads();
      f32x4 a2[2][4];
#pragma unroll
      for (int mm = 0; mm < 2; ++mm)
#pragma unroll
        for (int nn = 0; nn < 4; ++nn) a2[mm][nn] = f32x4{0.f, 0.f, 0.f, 0.f};
#pragma unroll
      for (int ks = 0; ks < 4; ++ks) {
        bf16x8 af[2], bfr[4];
#pragma unroll
        for (int mm = 0; mm < 2; ++mm) af[mm] = *(const bf16x8*)(Hs + (w * 32 + mm * 16 + l15) * HS_LD + ks * 32 + grp * 8);
#pragma unroll
        for (int nn = 0; nn < 4; ++nn) bfr[nn] = *(const bf16x8*)(W2s + (nn * 16 + l15) * HS_LD + ks * 32 + grp * 8);
#pragma unroll
        for (int mm = 0; mm < 2; ++mm)
#pragma unroll
          for (int nn = 0; nn < 4; ++nn) a2[mm][nn] = mfma16(af[mm], bfr[nn], a2[mm][nn]);
      }
      bf16_t* outp = (bf16_t*)(p.ws + (kv ? OFF_VCMP : OFF_KCMP));
#pragma unroll
      for (int mm = 0; mm < 2; ++mm)
#pragma unroll
        for (int nn = 0; nn < 4; ++nn)
#pragma unroll
          for (int j = 0; j < 4; ++j) {
            int row = mt * 128 + w * 32 + mm * 16 + 4 * grp + j;
            outp[(size_t)row * 64 + nn * 16 + l15] = f2bf(a2[mm][nn][j]);
          }
      __syncthreads();
    }
  }
}

struct KVRegs { u32x4 k0, k1, v0, v1; };

__device__ __forceinline__ void kv_issue(KVRegs& r, const bf16_t* kbase, const bf16_t* vbase, size_t ld, bool wantV, int tid) {
  const uint32_t row = (uint32_t)tid >> 3, c = ((uint32_t)tid & 7u) * 8u;
  const uint32_t ldu = (ld == 64 ? 64u : 1536u);
  const uint32_t off = row * ldu + c;
  const bf16_t* kp = kbase + off;
  r.k0 = *(const u32x4*)kp; r.k1 = *(const u32x4*)(kp + 32u * ldu);
  if (wantV) {
    const bf16_t* vp = vbase + off;
    r.v0 = *(const u32x4*)vp; r.v1 = *(const u32x4*)(vp + 32u * ldu);
  }
}
__device__ __forceinline__ void kv_commit(const KVRegs& r, bf16_t* Ks, bf16_t* Vs, bool wantV, int tid) {
  int row = tid >> 3, c = (tid & 7) * 8;
  *(u32x4*)(Ks + row * KS_LD + c) = r.k0;
  *(u32x4*)(Ks + (row + 32) * KS_LD + c) = r.k1;
  if (wantV) {
    *(u32x4*)(Vs + row * KS_LD + c) = r.v0;
    *(u32x4*)(Vs + (row + 32) * KS_LD + c) = r.v1;
  }
}

typedef short s16x4 __attribute__((ext_vector_type(4)));
__device__ __forceinline__ s16x4 tr_read(const bf16_t* ptr) {
  return __builtin_amdgcn_ds_read_tr16_b64_v4i16((s16x4 __attribute__((address_space(3)))*)ptr);
}

#define ADSR(dst, base, OFF) asm volatile("ds_read_b128 %0, %1 offset:" #OFF : "=v"(dst) : "v"(base) : "memory")
#define ATRR(dst, base, OFF) asm volatile("ds_read_b64_tr_b16 %0, %1 offset:" #OFF : "=v"(dst) : "v"(base) : "memory")
template <bool MASKED>
__device__ __forceinline__ void attn_block64(const bf16_t* Ks, const bf16_t* Vs, bf16x8 q0, bf16x8 q1, int tq, int kp0, int kpstride,
                                             int maxdist, bool extra_ok, float slope, float& m, float& lsum, f32x4 (&o)[4], int l15, int grp,
                                             const f32x4 (&tb)[4]) {
  const float fst = (float)kpstride;
  const int d0 = tq - kp0 - 4 * grp * kpstride;
  const float base = -slope * (float)d0;
  const unsigned kaddr = (unsigned)(size_t)(Ks + l15 * KS_LD + grp * 8);
  const unsigned vaddr = (unsigned)(size_t)(Vs + (4 * grp + (l15 >> 2)) * KS_LD + 4 * (l15 & 3));
  bf16x8 kf[8];
  ADSR(kf[0], kaddr, 0);    ADSR(kf[1], kaddr, 64);   ADSR(kf[2], kaddr, 2560); ADSR(kf[3], kaddr, 2624);
  ADSR(kf[4], kaddr, 5120); ADSR(kf[5], kaddr, 5184); ADSR(kf[6], kaddr, 7680); ADSR(kf[7], kaddr, 7744);
  f32x4 s[4];
  asm volatile("s_waitcnt lgkmcnt(6)" : "+v"(kf[0]), "+v"(kf[1]) :: "memory");
  s[0] = mfma16(kf[1], q1, mfma16(kf[0], q0, f32x4{0.f, 0.f, 0.f, 0.f}));
  asm volatile("s_waitcnt lgkmcnt(4)" : "+v"(kf[2]), "+v"(kf[3]) :: "memory");
  s[1] = mfma16(kf[3], q1, mfma16(kf[2], q0, f32x4{0.f, 0.f, 0.f, 0.f}));
  asm volatile("s_waitcnt lgkmcnt(2)" : "+v"(kf[4]), "+v"(kf[5]) :: "memory");
  s[2] = mfma16(kf[5], q1, mfma16(kf[4], q0, f32x4{0.f, 0.f, 0.f, 0.f}));
  asm volatile("s_waitcnt lgkmcnt(0)" : "+v"(kf[6]), "+v"(kf[7]) :: "memory");
  s[3] = mfma16(kf[7], q1, mfma16(kf[6], q0, f32x4{0.f, 0.f, 0.f, 0.f}));
  s16x4 vt[16];
  ATRR(vt[0], vaddr, 0);     ATRR(vt[1], vaddr, 2560);  ATRR(vt[2], vaddr, 32);    ATRR(vt[3], vaddr, 2592);
  ATRR(vt[4], vaddr, 64);    ATRR(vt[5], vaddr, 2624);  ATRR(vt[6], vaddr, 96);    ATRR(vt[7], vaddr, 2656);
  ATRR(vt[8], vaddr, 5120);  ATRR(vt[9], vaddr, 7680);  ATRR(vt[10], vaddr, 5152); ATRR(vt[11], vaddr, 7712);
  ATRR(vt[12], vaddr, 5184); ATRR(vt[13], vaddr, 7744); ATRR(vt[14], vaddr, 5216); ATRR(vt[15], vaddr, 7776);
  float cmax = -1e30f;
#pragma unroll
  for (int t = 0; t < 4; ++t)
#pragma unroll
    for (int j = 0; j < 4; ++j) {
      const int ci = t * 16 + j;
      float v = __builtin_fmaf(tb[t][j], fst, s[t][j]);
      if (MASKED) {
        const int dist = d0 - ci * kpstride;
        const bool valid = extra_ok && dist >= 0 && dist < maxdist;
        v = valid ? v : -1e30f;
      }
      s[t][j] = v;
      cmax = fmaxf(cmax, v);
    }
  if (!MASKED) cmax = extra_ok ? cmax : -1e30f;
  if (__ballot(cmax + base > m + 40.f) != 0ull) {
    cmax = (cmax > -1e29f) ? cmax + base : -1e30f;
    cmax = fmaxf(cmax, bperm(cmax, (l15 + 16 * grp) ^ 16));
    cmax = fmaxf(cmax, bperm(cmax, (l15 + 16 * grp) ^ 32));
    const float mnew = fmaxf(m, cmax);
    const float alpha = __builtin_amdgcn_exp2f(m - mnew);
    lsum *= alpha;
#pragma unroll
    for (int dt = 0; dt < 4; ++dt) o[dt] *= alpha;
    m = mnew;
  }
  float psum = 0.f;
  const float mb = m - base;
#pragma unroll
  for (int t = 0; t < 4; ++t)
#pragma unroll
    for (int j = 0; j < 4; ++j) {
      const float v = s[t][j];
      float pe = __builtin_amdgcn_exp2f(v - mb);
      if (MASKED) pe = (v > -1e29f) ? pe : 0.f;
      s[t][j] = pe;
      psum += pe;
    }
  if (!MASKED) psum = extra_ok ? psum : 0.f;
  lsum += psum;
  const uint32_t rowm = (MASKED || extra_ok) ? 0xffffffffu : 0u;
  asm volatile("s_waitcnt lgkmcnt(0)"
               : "+v"(vt[0]), "+v"(vt[1]), "+v"(vt[2]), "+v"(vt[3]), "+v"(vt[4]), "+v"(vt[5]), "+v"(vt[6]), "+v"(vt[7]),
                 "+v"(vt[8]), "+v"(vt[9]), "+v"(vt[10]), "+v"(vt[11]), "+v"(vt[12]), "+v"(vt[13]), "+v"(vt[14]), "+v"(vt[15])
               :: "memory");
#pragma unroll
  for (int sc = 0; sc < 2; ++sc) {
    const bf16x8 pb = __builtin_bit_cast(bf16x8, u32x4{pack2(s[2 * sc][0], s[2 * sc][1]) & rowm, pack2(s[2 * sc][2], s[2 * sc][3]) & rowm,
                                                       pack2(s[2 * sc + 1][0], s[2 * sc + 1][1]) & rowm, pack2(s[2 * sc + 1][2], s[2 * sc + 1][3]) & rowm});
#pragma unroll
    for (int dt = 0; dt < 4; ++dt) {
      const s16x4 vlo = vt[sc * 8 + dt * 2], vhi = vt[sc * 8 + dt * 2 + 1];
      const bf16x8 vf = {vlo[0], vlo[1], vlo[2], vlo[3], vhi[0], vhi[1], vhi[2], vhi[3]};
      o[dt] = mfma16(vf, pb, o[dt]);
    }
  }
}

constexpr int ATT_TILE = 64 * KS_LD * 2;
constexpr int ATT_BUF = 2 * ATT_TILE;

template <class DescF, class ProcF>
__device__ __forceinline__ void kv_stream_run(int n, DescF desc, ProcF proc, char* smraw, int tid, KVRegs& r0, KVRegs& r1) {
  const bf16_t *kp, *vp; size_t ld;
  __syncthreads();
  kv_commit(r0, (bf16_t*)smraw, (bf16_t*)(smraw + ATT_TILE), true, tid);
  desc(2 < n ? 2 : n - 1, kp, vp, ld); kv_issue(r0, kp, vp, ld, true, tid);
  __syncthreads();
  for (int e0 = 0; e0 < n; e0 += 2) {
    {
      const int e = e0;
      proc(e, (const bf16_t*)smraw, (const bf16_t*)(smraw + ATT_TILE));
      kv_commit(r1, (bf16_t*)(smraw + ATT_BUF), (bf16_t*)(smraw + ATT_BUF + ATT_TILE), true, tid);
      desc(e + 3 < n ? e + 3 : n - 1, kp, vp, ld); kv_issue(r1, kp, vp, ld, true, tid);
      __syncthreads();
    }
    {
      const int e = e0 + 1;
      if (e < n) proc(e, (const bf16_t*)(smraw + ATT_BUF), (const bf16_t*)(smraw + ATT_BUF + ATT_TILE));
      kv_commit(r0, (bf16_t*)smraw, (bf16_t*)(smraw + ATT_TILE), true, tid);
      desc(e + 3 < n ? e + 3 : n - 1, kp, vp, ld); kv_issue(r0, kp, vp, ld, true, tid);
      __syncthreads();
    }
  }
}

template <class DescF, class ProcF>
__device__ __forceinline__ void kv_stream(int n, DescF desc, ProcF proc, char* smraw, int tid) {
  if (n <= 0) return;
  KVRegs r0, r1;
  const bf16_t *kp, *vp; size_t ld;
  desc(0, kp, vp, ld); kv_issue(r0, kp, vp, ld, true, tid);
  desc(1 < n ? 1 : n - 1, kp, vp, ld); kv_issue(r1, kp, vp, ld, true, tid);
  kv_stream_run(n, desc, proc, smraw, tid, r0, r1);
}

__device__ __forceinline__ void attn_unit(const Params& p, char* smraw, int bl, int g, int qb) {
  float* impbuf = (float*)(smraw + 2 * ATT_BUF);
  unsigned long long* selmask = (unsigned long long*)(smraw + 2 * ATT_BUF + 16640);
  int* sellist = (int*)(smraw + 2 * ATT_BUF + 16640 + 128);
  const bf16_t* qbuf = (const bf16_t*)(p.ws + OFF_Q);
  const bf16_t* zbuf = (const bf16_t*)(p.ws + OFF_ZB);
  const bf16_t* kvb = (const bf16_t*)(p.ws + OFF_KV);
  const float* glb = (const float*)(p.ws + OFF_GL);
  bf16_t* yB = (bf16_t*)(p.ws + OFF_YB);
  const int tid = opaque_tid(); const int lane = tid & 63, n = tid >> 6, l15 = lane & 15, grp = lane >> 4;
  const int h = g * 4 + n, t0 = qb * 16, tq = t0 + l15;
  const float slope = exp2f(-0.5f * (float)(h + 1)) * 1.44269504f;
  f32x4 tb[4];
#pragma unroll
  for (int t = 0; t < 4; ++t) tb[t] = f32x4{slope * (float)(16 * t), slope * (float)(16 * t + 1), slope * (float)(16 * t + 2), slope * (float)(16 * t + 3)};
  const size_t rowq = (size_t)bl * SEQ + tq;
  bf16x8 q0, q1;
  {
    const bf16_t* qp = qbuf + rowq * 1024 + h * 64 + grp * 8;
    q0 = *(const bf16x8*)qp; q1 = *(const bf16x8*)(qp + 32);
  }
  const float g0 = glb[rowq * 48 + h * 3 + 0], g1 = glb[rowq * 48 + h * 3 + 1], g2 = glb[rowq * 48 + h * 3 + 2];
  f32x4 otot[4];
#pragma unroll
  for (int dt = 0; dt < 4; ++dt) otot[dt] = f32x4{0.f, 0.f, 0.f, 0.f};
  const size_t seqbase = (size_t)bl * SEQ * 1536 + g * 64;
  const int BIG = 1 << 30;
  const bf16_t* kcb = (const bf16_t*)(p.ws + OFF_KCMP) + (size_t)(bl * 4 + g) * 256 * 64;
  const bf16_t* vcb = (const bf16_t*)(p.ws + OFF_VCMP) + (size_t)(bl * 4 + g) * 256 * 64;
  const bf16_t* kwb = kvb + seqbase + 1024;
  const bf16_t* vwb = kvb + seqbase + 1280;
  const bf16_t* ksb = kvb + seqbase + 512;
  const bf16_t* vsb = kvb + seqbase + 768;

  float m = -1e30f, lsum = 0.f;
  f32x4 o[4];
#pragma unroll
  for (int dt = 0; dt < 4; ++dt) o[dt] = f32x4{0.f, 0.f, 0.f, 0.f};
  float m_c = -1e30f, inv_c = 0.f, prev_rot = 0.f;
  float* myimp = impbuf + n * 1040;
#pragma unroll
  for (int i = 0; i < 16; ++i) myimp[i * 65 + lane] = 0.f;

  int lo = t0 - 511; lo = lo < 0 ? 0 : lo;
  const int wlo = lo >> 6, whi = t0 >> 6, nW = whi - wlo + 1;
  const int nck = (qb + 63) >> 6;
  auto finish = [&](float gate) -> float {
    float lt = lsum + bperm(lsum, lane ^ 16);
    lt += bperm(lt, lane ^ 32);
    const float inv = lt > 0.f ? 1.f / lt : 0.f;
    const float sc_ = gate * inv;
#pragma unroll
    for (int dt = 0; dt < 4; ++dt) { otot[dt] += o[dt] * sc_; o[dt] = f32x4{0.f, 0.f, 0.f, 0.f}; }
    lsum = 0.f;
    return inv;
  };
  kv_stream(nW + 2 * nck,
    [&](int e, const bf16_t*& kp, const bf16_t*& vp, size_t& ld) {
      if (e < nW) { const size_t off = (size_t)(whi - e) * 64 * 1536; kp = kwb + off; vp = vwb + off; ld = 1536; }
      else { const int c = (e < nW + nck) ? (nW + nck - 1 - e) : (e - nW - nck); kp = kcb + c * 4096; vp = vcb + c * 4096; ld = 64; }
    },
    [&](int e, const bf16_t* Ks, const bf16_t* Vt) {
      if (e < nW) {
        const int wb = whi - e;
        if (wb < whi && wb * 64 >= t0 - 496) attn_block64<false>(Ks, Vt, q0, q1, tq, wb * 64, 1, 512, true, slope, m, lsum, o, l15, grp, tb);
        else attn_block64<true>(Ks, Vt, q0, q1, tq, wb * 64, 1, 512, true, slope, m, lsum, o, l15, grp, tb);
        if (e == nW - 1) { (void)finish(g2); m = -1e30f; }
      } else if (e < nW + nck) {
        const int c = nW + nck - 1 - e;
        if (16 * (64 * c + 63) + 31 <= t0) attn_block64<false>(Ks, Vt, q0, q1, tq, 1024 * c + 31, 16, BIG, true, slope, m, lsum, o, l15, grp, tb);
        else attn_block64<true>(Ks, Vt, q0, q1, tq, 1024 * c + 31, 16, BIG, true, slope, m, lsum, o, l15, grp, tb);
        if (e == nW + nck - 1) { inv_c = finish(g0); m_c = m; m = -1e30f; }
      } else {
        const int c = e - nW - nck;
#pragma unroll
        for (int tt = 0; tt < 4; ++tt) {
          const bf16_t* krp = Ks + (tt * 16 + l15) * KS_LD + grp * 8;
          bf16x8 k0 = *(const bf16x8*)krp, k1 = *(const bf16x8*)(krp + 32);
          f32x4 z = f32x4{0.f, 0.f, 0.f, 0.f};
          z = mfma16(k0, q0, z);
          z = mfma16(k1, q1, z);
          float sum4 = 0.f, p3 = 0.f;
#pragma unroll
          for (int j = 0; j < 4; ++j) {
            int kidx = c * 64 + tt * 16 + 4 * grp + j;
            int dist = tq - (16 * kidx + 31);
            float pe = (dist >= 0) ? __builtin_amdgcn_exp2f(z[j] - slope * (float)dist - m_c) * inv_c : 0.f;
            sum4 += pe;
            if (j == 3) p3 = pe;
          }
          float rot = bperm(p3, (lane + 48) & 63);
          float extra = (grp == 0) ? prev_rot : rot;
          myimp[l15 * 65 + (c * 4 + tt) * 4 + grp] = sum4 + extra;
          prev_rot = rot;
        }
      }
    }, smraw, tid);
  KVRegs sr0, sr1;
  {
    const int b0 = whi, b1 = whi > 0 ? whi - 1 : 0;
    kv_issue(sr0, ksb + (size_t)b0 * 64 * 1536, vsb + (size_t)b0 * 64 * 1536, 1536, true, tid);
    kv_issue(sr1, ksb + (size_t)b1 * 64 * 1536, vsb + (size_t)b1 * 64 * 1536, 1536, true, tid);
  }
  if (nck < 4 && grp == 0) myimp[l15 * 65 + nck * 16] = prev_rot;
  __syncthreads();
#pragma unroll 1
  for (int i = 0; i < 4; ++i) {
    int qi = n * 4 + i;
    const int cur = t0 >> 6, s = lane;
    float imp = impbuf[qi * 65 + s] + impbuf[1040 + qi * 65 + s] + impbuf[2080 + qi * 65 + s] + impbuf[3120 + qi * 65 + s];
    bool forced = (s == 0) || (s == cur) || (s == cur - 1);
    bool valid = s <= cur;
    float score = forced ? __builtin_inff() : (valid ? imp : -__builtin_inff());
    unsigned long long mk;
    if (cur < 16) {
      mk = __ballot(valid);
    } else {
      const int key = (int)(((forced ? 0x7F800000u : __float_as_uint(imp)) & 0xFFFFFFC0u) | (unsigned)(63 - s));
      int rank = 0;
#pragma unroll 8
      for (int sp = 0; sp <= cur; ++sp)
        rank += (__builtin_amdgcn_readlane(key, sp) > key) ? 1 : 0;
      mk = __ballot((rank < 16) && valid);
    }
    if (lane == 0) selmask[qi] = mk;
  }
  __syncthreads();
  const unsigned long long mymask = selmask[l15];
  unsigned long long U = 0, Uand = ~0ull;
#pragma unroll
  for (int i = 0; i < 16; ++i) { const unsigned long long mk = selmask[i]; U |= mk; Uand &= mk; }
  {
    uint32_t ulo = __builtin_amdgcn_readfirstlane((uint32_t)U), uhi = __builtin_amdgcn_readfirstlane((uint32_t)(U >> 32));
    U = ((unsigned long long)uhi << 32) | ulo;
    ulo = __builtin_amdgcn_readfirstlane((uint32_t)Uand); uhi = __builtin_amdgcn_readfirstlane((uint32_t)(Uand >> 32));
    Uand = ((unsigned long long)uhi << 32) | ulo;
  }
  const int nsel = __popcll(U);
  if (n == 0) {
    if ((U >> lane) & 1ull) sellist[__popcll(U >> lane) - 1] = lane;
  }
  __syncthreads();
  kv_stream_run(nsel,
    [&](int e, const bf16_t*& kp, const bf16_t*& vp, size_t& ld) {
      const int s = __builtin_amdgcn_readfirstlane(sellist[e]);
      const size_t off = (size_t)s * 64 * 1536; kp = ksb + off; vp = vsb + off; ld = 1536;
    },
    [&](int e, const bf16_t* Ks, const bf16_t* Vt) {
      const int s = __builtin_amdgcn_readfirstlane(sellist[e]);
      const bool ok = (mymask >> s) & 1ull;
      if (s < whi) attn_block64<false>(Ks, Vt, q0, q1, tq, s * 64, 1, BIG, ok, slope, m, lsum, o, l15, grp, tb);
      else attn_block64<true>(Ks, Vt, q0, q1, tq, s * 64, 1, BIG, ok, slope, m, lsum, o, l15, grp, tb);
    }, smraw, tid, sr0, sr1);
  (void)finish(g1);
#pragma unroll
  for (int dt = 0; dt < 4; ++dt) {
    size_t off = rowq * 1024 + h * 64 + dt * 16 + 4 * grp;
    u32x2 zz = *(const u32x2*)(zbuf + off);
    u32x2 ov;
    ov.x = pack2(otot[dt][0] * bf2f(zz.x & 0xffffu), otot[dt][1] * bf2f(zz.x >> 16));
    ov.y = pack2(otot[dt][2] * bf2f(zz.y & 0xffffu), otot[dt][3] * bf2f(zz.y >> 16));
    *(u32x2*)(yB + off) = ov;
  }
}

struct GmlpBLoader {
  const bf16_t* gvbase;
  const float* stats;
  const float* lg; const float* lb;
  int tid;
  u32x4 r[2]; f32x2 st[2];
  __device__ __forceinline__ void load(int kt) {
#pragma unroll
    for (int i = 0; i < 2; ++i) {
      int v = tid + 256 * i;
      int j = kt * 32 + (v >> 4), c8 = (v & 15) * 8;
      r[i] = *(const u32x4*)(gvbase + (size_t)j * 1024 + c8);
      st[i] = *(const f32x2*)(stats + j * 2);
    }
  }
  __device__ __forceinline__ void store(bf16_t* tile) {
#pragma unroll
    for (int i = 0; i < 2; ++i) {
      int v = tid + 256 * i;
      int jl = v >> 4, c8 = (v & 15) * 8;
      const u32x4 u = r[i];
#pragma unroll
      for (int e = 0; e < 4; ++e) {
        int c = c8 + 2 * e;
        float a = (bf2f(u[e] & 0xffffu) - st[i].x) * st[i].y * lg[c] + lb[c];
        float b = (bf2f(u[e] >> 16) - st[i].x) * st[i].y * lg[c + 1] + lb[c + 1];
        tile[c * LDK + jl] = f2bf(a);
        tile[(c + 1) * LDK + jl] = f2bf(b);
      }
    }
  }
};

__device__ __forceinline__ void gmlp_unit(const Params& p, int l, char* smraw, int bl, int chunk, int g) {
  bf16_t* sm = (bf16_t*)smraw;
  const int tid = opaque_tid(); const int lane = tid & 63, w = tid >> 6, wr = w >> 1, wc = w & 1, l15 = lane & 15, grp = lane >> 4;
  const size_t row0 = (size_t)bl * SEQ + chunk * 128;
  f32x4 acc[4][4];
  zero_acc(acc);
  StdLoader al;
  al.init((const bf16_t*)(p.ws + OFF_WM) + (size_t)(l * 8 + g) * 128 * 128, 128, tid);
  GmlpBLoader bl_;
  bl_.tid = tid;
  bl_.gvbase = (const bf16_t*)(p.ws + OFF_GV) + row0 * 1024 + g * 128;
  bl_.stats = (const float*)(p.ws + OFF_STATS) + row0 * 2;
  bl_.lg = p.ln_g + l * 1024 + g * 128;
  bl_.lb = p.ln_b + l * 1024 + g * 128;
  gemm_core(acc, al, bl_, 4, sm, tid);
  const bf16_t* uz = (const bf16_t*)(p.ws + OFF_UZ);
  bf16_t* yC = (bf16_t*)(p.ws + OFF_YC);
  const float* bs = p.b_s + (size_t)(l * 8 + g) * 128;
#pragma unroll
  for (int m = 0; m < 4; ++m)
#pragma unroll
    for (int j = 0; j < 4; ++j) {
      int i = wr * 64 + m * 16 + 4 * grp + j;
      float bb = bs[i];
#pragma unroll
      for (int n = 0; n < 4; ++n) {
        size_t off = (row0 + i) * 1024 + g * 128 + wc * 64 + n * 16 + l15;
        yC[off] = f2bf(bf2f(uz[off]) * (acc[m][n][j] + bb));
      }
    }
}

__device__ __forceinline__ void phase_mix2(const Params& p, int l, char* smraw) {
  constexpr int NATT = NB * 4 * 256, NGM = NB * 32 * 8;
  for (int u = blockIdx.x; u < NATT + NGM; u += gridDim.x) {
    if (u < NATT) {
      int qb = 255 - (u / (NB * 4)), r = u % (NB * 4);
      attn_unit(p, smraw, r >> 2, r & 3, qb);
    } else {
      int v = u - NATT;
      gmlp_unit(p, l, smraw, v >> 8, (v >> 3) & 31, v & 7);
    }
  }
}

__device__ __forceinline__ void phase_merge(const Params& p, int l, char* smraw) {
  bf16_t* sm = (bf16_t*)smraw;
  const bf16_t* WbrT = (const bf16_t*)(p.ws + OFF_WBRT) + (size_t)l * 3 * D * D;
  const bf16_t* gates = (const bf16_t*)(p.ws + OFF_GATES);
  bf16_t* merged = (bf16_t*)(p.ws + OFF_H);
  const int tid = opaque_tid(); const int lane = tid & 63, w = tid >> 6, wr = w >> 1, wc = w & 1, l15 = lane & 15, grp = lane >> 4;
  const int nx = gridDim.x >> 3;
  constexpr int CJ_END = (R / 1024) * 64;
  auto cj_next = [&](int c) { return ((c & 63) + nx < 64) ? (c + nx) : (((c >> 6) + 8) * 64 + (int)(blockIdx.x >> 3)); };
  auto ybuf = [&](int i) { return (const bf16_t*)(p.ws + (i == 0 ? OFF_YA : (i == 1 ? OFF_YB : OFF_YC))); };
  int cj = (blockIdx.x & 7) * 64 + (blockIdx.x >> 3);
  __syncthreads();
  if (cj < CJ_END) glds_prefetch0(ybuf(0) + (size_t)((cj >> 6) * 8 + (cj & 7)) * 128 * D, D, WbrT + (size_t)((cj & 63) >> 3) * 128 * D, D, sm, tid);
  for (; cj < CJ_END; cj = cj_next(cj)) {
    const int nt = (cj & 63) >> 3, mt = (cj >> 6) * 8 + (cj & 7);
    const int rbase = mt * 128 + wr * 64 + l15, cbase = nt * 128 + wc * 64 + 4 * grp;
    f32x4 tot[4][4];
    zero_acc(tot);
#pragma unroll 1
    for (int i = 0; i < 3; ++i) {
      f32x4 acc[4][4];
      zero_acc(acc);
      const bf16_t* Y = ybuf(i);
      gemm_core_glds<false>(acc, Y + (size_t)mt * 128 * D, D, WbrT + (size_t)i * D * D + (size_t)nt * 128 * D, D, D / 64, sm, tid);
      if (i < 2) {
        glds_prefetch0(ybuf(i + 1) + (size_t)mt * 128 * D, D, WbrT + (size_t)(i + 1) * D * D + (size_t)nt * 128 * D, D, sm, tid);
      } else {
        const int c2 = cj_next(cj);
        if (c2 < CJ_END) glds_prefetch0(ybuf(0) + (size_t)((c2 >> 6) * 8 + (c2 & 7)) * 128 * D, D, WbrT + (size_t)((c2 & 63) >> 3) * 128 * D, D, sm, tid);
      }
#pragma unroll
      for (int m = 0; m < 4; ++m)
#pragma unroll
        for (int n = 0; n < 4; ++n) {
          const u32x2 gt = *(const u32x2*)(gates + (size_t)(rbase + m * 16) * 3072 + i * 1024 + cbase + n * 16);
          tot[m][n][0] += bf2f(gt.x & 0xffffu) * acc[m][n][0];
          tot[m][n][1] += bf2f(gt.x >> 16) * acc[m][n][1];
          tot[m][n][2] += bf2f(gt.y & 0xffffu) * acc[m][n][2];
          tot[m][n][3] += bf2f(gt.y >> 16) * acc[m][n][3];
        }
    }
#pragma unroll
    for (int m = 0; m < 4; ++m)
#pragma unroll
      for (int n = 0; n < 4; ++n)
        *(u32x2*)(merged + (size_t)(rbase + m * 16) * 1024 + cbase + n * 16) = u32x2{pack2(tot[m][n][0], tot[m][n][1]), pack2(tot[m][n][2], tot[m][n][3])};
  }
}

__device__ __forceinline__ void phase_outproj(const Params& p, int l, char* smraw) {
  bf16_t* sm = (bf16_t*)smraw;
  const bf16_t* WoutT = (const bf16_t*)(p.ws + OFF_WOUTT) + (size_t)l * D * D;
  const bf16_t* merged = (const bf16_t*)(p.ws + OFF_H);
  bf16_t* opre = (bf16_t*)(p.ws + OFF_YAPRE);
  const int tid = opaque_tid(); const int lane = tid & 63, w = tid >> 6, wr = w >> 1, wc = w & 1, l15 = lane & 15, grp = lane >> 4;
  const int nx = gridDim.x >> 3;
  constexpr int CJ_END = (R / 1024) * 64;
  auto cj_next = [&](int c) { return ((c & 63) + nx < 64) ? (c + nx) : (((c >> 6) + 8) * 64 + (int)(blockIdx.x >> 3)); };
  int cj = (blockIdx.x & 7) * 64 + (blockIdx.x >> 3);
  __syncthreads();
  if (cj < CJ_END) glds_prefetch0(merged + (size_t)((cj >> 6) * 8 + (cj & 7)) * 128 * D, D, WoutT + (size_t)((cj & 63) >> 3) * 128 * D, D, sm, tid);
  for (; cj < CJ_END; cj = cj_next(cj)) {
    const int nt = (cj & 63) >> 3, mt = (cj >> 6) * 8 + (cj & 7);
    f32x4 acc[4][4];
    zero_acc(acc);
    gemm_core_glds<true>(acc, merged + (size_t)mt * 128 * D, D, WoutT + (size_t)nt * 128 * D, D, D / 64, sm, tid);
    {
      const int c2 = cj_next(cj);
      if (c2 < CJ_END) glds_prefetch0(merged + (size_t)((c2 >> 6) * 8 + (c2 & 7)) * 128 * D, D, WoutT + (size_t)((c2 & 63) >> 3) * 128 * D, D, sm, tid);
    }
    const int rbase = mt * 128 + wr * 64 + l15, cbase = nt * 128 + wc * 64 + 4 * grp;
#pragma unroll
    for (int m = 0; m < 4; ++m)
#pragma unroll
      for (int n = 0; n < 4; ++n)
        *(u32x2*)(opre + (size_t)(rbase + m * 16) * 1024 + cbase + n * 16) = u32x2{pack2(acc[m][n][0], acc[m][n][1]), pack2(acc[m][n][2], acc[m][n][3])};
  }
}

#define XB_TMO      128
#define XB_XCNT(j)  (256  + 64 * (j))
#define XB_XSUB(j)  (1280 + 64 * (j))
#define XB_XGEN(j)  (2304 + 64 * (j))
#define XB_TOP      3328
#define XB_TOPGEN   3392
#define XCD_BAR_WORDS 3456
#define XB_SPIN_CAP (1u << 18)
#define LAS __attribute__((address_space(3)))

__device__ __forceinline__ unsigned xb_ld(unsigned* p)              { return __hip_atomic_load(p, __ATOMIC_RELAXED, __HIP_MEMORY_SCOPE_AGENT); }
__device__ __forceinline__ unsigned xb_add(unsigned* p, unsigned v) { return __hip_atomic_fetch_add(p, v, __ATOMIC_RELAXED, __HIP_MEMORY_SCOPE_AGENT); }
__device__ __forceinline__ unsigned xb_xcc_id() { return (unsigned)__builtin_amdgcn_s_getreg((3 << 11) | 20) & 0xFu; }
#define XB_SPIN(cond, bar) do { unsigned _sp = 0; while (cond) { __builtin_amdgcn_s_sleep(1); \
    if ((++_sp & 255u) == 0u) { if (xb_ld(&(bar)[XB_TMO])) break; if (_sp > XB_SPIN_CAP) { atomicAdd(&(bar)[XB_TMO], 1u); break; } } } } while (0)

struct XcdBarrier {
    unsigned* bar; unsigned x;
    volatile LAS unsigned* st;
};

__device__ __forceinline__ XcdBarrier xcd_barrier_post(unsigned* bar, volatile LAS unsigned* st) {
    XcdBarrier b; b.bar = bar; b.x = xb_xcc_id(); b.st = st;
    if (threadIdx.x == 0) (void)xb_add(&bar[XB_XCNT(b.x)], 1u);
    return b;
}
__device__ __forceinline__ void xcd_barrier_complete(unsigned* bar, unsigned x, unsigned& nloc, unsigned& nx) {
    const unsigned G = gridDim.x * gridDim.y * gridDim.z;
    unsigned sum, cnt, mine, sp = 0u;
    for (;;) {
        sum = 0u; cnt = 0u; mine = 0u;
#pragma unroll
        for (unsigned j = 0; j < 16; ++j) { const unsigned c = xb_ld(&bar[XB_XCNT(j)]); sum += c; cnt += (c > 0u) ? 1u : 0u; mine = (j == x) ? c : mine; }
        if (sum == G) break;
        __builtin_amdgcn_s_sleep(1);
        if ((++sp & 255u) == 0u) { if (xb_ld(&bar[XB_TMO])) break; if (sp > XB_SPIN_CAP) { atomicAdd(&bar[XB_TMO], 1u); break; } }
    }
    nloc = mine > 0u ? mine : 1u; nx = cnt > 0u ? cnt : 1u;
}
__device__ __forceinline__ void xcd_barrier(const XcdBarrier& b) {
    asm volatile("s_waitcnt vmcnt(0)" ::: "memory");
    __syncthreads();
    if (threadIdx.x == 0) {
        unsigned* bar = b.bar;
        __builtin_amdgcn_s_waitcnt(0);
        unsigned nloc = b.st[0], nx = b.st[1];
        if (nloc == 0u) { xcd_barrier_complete(bar, b.x, nloc, nx); b.st[0] = nloc; b.st[1] = nx; }
        const unsigned old = xb_add(&bar[XB_XSUB(b.x)], 1u);
        const unsigned gen = old / nloc;
        if (old + 1u == (gen + 1u) * nloc) {
            __builtin_amdgcn_fence(__ATOMIC_RELEASE, "agent");
            asm volatile("s_waitcnt vmcnt(0)" ::: "memory");
            const unsigned og = xb_add(&bar[XB_TOP], 1u);
            const unsigned tg = og / nx;
            if (og + 1u == (tg + 1u) * nx) xb_add(&bar[XB_TOPGEN], 1u);
            else XB_SPIN(xb_ld(&bar[XB_TOPGEN]) == tg, bar);
            __builtin_amdgcn_fence(__ATOMIC_ACQUIRE, "agent");
            xb_add(&bar[XB_XGEN(b.x)], 1u);
            asm volatile("s_waitcnt vmcnt(0)" ::: "memory");
        } else {
            XB_SPIN(xb_ld(&bar[XB_XGEN(b.x)]) == gen, bar);
            __builtin_amdgcn_fence(__ATOMIC_ACQUIRE, "agent");
            asm volatile("s_waitcnt vmcnt(0)" ::: "memory");
        }
    }
    __syncthreads();
}

__global__ void __launch_bounds__(256, 2) hybrid_fwd(Params p) {
  __shared__ __attribute__((aligned(16))) char smraw[SMEM_BYTES];
  cg::grid_group grid = cg::this_grid();
  if (threadIdx.x == 0) *(u32x4*)(smraw + 65536) = u32x4{0u, 0u, 0u, 0u};
  __syncthreads();
  const XcdBarrier xb = xcd_barrier_post((unsigned*)(p.ws + OFF_BAR), (volatile LAS unsigned*)(smraw + 65536));
  phase0(p, smraw);
  grid.sync();
  for (int gi = 0; gi < NGRP; ++gi) {
    phase_h0(p, gi);
    xcd_barrier(xb);
    for (int l = 0; l < DEPTH; ++l) {
      phase_inproj(p, l, smraw);
      xcd_barrier(xb);
      phase_mix1(p, l, smraw);
      xcd_barrier(xb);
      phase_mix2(p, l, smraw);
      xcd_barrier(xb);
      phase_merge(p, l, smraw);
      xcd_barrier(xb);
      phase_outproj(p, l, smraw);
      xcd_barrier(xb);
      phase_final(p, gi, l);
      xcd_barrier(xb);
    }
  }
}

extern "C" void kernel_launch(void* const* d_in, const int* in_sizes, int n_in, void* d_out, int out_size, void* d_ws,
                              size_t ws_size, hipStream_t stream) {
  static int grid_blocks = 0;
  if (!grid_blocks) {
    int dev = 0, cus = 0, per_cu = 0;
    hipGetDevice(&dev);
    hipDeviceGetAttribute(&cus, hipDeviceAttributeMultiprocessorCount, dev);
    hipOccupancyMaxActiveBlocksPerMultiprocessor(&per_cu, hybrid_fwd, 256, 0);
    if (per_cu < 1) per_cu = 1;
    if (per_cu > 2) per_cu = 2;
    grid_blocks = cus * per_cu;
    if (ws_size < WS_END) fprintf(stderr, "kernel_launch: workspace too small: %zu < %zu\n", ws_size, (size_t)WS_END);
  }
  Params p{};
  const float** pp = (const float**)&p;
  for (int i = 0; i < 21; ++i) pp[i] = (const float*)d_in[i];
  p.out = (float*)d_out;
  p.ws = (unsigned char*)d_ws;
  (void)hipMemsetAsync((char*)d_ws + OFF_BAR, 0, 3456 * 4, stream);
  void* args[] = {&p};
  hipError_t e = hipLaunchCooperativeKernel((void*)hybrid_fwd, dim3(grid_blocks), dim3(256), args, 0, stream);
  if (e != hipSuccess) fprintf(stderr, "cooperative launch failed: %s (grid %d)\n", hipGetErrorString(e), grid_blocks);
}
```

```cpp
#include <hip/hip_runtime.h>
#include <hip/hip_cooperative_groups.h>
#include <cstdio>
#include <cstdint>
namespace cg = cooperative_groups;

typedef unsigned short bf16_t;
using bf16x8 = __attribute__((ext_vector_type(8))) short;
using f32x4 = __attribute__((ext_vector_type(4))) float;
using f32x2 = __attribute__((ext_vector_type(2))) float;
using u32x4 = __attribute__((ext_vector_type(4))) uint32_t;
using u32x2 = __attribute__((ext_vector_type(2))) uint32_t;

constexpr int D = 1024, SEQ = 4096, BATCH = 16, DEPTH = 2;
constexpr int IN_COLS = 13872;
constexpr int A_OFF = 0, B_OFF = 4096, C_OFF = 7728, G_OFF = 10800;
constexpr int NT_IN = 109, NP = NT_IN * 128;
constexpr int NB = 4, R = NB * SEQ, NGRP = BATCH / NB;
constexpr int LDK = 40;
constexpr int KS_LD = 80;
constexpr int VT_LD = 68;
constexpr int HS_LD = 136;
constexpr int SMEM_BYTES = 65536 + 16;

constexpr size_t al256(size_t x) { return (x + 255) & ~size_t(255); }
constexpr size_t OFF_WINT = 0;
constexpr size_t OFF_WBRT = al256(OFF_WINT + (size_t)DEPTH * NP * D * 2);
constexpr size_t OFF_WOUTT = al256(OFF_WBRT + (size_t)DEPTH * 3 * D * D * 2);
constexpr size_t OFF_WC1T = al256(OFF_WOUTT + (size_t)DEPTH * D * D * 2);
constexpr size_t OFF_WM = al256(OFF_WC1T + (size_t)DEPTH * 2 * 128 * 2048 * 2);
constexpr size_t OFF_BIAS1 = al256(OFF_WM + (size_t)DEPTH * 8 * 128 * 128 * 2);
constexpr size_t OFF_MOD = al256(OFF_BIAS1 + (size_t)DEPTH * 2 * 8 * 128 * 4);
constexpr size_t OFF_H = al256(OFF_MOD + (size_t)DEPTH * 16 * 3072 * 4);
constexpr size_t SZ_ACT = (size_t)R * 1024 * 2;
constexpr size_t OFF_YAPRE = al256(OFF_H + SZ_ACT);
constexpr size_t OFF_BZA = al256(OFF_YAPRE + SZ_ACT);
constexpr size_t OFF_Q = al256(OFF_BZA + SZ_ACT);
constexpr size_t OFF_ZB = al256(OFF_Q + SZ_ACT);
constexpr size_t OFF_UZ = al256(OFF_ZB + SZ_ACT);
constexpr size_t OFF_GV = al256(OFF_UZ + SZ_ACT);
constexpr size_t OFF_KV = al256(OFF_GV + SZ_ACT);
constexpr size_t OFF_GL = al256(OFF_KV + (size_t)R * 1536 * 2);
constexpr size_t OFF_GATES = al256(OFF_GL + (size_t)R * 48 * 4);
constexpr size_t OFF_YA = al256(OFF_GATES + (size_t)R * 3072 * 2);
constexpr size_t OFF_YB = al256(OFF_YA + SZ_ACT);
constexpr size_t OFF_YC = al256(OFF_YB + SZ_ACT);
constexpr size_t OFF_KCMP = al256(OFF_YC + SZ_ACT);
constexpr size_t OFF_VCMP = al256(OFF_KCMP + (size_t)NB * 4 * 256 * 64 * 2);
constexpr size_t OFF_STATS = al256(OFF_VCMP + (size_t)NB * 4 * 256 * 64 * 2);
constexpr size_t OFF_BAR = al256(OFF_STATS + (size_t)R * 2 * 4);
constexpr size_t WS_END = al256(OFF_BAR + 3456 * 4);

struct Params {
  const float *x, *c, *g_pre, *g_post, *w_ada, *b_ada, *w_in, *conv_w, *conv_b, *pos_ck, *w_ck1, *w_ck2,
      *pos_cv, *w_cv1, *w_cv2, *ln_g, *ln_b, *w_s, *b_s, *w_br, *w_out;
  float* out;
  unsigned char* ws;
};

typedef __bf16 bf16x2_native __attribute__((ext_vector_type(2)));
__device__ __forceinline__ uint32_t pack2(float a, float b) {
  f32x2 v = {a, b};
  return __builtin_bit_cast(uint32_t, __builtin_convertvector(v, bf16x2_native));
}
__device__ __forceinline__ bf16_t f2bf(float f) { return (bf16_t)(pack2(f, f) & 0xffffu); }
__device__ __forceinline__ float bf2f(uint32_t h) { return __uint_as_float(h << 16); }
__device__ __forceinline__ float sigmoid_(float x) { return __builtin_amdgcn_rcpf(1.f + __expf(-x)); }
__device__ __forceinline__ float silu_(float x) { return x * __builtin_amdgcn_rcpf(1.f + __expf(-x)); }
__device__ __forceinline__ float gelu_(float x) {
  float y = 0.7978845608f * (x + 0.044715f * x * x * x);
  return x * __builtin_amdgcn_rcpf(1.f + __expf(-2.f * y));
}
__device__ __forceinline__ f32x4 mfma16(bf16x8 a, bf16x8 b, f32x4 c) {
  return __builtin_amdgcn_mfma_f32_16x16x32_bf16(a, b, c, 0, 0, 0);
}
__device__ __forceinline__ float bperm(float v, int srclane) {
  return __int_as_float(__builtin_amdgcn_ds_bpermute(srclane << 2, __float_as_int(v)));
}
__device__ __forceinline__ float wave_sum(float v, int lane) {
#pragma unroll
  for (int o = 32; o >= 1; o >>= 1) v += bperm(v, lane ^ o);
  return v;
}

__device__ __forceinline__ int opaque_tid() {
  int t = threadIdx.x;
  asm volatile("" : "+v"(t));
  return t;
}

__device__ __forceinline__ int win_colmap(int np) {
  int tile = np >> 7, r = np & 127;
  if (tile < 32) { int wc = r >> 6, t = (r >> 4) & 3, i = r & 15; return A_OFF + t * 1024 + tile * 32 + wc * 16 + i; }
  if (tile < 40) return B_OFF + (np - 32 * 128);
  if (tile < 52) return B_OFF + 1024 + (np - 40 * 128);
  if (tile < 60) return B_OFF + 2560 + (np - 52 * 128);
  if (tile == 60) return r < 48 ? B_OFF + 3584 + r : -1;
  if (tile < 77) { int tb = tile - 61, wc = r >> 6, t = (r >> 4) & 3, i = r & 15; return C_OFF + ((t & 1) ? 2048 : 0) + tb * 64 + wc * 32 + (t >> 1) * 16 + i; }
  if (tile < 85) return C_OFF + 1024 + (np - 77 * 128);
  return G_OFF + (np - 85 * 128);
}

template <bool WIN>
__device__ __forceinline__ void transpose_tile(const float* __restrict__ src, int ld_src, bf16_t* __restrict__ dst, int Kdim, int n0, int k0, float* sm, int tid) {
  const int tx = tid & 63, ty = tid >> 6;
  const int col = WIN ? win_colmap(n0 + tx) : (n0 + tx);
  __syncthreads();
#pragma unroll
  for (int i = 0; i < 16; ++i) {
    int k = ty * 16 + i;
    float v = (col >= 0) ? src[(size_t)(k0 + k) * ld_src + col] : 0.f;
    sm[k * 65 + tx] = v;
  }
  __syncthreads();
#pragma unroll
  for (int i = 0; i < 16; ++i) {
    int n = ty * 16 + i;
    dst[(size_t)(n0 + n) * Kdim + k0 + tx] = f2bf(sm[tx * 65 + n]);
  }
}

__device__ __forceinline__ void phase0(const Params& p, char* smraw) {
  float* smf = (float*)smraw;
  const int bid = blockIdx.x, nblk = gridDim.x, tid = opaque_tid();
  bf16_t* WinT = (bf16_t*)(p.ws + OFF_WINT);
  bf16_t* WbrT = (bf16_t*)(p.ws + OFF_WBRT);
  bf16_t* WoutT = (bf16_t*)(p.ws + OFF_WOUTT);
  bf16_t* Wc1T = (bf16_t*)(p.ws + OFF_WC1T);
  bf16_t* Wm = (bf16_t*)(p.ws + OFF_WM);
  float* bias1 = (float*)(p.ws + OFF_BIAS1);
  float* mod = (float*)(p.ws + OFF_MOD);
  for (int t = bid; t < DEPTH * 218 * 16; t += nblk) {
    int l = t / (218 * 16), r = t % (218 * 16), nt = r >> 4, kt = r & 15;
    transpose_tile<true>(p.w_in + (size_t)l * D * IN_COLS, IN_COLS, WinT + (size_t)l * NP * D, D, nt * 64, kt * 64, smf, tid);
  }
  for (int t = bid; t < DEPTH * 3 * 256; t += nblk) {
    int li = t >> 8, r = t & 255, nt = r >> 4, kt = r & 15;
    transpose_tile<false>(p.w_br + (size_t)li * D * D, D, WbrT + (size_t)li * D * D, D, nt * 64, kt * 64, smf, tid);
  }
  for (int t = bid; t < DEPTH * 256; t += nblk) {
    int l = t >> 8, r = t & 255, nt = r >> 4, kt = r & 15;
    transpose_tile<false>(p.w_out + (size_t)l * D * D, D, WoutT + (size_t)l * D * D, D, nt * 64, kt * 64, smf, tid);
  }
  for (int t = bid; t < DEPTH * 2 * 64; t += nblk) {
    int lk = t >> 6, r = t & 63, nt = r >> 5, kt = r & 31;
    int l = lk >> 1, kv = lk & 1;
    const float* src = (kv ? p.w_cv1 : p.w_ck1) + (size_t)l * 2048 * 128;
    transpose_tile<false>(src, 128, Wc1T + (size_t)lk * 128 * 2048, 2048, nt * 64, kt * 64, smf, tid);
  }
  for (int e = bid * 256 + tid; e < DEPTH * 8 * 128 * 128; e += nblk * 256) {
    int j = e & 127, i = (e >> 7) & 127;
    Wm[e] = (j <= i) ? f2bf(p.w_s[e]) : (bf16_t)0;
  }
  for (int t = bid - 128; t >= 0 && t < DEPTH * 2 * 8; t += nblk) {
    int lk = t >> 3, ks = t & 7, l = lk >> 1, kv = lk & 1;
    const float* pos = (kv ? p.pos_cv : p.pos_ck) + (size_t)l * 2048;
    const float* w1 = (kv ? p.w_cv1 : p.w_ck1) + (size_t)l * 2048 * 128;
    int n = tid & 127, half = tid >> 7;
    float acc = 0.f;
    const int kb = ks * 256 + half * 128;
#pragma unroll 16
    for (int k = kb; k < kb + 128; ++k) acc += pos[k] * w1[(size_t)k * 128 + n];
    __syncthreads();
    smf[tid] = acc;
    __syncthreads();
    if (tid < 128) bias1[t * 128 + tid] = smf[tid] + smf[tid + 128];
  }
  for (int t = nblk - 1 - bid; t < DEPTH * 48; t += nblk) {
    int l = t / 48, ch = t % 48;
    int tx = tid & 63, ty = tid >> 6;
    int col = ch * 64 + tx;
    __syncthreads();
    for (int i = 0; i < 64; ++i) {
      int e = tid + 256 * i;
      smf[(e & 1023) * 16 + (e >> 10)] = silu_(p.c[e]);
    }
    __syncthreads();
    float acc[16];
#pragma unroll
    for (int b = 0; b < 16; ++b) acc[b] = 0.f;
    const float* w = p.w_ada + (size_t)l * D * 3072 + col;
#pragma unroll 8
    for (int k = ty * 256; k < ty * 256 + 256; ++k) {
      float wv = w[(size_t)k * 3072];
      const f32x4 s0 = *(const f32x4*)(smf + k * 16), s1 = *(const f32x4*)(smf + k * 16 + 4), s2 = *(const f32x4*)(smf + k * 16 + 8), s3 = *(const f32x4*)(smf + k * 16 + 12);
#pragma unroll
      for (int b = 0; b < 4; ++b) { acc[b] += s0[b] * wv; acc[4 + b] += s1[b] * wv; acc[8 + b] += s2[b] * wv; acc[12 + b] += s3[b] * wv; }
    }
    __syncthreads();
#pragma unroll
    for (int b = 0; b < 16; ++b) smf[(ty * 16 + b) * 64 + tx] = acc[b];
    __syncthreads();
    if (ty == 0) {
#pragma unroll
      for (int b = 0; b < 16; ++b) {
        float s_ = smf[b * 64 + tx] + smf[(16 + b) * 64 + tx] + smf[(32 + b) * 64 + tx] + smf[(48 + b) * 64 + tx];
        mod[((size_t)l * 16 + b) * 3072 + col] = s_ + p.b_ada[l * 3072 + col];
      }
    }
  }
}

__device__ __forceinline__ void write_h_row(const f32x4 (&xv)[4], float ss, const float* g_pre, const float* modl_b, bf16_t* hrow, int lane) {
  float rs = rsqrtf(ss * (1.f / 1024.f) + 1e-6f);
#pragma unroll
  for (int i = 0; i < 4; ++i) {
    int c = i * 256 + lane * 4;
    f32x4 g = *(const f32x4*)(g_pre + c);
    f32x4 sh = *(const f32x4*)(modl_b + c);
    f32x4 sc = *(const f32x4*)(modl_b + 1024 + c);
    float h0 = xv[i].x * rs * g.x * (1.f + sc.x) + sh.x;
    float h1 = xv[i].y * rs * g.y * (1.f + sc.y) + sh.y;
    float h2 = xv[i].z * rs * g.z * (1.f + sc.z) + sh.z;
    float h3 = xv[i].w * rs * g.w * (1.f + sc.w) + sh.w;
    u32x2 o; o.x = pack2(h0, h1); o.y = pack2(h2, h3);
    *(u32x2*)(hrow + c) = o;
  }
}

__device__ __forceinline__ void phase_h0(const Params& p, int grp_i) {
  const int tid = opaque_tid(); const int lane = tid & 63, w = tid >> 6;
  bf16_t* H = (bf16_t*)(p.ws + OFF_H);
  const float* mod = (const float*)(p.ws + OFF_MOD);
  for (int r = blockIdx.x * 4 + w; r < R; r += gridDim.x * 4) {
    size_t grow = (size_t)grp_i * R + r;
    int b = (int)(grow >> 12);
    const float* xr = p.x + grow * D;
    f32x4 xv[4]; float ss = 0.f;
#pragma unroll
    for (int i = 0; i < 4; ++i) {
      xv[i] = *(const f32x4*)(xr + i * 256 + lane * 4);
      ss += xv[i].x * xv[i].x + xv[i].y * xv[i].y + xv[i].z * xv[i].z + xv[i].w * xv[i].w;
    }
    ss = wave_sum(ss, lane);
    write_h_row(xv, ss, p.g_pre, mod + (size_t)b * 3072, H + (size_t)r * D, lane);
  }
}

__device__ __forceinline__ void phase_final(const Params& p, int grp_i, int l) {
  const int tid = opaque_tid(); const int lane = tid & 63, w = tid >> 6;
  bf16_t* H = (bf16_t*)(p.ws + OFF_H);
  const bf16_t* OP = (const bf16_t*)(p.ws + OFF_YAPRE);
  const float* mod = (const float*)(p.ws + OFF_MOD);
  const float* xin = (l == 0) ? p.x : p.out;
  for (int r = blockIdx.x * 4 + w; r < R; r += gridDim.x * 4) {
    size_t grow = (size_t)grp_i * R + r;
    int b = (int)(grow >> 12);
    const float* xr = xin + grow * D;
    const bf16_t* orow = OP + (size_t)r * D;
    const float* gate = mod + ((size_t)l * 16 + b) * 3072 + 2048;
    const float* gp = p.g_post + l * D;
    f32x4 xv[4], ov[4]; float ss = 0.f;
#pragma unroll
    for (int i = 0; i < 4; ++i) {
      int c = i * 256 + lane * 4;
      xv[i] = *(const f32x4*)(xr + c);
      u32x2 u = *(const u32x2*)(orow + c);
      ov[i].x = bf2f(u.x & 0xffffu); ov[i].y = bf2f(u.x >> 16); ov[i].z = bf2f(u.y & 0xffffu); ov[i].w = bf2f(u.y >> 16);
      ss += ov[i].x * ov[i].x + ov[i].y * ov[i].y + ov[i].z * ov[i].z + ov[i].w * ov[i].w;
    }
    ss = wave_sum(ss, lane);
    float rs = rsqrtf(ss * (1.f / 1024.f) + 1e-6f);
    float ss2 = 0.f;
#pragma unroll
    for (int i = 0; i < 4; ++i) {
      int c = i * 256 + lane * 4;
      f32x4 g = *(const f32x4*)(gp + c);
      f32x4 ga = *(const f32x4*)(gate + c);
      xv[i].x += ga.x * (ov[i].x * rs * g.x);
      xv[i].y += ga.y * (ov[i].y * rs * g.y);
      xv[i].z += ga.z * (ov[i].z * rs * g.z);
      xv[i].w += ga.w * (ov[i].w * rs * g.w);
      *(f32x4*)(p.out + grow * D + c) = xv[i];
      ss2 += xv[i].x * xv[i].x + xv[i].y * xv[i].y + xv[i].z * xv[i].z + xv[i].w * xv[i].w;
    }
    if (l == 0) {
      ss2 = wave_sum(ss2, lane);
      write_h_row(xv, ss2, p.g_pre + D, mod + ((size_t)16 + b) * 3072, H + (size_t)r * D, lane);
    }
  }
}

struct StdLoader {
  const bf16_t* base;
  int soff;
  u32x4 r0, r1;
  __device__ __forceinline__ void init(const bf16_t* tile_base, size_t ld, int tid) {
    base = tile_base + (size_t)(tid >> 1) * ld + (tid & 1) * 16;
    soff = (tid >> 1) * LDK + (tid & 1) * 16;
  }
  __device__ __forceinline__ void load(int kt) {
    const bf16_t* q = base + kt * 32;
    r0 = *(const u32x4*)q; r1 = *(const u32x4*)(q + 8);
  }
  __device__ __forceinline__ void store(bf16_t* tile) {
    bf16_t* q = tile + soff;
    *(u32x4*)q = r0; *(u32x4*)(q + 8) = r1;
  }
};

template <class AL, class BL>
__device__ __forceinline__ void gemm_core(f32x4 (&acc)[4][4], AL& al, BL& bl, int nk, bf16_t* sm, int tid) {
  const int lane = tid & 63, w = tid >> 6, wr = w >> 1, wc = w & 1, l15 = lane & 15, grp = lane >> 4;
  al.load(0); bl.load(0);
  __syncthreads();
  al.store(sm); bl.store(sm + 2 * 128 * LDK);
  __syncthreads();
  for (int kt = 0; kt < nk; ++kt) {
    const bf16_t* Ab = sm + (kt & 1) * 128 * LDK;
    const bf16_t* Bb = sm + (2 + (kt & 1)) * 128 * LDK;
    if (kt + 1 < nk) { al.load(kt + 1); bl.load(kt + 1); }
    bf16x8 a[4], b[4];
#pragma unroll
    for (int m = 0; m < 4; ++m) a[m] = *(const bf16x8*)(Ab + (wr * 64 + m * 16 + l15) * LDK + grp * 8);
#pragma unroll
    for (int n = 0; n < 4; ++n) b[n] = *(const bf16x8*)(Bb + (wc * 64 + n * 16 + l15) * LDK + grp * 8);
#pragma unroll
    for (int m = 0; m < 4; ++m)
#pragma unroll
      for (int n = 0; n < 4; ++n) acc[m][n] = mfma16(a[m], b[n], acc[m][n]);
    if (kt + 1 < nk) {
      al.store(sm + ((kt + 1) & 1) * 128 * LDK);
      bl.store(sm + (2 + ((kt + 1) & 1)) * 128 * LDK);
    }
    __syncthreads();
  }
}

struct Regs4 { u32x4 r0, r1, r2, r3; };
struct StdLoader64 {
  typedef Regs4 Regs;
  const bf16_t* base;
  size_t ld32;
  int soff;
  __device__ __forceinline__ void init(const bf16_t* tile_base, size_t ld, int tid) {
    base = tile_base + (size_t)(tid >> 3) * ld + (tid & 7) * 8;
    ld32 = ld * 32;
    soff = (tid >> 3) * 64 + (((tid & 7) ^ ((tid >> 4) & 7)) * 8);
  }
  __device__ __forceinline__ void load(int kt, Regs& r) const {
    const bf16_t* q = base + kt * 64;
    r.r0 = *(const u32x4*)q; r.r1 = *(const u32x4*)(q + ld32); r.r2 = *(const u32x4*)(q + 2 * ld32); r.r3 = *(const u32x4*)(q + 3 * ld32);
  }
  __device__ __forceinline__ void store(bf16_t* tile, const Regs& r) const {
    bf16_t* q = tile + soff;
    *(u32x4*)q = r.r0; *(u32x4*)(q + 2048) = r.r1; *(u32x4*)(q + 4096) = r.r2; *(u32x4*)(q + 6144) = r.r3;
  }
};

template <int NST, class AL, class BL>
__device__ __forceinline__ void gemm_core64(f32x4 (&acc)[4][4], const AL& al, const BL& bl, int nk, bf16_t* sm, int tid) {
  const int lane = tid & 63, w = tid >> 6, wr = w >> 1, wc = w & 1, l15 = lane & 15, grp = lane >> 4;
  constexpr int TILE = 128 * 64;
  const int sw = (l15 >> 1) & 7;
  const int fo0 = l15 * 64 + ((grp ^ sw) * 8), fo1 = l15 * 64 + (((4 + grp) ^ sw) * 8);
  typename AL::Regs ra[NST];
  typename BL::Regs rb[NST];
#pragma unroll
  for (int s_ = 0; s_ < NST; ++s_) { al.load(s_, ra[s_]); bl.load(s_, rb[s_]); }
  __syncthreads();
  al.store(sm, ra[0]); bl.store(sm + 2 * TILE, rb[0]);
  { const int k2 = NST < nk ? NST : nk - 1; al.load(k2, ra[0]); bl.load(k2, rb[0]); }
  __syncthreads();
  for (int kt0 = 0; kt0 < nk; kt0 += NST) {
#pragma unroll
    for (int u = 0; u < NST; ++u) {
      const int kt = kt0 + u;
      const bf16_t* Ab = sm + (kt & 1) * TILE + wr * 64 * 64;
      const bf16_t* Bb = sm + (2 + (kt & 1)) * TILE + wc * 64 * 64;
#pragma unroll
      for (int ks = 0; ks < 2; ++ks) {
        const int fo = ks ? fo1 : fo0;
        bf16x8 a[4], b[4];
#pragma unroll
        for (int m = 0; m < 4; ++m) a[m] = *(const bf16x8*)(Ab + m * 16 * 64 + fo);
#pragma unroll
        for (int n = 0; n < 4; ++n) b[n] = *(const bf16x8*)(Bb + n * 16 * 64 + fo);
#pragma unroll
        for (int m = 0; m < 4; ++m)
#pragma unroll
          for (int n = 0; n < 4; ++n) acc[m][n] = mfma16(b[n], a[m], acc[m][n]);
      }
      al.store(sm + ((kt + 1) & 1) * TILE, ra[(u + 1) % NST]);
      bl.store(sm + (2 + ((kt + 1) & 1)) * TILE, rb[(u + 1) % NST]);
      {
        int k2 = kt + 1 + NST;
        k2 = k2 < nk ? k2 : nk - 1;
        al.load(k2, ra[(u + 1) % NST]); bl.load(k2, rb[(u + 1) % NST]);
      }
      __syncthreads();
    }
  }
}

__device__ __forceinline__ void glds_prefetch0(const bf16_t* Atile, size_t lda, const bf16_t* Btile, size_t ldb, bf16_t* sm, int tid) {
  constexpr int TILE = 128 * 64;
  const int gch = ((tid & 7) ^ ((tid >> 4) & 7)) * 8;
  const bf16_t* ga = Atile + (size_t)(tid >> 3) * lda + gch;
  const bf16_t* gb = Btile + (size_t)(tid >> 3) * ldb + gch;
  const size_t a32 = lda * 32, b32 = ldb * 32;
  bf16_t* lbase = sm + tid * 8;
#pragma unroll
  for (int i_ = 0; i_ < 4; ++i_) {
    __builtin_amdgcn_global_load_lds((const unsigned*)(ga + i_ * a32), (unsigned*)(lbase + i_ * 2048), 16, 0, 0);
    __builtin_amdgcn_global_load_lds((const unsigned*)(gb + i_ * b32), (unsigned*)(lbase + 2 * TILE + i_ * 2048), 16, 0, 0);
  }
}

#define DSR1(dst, base, OFF) asm volatile("ds_read_b128 %0, %1 offset:" #OFF : "=v"(dst) : "v"(base) : "memory")
#define DSR4(arr, base) do { DSR1(arr[0], base, 0); DSR1(arr[1], base, 2048); DSR1(arr[2], base, 4096); DSR1(arr[3], base, 6144); } while (0)
template <bool HOIST>
__device__ __forceinline__ void gemm_core_glds(f32x4 (&acc)[4][4], const bf16_t* Atile, size_t lda, const bf16_t* Btile, size_t ldb,
                                               int nk, bf16_t* sm, int tid) {
  const int lane = tid & 63, w = tid >> 6, wr = w >> 1, wc = w & 1, l15 = lane & 15, grp = lane >> 4;
  constexpr int TILE = 128 * 64;
  const int sw = (l15 >> 1) & 7;
  const int fo0 = l15 * 64 + ((grp ^ sw) * 8), fo1 = l15 * 64 + (((4 + grp) ^ sw) * 8);
  const int gch = ((tid & 7) ^ ((tid >> 4) & 7)) * 8;
  const bf16_t* ga = Atile + (size_t)(tid >> 3) * lda + gch;
  const bf16_t* gb = Btile + (size_t)(tid >> 3) * ldb + gch;
  const size_t a32 = lda * 32, b32 = ldb * 32;
  bf16_t* lbase = sm + tid * 8;
#define GLDS_ISSUE(KT, BUF)                                                                                                            \
  do {                                                                                                                                 \
    _Pragma("unroll") for (int i_ = 0; i_ < 4; ++i_) {                                                                                 \
      __builtin_amdgcn_global_load_lds((const unsigned*)(ga + i_ * a32 + (KT) * 64), (unsigned*)(lbase + (BUF) * TILE + i_ * 2048), 16, 0, 0);       \
      __builtin_amdgcn_global_load_lds((const unsigned*)(gb + i_ * b32 + (KT) * 64), (unsigned*)(lbase + (2 + (BUF)) * TILE + i_ * 2048), 16, 0, 0); \
    }                                                                                                                                  \
  } while (0)
#define GLDS_COMPUTE(BUF)                                                                             \
  do {                                                                                                \
    const bf16_t* Ab = sm + (BUF) * TILE + wr * 64 * 64;                                              \
    const bf16_t* Bb = sm + (2 + (BUF)) * TILE + wc * 64 * 64;                                        \
    if (HOIST) {                                                                                      \
        \
      bf16x8 a0[4], b0[4], a1[4], b1[4];                                                              \
      const unsigned pa0 = (unsigned)(size_t)(Ab + fo0), pb0 = (unsigned)(size_t)(Bb + fo0);          \
      const unsigned pa1 = (unsigned)(size_t)(Ab + fo1), pb1 = (unsigned)(size_t)(Bb + fo1);          \
      DSR4(a0, pa0); DSR4(b0, pb0); DSR4(a1, pa1); DSR4(b1, pb1);                                     \
      asm volatile("s_waitcnt lgkmcnt(8)" : "+v"(a0[0]), "+v"(a0[1]), "+v"(a0[2]), "+v"(a0[3]), "+v"(b0[0]), "+v"(b0[1]), "+v"(b0[2]), "+v"(b0[3]) :: "memory"); \
      _Pragma("unroll") for (int m = 0; m < 4; ++m)                                                   \
        _Pragma("unroll") for (int n = 0; n < 4; ++n) acc[m][n] = mfma16(b0[n], a0[m], acc[m][n]);    \
      __builtin_amdgcn_sched_barrier(0);             \
      asm volatile("s_waitcnt lgkmcnt(0)" : "+v"(a1[0]), "+v"(a1[1]), "+v"(a1[2]), "+v"(a1[3]), "+v"(b1[0]), "+v"(b1[1]), "+v"(b1[2]), "+v"(b1[3]) :: "memory"); \
      _Pragma("unroll") for (int m = 0; m < 4; ++m)                                                   \
        _Pragma("unroll") for (int n = 0; n < 4; ++n) acc[m][n] = mfma16(b1[n], a1[m], acc[m][n]);    \
      __builtin_amdgcn_sched_barrier(0);             \
    } else {                                                                                          \
      _Pragma("unroll") for (int ks = 0; ks < 2; ++ks) {                                              \
        const int fo = ks ? fo1 : fo0;                                                                \
        bf16x8 a[4], b[4];                                                                            \
        _Pragma("unroll") for (int m = 0; m < 4; ++m) a[m] = *(const bf16x8*)(Ab + m * 16 * 64 + fo); \
        _Pragma("unroll") for (int n = 0; n < 4; ++n) b[n] = *(const bf16x8*)(Bb + n * 16 * 64 + fo); \
        _Pragma("unroll") for (int m = 0; m < 4; ++m)                                                 \
          _Pragma("unroll") for (int n = 0; n < 4; ++n) acc[m][n] = mfma16(b[n], a[m], acc[m][n]);     \
      }                                                                                               \
    }                                                                                                 \
  } while (0)
  asm volatile("s_waitcnt vmcnt(0)" ::: "memory");
  __syncthreads();
  for (int kt = 0; kt < nk; kt += 2) {
    GLDS_ISSUE(kt + 1, 1);
    GLDS_COMPUTE(0);
    asm volatile("s_waitcnt vmcnt(0)" ::: "memory");
    __syncthreads();
    if (kt + 2 < nk) GLDS_ISSUE(kt + 2, 0);
    GLDS_COMPUTE(1);
    asm volatile("s_waitcnt vmcnt(0)" ::: "memory");
    __syncthreads();
  }
#undef GLDS_ISSUE
#undef GLDS_COMPUTE
}

__device__ __forceinline__ void gemm_core_glds_cmp(f32x4 (&acc)[4][4], const bf16_t* colptr, int r0, const bf16_t* Btile, size_t ldb,
                                                   int nk, bf16_t* sm, int tid) {
  const int lane = tid & 63, w = tid >> 6, wr = w >> 1, wc = w & 1, l15 = lane & 15, grp = lane >> 4;
  constexpr int TILE = 128 * 64;
  const int sw = (l15 >> 1) & 7;
  const int fo0 = l15 * 64 + ((grp ^ sw) * 8), fo1 = l15 * 64 + (((4 + grp) ^ sw) * 8);
  const int gch = ((tid & 7) ^ ((tid >> 4) & 7)) * 8;
  const bf16_t* gb = Btile + (size_t)(tid >> 3) * ldb + gch;
  const size_t b32 = ldb * 32;
  bf16_t* lbase = sm + tid * 8;
#define CMP_ISSUE(KT, BUF)                                                                                                             \
  do {                                                                                                                                 \
    _Pragma("unroll") for (int i_ = 0; i_ < 4; ++i_) {                                                                                 \
      int tok_ = 16 * (r0 + 32 * i_) + (KT);                                                                                           \
      tok_ = tok_ > (SEQ - 1) ? (SEQ - 1) : tok_;                                                                                      \
      __builtin_amdgcn_global_load_lds((const unsigned*)(colptr + (size_t)tok_ * 1536), (unsigned*)(lbase + (BUF) * TILE + i_ * 2048), 16, 0, 0);     \
      __builtin_amdgcn_global_load_lds((const unsigned*)(gb + i_ * b32 + (KT) * 64), (unsigned*)(lbase + (2 + (BUF)) * TILE + i_ * 2048), 16, 0, 0); \
    }                                                                                                                                  \
  } while (0)
#define CMP_COMPUTE(BUF)                                                                              \
  do {                                                                                                \
    const bf16_t* Ab = sm + (BUF) * TILE + wr * 64 * 64;                                              \
    const bf16_t* Bb = sm + (2 + (BUF)) * TILE + wc * 64 * 64;                                        \
    _Pragma("unroll") for (int ks = 0; ks < 2; ++ks) {                                                \
      const int fo = ks ? fo1 : fo0;                                                                  \
      bf16x8 a[4], b[4];                                                                              \
      _Pragma("unroll") for (int m = 0; m < 4; ++m) a[m] = *(const bf16x8*)(Ab + m * 16 * 64 + fo);   \
      _Pragma("unroll") for (int n = 0; n < 4; ++n) b[n] = *(const bf16x8*)(Bb + n * 16 * 64 + fo);   \
      _Pragma("unroll") for (int m = 0; m < 4; ++m)                                                   \
        _Pragma("unroll") for (int n = 0; n < 4; ++n) acc[m][n] = mfma16(b[n], a[m], acc[m][n]);     \
    }                                                                                                 \
  } while (0)
  __syncthreads();
  CMP_ISSUE(0, 0);
  asm volatile("s_waitcnt vmcnt(0)" ::: "memory");
  __syncthreads();
  for (int kt = 0; kt < nk; kt += 2) {
    CMP_ISSUE(kt + 1, 1);
    CMP_COMPUTE(0);
    asm volatile("s_waitcnt vmcnt(0)" ::: "memory");
    __syncthreads();
    if (kt + 2 < nk) CMP_ISSUE(kt + 2, 0);
    CMP_COMPUTE(1);
    asm volatile("s_waitcnt vmcnt(0)" ::: "memory");
    __syncthreads();
  }
#undef CMP_ISSUE
#undef CMP_COMPUTE
}

__device__ __forceinline__ void zero_acc(f32x4 (&acc)[4][4]) {
#pragma unroll
  for (int m = 0; m < 4; ++m)
#pragma unroll
    for (int n = 0; n < 4; ++n) acc[m][n] = f32x4{0.f, 0.f, 0.f, 0.f};
}

__device__ __forceinline__ void phase_inproj(const Params& p, int l, char* smraw) {
  bf16_t* sm = (bf16_t*)smraw;
  const bf16_t* H = (const bf16_t*)(p.ws + OFF_H);
  const bf16_t* W = (const bf16_t*)(p.ws + OFF_WINT) + (size_t)l * NP * D;
  bf16_t* yApre = (bf16_t*)(p.ws + OFF_YAPRE);
  bf16_t* bzA = (bf16_t*)(p.ws + OFF_BZA);
  bf16_t* qb = (bf16_t*)(p.ws + OFF_Q);
  bf16_t* zb = (bf16_t*)(p.ws + OFF_ZB);
  bf16_t* uz = (bf16_t*)(p.ws + OFF_UZ);
  bf16_t* gv = (bf16_t*)(p.ws + OFF_GV);
  bf16_t* kvb = (bf16_t*)(p.ws + OFF_KV);
  float* glb = (float*)(p.ws + OFF_GL);
  bf16_t* gates = (bf16_t*)(p.ws + OFF_GATES);
  const int tid = opaque_tid(); const int lane = tid & 63, w = tid >> 6, wr = w >> 1, wc = w & 1, l15 = lane & 15, grp = lane >> 4;
  constexpr int MT = R / 128;
  constexpr int NC = (NT_IN + 7) / 8;
  const int nx = gridDim.x >> 3;
  constexpr int CJ_END = (MT / 8) * NC * 64;
  auto cj_valid = [&](int c) { return c < CJ_END && ((c >> 6) % NC) * 8 + ((c & 63) >> 3) < NT_IN; };
  auto cj_next = [&](int c) {
    do { c = ((c & 63) + nx < 64) ? (c + nx) : (((c >> 6) + 8) * 64 + (int)(blockIdx.x >> 3)); } while (c < CJ_END && !cj_valid(c));
    return c;
  };
  int cj = (blockIdx.x & 7) * 64 + (blockIdx.x >> 3);
  if (!cj_valid(cj)) cj = cj_next(cj);
  __syncthreads();
  if (cj < CJ_END) {
    const int cell = cj >> 6, jj = cj & 63;
    glds_prefetch0(H + (size_t)((cell / NC) * 8 + (jj & 7)) * 128 * D, D, W + (size_t)((cell % NC) * 8 + (jj >> 3)) * 128 * D, D, sm, tid);
  }
  while (cj < CJ_END) {
    const int cell = cj >> 6, jj = cj & 63;
    const int nt = (cell % NC) * 8 + (jj >> 3), mt = (cell / NC) * 8 + (jj & 7);
    f32x4 acc[4][4];
    zero_acc(acc);
    gemm_core_glds<true>(acc, H + (size_t)mt * 128 * D, D, W + (size_t)nt * 128 * D, D, D / 64, sm, tid);
    cj = cj_next(cj);
    if (cj < CJ_END) {
      const int cell2 = cj >> 6, jj2 = cj & 63;
      glds_prefetch0(H + (size_t)((cell2 / NC) * 8 + (jj2 & 7)) * 128 * D, D, W + (size_t)((cell2 % NC) * 8 + (jj2 >> 3)) * 128 * D, D, sm, tid);
    }
    const int rbase = mt * 128 + wr * 64 + l15;
    const int c4 = 4 * grp;
#define ST4(PTR, V0, V1, V2, V3) *(u32x2*)(PTR) = u32x2{pack2((V0), (V1)), pack2((V2), (V3))}
    if (nt < 32) {
      const int ch = nt * 32 + wc * 16 + c4;
#pragma unroll
      for (int m = 0; m < 4; ++m) {
        const size_t row = rbase + m * 16;
        ST4(yApre + row * 1024 + ch, acc[m][1][0] * acc[m][2][0], acc[m][1][1] * acc[m][2][1], acc[m][1][2] * acc[m][2][2], acc[m][1][3] * acc[m][2][3]);
        ST4(bzA + row * 1024 + ch, acc[m][0][0] * silu_(acc[m][3][0]), acc[m][0][1] * silu_(acc[m][3][1]), acc[m][0][2] * silu_(acc[m][3][2]), acc[m][0][3] * silu_(acc[m][3][3]));
      }
    } else if (nt < 40) {
      const int cb = (nt - 32) * 128 + wc * 64 + c4;
      const float qs = 0.125f * 1.44269504f;
#pragma unroll
      for (int m = 0; m < 4; ++m)
#pragma unroll
        for (int n = 0; n < 4; ++n)
          ST4(qb + (size_t)(rbase + m * 16) * 1024 + cb + n * 16, acc[m][n][0] * qs, acc[m][n][1] * qs, acc[m][n][2] * qs, acc[m][n][3] * qs);
    } else if (nt < 52) {
      const int cb = (nt - 40) * 128 + wc * 64 + c4;
#pragma unroll
      for (int m = 0; m < 4; ++m)
#pragma unroll
        for (int n = 0; n < 4; ++n)
          ST4(kvb + (size_t)(rbase + m * 16) * 1536 + cb + n * 16, acc[m][n][0], acc[m][n][1], acc[m][n][2], acc[m][n][3]);
    } else if (nt < 60) {
      const int cb = (nt - 52) * 128 + wc * 64 + c4;
#pragma unroll
      for (int m = 0; m < 4; ++m)
#pragma unroll
        for (int n = 0; n < 4; ++n)
          ST4(zb + (size_t)(rbase + m * 16) * 1024 + cb + n * 16, silu_(acc[m][n][0]), silu_(acc[m][n][1]), silu_(acc[m][n][2]), silu_(acc[m][n][3]));
    } else if (nt == 60) {
      if (wc == 0) {
#pragma unroll
        for (int m = 0; m < 4; ++m)
#pragma unroll
          for (int n = 0; n < 3; ++n)
            *(f32x4*)(glb + (size_t)(rbase + m * 16) * 48 + n * 16 + c4) =
                f32x4{sigmoid_(acc[m][n][0]), sigmoid_(acc[m][n][1]), sigmoid_(acc[m][n][2]), sigmoid_(acc[m][n][3])};
      }
    } else if (nt < 77) {
      const int chb = (nt - 61) * 64 + wc * 32 + c4;
#pragma unroll
      for (int m = 0; m < 4; ++m)
#pragma unroll
        for (int pr = 0; pr < 2; ++pr)
          ST4(uz + (size_t)(rbase + m * 16) * 1024 + chb + pr * 16,
              gelu_(acc[m][2 * pr][0]) * silu_(acc[m][2 * pr + 1][0]), gelu_(acc[m][2 * pr][1]) * silu_(acc[m][2 * pr + 1][1]),
              gelu_(acc[m][2 * pr][2]) * silu_(acc[m][2 * pr + 1][2]), gelu_(acc[m][2 * pr][3]) * silu_(acc[m][2 * pr + 1][3]));
    } else if (nt < 85) {
      const int cb = (nt - 77) * 128 + wc * 64 + c4;
#pragma unroll
      for (int m = 0; m < 4; ++m)
#pragma unroll
        for (int n = 0; n < 4; ++n)
          ST4(gv + (size_t)(rbase + m * 16) * 1024 + cb + n * 16, gelu_(acc[m][n][0]), gelu_(acc[m][n][1]), gelu_(acc[m][n][2]), gelu_(acc[m][n][3]));
    } else {
      const int cb = (nt - 85) * 128 + wc * 64 + c4;
#pragma unroll
      for (int m = 0; m < 4; ++m)
#pragma unroll
        for (int n = 0; n < 4; ++n)
          ST4(gates + (size_t)(rbase + m * 16) * 3072 + cb + n * 16, sigmoid_(acc[m][n][0]), sigmoid_(acc[m][n][1]), sigmoid_(acc[m][n][2]), sigmoid_(acc[m][n][3]));
    }
#undef ST4
  }
}

struct CmpALoader {
  const bf16_t* rowptr;
  int r, soff;
  u32x4 r0, r1;
  __device__ __forceinline__ void load(int kt) {
    int tok = 16 * r + (kt >> 1);
    tok = tok > (SEQ - 1) ? (SEQ - 1) : tok;
    const bf16_t* q = rowptr + (size_t)tok * 1536 + (kt & 1) * 32;
    r0 = *(const u32x4*)q; r1 = *(const u32x4*)(q + 8);
  }
  __device__ __forceinline__ void store(bf16_t* tile) {
    bf16_t* q = tile + soff;
    *(u32x4*)q = r0; *(u32x4*)(q + 8) = r1;
  }
};

__device__ __forceinline__ void phase_mix1(const Params& p, int l, char* smraw) {
  const int tid = opaque_tid(); const int lane = tid & 63, w = tid >> 6, l15 = lane & 15, grp = lane >> 4;
  const bf16_t* gv = (const bf16_t*)(p.ws + OFF_GV);
  float* stats = (float*)(p.ws + OFF_STATS);
  constexpr int NCB = 2 * (NB * 4 * 256 / 128);
  const bool split = (int)gridDim.x >= 2 * NCB;
  const int eb = split ? (int)blockIdx.x - NCB : (int)blockIdx.x;
  const int neb = split ? (int)gridDim.x - NCB : (int)gridDim.x;
  for (int r = eb * 4 + w; eb >= 0 && r < R; r += neb * 4) {
    const bf16_t* row = gv + (size_t)r * 1024;
    float v[16]; float s = 0.f;
#pragma unroll
    for (int i = 0; i < 2; ++i) {
      u32x4 u = *(const u32x4*)(row + i * 512 + lane * 8);
      v[i * 8 + 0] = bf2f(u.x & 0xffffu); v[i * 8 + 1] = bf2f(u.x >> 16);
      v[i * 8 + 2] = bf2f(u.y & 0xffffu); v[i * 8 + 3] = bf2f(u.y >> 16);
      v[i * 8 + 4] = bf2f(u.z & 0xffffu); v[i * 8 + 5] = bf2f(u.z >> 16);
      v[i * 8 + 6] = bf2f(u.w & 0xffffu); v[i * 8 + 7] = bf2f(u.w >> 16);
    }
#pragma unroll
    for (int i = 0; i < 16; ++i) s += v[i];
    s = wave_sum(s, lane);
    float mu = s * (1.f / 1024.f);
    float q = 0.f;
#pragma unroll
    for (int i = 0; i < 16; ++i) { float d = v[i] - mu; q += d * d; }
    q = wave_sum(q, lane);
    if (lane == 0) { stats[r * 2] = mu; stats[r * 2 + 1] = rsqrtf(q * (1.f / 1024.f) + 1e-6f); }
  }
  {
    const bf16_t* yApre = (const bf16_t*)(p.ws + OFF_YAPRE);
    const bf16_t* bzA = (const bf16_t*)(p.ws + OFF_BZA);
    bf16_t* yA = (bf16_t*)(p.ws + OFF_YA);
    const float* cw = p.conv_w + (size_t)l * 3 * 1024;
    const float* cb = p.conv_b + (size_t)l * 1024;
    for (int e = eb * 256 + tid; eb >= 0 && e < R * 128; e += neb * 256) {
      int row = e >> 7, c8 = (e & 127) * 8;
      int t = row & (SEQ - 1);
      u32x4 y2 = *(const u32x4*)(yApre + (size_t)row * 1024 + c8);
      u32x4 y1 = (t >= 1) ? *(const u32x4*)(yApre + (size_t)(row - 1) * 1024 + c8) : u32x4{0, 0, 0, 0};
      u32x4 y0 = (t >= 2) ? *(const u32x4*)(yApre + (size_t)(row - 2) * 1024 + c8) : u32x4{0, 0, 0, 0};
      u32x4 bz = *(const u32x4*)(bzA + (size_t)row * 1024 + c8);
      u32x4 o;
#pragma unroll
      for (int i = 0; i < 4; ++i) {
        int c = c8 + i * 2;
        float r0 = cb[c] + cw[c] * bf2f(y0[i] & 0xffffu) + cw[1024 + c] * bf2f(y1[i] & 0xffffu) + cw[2048 + c] * bf2f(y2[i] & 0xffffu);
        float r1 = cb[c + 1] + cw[c + 1] * bf2f(y0[i] >> 16) + cw[1024 + c + 1] * bf2f(y1[i] >> 16) + cw[2048 + c + 1] * bf2f(y2[i] >> 16);
        o[i] = pack2(bf2f(bz[i] & 0xffffu) * r0, bf2f(bz[i] >> 16) * r1);
      }
      *(u32x4*)(yA + (size_t)row * 1024 + c8) = o;
    }
  }
  {
    bf16_t* sm = (bf16_t*)smraw;
    const bf16_t* kvb = (const bf16_t*)(p.ws + OFF_KV);
    const bf16_t* Wc1T = (const bf16_t*)(p.ws + OFF_WC1T);
    const float* bias1 = (const float*)(p.ws + OFF_BIAS1);
    const int wr = w >> 1, wc = w & 1;
    constexpr int MTC = NB * 4 * 256 / 128;
    for (int t = blockIdx.x; t < 2 * MTC; t += gridDim.x) {
      int kv = t / MTC, mt = t % MTC;
      f32x4 acc[4][4];
      zero_acc(acc);
      {
        const int rr = mt * 128 + (tid >> 3);
        const int bl = rr >> 10, g = (rr >> 8) & 3;
        const int gch = ((tid & 7) ^ ((tid >> 4) & 7)) * 8;
        gemm_core_glds_cmp(acc, kvb + (size_t)bl * SEQ * 1536 + kv * 256 + g * 64 + gch, rr & 255,
                           Wc1T + (size_t)(l * 2 + kv) * 128 * 2048, 2048, 2048 / 64, sm, tid);
      }
      bf16_t* Hs = sm;
      bf16_t* W2s = sm + 128 * HS_LD;
      const float* b1 = bias1 + (l * 2 + kv) * 8 * 128;
#pragma unroll
      for (int n = 0; n < 4; ++n) {
        const int col = wc * 64 + n * 16 + 4 * grp;
        f32x4 bb = f32x4{0.f, 0.f, 0.f, 0.f};
#pragma unroll
        for (int ks = 0; ks < 8; ++ks) bb += *(const f32x4*)(b1 + ks * 128 + col);
#pragma unroll
        for (int m = 0; m < 4; ++m)
          *(u32x2*)(Hs + (wr * 64 + m * 16 + l15) * HS_LD + col) =
              u32x2{pack2(silu_(acc[m][n][0] + bb[0]), silu_(acc[m][n][1] + bb[1])), pack2(silu_(acc[m][n][2] + bb[2]), silu_(acc[m][n][3] + bb[3]))};
      }
      const float* w2 = (kv ? p.w_cv2 : p.w_ck2) + (size_t)l * 128 * 64;
      for (int i = 0; i < 32; ++i) {
        int e = tid + 256 * i;
        int j = e >> 6, d = e & 63;
        W2s[d * HS_LD + j] = f2bf(w2[e]);
      }
      __syncthreads();
      f32x4 a2[2][4];
#pragma unroll
      for (int mm = 0; mm < 2; ++mm)
#pragma unroll
        for (int nn = 0; nn < 4; ++nn) a2[mm][nn] = f32x4{0.f, 0.f, 0.f, 0.f};
#pragma unroll
      for (int ks = 0; ks < 4; ++ks) {
        bf16x8 af[2], bfr[4];
#pragma unroll
        for (int mm = 0; mm < 2; ++mm) af[mm] = *(const bf16x8*)(Hs + (w * 32 + mm * 16 + l15) * HS_LD + ks * 32 + grp * 8);
#pragma unroll
        for (int nn = 0; nn < 4; ++nn) bfr[nn] = *(const bf16x8*)(W2s + (nn * 16 + l15) * HS_LD + ks * 32 + grp * 8);
#pragma unroll
        for (int mm = 0; mm < 2; ++mm)
#pragma unroll
          for (int nn = 0; nn < 4; ++nn) a2[mm][nn] = mfma16(af[mm], bfr[nn], a2[mm][nn]);
      }
      bf16_t* outp = (bf16_t*)(p.ws + (kv ? OFF_VCMP : OFF_KCMP));
#pragma unroll
      for (int mm = 0; mm < 2; ++mm)
#pragma unroll
        for (int nn = 0; nn < 4; ++nn)
#pragma unroll
          for (int j = 0; j < 4; ++j) {
            int row = mt * 128 + w * 32 + mm * 16 + 4 * grp + j;
            outp[(size_t)row * 64 + nn * 16 + l15] = f2bf(a2[mm][nn][j]);
          }
      __syncthreads();
    }
  }
}

struct KVRegs { u32x4 k0, k1, v0, v1; };

__device__ __forceinline__ void kv_issue(KVRegs& r, const bf16_t* kbase, const bf16_t* vbase, size_t ld, bool wantV, int tid) {
  const uint32_t row = (uint32_t)tid >> 3, c = ((uint32_t)tid & 7u) * 8u;
  const uint32_t ldu = (ld == 64 ? 64u : 1536u);
  const uint32_t off = row * ldu + c;
  const bf16_t* kp = kbase + off;
  r.k0 = *(const u32x4*)kp; r.k1 = *(const u32x4*)(kp + 32u * ldu);
  if (wantV) {
    const bf16_t* vp = vbase + off;
    r.v0 = *(const u32x4*)vp; r.v1 = *(const u32x4*)(vp + 32u * ldu);
  }
}
__device__ __forceinline__ void kv_commit(const KVRegs& r, bf16_t* Ks, bf16_t* Vs, bool wantV, int tid) {
  int row = tid >> 3, c = (tid & 7) * 8;
  *(u32x4*)(Ks + row * KS_LD + c) = r.k0;
  *(u32x4*)(Ks + (row + 32) * KS_LD + c) = r.k1;
  if (wantV) {
    *(u32x4*)(Vs + row * KS_LD + c) = r.v0;
    *(u32x4*)(Vs + (row + 32) * KS_LD + c) = r.v1;
  }
}

typedef short s16x4 __attribute__((ext_vector_type(4)));
__device__ __forceinline__ s16x4 tr_read(const bf16_t* ptr) {
  return __builtin_amdgcn_ds_read_tr16_b64_v4i16((s16x4 __attribute__((address_space(3)))*)ptr);
}

#define ADSR(dst, base, OFF) asm volatile("ds_read_b128 %0, %1 offset:" #OFF : "=v"(dst) : "v"(base) : "memory")
#define ATRR(dst, base, OFF) asm volatile("ds_read_b64_tr_b16 %0, %1 offset:" #OFF : "=v"(dst) : "v"(base) : "memory")
template <bool MASKED>
__device__ __forceinline__ void attn_block64(const bf16_t* Ks, const bf16_t* Vs, bf16x8 q0, bf16x8 q1, int tq, int kp0, int kpstride,
                                             int maxdist, bool extra_ok, float slope, float& m, f32x4& lsum, f32x4 (&o)[4], int l15, int grp,
                                             const f32x4 (&tb)[4]) {
  const float fst = (float)kpstride;
  const int d0 = tq - kp0 - 4 * grp * kpstride;
  const float base = -slope * (float)d0;
  const unsigned kaddr = (unsigned)(size_t)(Ks + l15 * KS_LD + grp * 8);
  const unsigned vaddr = (unsigned)(size_t)(Vs + (4 * grp + (l15 >> 2)) * KS_LD + 4 * (l15 & 3));
  bf16x8 kf[8];
  ADSR(kf[0], kaddr, 0);    ADSR(kf[1], kaddr, 64);   ADSR(kf[2], kaddr, 2560); ADSR(kf[3], kaddr, 2624);
  ADSR(kf[4], kaddr, 5120); ADSR(kf[5], kaddr, 5184); ADSR(kf[6], kaddr, 7680); ADSR(kf[7], kaddr, 7744);
  f32x4 s[4];
  asm volatile("s_waitcnt lgkmcnt(6)" : "+v"(kf[0]), "+v"(kf[1]) :: "memory");
  s[0] = mfma16(kf[1], q1, mfma16(kf[0], q0, f32x4{0.f, 0.f, 0.f, 0.f}));
  asm volatile("s_waitcnt lgkmcnt(4)" : "+v"(kf[2]), "+v"(kf[3]) :: "memory");
  s[1] = mfma16(kf[3], q1, mfma16(kf[2], q0, f32x4{0.f, 0.f, 0.f, 0.f}));
  asm volatile("s_waitcnt lgkmcnt(2)" : "+v"(kf[4]), "+v"(kf[5]) :: "memory");
  s[2] = mfma16(kf[5], q1, mfma16(kf[4], q0, f32x4{0.f, 0.f, 0.f, 0.f}));
  asm volatile("s_waitcnt lgkmcnt(0)" : "+v"(kf[6]), "+v"(kf[7]) :: "memory");
  s[3] = mfma16(kf[7], q1, mfma16(kf[6], q0, f32x4{0.f, 0.f, 0.f, 0.f}));
  s16x4 vt[16];
  ATRR(vt[0], vaddr, 0);     ATRR(vt[1], vaddr, 2560);  ATRR(vt[2], vaddr, 32);    ATRR(vt[3], vaddr, 2592);
  ATRR(vt[4], vaddr, 64);    ATRR(vt[5], vaddr, 2624);  ATRR(vt[6], vaddr, 96);    ATRR(vt[7], vaddr, 2656);
  ATRR(vt[8], vaddr, 5120);  ATRR(vt[9], vaddr, 7680);  ATRR(vt[10], vaddr, 5152); ATRR(vt[11], vaddr, 7712);
  ATRR(vt[12], vaddr, 5184); ATRR(vt[13], vaddr, 7744); ATRR(vt[14], vaddr, 5216); ATRR(vt[15], vaddr, 7776);
  float cmax = -1e30f;
#pragma unroll
  for (int t = 0; t < 4; ++t)
#pragma unroll
    for (int j = 0; j < 4; ++j) {
      const int ci = t * 16 + j;
      float v = __builtin_fmaf(tb[t][j], fst, s[t][j]);
      if (MASKED) {
        const int dist = d0 - ci * kpstride;
        const bool valid = extra_ok && dist >= 0 && dist < maxdist;
        v = valid ? v : -1e30f;
      }
      s[t][j] = v;
      cmax = fmaxf(cmax, v);
    }
  if (!MASKED) cmax = extra_ok ? cmax : -1e30f;
  if (__ballot(cmax + base > m + 40.f) != 0ull) {
    cmax = (cmax > -1e29f) ? cmax + base : -1e30f;
    cmax = fmaxf(cmax, bperm(cmax, (l15 + 16 * grp) ^ 16));
    cmax = fmaxf(cmax, bperm(cmax, (l15 + 16 * grp) ^ 32));
    const float mnew = fmaxf(m, cmax);
    const float alpha = __builtin_amdgcn_exp2f(m - mnew);
    lsum *= alpha;
#pragma unroll
    for (int dt = 0; dt < 4; ++dt) o[dt] *= alpha;
    m = mnew;
  }
  const float mb = m - base;
#pragma unroll
  for (int t = 0; t < 4; ++t)
#pragma unroll
    for (int j = 0; j < 4; ++j) {
      const float v = s[t][j];
      float pe = __builtin_amdgcn_exp2f(v - mb);
      if (MASKED) pe = (v > -1e29f) ? pe : 0.f;
      s[t][j] = pe;
    }
  const bf16x8 ones = {0x3F80, 0x3F80, 0x3F80, 0x3F80, 0x3F80, 0x3F80, 0x3F80, 0x3F80};
  const uint32_t rowm = (MASKED || extra_ok) ? 0xffffffffu : 0u;
  asm volatile("s_waitcnt lgkmcnt(0)"
               : "+v"(vt[0]), "+v"(vt[1]), "+v"(vt[2]), "+v"(vt[3]), "+v"(vt[4]), "+v"(vt[5]), "+v"(vt[6]), "+v"(vt[7]),
                 "+v"(vt[8]), "+v"(vt[9]), "+v"(vt[10]), "+v"(vt[11]), "+v"(vt[12]), "+v"(vt[13]), "+v"(vt[14]), "+v"(vt[15])
               :: "memory");
#pragma unroll
  for (int sc = 0; sc < 2; ++sc) {
    const bf16x8 pb = __builtin_bit_cast(bf16x8, u32x4{pack2(s[2 * sc][0], s[2 * sc][1]) & rowm, pack2(s[2 * sc][2], s[2 * sc][3]) & rowm,
                                                       pack2(s[2 * sc + 1][0], s[2 * sc + 1][1]) & rowm, pack2(s[2 * sc + 1][2], s[2 * sc + 1][3]) & rowm});
    lsum = mfma16(ones, pb, lsum);
#pragma unroll
    for (int dt = 0; dt < 4; ++dt) {
      const s16x4 vlo = vt[sc * 8 + dt * 2], vhi = vt[sc * 8 + dt * 2 + 1];
      const bf16x8 vf = {vlo[0], vlo[1], vlo[2], vlo[3], vhi[0], vhi[1], vhi[2], vhi[3]};
      o[dt] = mfma16(vf, pb, o[dt]);
    }
  }
}

constexpr int ATT_TILE = 64 * KS_LD * 2;
constexpr int ATT_BUF = 2 * ATT_TILE;

template <class DescF, class ProcF>
__device__ __forceinline__ void kv_stream_run(int n, DescF desc, ProcF proc, char* smraw, int tid, KVRegs& r0, KVRegs& r1) {
  const bf16_t *kp, *vp; size_t ld;
  __syncthreads();
  kv_commit(r0, (bf16_t*)smraw, (bf16_t*)(smraw + ATT_TILE), true, tid);
  desc(2 < n ? 2 : n - 1, kp, vp, ld); kv_issue(r0, kp, vp, ld, true, tid);
  __syncthreads();
  for (int e0 = 0; e0 < n; e0 += 2) {
    {
      const int e = e0;
      proc(e, (const bf16_t*)smraw, (const bf16_t*)(smraw + ATT_TILE));
      kv_commit(r1, (bf16_t*)(smraw + ATT_BUF), (bf16_t*)(smraw + ATT_BUF + ATT_TILE), true, tid);
      desc(e + 3 < n ? e + 3 : n - 1, kp, vp, ld); kv_issue(r1, kp, vp, ld, true, tid);
      __syncthreads();
    }
    {
      const int e = e0 + 1;
      if (e < n) proc(e, (const bf16_t*)(smraw + ATT_BUF), (const bf16_t*)(smraw + ATT_BUF + ATT_TILE));
      kv_commit(r0, (bf16_t*)smraw, (bf16_t*)(smraw + ATT_TILE), true, tid);
      desc(e + 3 < n ? e + 3 : n - 1, kp, vp, ld); kv_issue(r0, kp, vp, ld, true, tid);
      __syncthreads();
    }
  }
}

template <class DescF, class ProcF>
__device__ __forceinline__ void kv_stream(int n, DescF desc, ProcF proc, char* smraw, int tid) {
  if (n <= 0) return;
  KVRegs r0, r1;
  const bf16_t *kp, *vp; size_t ld;
  desc(0, kp, vp, ld); kv_issue(r0, kp, vp, ld, true, tid);
  desc(1 < n ? 1 : n - 1, kp, vp, ld); kv_issue(r1, kp, vp, ld, true, tid);
  kv_stream_run(n, desc, proc, smraw, tid, r0, r1);
}

__device__ __forceinline__ void attn_unit(const Params& p, char* smraw, int bl, int g, int qb) {
  float* impbuf = (float*)(smraw + 2 * ATT_BUF);
  unsigned long long* selmask = (unsigned long long*)(smraw + 2 * ATT_BUF + 16640);
  int* sellist = (int*)(smraw + 2 * ATT_BUF + 16640 + 128);
  const bf16_t* qbuf = (const bf16_t*)(p.ws + OFF_Q);
  const bf16_t* zbuf = (const bf16_t*)(p.ws + OFF_ZB);
  const bf16_t* kvb = (const bf16_t*)(p.ws + OFF_KV);
  const float* glb = (const float*)(p.ws + OFF_GL);
  bf16_t* yB = (bf16_t*)(p.ws + OFF_YB);
  const int tid = opaque_tid(); const int lane = tid & 63, n = tid >> 6, l15 = lane & 15, grp = lane >> 4;
  const int h = g * 4 + n, t0 = qb * 16, tq = t0 + l15;
  const float slope = exp2f(-0.5f * (float)(h + 1)) * 1.44269504f;
  f32x4 tb[4];
#pragma unroll
  for (int t = 0; t < 4; ++t) tb[t] = f32x4{slope * (float)(16 * t), slope * (float)(16 * t + 1), slope * (float)(16 * t + 2), slope * (float)(16 * t + 3)};
  const size_t rowq = (size_t)bl * SEQ + tq;
  bf16x8 q0, q1;
  {
    const bf16_t* qp = qbuf + rowq * 1024 + h * 64 + grp * 8;
    q0 = *(const bf16x8*)qp; q1 = *(const bf16x8*)(qp + 32);
  }
  const float g0 = glb[rowq * 48 + h * 3 + 0], g1 = glb[rowq * 48 + h * 3 + 1], g2 = glb[rowq * 48 + h * 3 + 2];
  f32x4 otot[4];
#pragma unroll
  for (int dt = 0; dt < 4; ++dt) otot[dt] = f32x4{0.f, 0.f, 0.f, 0.f};
  const size_t seqbase = (size_t)bl * SEQ * 1536 + g * 64;
  const int BIG = 1 << 30;
  const bf16_t* kcb = (const bf16_t*)(p.ws + OFF_KCMP) + (size_t)(bl * 4 + g) * 256 * 64;
  const bf16_t* vcb = (const bf16_t*)(p.ws + OFF_VCMP) + (size_t)(bl * 4 + g) * 256 * 64;
  const bf16_t* kwb = kvb + seqbase + 1024;
  const bf16_t* vwb = kvb + seqbase + 1280;
  const bf16_t* ksb = kvb + seqbase + 512;
  const bf16_t* vsb = kvb + seqbase + 768;

  float m = -1e30f;
  f32x4 lsum = f32x4{0.f, 0.f, 0.f, 0.f};
  f32x4 o[4];
#pragma unroll
  for (int dt = 0; dt < 4; ++dt) o[dt] = f32x4{0.f, 0.f, 0.f, 0.f};
  float m_c = -1e30f, inv_c = 0.f, prev_rot = 0.f;
  float* myimp = impbuf + n * 1040;
#pragma unroll
  for (int i = 0; i < 16; ++i) myimp[i * 65 + lane] = 0.f;

  int lo = t0 - 511; lo = lo < 0 ? 0 : lo;
  const int wlo = lo >> 6, whi = t0 >> 6, nW = whi - wlo + 1;
  const int nck = (qb + 63) >> 6;
  auto finish = [&](float gate) -> float {
    const float lt = lsum[0];
    const float inv = lt > 0.f ? 1.f / lt : 0.f;
    const float sc_ = gate * inv;
#pragma unroll
    for (int dt = 0; dt < 4; ++dt) { otot[dt] += o[dt] * sc_; o[dt] = f32x4{0.f, 0.f, 0.f, 0.f}; }
    lsum = f32x4{0.f, 0.f, 0.f, 0.f};
    return inv;
  };
  kv_stream(nW + 2 * nck,
    [&](int e, const bf16_t*& kp, const bf16_t*& vp, size_t& ld) {
      if (e < nW) { const size_t off = (size_t)(whi - e) * 64 * 1536; kp = kwb + off; vp = vwb + off; ld = 1536; }
      else { const int c = (e < nW + nck) ? (nW + nck - 1 - e) : (e - nW - nck); kp = kcb + c * 4096; vp = vcb + c * 4096; ld = 64; }
    },
    [&](int e, const bf16_t* Ks, const bf16_t* Vt) {
      if (e < nW) {
        const int wb = whi - e;
        if (wb < whi && wb * 64 >= t0 - 496) attn_block64<false>(Ks, Vt, q0, q1, tq, wb * 64, 1, 512, true, slope, m, lsum, o, l15, grp, tb);
        else attn_block64<true>(Ks, Vt, q0, q1, tq, wb * 64, 1, 512, true, slope, m, lsum, o, l15, grp, tb);
        if (e == nW - 1) { (void)finish(g2); m = -1e30f; }
      } else if (e < nW + nck) {
        const int c = nW + nck - 1 - e;
        if (16 * (64 * c + 63) + 31 <= t0) attn_block64<false>(Ks, Vt, q0, q1, tq, 1024 * c + 31, 16, BIG, true, slope, m, lsum, o, l15, grp, tb);
        else attn_block64<true>(Ks, Vt, q0, q1, tq, 1024 * c + 31, 16, BIG, true, slope, m, lsum, o, l15, grp, tb);
        if (e == nW + nck - 1) { inv_c = finish(g0); m_c = m; m = -1e30f; }
      } else {
        const int c = e - nW - nck;
#pragma unroll
        for (int tt = 0; tt < 4; ++tt) {
          const bf16_t* krp = Ks + (tt * 16 + l15) * KS_LD + grp * 8;
          bf16x8 k0 = *(const bf16x8*)krp, k1 = *(const bf16x8*)(krp + 32);
          f32x4 z = f32x4{0.f, 0.f, 0.f, 0.f};
          z = mfma16(k0, q0, z);
          z = mfma16(k1, q1, z);
          float sum4 = 0.f, p3 = 0.f;
#pragma unroll
          for (int j = 0; j < 4; ++j) {
            int kidx = c * 64 + tt * 16 + 4 * grp + j;
            int dist = tq - (16 * kidx + 31);
            float pe = (dist >= 0) ? __builtin_amdgcn_exp2f(z[j] - slope * (float)dist - m_c) * inv_c : 0.f;
            sum4 += pe;
            if (j == 3) p3 = pe;
          }
          float rot = bperm(p3, (lane + 48) & 63);
          float extra = (grp == 0) ? prev_rot : rot;
          myimp[l15 * 65 + (c * 4 + tt) * 4 + grp] = sum4 + extra;
          prev_rot = rot;
        }
      }
    }, smraw, tid);
  KVRegs sr0, sr1;
  {
    const int b0 = whi, b1 = whi > 0 ? whi - 1 : 0;
    kv_issue(sr0, ksb + (size_t)b0 * 64 * 1536, vsb + (size_t)b0 * 64 * 1536, 1536, true, tid);
    kv_issue(sr1, ksb + (size_t)b1 * 64 * 1536, vsb + (size_t)b1 * 64 * 1536, 1536, true, tid);
  }
  if (nck < 4 && grp == 0) myimp[l15 * 65 + nck * 16] = prev_rot;
  __syncthreads();
#pragma unroll 1
  for (int i = 0; i < 4; ++i) {
    int qi = n * 4 + i;
    const int cur = t0 >> 6, s = lane;
    float imp = impbuf[qi * 65 + s] + impbuf[1040 + qi * 65 + s] + impbuf[2080 + qi * 65 + s] + impbuf[3120 + qi * 65 + s];
    bool forced = (s == 0) || (s == cur) || (s == cur - 1);
    bool valid = s <= cur;
    float score = forced ? __builtin_inff() : (valid ? imp : -__builtin_inff());
    unsigned long long mk;
    if (cur < 16) {
      mk = __ballot(valid);
    } else {
      const int key = (int)(((forced ? 0x7F800000u : __float_as_uint(imp)) & 0xFFFFFFC0u) | (unsigned)(63 - s));
      int rank = 0;
#pragma unroll 8
      for (int sp = 0; sp <= cur; ++sp)
        rank += (__builtin_amdgcn_readlane(key, sp) > key) ? 1 : 0;
      mk = __ballot((rank < 16) && valid);
    }
    if (lane == 0) selmask[qi] = mk;
  }
  __syncthreads();
  const unsigned long long mymask = selmask[l15];
  unsigned long long U = 0, Uand = ~0ull;
#pragma unroll
  for (int i = 0; i < 16; ++i) { const unsigned long long mk = selmask[i]; U |= mk; Uand &= mk; }
  {
    uint32_t ulo = __builtin_amdgcn_readfirstlane((uint32_t)U), uhi = __builtin_amdgcn_readfirstlane((uint32_t)(U >> 32));
    U = ((unsigned long long)uhi << 32) | ulo;
    ulo = __builtin_amdgcn_readfirstlane((uint32_t)Uand); uhi = __builtin_amdgcn_readfirstlane((uint32_t)(Uand >> 32));
    Uand = ((unsigned long long)uhi << 32) | ulo;
  }
  const int nsel = __popcll(U);
  if (n == 0) {
    if ((U >> lane) & 1ull) sellist[__popcll(U >> lane) - 1] = lane;
  }
  __syncthreads();
  kv_stream_run(nsel,
    [&](int e, const bf16_t*& kp, const bf16_t*& vp, size_t& ld) {
      const int s = __builtin_amdgcn_readfirstlane(sellist[e]);
      const size_t off = (size_t)s * 64 * 1536; kp = ksb + off; vp = vsb + off; ld = 1536;
    },
    [&](int e, const bf16_t* Ks, const bf16_t* Vt) {
      const int s = __builtin_amdgcn_readfirstlane(sellist[e]);
      const bool ok = (mymask >> s) & 1ull;
      if (s < whi) attn_block64<false>(Ks, Vt, q0, q1, tq, s * 64, 1, BIG, ok, slope, m, lsum, o, l15, grp, tb);
      else attn_block64<true>(Ks, Vt, q0, q1, tq, s * 64, 1, BIG, ok, slope, m, lsum, o, l15, grp, tb);
    }, smraw, tid, sr0, sr1);
  (void)finish(g1);
#pragma unroll
  for (int dt = 0; dt < 4; ++dt) {
    size_t off = rowq * 1024 + h * 64 + dt * 16 + 4 * grp;
    u32x2 zz = *(const u32x2*)(zbuf + off);
    u32x2 ov;
    ov.x = pack2(otot[dt][0] * bf2f(zz.x & 0xffffu), otot[dt][1] * bf2f(zz.x >> 16));
    ov.y = pack2(otot[dt][2] * bf2f(zz.y & 0xffffu), otot[dt][3] * bf2f(zz.y >> 16));
    *(u32x2*)(yB + off) = ov;
  }
}

struct GmlpBLoader {
  const bf16_t* gvbase;
  const float* stats;
  const float* lg; const float* lb;
  int tid;
  u32x4 r[2]; f32x2 st[2];
  __device__ __forceinline__ void load(int kt) {
#pragma unroll
    for (int i = 0; i < 2; ++i) {
      int v = tid + 256 * i;
      int j = kt * 32 + (v >> 4), c8 = (v & 15) * 8;
      r[i] = *(const u32x4*)(gvbase + (size_t)j * 1024 + c8);
      st[i] = *(const f32x2*)(stats + j * 2);
    }
  }
  __device__ __forceinline__ void store(bf16_t* tile) {
#pragma unroll
    for (int i = 0; i < 2; ++i) {
      int v = tid + 256 * i;
      int jl = v >> 4, c8 = (v & 15) * 8;
      const u32x4 u = r[i];
#pragma unroll
      for (int e = 0; e < 4; ++e) {
        int c = c8 + 2 * e;
        float a = (bf2f(u[e] & 0xffffu) - st[i].x) * st[i].y * lg[c] + lb[c];
        float b = (bf2f(u[e] >> 16) - st[i].x) * st[i].y * lg[c + 1] + lb[c + 1];
        tile[c * LDK + jl] = f2bf(a);
        tile[(c + 1) * LDK + jl] = f2bf(b);
      }
    }
  }
};

__device__ __forceinline__ void gmlp_unit(const Params& p, int l, char* smraw, int bl, int chunk, int g) {
  bf16_t* sm = (bf16_t*)smraw;
  const int tid = opaque_tid(); const int lane = tid & 63, w = tid >> 6, wr = w >> 1, wc = w & 1, l15 = lane & 15, grp = lane >> 4;
  const size_t row0 = (size_t)bl * SEQ + chunk * 128;
  f32x4 acc[4][4];
  zero_acc(acc);
  StdLoader al;
  al.init((const bf16_t*)(p.ws + OFF_WM) + (size_t)(l * 8 + g) * 128 * 128, 128, tid);
  GmlpBLoader bl_;
  bl_.tid = tid;
  bl_.gvbase = (const bf16_t*)(p.ws + OFF_GV) + row0 * 1024 + g * 128;
  bl_.stats = (const float*)(p.ws + OFF_STATS) + row0 * 2;
  bl_.lg = p.ln_g + l * 1024 + g * 128;
  bl_.lb = p.ln_b + l * 1024 + g * 128;
  gemm_core(acc, al, bl_, 4, sm, tid);
  const bf16_t* uz = (const bf16_t*)(p.ws + OFF_UZ);
  bf16_t* yC = (bf16_t*)(p.ws + OFF_YC);
  const float* bs = p.b_s + (size_t)(l * 8 + g) * 128;
#pragma unroll
  for (int m = 0; m < 4; ++m)
#pragma unroll
    for (int j = 0; j < 4; ++j) {
      int i = wr * 64 + m * 16 + 4 * grp + j;
      float bb = bs[i];
#pragma unroll
      for (int n = 0; n < 4; ++n) {
        size_t off = (row0 + i) * 1024 + g * 128 + wc * 64 + n * 16 + l15;
        yC[off] = f2bf(bf2f(uz[off]) * (acc[m][n][j] + bb));
      }
    }
}

__device__ __forceinline__ void phase_mix2(const Params& p, int l, char* smraw) {
  constexpr int NATT = NB * 4 * 256, NGM = NB * 32 * 8;
  for (int u = blockIdx.x; u < NATT + NGM; u += gridDim.x) {
    if (u < NATT) {
      int qb = 255 - (u / (NB * 4)), r = u % (NB * 4);
      attn_unit(p, smraw, r >> 2, r & 3, qb);
    } else {
      int v = u - NATT;
      gmlp_unit(p, l, smraw, v >> 8, (v >> 3) & 31, v & 7);
    }
  }
}

__device__ __forceinline__ void phase_merge(const Params& p, int l, char* smraw) {
  bf16_t* sm = (bf16_t*)smraw;
  const bf16_t* WbrT = (const bf16_t*)(p.ws + OFF_WBRT) + (size_t)l * 3 * D * D;
  const bf16_t* gates = (const bf16_t*)(p.ws + OFF_GATES);
  bf16_t* merged = (bf16_t*)(p.ws + OFF_H);
  const int tid = opaque_tid(); const int lane = tid & 63, w = tid >> 6, wr = w >> 1, wc = w & 1, l15 = lane & 15, grp = lane >> 4;
  const int nx = gridDim.x >> 3;
  constexpr int CJ_END = (R / 1024) * 64;
  auto cj_next = [&](int c) { return ((c & 63) + nx < 64) ? (c + nx) : (((c >> 6) + 8) * 64 + (int)(blockIdx.x >> 3)); };
  auto ybuf = [&](int i) { return (const bf16_t*)(p.ws + (i == 0 ? OFF_YA : (i == 1 ? OFF_YB : OFF_YC))); };
  int cj = (blockIdx.x & 7) * 64 + (blockIdx.x >> 3);
  __syncthreads();
  if (cj < CJ_END) glds_prefetch0(ybuf(0) + (size_t)((cj >> 6) * 8 + (cj & 7)) * 128 * D, D, WbrT + (size_t)((cj & 63) >> 3) * 128 * D, D, sm, tid);
  for (; cj < CJ_END; cj = cj_next(cj)) {
    const int nt = (cj & 63) >> 3, mt = (cj >> 6) * 8 + (cj & 7);
    const int rbase = mt * 128 + wr * 64 + l15, cbase = nt * 128 + wc * 64 + 4 * grp;
    f32x4 tot[4][4];
    zero_acc(tot);
#pragma unroll 1
    for (int i = 0; i < 3; ++i) {
      f32x4 acc[4][4];
      zero_acc(acc);
      const bf16_t* Y = ybuf(i);
      gemm_core_glds<false>(acc, Y + (size_t)mt * 128 * D, D, WbrT + (size_t)i * D * D + (size_t)nt * 128 * D, D, D / 64, sm, tid);
      if (i < 2) {
        glds_prefetch0(ybuf(i + 1) + (size_t)mt * 128 * D, D, WbrT + (size_t)(i + 1) * D * D + (size_t)nt * 128 * D, D, sm, tid);
      } else {
        const int c2 = cj_next(cj);
        if (c2 < CJ_END) glds_prefetch0(ybuf(0) + (size_t)((c2 >> 6) * 8 + (c2 & 7)) * 128 * D, D, WbrT + (size_t)((c2 & 63) >> 3) * 128 * D, D, sm, tid);
      }
#pragma unroll
      for (int m = 0; m < 4; ++m)
#pragma unroll
        for (int n = 0; n < 4; ++n) {
          const u32x2 gt = *(const u32x2*)(gates + (size_t)(rbase + m * 16) * 3072 + i * 1024 + cbase + n * 16);
          tot[m][n][0] += bf2f(gt.x & 0xffffu) * acc[m][n][0];
          tot[m][n][1] += bf2f(gt.x >> 16) * acc[m][n][1];
          tot[m][n][2] += bf2f(gt.y & 0xffffu) * acc[m][n][2];
          tot[m][n][3] += bf2f(gt.y >> 16) * acc[m][n][3];
        }
    }
#pragma unroll
    for (int m = 0; m < 4; ++m)
#pragma unroll
      for (int n = 0; n < 4; ++n)
        *(u32x2*)(merged + (size_t)(rbase + m * 16) * 1024 + cbase + n * 16) = u32x2{pack2(tot[m][n][0], tot[m][n][1]), pack2(tot[m][n][2], tot[m][n][3])};
  }
}

__device__ __forceinline__ void phase_outproj(const Params& p, int l, char* smraw) {
  bf16_t* sm = (bf16_t*)smraw;
  const bf16_t* WoutT = (const bf16_t*)(p.ws + OFF_WOUTT) + (size_t)l * D * D;
  const bf16_t* merged = (const bf16_t*)(p.ws + OFF_H);
  bf16_t* opre = (bf16_t*)(p.ws + OFF_YAPRE);
  const int tid = opaque_tid(); const int lane = tid & 63, w = tid >> 6, wr = w >> 1, wc = w & 1, l15 = lane & 15, grp = lane >> 4;
  const int nx = gridDim.x >> 3;
  constexpr int CJ_END = (R / 1024) * 64;
  auto cj_next = [&](int c) { return ((c & 63) + nx < 64) ? (c + nx) : (((c >> 6) + 8) * 64 + (int)(blockIdx.x >> 3)); };
  int cj = (blockIdx.x & 7) * 64 + (blockIdx.x >> 3);
  __syncthreads();
  if (cj < CJ_END) glds_prefetch0(merged + (size_t)((cj >> 6) * 8 + (cj & 7)) * 128 * D, D, WoutT + (size_t)((cj & 63) >> 3) * 128 * D, D, sm, tid);
  for (; cj < CJ_END; cj = cj_next(cj)) {
    const int nt = (cj & 63) >> 3, mt = (cj >> 6) * 8 + (cj & 7);
    f32x4 acc[4][4];
    zero_acc(acc);
    gemm_core_glds<true>(acc, merged + (size_t)mt * 128 * D, D, WoutT + (size_t)nt * 128 * D, D, D / 64, sm, tid);
    {
      const int c2 = cj_next(cj);
      if (c2 < CJ_END) glds_prefetch0(merged + (size_t)((c2 >> 6) * 8 + (c2 & 7)) * 128 * D, D, WoutT + (size_t)((c2 & 63) >> 3) * 128 * D, D, sm, tid);
    }
    const int rbase = mt * 128 + wr * 64 + l15, cbase = nt * 128 + wc * 64 + 4 * grp;
#pragma unroll
    for (int m = 0; m < 4; ++m)
#pragma unroll
      for (int n = 0; n < 4; ++n)
        *(u32x2*)(opre + (size_t)(rbase + m * 16) * 1024 + cbase + n * 16) = u32x2{pack2(acc[m][n][0], acc[m][n][1]), pack2(acc[m][n][2], acc[m][n][3])};
  }
}

#define XB_TMO      128
#define XB_XCNT(j)  (256  + 64 * (j))
#define XB_XSUB(j)  (1280 + 64 * (j))
#define XB_XGEN(j)  (2304 + 64 * (j))
#define XB_TOP      3328
#define XB_TOPGEN   3392
#define XCD_BAR_WORDS 3456
#define XB_SPIN_CAP (1u << 18)
#define LAS __attribute__((address_space(3)))

__device__ __forceinline__ unsigned xb_ld(unsigned* p)              { return __hip_atomic_load(p, __ATOMIC_RELAXED, __HIP_MEMORY_SCOPE_AGENT); }
__device__ __forceinline__ unsigned xb_add(unsigned* p, unsigned v) { return __hip_atomic_fetch_add(p, v, __ATOMIC_RELAXED, __HIP_MEMORY_SCOPE_AGENT); }
__device__ __forceinline__ unsigned xb_xcc_id() { return (unsigned)__builtin_amdgcn_s_getreg((3 << 11) | 20) & 0xFu; }
#define XB_SPIN(cond, bar) do { unsigned _sp = 0; while (cond) { __builtin_amdgcn_s_sleep(1); \
    if ((++_sp & 255u) == 0u) { if (xb_ld(&(bar)[XB_TMO])) break; if (_sp > XB_SPIN_CAP) { atomicAdd(&(bar)[XB_TMO], 1u); break; } } } } while (0)

struct XcdBarrier {
    unsigned* bar; unsigned x;
    volatile LAS unsigned* st;
};

__device__ __forceinline__ XcdBarrier xcd_barrier_post(unsigned* bar, volatile LAS unsigned* st) {
    XcdBarrier b; b.bar = bar; b.x = xb_xcc_id(); b.st = st;
    if (threadIdx.x == 0) (void)xb_add(&bar[XB_XCNT(b.x)], 1u);
    return b;
}
__device__ __forceinline__ void xcd_barrier_complete(unsigned* bar, unsigned x, unsigned& nloc, unsigned& nx) {
    const unsigned G = gridDim.x * gridDim.y * gridDim.z;
    unsigned sum, cnt, mine, sp = 0u;
    for (;;) {
        sum = 0u; cnt = 0u; mine = 0u;
#pragma unroll
        for (unsigned j = 0; j < 16; ++j) { const unsigned c = xb_ld(&bar[XB_XCNT(j)]); sum += c; cnt += (c > 0u) ? 1u : 0u; mine = (j == x) ? c : mine; }
        if (sum == G) break;
        __builtin_amdgcn_s_sleep(1);
        if ((++sp & 255u) == 0u) { if (xb_ld(&bar[XB_TMO])) break; if (sp > XB_SPIN_CAP) { atomicAdd(&bar[XB_TMO], 1u); break; } }
    }
    nloc = mine > 0u ? mine : 1u; nx = cnt > 0u ? cnt : 1u;
}
__device__ __forceinline__ void xcd_barrier(const XcdBarrier& b) {
    asm volatile("s_waitcnt vmcnt(0)" ::: "memory");
    __syncthreads();
    if (threadIdx.x == 0) {
        unsigned* bar = b.bar;
        __builtin_amdgcn_s_waitcnt(0);
        unsigned nloc = b.st[0], nx = b.st[1];
        if (nloc == 0u) { xcd_barrier_complete(bar, b.x, nloc, nx); b.st[0] = nloc; b.st[1] = nx; }
        const unsigned old = xb_add(&bar[XB_XSUB(b.x)], 1u);
        const unsigned gen = old / nloc;
        if (old + 1u == (gen + 1u) * nloc) {
            __builtin_amdgcn_fence(__ATOMIC_RELEASE, "agent");
            asm volatile("s_waitcnt vmcnt(0)" ::: "memory");
            const unsigned og = xb_add(&bar[XB_TOP], 1u);
            const unsigned tg = og / nx;
            if (og + 1u == (tg + 1u) * nx) xb_add(&bar[XB_TOPGEN], 1u);
            else XB_SPIN(xb_ld(&bar[XB_TOPGEN]) == tg, bar);
            __builtin_amdgcn_fence(__ATOMIC_ACQUIRE, "agent");
            xb_add(&bar[XB_XGEN(b.x)], 1u);
            asm volatile("s_waitcnt vmcnt(0)" ::: "memory");
        } else {
            XB_SPIN(xb_ld(&bar[XB_XGEN(b.x)]) == gen, bar);
            __builtin_amdgcn_fence(__ATOMIC_ACQUIRE, "agent");
            asm volatile("s_waitcnt vmcnt(0)" ::: "memory");
        }
    }
    __syncthreads();
}

__global__ void __launch_bounds__(256, 2) hybrid_fwd(Params p) {
  __shared__ __attribute__((aligned(16))) char smraw[SMEM_BYTES];
  cg::grid_group grid = cg::this_grid();
  if (threadIdx.x == 0) *(u32x4*)(smraw + 65536) = u32x4{0u, 0u, 0u, 0u};
  __syncthreads();
  const XcdBarrier xb = xcd_barrier_post((unsigned*)(p.ws + OFF_BAR), (volatile LAS unsigned*)(smraw + 65536));
  phase0(p, smraw);
  grid.sync();
  for (int gi = 0; gi < NGRP; ++gi) {
    phase_h0(p, gi);
    xcd_barrier(xb);
    for (int l = 0; l < DEPTH; ++l) {
      phase_inproj(p, l, smraw);
      xcd_barrier(xb);
      phase_mix1(p, l, smraw);
      xcd_barrier(xb);
      phase_mix2(p, l, smraw);
      xcd_barrier(xb);
      phase_merge(p, l, smraw);
      xcd_barrier(xb);
      phase_outproj(p, l, smraw);
      xcd_barrier(xb);
      phase_final(p, gi, l);
      xcd_barrier(xb);
    }
  }
}

extern "C" void kernel_launch(void* const* d_in, const int* in_sizes, int n_in, void* d_out, int out_size, void* d_ws,
                              size_t ws_size, hipStream_t stream) {
  static int grid_blocks = 0;
  if (!grid_blocks) {
    int dev = 0, cus = 0, per_cu = 0;
    hipGetDevice(&dev);
    hipDeviceGetAttribute(&cus, hipDeviceAttributeMultiprocessorCount, dev);
    hipOccupancyMaxActiveBlocksPerMultiprocessor(&per_cu, hybrid_fwd, 256, 0);
    if (per_cu < 1) per_cu = 1;
    if (per_cu > 2) per_cu = 2;
    grid_blocks = cus * per_cu;
    if (ws_size < WS_END) fprintf(stderr, "kernel_launch: workspace too small: %zu < %zu\n", ws_size, (size_t)WS_END);
  }
  Params p{};
  const float** pp = (const float**)&p;
  for (int i = 0; i < 21; ++i) pp[i] = (const float*)d_in[i];
  p.out = (float*)d_out;
  p.ws = (unsigned char*)d_ws;
  (void)hipMemsetAsync((char*)d_ws + OFF_BAR, 0, 3456 * 4, stream);
  void* args[] = {&p};
  hipError_t e = hipLaunchCooperativeKernel((void*)hybrid_fwd, dim3(grid_blocks), dim3(256), args, 0, stream);
  if (e != hipSuccess) fprintf(stderr, "cooperative launch failed: %s (grid %d)\n", hipGetErrorString(e), grid_blocks);
}
```

```cpp
#include <hip/hip_runtime.h>
#include <hip/hip_cooperative_groups.h>
#include <cstdio>
#include <cstdint>
namespace cg = cooperative_groups;

typedef unsigned short bf16_t;
using bf16x8 = __attribute__((ext_vector_type(8))) short;
using f32x4 = __attribute__((ext_vector_type(4))) float;
using f32x2 = __attribute__((ext_vector_type(2))) float;
using u32x4 = __attribute__((ext_vector_type(4))) uint32_t;
using u32x2 = __attribute__((ext_vector_type(2))) uint32_t;

constexpr int D = 1024, SEQ = 4096, BATCH = 16, DEPTH = 2;
constexpr int IN_COLS = 13872;
constexpr int A_OFF = 0, B_OFF = 4096, C_OFF = 7728, G_OFF = 10800;
constexpr int NT_IN = 109, NP = NT_IN * 128;
constexpr int NB = 4, R = NB * SEQ, NGRP = BATCH / NB;
constexpr int LDK = 40;
constexpr int KS_LD = 80;
constexpr int VT_LD = 68;
constexpr int HS_LD = 136;
constexpr int SMEM_BYTES = 65536 + 16;

constexpr size_t al256(size_t x) { return (x + 255) & ~size_t(255); }
constexpr size_t OFF_WINT = 0;
constexpr size_t OFF_WBRT = al256(OFF_WINT + (size_t)DEPTH * NP * D * 2);
constexpr size_t OFF_WOUTT = al256(OFF_WBRT + (size_t)DEPTH * 3 * D * D * 2);
constexpr size_t OFF_WC1T = al256(OFF_WOUTT + (size_t)DEPTH * D * D * 2);
constexpr size_t OFF_WM = al256(OFF_WC1T + (size_t)DEPTH * 2 * 128 * 2048 * 2);
constexpr size_t OFF_BIAS1 = al256(OFF_WM + (size_t)DEPTH * 8 * 128 * 128 * 2);
constexpr size_t OFF_MOD = al256(OFF_BIAS1 + (size_t)DEPTH * 2 * 8 * 128 * 4);
constexpr size_t OFF_H = al256(OFF_MOD + (size_t)DEPTH * 16 * 3072 * 4);
constexpr size_t SZ_ACT = (size_t)R * 1024 * 2;
constexpr size_t OFF_YAPRE = al256(OFF_H + SZ_ACT);
constexpr size_t OFF_BZA = al256(OFF_YAPRE + SZ_ACT);
constexpr size_t OFF_Q = al256(OFF_BZA + SZ_ACT);
constexpr size_t OFF_ZB = al256(OFF_Q + SZ_ACT);
constexpr size_t OFF_UZ = al256(OFF_ZB + SZ_ACT);
constexpr size_t OFF_GV = al256(OFF_UZ + SZ_ACT);
constexpr size_t OFF_KV = al256(OFF_GV + SZ_ACT);
constexpr size_t OFF_GL = al256(OFF_KV + (size_t)R * 1536 * 2);
constexpr size_t OFF_GATES = al256(OFF_GL + (size_t)R * 48 * 4);
constexpr size_t OFF_YA = al256(OFF_GATES + (size_t)R * 3072 * 2);
constexpr size_t OFF_YB = al256(OFF_YA + SZ_ACT);
constexpr size_t OFF_YC = al256(OFF_YB + SZ_ACT);
constexpr size_t OFF_KCMP = al256(OFF_YC + SZ_ACT);
constexpr size_t OFF_VCMP = al256(OFF_KCMP + (size_t)NB * 4 * 256 * 64 * 2);
constexpr size_t OFF_STATS = al256(OFF_VCMP + (size_t)NB * 4 * 256 * 64 * 2);
constexpr size_t OFF_BAR = al256(OFF_STATS + (size_t)R * 2 * 4);
constexpr size_t WS_END = al256(OFF_BAR + 3456 * 4);

struct Params {
  const float *x, *c, *g_pre, *g_post, *w_ada, *b_ada, *w_in, *conv_w, *conv_b, *pos_ck, *w_ck1, *w_ck2,
      *pos_cv, *w_cv1, *w_cv2, *ln_g, *ln_b, *w_s, *b_s, *w_br, *w_out;
  float* out;
  unsigned char* ws;
};

typedef __bf16 bf16x2_native __attribute__((ext_vector_type(2)));
__device__ __forceinline__ uint32_t pack2(float a, float b) {
  f32x2 v = {a, b};
  return __builtin_bit_cast(uint32_t, __builtin_convertvector(v, bf16x2_native));
}
__device__ __forceinline__ bf16_t f2bf(float f) { return (bf16_t)(pack2(f, f) & 0xffffu); }
__device__ __forceinline__ float bf2f(uint32_t h) { return __uint_as_float(h << 16); }
__device__ __forceinline__ float sigmoid_(float x) { return __builtin_amdgcn_rcpf(1.f + __expf(-x)); }
__device__ __forceinline__ float silu_(float x) { return x * __builtin_amdgcn_rcpf(1.f + __expf(-x)); }
__device__ __forceinline__ float gelu_(float x) {
  float y = 0.7978845608f * (x + 0.044715f * x * x * x);
  return x * __builtin_amdgcn_rcpf(1.f + __expf(-2.f * y));
}
__device__ __forceinline__ f32x4 mfma16(bf16x8 a, bf16x8 b, f32x4 c) {
  return __builtin_amdgcn_mfma_f32_16x16x32_bf16(a, b, c, 0, 0, 0);
}
__device__ __forceinline__ float bperm(float v, int srclane) {
  return __int_as_float(__builtin_amdgcn_ds_bpermute(srclane << 2, __float_as_int(v)));
}
__device__ __forceinline__ float wave_sum(float v, int lane) {
#pragma unroll
  for (int o = 32; o >= 1; o >>= 1) v += bperm(v, lane ^ o);
  return v;
}

__device__ __forceinline__ int opaque_tid() {
  int t = threadIdx.x;
  asm volatile("" : "+v"(t));
  return t;
}

__device__ __forceinline__ int win_colmap(int np) {
  int tile = np >> 7, r = np & 127;
  if (tile < 32) { int wc = r >> 6, t = (r >> 4) & 3, i = r & 15; return A_OFF + t * 1024 + tile * 32 + wc * 16 + i; }
  if (tile < 40) return B_OFF + (np - 32 * 128);
  if (tile < 52) return B_OFF + 1024 + (np - 40 * 128);
  if (tile < 60) return B_OFF + 2560 + (np - 52 * 128);
  if (tile == 60) return r < 48 ? B_OFF + 3584 + r : -1;
  if (tile < 77) { int tb = tile - 61, wc = r >> 6, t = (r >> 4) & 3, i = r & 15; return C_OFF + ((t & 1) ? 2048 : 0) + tb * 64 + wc * 32 + (t >> 1) * 16 + i; }
  if (tile < 85) return C_OFF + 1024 + (np - 77 * 128);
  return G_OFF + (np - 85 * 128);
}

template <bool WIN>
__device__ __forceinline__ void transpose_tile(const float* __restrict__ src, int ld_src, bf16_t* __restrict__ dst, int Kdim, int n0, int k0, float* sm, int tid) {
  const int tx = tid & 63, ty = tid >> 6;
  const int col = WIN ? win_colmap(n0 + tx) : (n0 + tx);
  __syncthreads();
#pragma unroll
  for (int i = 0; i < 16; ++i) {
    int k = ty * 16 + i;
    float v = (col >= 0) ? src[(size_t)(k0 + k) * ld_src + col] : 0.f;
    sm[k * 65 + tx] = v;
  }
  __syncthreads();
#pragma unroll
  for (int i = 0; i < 16; ++i) {
    int n = ty * 16 + i;
    dst[(size_t)(n0 + n) * Kdim + k0 + tx] = f2bf(sm[tx * 65 + n]);
  }
}

__device__ __forceinline__ void phase0(const Params& p, char* smraw) {
  float* smf = (float*)smraw;
  const int bid = blockIdx.x, nblk = gridDim.x, tid = opaque_tid();
  bf16_t* WinT = (bf16_t*)(p.ws + OFF_WINT);
  bf16_t* WbrT = (bf16_t*)(p.ws + OFF_WBRT);
  bf16_t* WoutT = (bf16_t*)(p.ws + OFF_WOUTT);
  bf16_t* Wc1T = (bf16_t*)(p.ws + OFF_WC1T);
  bf16_t* Wm = (bf16_t*)(p.ws + OFF_WM);
  float* bias1 = (float*)(p.ws + OFF_BIAS1);
  float* mod = (float*)(p.ws + OFF_MOD);
  for (int t = bid; t < DEPTH * 218 * 16; t += nblk) {
    int l = t / (218 * 16), r = t % (218 * 16), nt = r >> 4, kt = r & 15;
    transpose_tile<true>(p.w_in + (size_t)l * D * IN_COLS, IN_COLS, WinT + (size_t)l * NP * D, D, nt * 64, kt * 64, smf, tid);
  }
  for (int t = bid; t < DEPTH * 3 * 256; t += nblk) {
    int li = t >> 8, r = t & 255, nt = r >> 4, kt = r & 15;
    transpose_tile<false>(p.w_br + (size_t)li * D * D, D, WbrT + (size_t)li * D * D, D, nt * 64, kt * 64, smf, tid);
  }
  for (int t = bid; t < DEPTH * 256; t += nblk) {
    int l = t >> 8, r = t & 255, nt = r >> 4, kt = r & 15;
    transpose_tile<false>(p.w_out + (size_t)l * D * D, D, WoutT + (size_t)l * D * D, D, nt * 64, kt * 64, smf, tid);
  }
  for (int t = bid; t < DEPTH * 2 * 64; t += nblk) {
    int lk = t >> 6, r = t & 63, nt = r >> 5, kt = r & 31;
    int l = lk >> 1, kv = lk & 1;
    const float* src = (kv ? p.w_cv1 : p.w_ck1) + (size_t)l * 2048 * 128;
    transpose_tile<false>(src, 128, Wc1T + (size_t)lk * 128 * 2048, 2048, nt * 64, kt * 64, smf, tid);
  }
  for (int e = bid * 256 + tid; e < DEPTH * 8 * 128 * 128; e += nblk * 256) {
    int j = e & 127, i = (e >> 7) & 127;
    Wm[e] = (j <= i) ? f2bf(p.w_s[e]) : (bf16_t)0;
  }
  for (int t = bid - 128; t >= 0 && t < DEPTH * 2 * 8; t += nblk) {
    int lk = t >> 3, ks = t & 7, l = lk >> 1, kv = lk & 1;
    const float* pos = (kv ? p.pos_cv : p.pos_ck) + (size_t)l * 2048;
    const float* w1 = (kv ? p.w_cv1 : p.w_ck1) + (size_t)l * 2048 * 128;
    int n = tid & 127, half = tid >> 7;
    float acc = 0.f;
    const int kb = ks * 256 + half * 128;
#pragma unroll 16
    for (int k = kb; k < kb + 128; ++k) acc += pos[k] * w1[(size_t)k * 128 + n];
    __syncthreads();
    smf[tid] = acc;
    __syncthreads();
    if (tid < 128) bias1[t * 128 + tid] = smf[tid] + smf[tid + 128];
  }
  for (int t = nblk - 1 - bid; t < DEPTH * 48; t += nblk) {
    int l = t / 48, ch = t % 48;
    int tx = tid & 63, ty = tid >> 6;
    int col = ch * 64 + tx;
    __syncthreads();
    for (int i = 0; i < 64; ++i) {
      int e = tid + 256 * i;
      smf[(e & 1023) * 16 + (e >> 10)] = silu_(p.c[e]);
    }
    __syncthreads();
    float acc[16];
#pragma unroll
    for (int b = 0; b < 16; ++b) acc[b] = 0.f;
    const float* w = p.w_ada + (size_t)l * D * 3072 + col;
#pragma unroll 8
    for (int k = ty * 256; k < ty * 256 + 256; ++k) {
      float wv = w[(size_t)k * 3072];
      const f32x4 s0 = *(const f32x4*)(smf + k * 16), s1 = *(const f32x4*)(smf + k * 16 + 4), s2 = *(const f32x4*)(smf + k * 16 + 8), s3 = *(const f32x4*)(smf + k * 16 + 12);
#pragma unroll
      for (int b = 0; b < 4; ++b) { acc[b] += s0[b] * wv; acc[4 + b] += s1[b] * wv; acc[8 + b] += s2[b] * wv; acc[12 + b] += s3[b] * wv; }
    }
    __syncthreads();
#pragma unroll
    for (int b = 0; b < 16; ++b) smf[(ty * 16 + b) * 64 + tx] = acc[b];
    __syncthreads();
    if (ty == 0) {
#pragma unroll
      for (int b = 0; b < 16; ++b) {
        float s_ = smf[b * 64 + tx] + smf[(16 + b) * 64 + tx] + smf[(32 + b) * 64 + tx] + smf[(48 + b) * 64 + tx];
        mod[((size_t)l * 16 + b) * 3072 + col] = s_ + p.b_ada[l * 3072 + col];
      }
    }
  }
}

__device__ __forceinline__ void write_h_row(const f32x4 (&xv)[4], float ss, const float* g_pre, const float* modl_b, bf16_t* hrow, int lane) {
  float rs = rsqrtf(ss * (1.f / 1024.f) + 1e-6f);
#pragma unroll
  for (int i = 0; i < 4; ++i) {
    int c = i * 256 + lane * 4;
    f32x4 g = *(const f32x4*)(g_pre + c);
    f32x4 sh = *(const f32x4*)(modl_b + c);
    f32x4 sc = *(const f32x4*)(modl_b + 1024 + c);
    float h0 = xv[i].x * rs * g.x * (1.f + sc.x) + sh.x;
    float h1 = xv[i].y * rs * g.y * (1.f + sc.y) + sh.y;
    float h2 = xv[i].z * rs * g.z * (1.f + sc.z) + sh.z;
    float h3 = xv[i].w * rs * g.w * (1.f + sc.w) + sh.w;
    u32x2 o; o.x = pack2(h0, h1); o.y = pack2(h2, h3);
    *(u32x2*)(hrow + c) = o;
  }
}

__device__ __forceinline__ void phase_h0(const Params& p, int grp_i) {
  const int tid = opaque_tid(); const int lane = tid & 63, w = tid >> 6;
  bf16_t* H = (bf16_t*)(p.ws + OFF_H);
  const float* mod = (const float*)(p.ws + OFF_MOD);
  for (int r = blockIdx.x * 4 + w; r < R; r += gridDim.x * 4) {
    size_t grow = (size_t)grp_i * R + r;
    int b = (int)(grow >> 12);
    const float* xr = p.x + grow * D;
    f32x4 xv[4]; float ss = 0.f;
#pragma unroll
    for (int i = 0; i < 4; ++i) {
      xv[i] = *(const f32x4*)(xr + i * 256 + lane * 4);
      ss += xv[i].x * xv[i].x + xv[i].y * xv[i].y + xv[i].z * xv[i].z + xv[i].w * xv[i].w;
    }
    ss = wave_sum(ss, lane);
    write_h_row(xv, ss, p.g_pre, mod + (size_t)b * 3072, H + (size_t)r * D, lane);
  }
}

__device__ __forceinline__ void phase_final(const Params& p, int grp_i, int l) {
  const int tid = opaque_tid(); const int lane = tid & 63, w = tid >> 6;
  bf16_t* H = (bf16_t*)(p.ws + OFF_H);
  const bf16_t* OP = (const bf16_t*)(p.ws + OFF_YAPRE);
  const float* mod = (const float*)(p.ws + OFF_MOD);
  const float* xin = (l == 0) ? p.x : p.out;
  for (int r = blockIdx.x * 4 + w; r < R; r += gridDim.x * 4) {
    size_t grow = (size_t)grp_i * R + r;
    int b = (int)(grow >> 12);
    const float* xr = xin + grow * D;
    const bf16_t* orow = OP + (size_t)r * D;
    const float* gate = mod + ((size_t)l * 16 + b) * 3072 + 2048;
    const float* gp = p.g_post + l * D;
    f32x4 xv[4], ov[4]; float ss = 0.f;
#pragma unroll
    for (int i = 0; i < 4; ++i) {
      int c = i * 256 + lane * 4;
      xv[i] = *(const f32x4*)(xr + c);
      u32x2 u = *(const u32x2*)(orow + c);
      ov[i].x = bf2f(u.x & 0xffffu); ov[i].y = bf2f(u.x >> 16); ov[i].z = bf2f(u.y & 0xffffu); ov[i].w = bf2f(u.y >> 16);
      ss += ov[i].x * ov[i].x + ov[i].y * ov[i].y + ov[i].z * ov[i].z + ov[i].w * ov[i].w;
    }
    ss = wave_sum(ss, lane);
    float rs = rsqrtf(ss * (1.f / 1024.f) + 1e-6f);
    float ss2 = 0.f;
#pragma unroll
    for (int i = 0; i < 4; ++i) {
      int c = i * 256 + lane * 4;
      f32x4 g = *(const f32x4*)(gp + c);
      f32x4 ga = *(const f32x4*)(gate + c);
      xv[i].x += ga.x * (ov[i].x * rs * g.x);
      xv[i].y += ga.y * (ov[i].y * rs * g.y);
      xv[i].z += ga.z * (ov[i].z * rs * g.z);
      xv[i].w += ga.w * (ov[i].w * rs * g.w);
      *(f32x4*)(p.out + grow * D + c) = xv[i];
      ss2 += xv[i].x * xv[i].x + xv[i].y * xv[i].y + xv[i].z * xv[i].z + xv[i].w * xv[i].w;
    }
    if (l == 0) {
      ss2 = wave_sum(ss2, lane);
      write_h_row(xv, ss2, p.g_pre + D, mod + ((size_t)16 + b) * 3072, H + (size_t)r * D, lane);
    }
  }
}

struct StdLoader {
  const bf16_t* base;
  int soff;
  u32x4 r0, r1;
  __device__ __forceinline__ void init(const bf16_t* tile_base, size_t ld, int tid) {
    base = tile_base + (size_t)(tid >> 1) * ld + (tid & 1) * 16;
    soff = (tid >> 1) * LDK + (tid & 1) * 16;
  }
  __device__ __forceinline__ void load(int kt) {
    const bf16_t* q = base + kt * 32;
    r0 = *(const u32x4*)q; r1 = *(const u32x4*)(q + 8);
  }
  __device__ __forceinline__ void store(bf16_t* tile) {
    bf16_t* q = tile + soff;
    *(u32x4*)q = r0; *(u32x4*)(q + 8) = r1;
  }
};

template <class AL, class BL>
__device__ __forceinline__ void gemm_core(f32x4 (&acc)[4][4], AL& al, BL& bl, int nk, bf16_t* sm, int tid) {
  const int lane = tid & 63, w = tid >> 6, wr = w >> 1, wc = w & 1, l15 = lane & 15, grp = lane >> 4;
  al.load(0); bl.load(0);
  __syncthreads();
  al.store(sm); bl.store(sm + 2 * 128 * LDK);
  __syncthreads();
  for (int kt = 0; kt < nk; ++kt) {
    const bf16_t* Ab = sm + (kt & 1) * 128 * LDK;
    const bf16_t* Bb = sm + (2 + (kt & 1)) * 128 * LDK;
    if (kt + 1 < nk) { al.load(kt + 1); bl.load(kt + 1); }
    bf16x8 a[4], b[4];
#pragma unroll
    for (int m = 0; m < 4; ++m) a[m] = *(const bf16x8*)(Ab + (wr * 64 + m * 16 + l15) * LDK + grp * 8);
#pragma unroll
    for (int n = 0; n < 4; ++n) b[n] = *(const bf16x8*)(Bb + (wc * 64 + n * 16 + l15) * LDK + grp * 8);
#pragma unroll
    for (int m = 0; m < 4; ++m)
#pragma unroll
      for (int n = 0; n < 4; ++n) acc[m][n] = mfma16(a[m], b[n], acc[m][n]);
    if (kt + 1 < nk) {
      al.store(sm + ((kt + 1) & 1) * 128 * LDK);
      bl.store(sm + (2 + ((kt + 1) & 1)) * 128 * LDK);
    }
    __syncthreads();
  }
}

struct Regs4 { u32x4 r0, r1, r2, r3; };
struct StdLoader64 {
  typedef Regs4 Regs;
  const bf16_t* base;
  size_t ld32;
  int soff;
  __device__ __forceinline__ void init(const bf16_t* tile_base, size_t ld, int tid) {
    base = tile_base + (size_t)(tid >> 3) * ld + (tid & 7) * 8;
    ld32 = ld * 32;
    soff = (tid >> 3) * 64 + (((tid & 7) ^ ((tid >> 4) & 7)) * 8);
  }
  __device__ __forceinline__ void load(int kt, Regs& r) const {
    const bf16_t* q = base + kt * 64;
    r.r0 = *(const u32x4*)q; r.r1 = *(const u32x4*)(q + ld32); r.r2 = *(const u32x4*)(q + 2 * ld32); r.r3 = *(const u32x4*)(q + 3 * ld32);
  }
  __device__ __forceinline__ void store(bf16_t* tile, const Regs& r) const {
    bf16_t* q = tile + soff;
    *(u32x4*)q = r.r0; *(u32x4*)(q + 2048) = r.r1; *(u32x4*)(q + 4096) = r.r2; *(u32x4*)(q + 6144) = r.r3;
  }
};

template <int NST, class AL, class BL>
__device__ __forceinline__ void gemm_core64(f32x4 (&acc)[4][4], const AL& al, const BL& bl, int nk, bf16_t* sm, int tid) {
  const int lane = tid & 63, w = tid >> 6, wr = w >> 1, wc = w & 1, l15 = lane & 15, grp = lane >> 4;
  constexpr int TILE = 128 * 64;
  const int sw = (l15 >> 1) & 7;
  const int fo0 = l15 * 64 + ((grp ^ sw) * 8), fo1 = l15 * 64 + (((4 + grp) ^ sw) * 8);
  typename AL::Regs ra[NST];
  typename BL::Regs rb[NST];
#pragma unroll
  for (int s_ = 0; s_ < NST; ++s_) { al.load(s_, ra[s_]); bl.load(s_, rb[s_]); }
  __syncthreads();
  al.store(sm, ra[0]); bl.store(sm + 2 * TILE, rb[0]);
  { const int k2 = NST < nk ? NST : nk - 1; al.load(k2, ra[0]); bl.load(k2, rb[0]); }
  __syncthreads();
  for (int kt0 = 0; kt0 < nk; kt0 += NST) {
#pragma unroll
    for (int u = 0; u < NST; ++u) {
      const int kt = kt0 + u;
      const bf16_t* Ab = sm + (kt & 1) * TILE + wr * 64 * 64;
      const bf16_t* Bb = sm + (2 + (kt & 1)) * TILE + wc * 64 * 64;
#pragma unroll
      for (int ks = 0; ks < 2; ++ks) {
        const int fo = ks ? fo1 : fo0;
        bf16x8 a[4], b[4];
#pragma unroll
        for (int m = 0; m < 4; ++m) a[m] = *(const bf16x8*)(Ab + m * 16 * 64 + fo);
#pragma unroll
        for (int n = 0; n < 4; ++n) b[n] = *(const bf16x8*)(Bb + n * 16 * 64 + fo);
#pragma unroll
        for (int m = 0; m < 4; ++m)
#pragma unroll
          for (int n = 0; n < 4; ++n) acc[m][n] = mfma16(b[n], a[m], acc[m][n]);
      }
      al.store(sm + ((kt + 1) & 1) * TILE, ra[(u + 1) % NST]);
      bl.store(sm + (2 + ((kt + 1) & 1)) * TILE, rb[(u + 1) % NST]);
      {
        int k2 = kt + 1 + NST;
        k2 = k2 < nk ? k2 : nk - 1;
        al.load(k2, ra[(u + 1) % NST]); bl.load(k2, rb[(u + 1) % NST]);
      }
      __syncthreads();
    }
  }
}

__device__ __forceinline__ void glds_prefetch0(const bf16_t* Atile, size_t lda, const bf16_t* Btile, size_t ldb, bf16_t* sm, int tid) {
  constexpr int TILE = 128 * 64;
  const int gch = ((tid & 7) ^ ((tid >> 4) & 7)) * 8;
  const bf16_t* ga = Atile + (size_t)(tid >> 3) * lda + gch;
  const bf16_t* gb = Btile + (size_t)(tid >> 3) * ldb + gch;
  const size_t a32 = lda * 32, b32 = ldb * 32;
  bf16_t* lbase = sm + tid * 8;
#pragma unroll
  for (int i_ = 0; i_ < 4; ++i_) {
    __builtin_amdgcn_global_load_lds((const unsigned*)(ga + i_ * a32), (unsigned*)(lbase + i_ * 2048), 16, 0, 0);
    __builtin_amdgcn_global_load_lds((const unsigned*)(gb + i_ * b32), (unsigned*)(lbase + 2 * TILE + i_ * 2048), 16, 0, 0);
  }
}

#define DSR1(dst, base, OFF) asm volatile("ds_read_b128 %0, %1 offset:" #OFF : "=v"(dst) : "v"(base) : "memory")
#define DSR4(arr, base) do { DSR1(arr[0], base, 0); DSR1(arr[1], base, 2048); DSR1(arr[2], base, 4096); DSR1(arr[3], base, 6144); } while (0)
template <bool HOIST>
__device__ __forceinline__ void gemm_core_glds(f32x4 (&acc)[4][4], const bf16_t* Atile, size_t lda, const bf16_t* Btile, size_t ldb,
                                               int nk, bf16_t* sm, int tid) {
  const int lane = tid & 63, w = tid >> 6, wr = w >> 1, wc = w & 1, l15 = lane & 15, grp = lane >> 4;
  constexpr int TILE = 128 * 64;
  const int sw = (l15 >> 1) & 7;
  const int fo0 = l15 * 64 + ((grp ^ sw) * 8), fo1 = l15 * 64 + (((4 + grp) ^ sw) * 8);
  const int gch = ((tid & 7) ^ ((tid >> 4) & 7)) * 8;
  const bf16_t* ga = Atile + (size_t)(tid >> 3) * lda + gch;
  const bf16_t* gb = Btile + (size_t)(tid >> 3) * ldb + gch;
  const size_t a32 = lda * 32, b32 = ldb * 32;
  bf16_t* lbase = sm + tid * 8;
#define GLDS_ISSUE(KT, BUF)                                                                                                            \
  do {                                                                                                                                 \
    _Pragma("unroll") for (int i_ = 0; i_ < 4; ++i_) {                                                                                 \
      __builtin_amdgcn_global_load_lds((const unsigned*)(ga + i_ * a32 + (KT) * 64), (unsigned*)(lbase + (BUF) * TILE + i_ * 2048), 16, 0, 0);       \
      __builtin_amdgcn_global_load_lds((const unsigned*)(gb + i_ * b32 + (KT) * 64), (unsigned*)(lbase + (2 + (BUF)) * TILE + i_ * 2048), 16, 0, 0); \
    }                                                                                                                                  \
  } while (0)
#define GLDS_COMPUTE(BUF)                                                                             \
  do {                                                                                                \
    const bf16_t* Ab = sm + (BUF) * TILE + wr * 64 * 64;                                              \
    const bf16_t* Bb = sm + (2 + (BUF)) * TILE + wc * 64 * 64;                                        \
    if (HOIST) {                                                                                      \
        \
      bf16x8 a0[4], b0[4], a1[4], b1[4];                                                              \
      const unsigned pa0 = (unsigned)(size_t)(Ab + fo0), pb0 = (unsigned)(size_t)(Bb + fo0);          \
      const unsigned pa1 = (unsigned)(size_t)(Ab + fo1), pb1 = (unsigned)(size_t)(Bb + fo1);          \
      DSR4(a0, pa0); DSR4(b0, pb0); DSR4(a1, pa1); DSR4(b1, pb1);                                     \
      asm volatile("s_waitcnt lgkmcnt(8)" : "+v"(a0[0]), "+v"(a0[1]), "+v"(a0[2]), "+v"(a0[3]), "+v"(b0[0]), "+v"(b0[1]), "+v"(b0[2]), "+v"(b0[3]) :: "memory"); \
      _Pragma("unroll") for (int m = 0; m < 4; ++m)                                                   \
        _Pragma("unroll") for (int n = 0; n < 4; ++n) acc[m][n] = mfma16(b0[n], a0[m], acc[m][n]);    \
      __builtin_amdgcn_sched_barrier(0);             \
      asm volatile("s_waitcnt lgkmcnt(0)" : "+v"(a1[0]), "+v"(a1[1]), "+v"(a1[2]), "+v"(a1[3]), "+v"(b1[0]), "+v"(b1[1]), "+v"(b1[2]), "+v"(b1[3]) :: "memory"); \
      _Pragma("unroll") for (int m = 0; m < 4; ++m)                                                   \
        _Pragma("unroll") for (int n = 0; n < 4; ++n) acc[m][n] = mfma16(b1[n], a1[m], acc[m][n]);    \
      __builtin_amdgcn_sched_barrier(0);             \
    } else {                                                                                          \
      _Pragma("unroll") for (int ks = 0; ks < 2; ++ks) {                                              \
        const int fo = ks ? fo1 : fo0;                                                                \
        bf16x8 a[4], b[4];                                                                            \
        _Pragma("unroll") for (int m = 0; m < 4; ++m) a[m] = *(const bf16x8*)(Ab + m * 16 * 64 + fo); \
        _Pragma("unroll") for (int n = 0; n < 4; ++n) b[n] = *(const bf16x8*)(Bb + n * 16 * 64 + fo); \
        _Pragma("unroll") for (int m = 0; m < 4; ++m)                                                 \
          _Pragma("unroll") for (int n = 0; n < 4; ++n) acc[m][n] = mfma16(b[n], a[m], acc[m][n]);     \
      }                                                                                               \
    }                                                                                                 \
  } while (0)
  asm volatile("s_waitcnt vmcnt(0)" ::: "memory");
  __syncthreads();
  for (int kt = 0; kt < nk; kt += 2) {
    GLDS_ISSUE(kt + 1, 1);
    GLDS_COMPUTE(0);
    asm volatile("s_waitcnt vmcnt(0)" ::: "memory");
    __syncthreads();
    if (kt + 2 < nk) GLDS_ISSUE(kt + 2, 0);
    GLDS_COMPUTE(1);
    asm volatile("s_waitcnt vmcnt(0)" ::: "memory");
    __syncthreads();
  }
#undef GLDS_ISSUE
#undef GLDS_COMPUTE
}

__device__ __forceinline__ void gemm_core_glds_cmp(f32x4 (&acc)[4][4], const bf16_t* colptr, int r0, const bf16_t* Btile, size_t ldb,
                                                   int nk, bf16_t* sm, int tid) {
  const int lane = tid & 63, w = tid >> 6, wr = w >> 1, wc = w & 1, l15 = lane & 15, grp = lane >> 4;
  constexpr int TILE = 128 * 64;
  const int sw = (l15 >> 1) & 7;
  const int fo0 = l15 * 64 + ((grp ^ sw) * 8), fo1 = l15 * 64 + (((4 + grp) ^ sw) * 8);
  const int gch = ((tid & 7) ^ ((tid >> 4) & 7)) * 8;
  const bf16_t* gb = Btile + (size_t)(tid >> 3) * ldb + gch;
  const size_t b32 = ldb * 32;
  bf16_t* lbase = sm + tid * 8;
#define CMP_ISSUE(KT, BUF)                                                                                                             \
  do {                                                                                                                                 \
    _Pragma("unroll") for (int i_ = 0; i_ < 4; ++i_) {                                                                                 \
      int tok_ = 16 * (r0 + 32 * i_) + (KT);                                                                                           \
      tok_ = tok_ > (SEQ - 1) ? (SEQ - 1) : tok_;                                                                                      \
      __builtin_amdgcn_global_load_lds((const unsigned*)(colptr + (size_t)tok_ * 1536), (unsigned*)(lbase + (BUF) * TILE + i_ * 2048), 16, 0, 0);     \
      __builtin_amdgcn_global_load_lds((const unsigned*)(gb + i_ * b32 + (KT) * 64), (unsigned*)(lbase + (2 + (BUF)) * TILE + i_ * 2048), 16, 0, 0); \
    }                                                                                                                                  \
  } while (0)
#define CMP_COMPUTE(BUF)                                                                              \
  do {                                                                                                \
    const bf16_t* Ab = sm + (BUF) * TILE + wr * 64 * 64;                                              \
    const bf16_t* Bb = sm + (2 + (BUF)) * TILE + wc * 64 * 64;                                        \
    _Pragma("unroll") for (int ks = 0; ks < 2; ++ks) {                                                \
      const int fo = ks ? fo1 : fo0;                                                                  \
      bf16x8 a[4], b[4];                                                                              \
      _Pragma("unroll") for (int m = 0; m < 4; ++m) a[m] = *(const bf16x8*)(Ab + m * 16 * 64 + fo);   \
      _Pragma("unroll") for (int n = 0; n < 4; ++n) b[n] = *(const bf16x8*)(Bb + n * 16 * 64 + fo);   \
      _Pragma("unroll") for (int m = 0; m < 4; ++m)                                                   \
        _Pragma("unroll") for (int n = 0; n < 4; ++n) acc[m][n] = mfma16(b[n], a[m], acc[m][n]);     \
    }                                                                                                 \
  } while (0)
  __syncthreads();
  CMP_ISSUE(0, 0);
  asm volatile("s_waitcnt vmcnt(0)" ::: "memory");
  __syncthreads();
  for (int kt = 0; kt < nk; kt += 2) {
    CMP_ISSUE(kt + 1, 1);
    CMP_COMPUTE(0);
    asm volatile("s_waitcnt vmcnt(0)" ::: "memory");
    __syncthreads();
    if (kt + 2 < nk) CMP_ISSUE(kt + 2, 0);
    CMP_COMPUTE(1);
    asm volatile("s_waitcnt vmcnt(0)" ::: "memory");
    __syncthreads();
  }
#undef CMP_ISSUE
#undef CMP_COMPUTE
}

__device__ __forceinline__ void zero_acc(f32x4 (&acc)[4][4]) {
#pragma unroll
  for (int m = 0; m < 4; ++m)
#pragma unroll
    for (int n = 0; n < 4; ++n) acc[m][n] = f32x4{0.f, 0.f, 0.f, 0.f};
}

__device__ __forceinline__ void phase_inproj(const Params& p, int l, char* smraw) {
  bf16_t* sm = (bf16_t*)smraw;
  const bf16_t* H = (const bf16_t*)(p.ws + OFF_H);
  const bf16_t* W = (const bf16_t*)(p.ws + OFF_WINT) + (size_t)l * NP * D;
  bf16_t* yApre = (bf16_t*)(p.ws + OFF_YAPRE);
  bf16_t* bzA = (bf16_t*)(p.ws + OFF_BZA);
  bf16_t* qb = (bf16_t*)(p.ws + OFF_Q);
  bf16_t* zb = (bf16_t*)(p.ws + OFF_ZB);
  bf16_t* uz = (bf16_t*)(p.ws + OFF_UZ);
  bf16_t* gv = (bf16_t*)(p.ws + OFF_GV);
  bf16_t* kvb = (bf16_t*)(p.ws + OFF_KV);
  float* glb = (float*)(p.ws + OFF_GL);
  bf16_t* gates = (bf16_t*)(p.ws + OFF_GATES);
  const int tid = opaque_tid(); const int lane = tid & 63, w = tid >> 6, wr = w >> 1, wc = w & 1, l15 = lane & 15, grp = lane >> 4;
  constexpr int MT = R / 128;
  constexpr int NC = (NT_IN + 7) / 8;
  const int nx = gridDim.x >> 3;
  constexpr int CJ_END = (MT / 8) * NC * 64;
  auto cj_valid = [&](int c) { return c < CJ_END && ((c >> 6) % NC) * 8 + ((c & 63) >> 3) < NT_IN; };
  auto cj_next = [&](int c) {
    do { c = ((c & 63) + nx < 64) ? (c + nx) : (((c >> 6) + 8) * 64 + (int)(blockIdx.x >> 3)); } while (c < CJ_END && !cj_valid(c));
    return c;
  };
  int cj = (blockIdx.x & 7) * 64 + (blockIdx.x >> 3);
  if (!cj_valid(cj)) cj = cj_next(cj);
  __syncthreads();
  if (cj < CJ_END) {
    const int cell = cj >> 6, jj = cj & 63;
    glds_prefetch0(H + (size_t)((cell / NC) * 8 + (jj & 7)) * 128 * D, D, W + (size_t)((cell % NC) * 8 + (jj >> 3)) * 128 * D, D, sm, tid);
  }
  while (cj < CJ_END) {
    const int cell = cj >> 6, jj = cj & 63;
    const int nt = (cell % NC) * 8 + (jj >> 3), mt = (cell / NC) * 8 + (jj & 7);
    f32x4 acc[4][4];
    zero_acc(acc);
    gemm_core_glds<true>(acc, H + (size_t)mt * 128 * D, D, W + (size_t)nt * 128 * D, D, D / 64, sm, tid);
    cj = cj_next(cj);
    if (cj < CJ_END) {
      const int cell2 = cj >> 6, jj2 = cj & 63;
      glds_prefetch0(H + (size_t)((cell2 / NC) * 8 + (jj2 & 7)) * 128 * D, D, W + (size_t)((cell2 % NC) * 8 + (jj2 >> 3)) * 128 * D, D, sm, tid);
    }
    const int rbase = mt * 128 + wr * 64 + l15;
    const int c4 = 4 * grp;
#define ST4(PTR, V0, V1, V2, V3) *(u32x2*)(PTR) = u32x2{pack2((V0), (V1)), pack2((V2), (V3))}
    if (nt < 32) {
      const int ch = nt * 32 + wc * 16 + c4;
#pragma unroll
      for (int m = 0; m < 4; ++m) {
        const size_t row = rbase + m * 16;
        ST4(yApre + row * 1024 + ch, acc[m][1][0] * acc[m][2][0], acc[m][1][1] * acc[m][2][1], acc[m][1][2] * acc[m][2][2], acc[m][1][3] * acc[m][2][3]);
        ST4(bzA + row * 1024 + ch, acc[m][0][0] * silu_(acc[m][3][0]), acc[m][0][1] * silu_(acc[m][3][1]), acc[m][0][2] * silu_(acc[m][3][2]), acc[m][0][3] * silu_(acc[m][3][3]));
      }
    } else if (nt < 40) {
      const int cb = (nt - 32) * 128 + wc * 64 + c4;
      const float qs = 0.125f * 1.44269504f;
#pragma unroll
      for (int m = 0; m < 4; ++m)
#pragma unroll
        for (int n = 0; n < 4; ++n)
          ST4(qb + (size_t)(rbase + m * 16) * 1024 + cb + n * 16, acc[m][n][0] * qs, acc[m][n][1] * qs, acc[m][n][2] * qs, acc[m][n][3] * qs);
    } else if (nt < 52) {
      const int cb = (nt - 40) * 128 + wc * 64 + c4;
#pragma unroll
      for (int m = 0; m < 4; ++m)
#pragma unroll
        for (int n = 0; n < 4; ++n)
          ST4(kvb + (size_t)(rbase + m * 16) * 1536 + cb + n * 16, acc[m][n][0], acc[m][n][1], acc[m][n][2], acc[m][n][3]);
    } else if (nt < 60) {
      const int cb = (nt - 52) * 128 + wc * 64 + c4;
#pragma unroll
      for (int m = 0; m < 4; ++m)
#pragma unroll
        for (int n = 0; n < 4; ++n)
          ST4(zb + (size_t)(rbase + m * 16) * 1024 + cb + n * 16, silu_(acc[m][n][0]), silu_(acc[m][n][1]), silu_(acc[m][n][2]), silu_(acc[m][n][3]));
    } else if (nt == 60) {
      if (wc == 0) {
#pragma unroll
        for (int m = 0; m < 4; ++m)
#pragma unroll
          for (int n = 0; n < 3; ++n)
            *(f32x4*)(glb + (size_t)(rbase + m * 16) * 48 + n * 16 + c4) =
                f32x4{sigmoid_(acc[m][n][0]), sigmoid_(acc[m][n][1]), sigmoid_(acc[m][n][2]), sigmoid_(acc[m][n][3])};
      }
    } else if (nt < 77) {
      const int chb = (nt - 61) * 64 + wc * 32 + c4;
#pragma unroll
      for (int m = 0; m < 4; ++m)
#pragma unroll
        for (int pr = 0; pr < 2; ++pr)
          ST4(uz + (size_t)(rbase + m * 16) * 1024 + chb + pr * 16,
              gelu_(acc[m][2 * pr][0]) * silu_(acc[m][2 * pr + 1][0]), gelu_(acc[m][2 * pr][1]) * silu_(acc[m][2 * pr + 1][1]),
              gelu_(acc[m][2 * pr][2]) * silu_(acc[m][2 * pr + 1][2]), gelu_(acc[m][2 * pr][3]) * silu_(acc[m][2 * pr + 1][3]));
    } else if (nt < 85) {
      const int cb = (nt - 77) * 128 + wc * 64 + c4;
#pragma unroll
      for (int m = 0; m < 4; ++m)
#pragma unroll
        for (int n = 0; n < 4; ++n)
          ST4(gv + (size_t)(rbase + m * 16) * 1024 + cb + n * 16, gelu_(acc[m][n][0]), gelu_(acc[m][n][1]), gelu_(acc[m][n][2]), gelu_(acc[m][n][3]));
    } else {
      const int cb = (nt - 85) * 128 + wc * 64 + c4;
#pragma unroll
      for (int m = 0; m < 4; ++m)
#pragma unroll
        for (int n = 0; n < 4; ++n)
          ST4(gates + (size_t)(rbase + m * 16) * 3072 + cb + n * 16, sigmoid_(acc[m][n][0]), sigmoid_(acc[m][n][1]), sigmoid_(acc[m][n][2]), sigmoid_(acc[m][n][3]));
    }
#undef ST4
  }
}

struct CmpALoader {
  const bf16_t* rowptr;
  int r, soff;
  u32x4 r0, r1;
  __device__ __forceinline__ void load(int kt) {
    int tok = 16 * r + (kt >> 1);
    tok = tok > (SEQ - 1) ? (SEQ - 1) : tok;
    const bf16_t* q = rowptr + (size_t)tok * 1536 + (kt & 1) * 32;
    r0 = *(const u32x4*)q; r1 = *(const u32x4*)(q + 8);
  }
  __device__ __forceinline__ void store(bf16_t* tile) {
    bf16_t* q = tile + soff;
    *(u32x4*)q = r0; *(u32x4*)(q + 8) = r1;
  }
};

__device__ __forceinline__ void phase_mix1(const Params& p, int l, char* smraw) {
  const int tid = opaque_tid(); const int lane = tid & 63, w = tid >> 6, l15 = lane & 15, grp = lane >> 4;
  const bf16_t* gv = (const bf16_t*)(p.ws + OFF_GV);
  float* stats = (float*)(p.ws + OFF_STATS);
  constexpr int NCB = 2 * (NB * 4 * 256 / 128);
  const bool split = (int)gridDim.x >= 2 * NCB;
  const int eb = split ? (int)blockIdx.x - NCB : (int)blockIdx.x;
  const int neb = split ? (int)gridDim.x - NCB : (int)gridDim.x;
  for (int r = eb * 4 + w; eb >= 0 && r < R; r += neb * 4) {
    const bf16_t* row = gv + (size_t)r * 1024;
    float v[16]; float s = 0.f;
#pragma unroll
    for (int i = 0; i < 2; ++i) {
      u32x4 u = *(const u32x4*)(row + i * 512 + lane * 8);
      v[i * 8 + 0] = bf2f(u.x & 0xffffu); v[i * 8 + 1] = bf2f(u.x >> 16);
      v[i * 8 + 2] = bf2f(u.y & 0xffffu); v[i * 8 + 3] = bf2f(u.y >> 16);
      v[i * 8 + 4] = bf2f(u.z & 0xffffu); v[i * 8 + 5] = bf2f(u.z >> 16);
      v[i * 8 + 6] = bf2f(u.w & 0xffffu); v[i * 8 + 7] = bf2f(u.w >> 16);
    }
#pragma unroll
    for (int i = 0; i < 16; ++i) s += v[i];
    s = wave_sum(s, lane);
    float mu = s * (1.f / 1024.f);
    float q = 0.f;
#pragma unroll
    for (int i = 0; i < 16; ++i) { float d = v[i] - mu; q += d * d; }
    q = wave_sum(q, lane);
    if (lane == 0) { stats[r * 2] = mu; stats[r * 2 + 1] = rsqrtf(q * (1.f / 1024.f) + 1e-6f); }
  }
  {
    const bf16_t* yApre = (const bf16_t*)(p.ws + OFF_YAPRE);
    const bf16_t* bzA = (const bf16_t*)(p.ws + OFF_BZA);
    bf16_t* yA = (bf16_t*)(p.ws + OFF_YA);
    const float* cw = p.conv_w + (size_t)l * 3 * 1024;
    const float* cb = p.conv_b + (size_t)l * 1024;
    for (int e = eb * 256 + tid; eb >= 0 && e < R * 128; e += neb * 256) {
      int row = e >> 7, c8 = (e & 127) * 8;
      int t = row & (SEQ - 1);
      u32x4 y2 = *(const u32x4*)(yApre + (size_t)row * 1024 + c8);
      u32x4 y1 = (t >= 1) ? *(const u32x4*)(yApre + (size_t)(row - 1) * 1024 + c8) : u32x4{0, 0, 0, 0};
      u32x4 y0 = (t >= 2) ? *(const u32x4*)(yApre + (size_t)(row - 2) * 1024 + c8) : u32x4{0, 0, 0, 0};
      u32x4 bz = *(const u32x4*)(bzA + (size_t)row * 1024 + c8);
      u32x4 o;
#pragma unroll
      for (int i = 0; i < 4; ++i) {
        int c = c8 + i * 2;
        float r0 = cb[c] + cw[c] * bf2f(y0[i] & 0xffffu) + cw[1024 + c] * bf2f(y1[i] & 0xffffu) + cw[2048 + c] * bf2f(y2[i] & 0xffffu);
        float r1 = cb[c + 1] + cw[c + 1] * bf2f(y0[i] >> 16) + cw[1024 + c + 1] * bf2f(y1[i] >> 16) + cw[2048 + c + 1] * bf2f(y2[i] >> 16);
        o[i] = pack2(bf2f(bz[i] & 0xffffu) * r0, bf2f(bz[i] >> 16) * r1);
      }
      *(u32x4*)(yA + (size_t)row * 1024 + c8) = o;
    }
  }
  {
    bf16_t* sm = (bf16_t*)smraw;
    const bf16_t* kvb = (const bf16_t*)(p.ws + OFF_KV);
    const bf16_t* Wc1T = (const bf16_t*)(p.ws + OFF_WC1T);
    const float* bias1 = (const float*)(p.ws + OFF_BIAS1);
    const int wr = w >> 1, wc = w & 1;
    constexpr int MTC = NB * 4 * 256 / 128;
    for (int t = blockIdx.x; t < 2 * MTC; t += gridDim.x) {
      int kv = t / MTC, mt = t % MTC;
      f32x4 acc[4][4];
      zero_acc(acc);
      {
        const int rr = mt * 128 + (tid >> 3);
        const int bl = rr >> 10, g = (rr >> 8) & 3;
        const int gch = ((tid & 7) ^ ((tid >> 4) & 7)) * 8;
        gemm_core_glds_cmp(acc, kvb + (size_t)bl * SEQ * 1536 + kv * 256 + g * 64 + gch, rr & 255,
                           Wc1T + (size_t)(l * 2 + kv) * 128 * 2048, 2048, 2048 / 64, sm, tid);
      }
      bf16_t* Hs = sm;
      bf16_t* W2s = sm + 128 * HS_LD;
      const float* b1 = bias1 + (l * 2 + kv) * 8 * 128;
#pragma unroll
      for (int n = 0; n < 4; ++n) {
        const int col = wc * 64 + n * 16 + 4 * grp;
        f32x4 bb = f32x4{0.f, 0.f, 0.f, 0.f};
#pragma unroll
        for (int ks = 0; ks < 8; ++ks) bb += *(const f32x4*)(b1 + ks * 128 + col);
#pragma unroll
        for (int m = 0; m < 4; ++m)
          *(u32x2*)(Hs + (wr * 64 + m * 16 + l15) * HS_LD + col) =
              u32x2{pack2(silu_(acc[m][n][0] + bb[0]), silu_(acc[m][n][1] + bb[1])), pack2(silu_(acc[m][n][2] + bb[2]), silu_(acc[m][n][3] + bb[3]))};
      }
      const float* w2 = (kv ? p.w_cv2 : p.w_ck2) + (size_t)l * 128 * 64;
      for (int i = 0; i < 32; ++i) {
        int e = tid + 256 * i;
        int j = e >> 6, d = e & 63;
        W2s[d * HS_LD + j] = f2bf(w2[e]);
      }
      __syncthreads();
      f32x4 a2[2][4];
#pragma unroll
      for (int mm = 0; mm < 2; ++mm)
#pragma unroll
        for (int nn = 0; nn < 4; ++nn) a2[mm][nn] = f32x4{0.f, 0.f, 0.f, 0.f};
#pragma unroll
      for (int ks = 0; ks < 4; ++ks) {
        bf16x8 af[2], bfr[4];
#pragma unroll
        for (int mm = 0; mm < 2; ++mm) af[mm] = *(const bf16x8*)(Hs + (w * 32 + mm * 16 + l15) * HS_LD + ks * 32 + grp * 8);
#pragma unroll
        for (int nn = 0; nn < 4; ++nn) bfr[nn] = *(const bf16x8*)(W2s + (nn * 16 + l15) * HS_LD + ks * 32 + grp * 8);
#pragma unroll
        for (int mm = 0; mm < 2; ++mm)
#pragma unroll
          for (int nn = 0; nn < 4; ++nn) a2[mm][nn] = mfma16(af[mm], bfr[nn], a2[mm][nn]);
      }
      bf16_t* outp = (bf16_t*)(p.ws + (kv ? OFF_VCMP : OFF_KCMP));
#pragma unroll
      for (int mm = 0; mm < 2; ++mm)
#pragma unroll
        for (int nn = 0; nn < 4; ++nn)
#pragma unroll
          for (int j = 0; j < 4; ++j) {
            int row = mt * 128 + w * 32 + mm * 16 + 4 * grp + j;
            outp[(size_t)row * 64 + nn * 16 + l15] = f2bf(a2[mm][nn][j]);
          }
      __syncthreads();
    }
  }
}

struct KVRegs { u32x4 k0, k1, v0, v1; };

__device__ __forceinline__ void kv_issue(KVRegs& r, const bf16_t* kbase, const bf16_t* vbase, size_t ld, bool wantV, int tid) {
  const uint32_t row = (uint32_t)tid >> 3, c = ((uint32_t)tid & 7u) * 8u;
  const uint32_t ldu = (ld == 64 ? 64u : 1536u);
  const uint32_t off = row * ldu + c;
  const bf16_t* kp = kbase + off;
  r.k0 = *(const u32x4*)kp; r.k1 = *(const u32x4*)(kp + 32u * ldu);
  if (wantV) {
    const bf16_t* vp = vbase + off;
    r.v0 = *(const u32x4*)vp; r.v1 = *(const u32x4*)(vp + 32u * ldu);
  }
}
__device__ __forceinline__ void kv_commit(const KVRegs& r, bf16_t* Ks, bf16_t* Vs, bool wantV, int tid) {
  int row = tid >> 3, c = (tid & 7) * 8;
  *(u32x4*)(Ks + row * KS_LD + c) = r.k0;
  *(u32x4*)(Ks + (row + 32) * KS_LD + c) = r.k1;
  if (wantV) {
    *(u32x4*)(Vs + row * KS_LD + c) = r.v0;
    *(u32x4*)(Vs + (row + 32) * KS_LD + c) = r.v1;
  }
}

typedef short s16x4 __attribute__((ext_vector_type(4)));
__device__ __forceinline__ s16x4 tr_read(const bf16_t* ptr) {
  return __builtin_amdgcn_ds_read_tr16_b64_v4i16((s16x4 __attribute__((address_space(3)))*)ptr);
}

#define ADSR(dst, base, OFF) asm volatile("ds_read_b128 %0, %1 offset:" #OFF : "=v"(dst) : "v"(base) : "memory")
#define ATRR(dst, base, OFF) asm volatile("ds_read_b64_tr_b16 %0, %1 offset:" #OFF : "=v"(dst) : "v"(base) : "memory")
template <bool MASKED, int KPSTRIDE>
__device__ __forceinline__ void attn_block64(const bf16_t* Ks, const bf16_t* Vs, bf16x8 q0, bf16x8 q1, int tq, int kp0, int kpstride_unused,
                                             int maxdist, bool extra_ok, float slope, float& m, f32x4& lsum, f32x4 (&o)[4], int l15, int grp,
                                             const f32x4 (&tb)[4]) {
  constexpr int kpstride = KPSTRIDE;
  const int d0 = tq - kp0 - 4 * grp * kpstride;
  const float base = -slope * (float)d0;
  const unsigned kaddr = (unsigned)(size_t)(Ks + l15 * KS_LD + grp * 8);
  const unsigned vaddr = (unsigned)(size_t)(Vs + (4 * grp + (l15 >> 2)) * KS_LD + 4 * (l15 & 3));
  bf16x8 kf[8];
  ADSR(kf[0], kaddr, 0);    ADSR(kf[1], kaddr, 64);   ADSR(kf[2], kaddr, 2560); ADSR(kf[3], kaddr, 2624);
  ADSR(kf[4], kaddr, 5120); ADSR(kf[5], kaddr, 5184); ADSR(kf[6], kaddr, 7680); ADSR(kf[7], kaddr, 7744);
  f32x4 s[4];
  asm volatile("s_waitcnt lgkmcnt(6)" : "+v"(kf[0]), "+v"(kf[1]) :: "memory");
  const f32x4 b0 = (KPSTRIDE == 1) ? tb[0] : tb[0] * (float)KPSTRIDE, b1 = (KPSTRIDE == 1) ? tb[1] : tb[1] * (float)KPSTRIDE;
  const f32x4 b2 = (KPSTRIDE == 1) ? tb[2] : tb[2] * (float)KPSTRIDE, b3 = (KPSTRIDE == 1) ? tb[3] : tb[3] * (float)KPSTRIDE;
  s[0] = mfma16(kf[1], q1, mfma16(kf[0], q0, b0));
  asm volatile("s_waitcnt lgkmcnt(4)" : "+v"(kf[2]), "+v"(kf[3]) :: "memory");
  s[1] = mfma16(kf[3], q1, mfma16(kf[2], q0, b1));
  asm volatile("s_waitcnt lgkmcnt(2)" : "+v"(kf[4]), "+v"(kf[5]) :: "memory");
  s[2] = mfma16(kf[5], q1, mfma16(kf[4], q0, b2));
  asm volatile("s_waitcnt lgkmcnt(0)" : "+v"(kf[6]), "+v"(kf[7]) :: "memory");
  s[3] = mfma16(kf[7], q1, mfma16(kf[6], q0, b3));
  s16x4 vt[16];
  ATRR(vt[0], vaddr, 0);     ATRR(vt[1], vaddr, 2560);  ATRR(vt[2], vaddr, 32);    ATRR(vt[3], vaddr, 2592);
  ATRR(vt[4], vaddr, 64);    ATRR(vt[5], vaddr, 2624);  ATRR(vt[6], vaddr, 96);    ATRR(vt[7], vaddr, 2656);
  ATRR(vt[8], vaddr, 5120);  ATRR(vt[9], vaddr, 7680);  ATRR(vt[10], vaddr, 5152); ATRR(vt[11], vaddr, 7712);
  ATRR(vt[12], vaddr, 5184); ATRR(vt[13], vaddr, 7744); ATRR(vt[14], vaddr, 5216); ATRR(vt[15], vaddr, 7776);
  float cmax = -1e30f;
#pragma unroll
  for (int t = 0; t < 4; ++t)
#pragma unroll
    for (int j = 0; j < 4; ++j) {
      const int ci = t * 16 + j;
      float v = s[t][j];
      if (MASKED) {
        const int dist = d0 - ci * kpstride;
        const bool valid = extra_ok && dist >= 0 && dist < maxdist;
        v = valid ? v : -1e30f;
      }
      s[t][j] = v;
      cmax = fmaxf(cmax, v);
    }
  if (!MASKED) cmax = extra_ok ? cmax : -1e30f;
  if (__ballot(cmax + base > m + 40.f) != 0ull) {
    cmax = (cmax > -1e29f) ? cmax + base : -1e30f;
    cmax = fmaxf(cmax, bperm(cmax, (l15 + 16 * grp) ^ 16));
    cmax = fmaxf(cmax, bperm(cmax, (l15 + 16 * grp) ^ 32));
    const float mnew = fmaxf(m, cmax);
    const float alpha = __builtin_amdgcn_exp2f(m - mnew);
    lsum *= alpha;
#pragma unroll
    for (int dt = 0; dt < 4; ++dt) o[dt] *= alpha;
    m = mnew;
  }
  const float mb = m - base;
#pragma unroll
  for (int t = 0; t < 4; ++t)
#pragma unroll
    for (int j = 0; j < 4; ++j) {
      const float v = s[t][j];
      float pe = __builtin_amdgcn_exp2f(v - mb);
      if (MASKED) pe = (v > -1e29f) ? pe : 0.f;
      s[t][j] = pe;
    }
  const bf16x8 ones = {0x3F80, 0x3F80, 0x3F80, 0x3F80, 0x3F80, 0x3F80, 0x3F80, 0x3F80};
  const uint32_t rowm = (MASKED || extra_ok) ? 0xffffffffu : 0u;
  asm volatile("s_waitcnt lgkmcnt(0)"
               : "+v"(vt[0]), "+v"(vt[1]), "+v"(vt[2]), "+v"(vt[3]), "+v"(vt[4]), "+v"(vt[5]), "+v"(vt[6]), "+v"(vt[7]),
                 "+v"(vt[8]), "+v"(vt[9]), "+v"(vt[10]), "+v"(vt[11]), "+v"(vt[12]), "+v"(vt[13]), "+v"(vt[14]), "+v"(vt[15])
               :: "memory");
#pragma unroll
  for (int sc = 0; sc < 2; ++sc) {
    const bf16x8 pb = __builtin_bit_cast(bf16x8, u32x4{pack2(s[2 * sc][0], s[2 * sc][1]) & rowm, pack2(s[2 * sc][2], s[2 * sc][3]) & rowm,
                                                       pack2(s[2 * sc + 1][0], s[2 * sc + 1][1]) & rowm, pack2(s[2 * sc + 1][2], s[2 * sc + 1][3]) & rowm});
    lsum = mfma16(ones, pb, lsum);
#pragma unroll
    for (int dt = 0; dt < 4; ++dt) {
      const s16x4 vlo = vt[sc * 8 + dt * 2], vhi = vt[sc * 8 + dt * 2 + 1];
      const bf16x8 vf = {vlo[0], vlo[1], vlo[2], vlo[3], vhi[0], vhi[1], vhi[2], vhi[3]};
      o[dt] = mfma16(vf, pb, o[dt]);
    }
  }
}

constexpr int ATT_TILE = 64 * KS_LD * 2;
constexpr int ATT_BUF = 2 * ATT_TILE;

template <class DescF, class ProcF>
__device__ __forceinline__ void kv_stream_run(int n, DescF desc, ProcF proc, char* smraw, int tid, KVRegs& r0, KVRegs& r1) {
  const bf16_t *kp, *vp; size_t ld;
  __syncthreads();
  kv_commit(r0, (bf16_t*)smraw, (bf16_t*)(smraw + ATT_TILE), true, tid);
  desc(2 < n ? 2 : n - 1, kp, vp, ld); kv_issue(r0, kp, vp, ld, true, tid);
  __syncthreads();
  for (int e0 = 0; e0 < n; e0 += 2) {
    {
      const int e = e0;
      proc(e, (const bf16_t*)smraw, (const bf16_t*)(smraw + ATT_TILE));
      kv_commit(r1, (bf16_t*)(smraw + ATT_BUF), (bf16_t*)(smraw + ATT_BUF + ATT_TILE), true, tid);
      desc(e + 3 < n ? e + 3 : n - 1, kp, vp, ld); kv_issue(r1, kp, vp, ld, true, tid);
      __syncthreads();
    }
    {
      const int e = e0 + 1;
      if (e < n) proc(e, (const bf16_t*)(smraw + ATT_BUF), (const bf16_t*)(smraw + ATT_BUF + ATT_TILE));
      kv_commit(r0, (bf16_t*)smraw, (bf16_t*)(smraw + ATT_TILE), true, tid);
      desc(e + 3 < n ? e + 3 : n - 1, kp, vp, ld); kv_issue(r0, kp, vp, ld, true, tid);
      __syncthreads();
    }
  }
}

template <class DescF, class ProcF>
__device__ __forceinline__ void kv_stream(int n, DescF desc, ProcF proc, char* smraw, int tid) {
  if (n <= 0) return;
  KVRegs r0, r1;
  const bf16_t *kp, *vp; size_t ld;
  desc(0, kp, vp, ld); kv_issue(r0, kp, vp, ld, true, tid);
  desc(1 < n ? 1 : n - 1, kp, vp, ld); kv_issue(r1, kp, vp, ld, true, tid);
  kv_stream_run(n, desc, proc, smraw, tid, r0, r1);
}

__device__ __forceinline__ void attn_unit(const Params& p, char* smraw, int bl, int g, int qb) {
  float* impbuf = (float*)(smraw + 2 * ATT_BUF);
  unsigned long long* selmask = (unsigned long long*)(smraw + 2 * ATT_BUF + 16640);
  int* sellist = (int*)(smraw + 2 * ATT_BUF + 16640 + 128);
  const bf16_t* qbuf = (const bf16_t*)(p.ws + OFF_Q);
  const bf16_t* zbuf = (const bf16_t*)(p.ws + OFF_ZB);
  const bf16_t* kvb = (const bf16_t*)(p.ws + OFF_KV);
  const float* glb = (const float*)(p.ws + OFF_GL);
  bf16_t* yB = (bf16_t*)(p.ws + OFF_YB);
  const int tid = opaque_tid(); const int lane = tid & 63, n = tid >> 6, l15 = lane & 15, grp = lane >> 4;
  const int h = g * 4 + n, t0 = qb * 16, tq = t0 + l15;
  const float slope = exp2f(-0.5f * (float)(h + 1)) * 1.44269504f;
  f32x4 tb[4];
#pragma unroll
  for (int t = 0; t < 4; ++t) tb[t] = f32x4{slope * (float)(16 * t), slope * (float)(16 * t + 1), slope * (float)(16 * t + 2), slope * (float)(16 * t + 3)};
  const size_t rowq = (size_t)bl * SEQ + tq;
  bf16x8 q0, q1;
  {
    const bf16_t* qp = qbuf + rowq * 1024 + h * 64 + grp * 8;
    q0 = *(const bf16x8*)qp; q1 = *(const bf16x8*)(qp + 32);
  }
  const float g0 = glb[rowq * 48 + h * 3 + 0], g1 = glb[rowq * 48 + h * 3 + 1], g2 = glb[rowq * 48 + h * 3 + 2];
  f32x4 otot[4];
#pragma unroll
  for (int dt = 0; dt < 4; ++dt) otot[dt] = f32x4{0.f, 0.f, 0.f, 0.f};
  const size_t seqbase = (size_t)bl * SEQ * 1536 + g * 64;
  const int BIG = 1 << 30;
  const bf16_t* kcb = (const bf16_t*)(p.ws + OFF_KCMP) + (size_t)(bl * 4 + g) * 256 * 64;
  const bf16_t* vcb = (const bf16_t*)(p.ws + OFF_VCMP) + (size_t)(bl * 4 + g) * 256 * 64;
  const bf16_t* kwb = kvb + seqbase + 1024;
  const bf16_t* vwb = kvb + seqbase + 1280;
  const bf16_t* ksb = kvb + seqbase + 512;
  const bf16_t* vsb = kvb + seqbase + 768;

  float m = -1e30f;
  f32x4 lsum = f32x4{0.f, 0.f, 0.f, 0.f};
  f32x4 o[4];
#pragma unroll
  for (int dt = 0; dt < 4; ++dt) o[dt] = f32x4{0.f, 0.f, 0.f, 0.f};
  float m_c = -1e30f, inv_c = 0.f, prev_rot = 0.f;
  float* myimp = impbuf + n * 1040;
#pragma unroll
  for (int i = 0; i < 16; ++i) myimp[i * 65 + lane] = 0.f;

  int lo = t0 - 511; lo = lo < 0 ? 0 : lo;
  const int wlo = lo >> 6, whi = t0 >> 6, nW = whi - wlo + 1;
  const int nck = (qb + 63) >> 6;
  auto finish = [&](float gate) -> float {
    const float lt = lsum[0];
    const float inv = lt > 0.f ? 1.f / lt : 0.f;
    const float sc_ = gate * inv;
#pragma unroll
    for (int dt = 0; dt < 4; ++dt) { otot[dt] += o[dt] * sc_; o[dt] = f32x4{0.f, 0.f, 0.f, 0.f}; }
    lsum = f32x4{0.f, 0.f, 0.f, 0.f};
    return inv;
  };
  kv_stream(nW + 2 * nck,
    [&](int e, const bf16_t*& kp, const bf16_t*& vp, size_t& ld) {
      if (e < nW) { const size_t off = (size_t)(whi - e) * 64 * 1536; kp = kwb + off; vp = vwb + off; ld = 1536; }
      else { const int c = (e < nW + nck) ? (nW + nck - 1 - e) : (e - nW - nck); kp = kcb + c * 4096; vp = vcb + c * 4096; ld = 64; }
    },
    [&](int e, const bf16_t* Ks, const bf16_t* Vt) {
      if (e < nW) {
        const int wb = whi - e;
        if (wb < whi && wb * 64 >= t0 - 496) attn_block64<false, 1>(Ks, Vt, q0, q1, tq, wb * 64, 1, 512, true, slope, m, lsum, o, l15, grp, tb);
        else attn_block64<true, 1>(Ks, Vt, q0, q1, tq, wb * 64, 1, 512, true, slope, m, lsum, o, l15, grp, tb);
        if (e == nW - 1) { (void)finish(g2); m = -1e30f; }
      } else if (e < nW + nck) {
        const int c = nW + nck - 1 - e;
        if (16 * (64 * c + 63) + 31 <= t0) attn_block64<false, 16>(Ks, Vt, q0, q1, tq, 1024 * c + 31, 16, BIG, true, slope, m, lsum, o, l15, grp, tb);
        else attn_block64<true, 16>(Ks, Vt, q0, q1, tq, 1024 * c + 31, 16, BIG, true, slope, m, lsum, o, l15, grp, tb);
        if (e == nW + nck - 1) { inv_c = finish(g0); m_c = m; m = -1e30f; }
      } else {
        const int c = e - nW - nck;
#pragma unroll
        for (int tt = 0; tt < 4; ++tt) {
          const bf16_t* krp = Ks + (tt * 16 + l15) * KS_LD + grp * 8;
          bf16x8 k0 = *(const bf16x8*)krp, k1 = *(const bf16x8*)(krp + 32);
          f32x4 z = f32x4{0.f, 0.f, 0.f, 0.f};
          z = mfma16(k0, q0, z);
          z = mfma16(k1, q1, z);
          float sum4 = 0.f, p3 = 0.f;
#pragma unroll
          for (int j = 0; j < 4; ++j) {
            int kidx = c * 64 + tt * 16 + 4 * grp + j;
            int dist = tq - (16 * kidx + 31);
            float pe = (dist >= 0) ? __builtin_amdgcn_exp2f(z[j] - slope * (float)dist - m_c) * inv_c : 0.f;
            sum4 += pe;
            if (j == 3) p3 = pe;
          }
          float rot = bperm(p3, (lane + 48) & 63);
          float extra = (grp == 0) ? prev_rot : rot;
          myimp[l15 * 65 + (c * 4 + tt) * 4 + grp] = sum4 + extra;
          prev_rot = rot;
        }
      }
    }, smraw, tid);
  KVRegs sr0, sr1;
  {
    const int b0 = whi, b1 = whi > 0 ? whi - 1 : 0;
    kv_issue(sr0, ksb + (size_t)b0 * 64 * 1536, vsb + (size_t)b0 * 64 * 1536, 1536, true, tid);
    kv_issue(sr1, ksb + (size_t)b1 * 64 * 1536, vsb + (size_t)b1 * 64 * 1536, 1536, true, tid);
  }
  if (nck < 4 && grp == 0) myimp[l15 * 65 + nck * 16] = prev_rot;
  __syncthreads();
#pragma unroll 1
  for (int i = 0; i < 4; ++i) {
    int qi = n * 4 + i;
    const int cur = t0 >> 6, s = lane;
    float imp = impbuf[qi * 65 + s] + impbuf[1040 + qi * 65 + s] + impbuf[2080 + qi * 65 + s] + impbuf[3120 + qi * 65 + s];
    bool forced = (s == 0) || (s == cur) || (s == cur - 1);
    bool valid = s <= cur;
    float score = forced ? __builtin_inff() : (valid ? imp : -__builtin_inff());
    unsigned long long mk;
    if (cur < 16) {
      mk = __ballot(valid);
    } else {
      const int key = (int)(((forced ? 0x7F800000u : __float_as_uint(imp)) & 0xFFFFFFC0u) | (unsigned)(63 - s));
      int rank = 0;
#pragma unroll 8
      for (int sp = 0; sp <= cur; ++sp)
        rank += (__builtin_amdgcn_readlane(key, sp) > key) ? 1 : 0;
      mk = __ballot((rank < 16) && valid);
    }
    if (lane == 0) selmask[qi] = mk;
  }
  __syncthreads();
  const unsigned long long mymask = selmask[l15];
  unsigned long long U = 0, Uand = ~0ull;
#pragma unroll
  for (int i = 0; i < 16; ++i) { const unsigned long long mk = selmask[i]; U |= mk; Uand &= mk; }
  {
    uint32_t ulo = __builtin_amdgcn_readfirstlane((uint32_t)U), uhi = __builtin_amdgcn_readfirstlane((uint32_t)(U >> 32));
    U = ((unsigned long long)uhi << 32) | ulo;
    ulo = __builtin_amdgcn_readfirstlane((uint32_t)Uand); uhi = __builtin_amdgcn_readfirstlane((uint32_t)(Uand >> 32));
    Uand = ((unsigned long long)uhi << 32) | ulo;
  }
  const int nsel = __popcll(U);
  if (n == 0) {
    if ((U >> lane) & 1ull) sellist[__popcll(U >> lane) - 1] = lane;
  }
  __syncthreads();
  kv_stream_run(nsel,
    [&](int e, const bf16_t*& kp, const bf16_t*& vp, size_t& ld) {
      const int s = __builtin_amdgcn_readfirstlane(sellist[e]);
      const size_t off = (size_t)s * 64 * 1536; kp = ksb + off; vp = vsb + off; ld = 1536;
    },
    [&](int e, const bf16_t* Ks, const bf16_t* Vt) {
      const int s = __builtin_amdgcn_readfirstlane(sellist[e]);
      const bool ok = (mymask >> s) & 1ull;
      if (s < whi) attn_block64<false, 1>(Ks, Vt, q0, q1, tq, s * 64, 1, BIG, ok, slope, m, lsum, o, l15, grp, tb);
      else attn_block64<true, 1>(Ks, Vt, q0, q1, tq, s * 64, 1, BIG, ok, slope, m, lsum, o, l15, grp, tb);
    }, smraw, tid, sr0, sr1);
  (void)finish(g1);
#pragma unroll
  for (int dt = 0; dt < 4; ++dt) {
    size_t off = rowq * 1024 + h * 64 + dt * 16 + 4 * grp;
    u32x2 zz = *(const u32x2*)(zbuf + off);
    u32x2 ov;
    ov.x = pack2(otot[dt][0] * bf2f(zz.x & 0xffffu), otot[dt][1] * bf2f(zz.x >> 16));
    ov.y = pack2(otot[dt][2] * bf2f(zz.y & 0xffffu), otot[dt][3] * bf2f(zz.y >> 16));
    *(u32x2*)(yB + off) = ov;
  }
}

struct GmlpBLoader {
  const bf16_t* gvbase;
  const float* stats;
  const float* lg; const float* lb;
  int tid;
  u32x4 r[2]; f32x2 st[2];
  __device__ __forceinline__ void load(int kt) {
#pragma unroll
    for (int i = 0; i < 2; ++i) {
      int v = tid + 256 * i;
      int j = kt * 32 + (v >> 4), c8 = (v & 15) * 8;
      r[i] = *(const u32x4*)(gvbase + (size_t)j * 1024 + c8);
      st[i] = *(const f32x2*)(stats + j * 2);
    }
  }
  __device__ __forceinline__ void store(bf16_t* tile) {
#pragma unroll
    for (int i = 0; i < 2; ++i) {
      int v = tid + 256 * i;
      int jl = v >> 4, c8 = (v & 15) * 8;
      const u32x4 u = r[i];
#pragma unroll
      for (int e = 0; e < 4; ++e) {
        int c = c8 + 2 * e;
        float a = (bf2f(u[e] & 0xffffu) - st[i].x) * st[i].y * lg[c] + lb[c];
        float b = (bf2f(u[e] >> 16) - st[i].x) * st[i].y * lg[c + 1] + lb[c + 1];
        tile[c * LDK + jl] = f2bf(a);
        tile[(c + 1) * LDK + jl] = f2bf(b);
      }
    }
  }
};

__device__ __forceinline__ void gmlp_unit(const Params& p, int l, char* smraw, int bl, int chunk, int g) {
  bf16_t* sm = (bf16_t*)smraw;
  const int tid = opaque_tid(); const int lane = tid & 63, w = tid >> 6, wr = w >> 1, wc = w & 1, l15 = lane & 15, grp = lane >> 4;
  const size_t row0 = (size_t)bl * SEQ + chunk * 128;
  f32x4 acc[4][4];
  zero_acc(acc);
  StdLoader al;
  al.init((const bf16_t*)(p.ws + OFF_WM) + (size_t)(l * 8 + g) * 128 * 128, 128, tid);
  GmlpBLoader bl_;
  bl_.tid = tid;
  bl_.gvbase = (const bf16_t*)(p.ws + OFF_GV) + row0 * 1024 + g * 128;
  bl_.stats = (const float*)(p.ws + OFF_STATS) + row0 * 2;
  bl_.lg = p.ln_g + l * 1024 + g * 128;
  bl_.lb = p.ln_b + l * 1024 + g * 128;
  gemm_core(acc, al, bl_, 4, sm, tid);
  const bf16_t* uz = (const bf16_t*)(p.ws + OFF_UZ);
  bf16_t* yC = (bf16_t*)(p.ws + OFF_YC);
  const float* bs = p.b_s + (size_t)(l * 8 + g) * 128;
#pragma unroll
  for (int m = 0; m < 4; ++m)
#pragma unroll
    for (int j = 0; j < 4; ++j) {
      int i = wr * 64 + m * 16 + 4 * grp + j;
      float bb = bs[i];
#pragma unroll
      for (int n = 0; n < 4; ++n) {
        size_t off = (row0 + i) * 1024 + g * 128 + wc * 64 + n * 16 + l15;
        yC[off] = f2bf(bf2f(uz[off]) * (acc[m][n][j] + bb));
      }
    }
}

__device__ __forceinline__ void phase_mix2(const Params& p, int l, char* smraw) {
  constexpr int NATT = NB * 4 * 256, NGM = NB * 32 * 8;
  for (int u = blockIdx.x; u < NATT + NGM; u += gridDim.x) {
    if (u < NATT) {
      int qb = 255 - (u / (NB * 4)), r = u % (NB * 4);
      attn_unit(p, smraw, r >> 2, r & 3, qb);
    } else {
      int v = u - NATT;
      gmlp_unit(p, l, smraw, v >> 8, (v >> 3) & 31, v & 7);
    }
  }
}

__device__ __forceinline__ void phase_merge(const Params& p, int l, char* smraw) {
  bf16_t* sm = (bf16_t*)smraw;
  const bf16_t* WbrT = (const bf16_t*)(p.ws + OFF_WBRT) + (size_t)l * 3 * D * D;
  const bf16_t* gates = (const bf16_t*)(p.ws + OFF_GATES);
  bf16_t* merged = (bf16_t*)(p.ws + OFF_H);
  const int tid = opaque_tid(); const int lane = tid & 63, w = tid >> 6, wr = w >> 1, wc = w & 1, l15 = lane & 15, grp = lane >> 4;
  const int nx = gridDim.x >> 3;
  constexpr int CJ_END = (R / 1024) * 64;
  auto cj_next = [&](int c) { return ((c & 63) + nx < 64) ? (c + nx) : (((c >> 6) + 8) * 64 + (int)(blockIdx.x >> 3)); };
  auto ybuf = [&](int i) { return (const bf16_t*)(p.ws + (i == 0 ? OFF_YA : (i == 1 ? OFF_YB : OFF_YC))); };
  int cj = (blockIdx.x & 7) * 64 + (blockIdx.x >> 3);
  __syncthreads();
  if (cj < CJ_END) glds_prefetch0(ybuf(0) + (size_t)((cj >> 6) * 8 + (cj & 7)) * 128 * D, D, WbrT + (size_t)((cj & 63) >> 3) * 128 * D, D, sm, tid);
  for (; cj < CJ_END; cj = cj_next(cj)) {
    const int nt = (cj & 63) >> 3, mt = (cj >> 6) * 8 + (cj & 7);
    const int rbase = mt * 128 + wr * 64 + l15, cbase = nt * 128 + wc * 64 + 4 * grp;
    f32x4 tot[4][4];
    zero_acc(tot);
#pragma unroll 1
    for (int i = 0; i < 3; ++i) {
      f32x4 acc[4][4];
      zero_acc(acc);
      const bf16_t* Y = ybuf(i);
      gemm_core_glds<false>(acc, Y + (size_t)mt * 128 * D, D, WbrT + (size_t)i * D * D + (size_t)nt * 128 * D, D, D / 64, sm, tid);
      if (i < 2) {
        glds_prefetch0(ybuf(i + 1) + (size_t)mt * 128 * D, D, WbrT + (size_t)(i + 1) * D * D + (size_t)nt * 128 * D, D, sm, tid);
      } else {
        const int c2 = cj_next(cj);
        if (c2 < CJ_END) glds_prefetch0(ybuf(0) + (size_t)((c2 >> 6) * 8 + (c2 & 7)) * 128 * D, D, WbrT + (size_t)((c2 & 63) >> 3) * 128 * D, D, sm, tid);
      }
#pragma unroll
      for (int m = 0; m < 4; ++m)
#pragma unroll
        for (int n = 0; n < 4; ++n) {
          const u32x2 gt = *(const u32x2*)(gates + (size_t)(rbase + m * 16) * 3072 + i * 1024 + cbase + n * 16);
          tot[m][n][0] += bf2f(gt.x & 0xffffu) * acc[m][n][0];
          tot[m][n][1] += bf2f(gt.x >> 16) * acc[m][n][1];
          tot[m][n][2] += bf2f(gt.y & 0xffffu) * acc[m][n][2];
          tot[m][n][3] += bf2f(gt.y >> 16) * acc[m][n][3];
        }
    }
#pragma unroll
    for (int m = 0; m < 4; ++m)
#pragma unroll
      for (int n = 0; n < 4; ++n)
        *(u32x2*)(merged + (size_t)(rbase + m * 16) * 1024 + cbase + n * 16) = u32x2{pack2(tot[m][n][0], tot[m][n][1]), pack2(tot[m][n][2], tot[m][n][3])};
  }
}

__device__ __forceinline__ void phase_outproj(const Params& p, int l, char* smraw) {
  bf16_t* sm = (bf16_t*)smraw;
  const bf16_t* WoutT = (const bf16_t*)(p.ws + OFF_WOUTT) + (size_t)l * D * D;
  const bf16_t* merged = (const bf16_t*)(p.ws + OFF_H);
  bf16_t* opre = (bf16_t*)(p.ws + OFF_YAPRE);
  const int tid = opaque_tid(); const int lane = tid & 63, w = tid >> 6, wr = w >> 1, wc = w & 1, l15 = lane & 15, grp = lane >> 4;
  const int nx = gridDim.x >> 3;
  constexpr int CJ_END = (R / 1024) * 64;
  auto cj_next = [&](int c) { return ((c & 63) + nx < 64) ? (c + nx) : (((c >> 6) + 8) * 64 + (int)(blockIdx.x >> 3)); };
  int cj = (blockIdx.x & 7) * 64 + (blockIdx.x >> 3);
  __syncthreads();
  if (cj < CJ_END) glds_prefetch0(merged + (size_t)((cj >> 6) * 8 + (cj & 7)) * 128 * D, D, WoutT + (size_t)((cj & 63) >> 3) * 128 * D, D, sm, tid);
  for (; cj < CJ_END; cj = cj_next(cj)) {
    const int nt = (cj & 63) >> 3, mt = (cj >> 6) * 8 + (cj & 7);
    f32x4 acc[4][4];
    zero_acc(acc);
    gemm_core_glds<true>(acc, merged + (size_t)mt * 128 * D, D, WoutT + (size_t)nt * 128 * D, D, D / 64, sm, tid);
    {
      const int c2 = cj_next(cj);
      if (c2 < CJ_END) glds_prefetch0(merged + (size_t)((c2 >> 6) * 8 + (c2 & 7)) * 128 * D, D, WoutT + (size_t)((c2 & 63) >> 3) * 128 * D, D, sm, tid);
    }
    const int rbase = mt * 128 + wr * 64 + l15, cbase = nt * 128 + wc * 64 + 4 * grp;
#pragma unroll
    for (int m = 0; m < 4; ++m)
#pragma unroll
      for (int n = 0; n < 4; ++n)
        *(u32x2*)(opre + (size_t)(rbase + m * 16) * 1024 + cbase + n * 16) = u32x2{pack2(acc[m][n][0], acc[m][n][1]), pack2(acc[m][n][2], acc[m][n][3])};
  }
}

#define XB_TMO      128
#define XB_XCNT(j)  (256  + 64 * (j))
#define XB_XSUB(j)  (1280 + 64 * (j))
#define XB_XGEN(j)  (2304 + 64 * (j))
#define XB_TOP      3328
#define XB_TOPGEN   3392
#define XCD_BAR_WORDS 3456
#define XB_SPIN_CAP (1u << 18)
#define LAS __attribute__((address_space(3)))

__device__ __forceinline__ unsigned xb_ld(unsigned* p)              { return __hip_atomic_load(p, __ATOMIC_RELAXED, __HIP_MEMORY_SCOPE_AGENT); }
__device__ __forceinline__ unsigned xb_add(unsigned* p, unsigned v) { return __hip_atomic_fetch_add(p, v, __ATOMIC_RELAXED, __HIP_MEMORY_SCOPE_AGENT); }
__device__ __forceinline__ unsigned xb_xcc_id() { return (unsigned)__builtin_amdgcn_s_getreg((3 << 11) | 20) & 0xFu; }
#define XB_SPIN(cond, bar) do { unsigned _sp = 0; while (cond) { __builtin_amdgcn_s_sleep(1); \
    if ((++_sp & 255u) == 0u) { if (xb_ld(&(bar)[XB_TMO])) break; if (_sp > XB_SPIN_CAP) { atomicAdd(&(bar)[XB_TMO], 1u); break; } } } } while (0)

struct XcdBarrier {
    unsigned* bar; unsigned x;
    volatile LAS unsigned* st;
};

__device__ __forceinline__ XcdBarrier xcd_barrier_post(unsigned* bar, volatile LAS unsigned* st) {
    XcdBarrier b; b.bar = bar; b.x = xb_xcc_id(); b.st = st;
    if (threadIdx.x == 0) (void)xb_add(&bar[XB_XCNT(b.x)], 1u);
    return b;
}
__device__ __forceinline__ void xcd_barrier_complete(unsigned* bar, unsigned x, unsigned& nloc, unsigned& nx) {
    const unsigned G = gridDim.x * gridDim.y * gridDim.z;
    unsigned sum, cnt, mine, sp = 0u;
    for (;;) {
        sum = 0u; cnt = 0u; mine = 0u;
#pragma unroll
        for (unsigned j = 0; j < 16; ++j) { const unsigned c = xb_ld(&bar[XB_XCNT(j)]); sum += c; cnt += (c > 0u) ? 1u : 0u; mine = (j == x) ? c : mine; }
        if (sum == G) break;
        __builtin_amdgcn_s_sleep(1);
        if ((++sp & 255u) == 0u) { if (xb_ld(&bar[XB_TMO])) break; if (sp > XB_SPIN_CAP) { atomicAdd(&bar[XB_TMO], 1u); break; } }
    }
    nloc = mine > 0u ? mine : 1u; nx = cnt > 0u ? cnt : 1u;
}
__device__ __forceinline__ void xcd_barrier(const XcdBarrier& b) {
    asm volatile("s_waitcnt vmcnt(0)" ::: "memory");
    __syncthreads();
    if (threadIdx.x == 0) {
        unsigned* bar = b.bar;
        __builtin_amdgcn_s_waitcnt(0);
        unsigned nloc = b.st[0], nx = b.st[1];
        if (nloc == 0u) { xcd_barrier_complete(bar, b.x, nloc, nx); b.st[0] = nloc; b.st[1] = nx; }
        const unsigned old = xb_add(&bar[XB_XSUB(b.x)], 1u);
        const unsigned gen = old / nloc;
        if (old + 1u == (gen + 1u) * nloc) {
            __builtin_amdgcn_fence(__ATOMIC_RELEASE, "agent");
            asm volatile("s_waitcnt vmcnt(0)" ::: "memory");
            const unsigned og = xb_add(&bar[XB_TOP], 1u);
            const unsigned tg = og / nx;
            if (og + 1u == (tg + 1u) * nx) xb_add(&bar[XB_TOPGEN], 1u);
            else XB_SPIN(xb_ld(&bar[XB_TOPGEN]) == tg, bar);
            __builtin_amdgcn_fence(__ATOMIC_ACQUIRE, "agent");
            xb_add(&bar[XB_XGEN(b.x)], 1u);
            asm volatile("s_waitcnt vmcnt(0)" ::: "memory");
        } else {
            XB_SPIN(xb_ld(&bar[XB_XGEN(b.x)]) == gen, bar);
            __builtin_amdgcn_fence(__ATOMIC_ACQUIRE, "agent");
            asm volatile("s_waitcnt vmcnt(0)" ::: "memory");
        }
    }
    __syncthreads();
}

__global__ void __launch_bounds__(256, 2) hybrid_fwd(Params p) {
  __shared__ __attribute__((aligned(16))) char smraw[SMEM_BYTES];
  cg::grid_group grid = cg::this_grid();
  if (threadIdx.x == 0) *(u32x4*)(smraw + 65536) = u32x4{0u, 0u, 0u, 0u};
  __syncthreads();
  const XcdBarrier xb = xcd_barrier_post((unsigned*)(p.ws + OFF_BAR), (volatile LAS unsigned*)(smraw + 65536));
  phase0(p, smraw);
  grid.sync();
  for (int gi = 0; gi < NGRP; ++gi) {
    phase_h0(p, gi);
    xcd_barrier(xb);
    for (int l = 0; l < DEPTH; ++l) {
      phase_inproj(p, l, smraw);
      xcd_barrier(xb);
      phase_mix1(p, l, smraw);
      xcd_barrier(xb);
      phase_mix2(p, l, smraw);
      xcd_barrier(xb);
      phase_merge(p, l, smraw);
      xcd_barrier(xb);
      phase_outproj(p, l, smraw);
      xcd_barrier(xb);
      phase_final(p, gi, l);
      xcd_barrier(xb);
    }
  }
}

extern "C" void kernel_launch(void* const* d_in, const int* in_sizes, int n_in, void* d_out, int out_size, void* d_ws,
                              size_t ws_size, hipStream_t stream) {
  static int grid_blocks = 0;
  if (!grid_blocks) {
    int dev = 0, cus = 0, per_cu = 0;
    hipGetDevice(&dev);
    hipDeviceGetAttribute(&cus, hipDeviceAttributeMultiprocessorCount, dev);
    hipOccupancyMaxActiveBlocksPerMultiprocessor(&per_cu, hybrid_fwd, 256, 0);
    if (per_cu < 1) per_cu = 1;
    if (per_cu > 2) per_cu = 2;
    grid_blocks = cus * per_cu;
    if (ws_size < WS_END) fprintf(stderr, "kernel_launch: workspace too small: %zu < %zu\n", ws_size, (size_t)WS_END);
  }
  Params p{};
  const float** pp = (const float**)&p;
  for (int i = 0; i < 21; ++i) pp[i] = (const float*)d_in[i];
  p.out = (float*)d_out;
  p.ws = (unsigned char*)d_ws;
  (void)hipMemsetAsync((char*)d_ws + OFF_BAR, 0, 3456 * 4, stream);
  void* args[] = {&p};
  hipError_t e = hipLaunchCooperativeKernel((void*)hybrid_fwd, dim3(grid_blocks), dim3(256), args, 0, stream);
  if (e != hipSuccess) fprintf(stderr, "cooperative launch failed: %s (grid %d)\n", hipGetErrorString(e), grid_blocks);
}
```

```cpp
#include <hip/hip_runtime.h>
#include <hip/hip_cooperative_groups.h>
#include <cstdio>
#include <cstdint>
namespace cg = cooperative_groups;

typedef unsigned short bf16_t;
using bf16x8 = __attribute__((ext_vector_type(8))) short;
using f32x4 = __attribute__((ext_vector_type(4))) float;
using f32x2 = __attribute__((ext_vector_type(2))) float;
using u32x4 = __attribute__((ext_vector_type(4))) uint32_t;
using u32x2 = __attribute__((ext_vector_type(2))) uint32_t;

constexpr int D = 1024, SEQ = 4096, BATCH = 16, DEPTH = 2;
constexpr int IN_COLS = 13872;
constexpr int A_OFF = 0, B_OFF = 4096, C_OFF = 7728, G_OFF = 10800;
constexpr int NT_IN = 109, NP = NT_IN * 128;
constexpr int NB = 4, R = NB * SEQ, NGRP = BATCH / NB;
constexpr int LDK = 40;
constexpr int KS_LD = 80;
constexpr int VT_LD = 68;
constexpr int HS_LD = 136;
constexpr int SMEM_BYTES = 65536 + 16;

constexpr size_t al256(size_t x) { return (x + 255) & ~size_t(255); }
constexpr size_t OFF_WINT = 0;
constexpr size_t OFF_WBRT = al256(OFF_WINT + (size_t)DEPTH * NP * D * 2);
constexpr size_t OFF_WOUTT = al256(OFF_WBRT + (size_t)DEPTH * 3 * D * D * 2);
constexpr size_t OFF_WC1T = al256(OFF_WOUTT + (size_t)DEPTH * D * D * 2);
constexpr size_t OFF_WM = al256(OFF_WC1T + (size_t)DEPTH * 2 * 128 * 2048 * 2);
constexpr size_t OFF_BIAS1 = al256(OFF_WM + (size_t)DEPTH * 8 * 128 * 128 * 2);
constexpr size_t OFF_MOD = al256(OFF_BIAS1 + (size_t)DEPTH * 2 * 8 * 128 * 4);
constexpr size_t OFF_H = al256(OFF_MOD + (size_t)DEPTH * 16 * 3072 * 4);
constexpr size_t SZ_ACT = (size_t)R * 1024 * 2;
constexpr size_t OFF_YAPRE = al256(OFF_H + SZ_ACT);
constexpr size_t OFF_BZA = al256(OFF_YAPRE + SZ_ACT);
constexpr size_t OFF_Q = al256(OFF_BZA + SZ_ACT);
constexpr size_t OFF_ZB = al256(OFF_Q + SZ_ACT);
constexpr size_t OFF_UZ = al256(OFF_ZB + SZ_ACT);
constexpr size_t OFF_GV = al256(OFF_UZ + SZ_ACT);
constexpr size_t OFF_KV = al256(OFF_GV + SZ_ACT);
constexpr size_t OFF_GL = al256(OFF_KV + (size_t)R * 1536 * 2);
constexpr size_t OFF_GATES = al256(OFF_GL + (size_t)R * 48 * 4);
constexpr size_t OFF_YA = al256(OFF_GATES + (size_t)R * 3072 * 2);
constexpr size_t OFF_YB = al256(OFF_YA + SZ_ACT);
constexpr size_t OFF_YC = al256(OFF_YB + SZ_ACT);
constexpr size_t OFF_KCMP = al256(OFF_YC + SZ_ACT);
constexpr size_t OFF_VCMP = al256(OFF_KCMP + (size_t)NB * 4 * 256 * 64 * 2);
constexpr size_t OFF_STATS = al256(OFF_VCMP + (size_t)NB * 4 * 256 * 64 * 2);
constexpr size_t OFF_BAR = al256(OFF_STATS + (size_t)R * 2 * 4);
constexpr size_t WS_END = al256(OFF_BAR + 3456 * 4);

struct Params {
  const float *x, *c, *g_pre, *g_post, *w_ada, *b_ada, *w_in, *conv_w, *conv_b, *pos_ck, *w_ck1, *w_ck2,
      *pos_cv, *w_cv1, *w_cv2, *ln_g, *ln_b, *w_s, *b_s, *w_br, *w_out;
  float* out;
  unsigned char* ws;
};

typedef __bf16 bf16x2_native __attribute__((ext_vector_type(2)));
__device__ __forceinline__ uint32_t pack2(float a, float b) {
  f32x2 v = {a, b};
  return __builtin_bit_cast(uint32_t, __builtin_convertvector(v, bf16x2_native));
}
__device__ __forceinline__ bf16_t f2bf(float f) { return (bf16_t)(pack2(f, f) & 0xffffu); }
__device__ __forceinline__ float bf2f(uint32_t h) { return __uint_as_float(h << 16); }
__device__ __forceinline__ float sigmoid_(float x) { return __builtin_amdgcn_rcpf(1.f + __expf(-x)); }
__device__ __forceinline__ float silu_(float x) { return x * __builtin_amdgcn_rcpf(1.f + __expf(-x)); }
__device__ __forceinline__ float gelu_(float x) {
  float y = 0.7978845608f * (x + 0.044715f * x * x * x);
  return x * __builtin_amdgcn_rcpf(1.f + __expf(-2.f * y));
}
__device__ __forceinline__ f32x4 mfma16(bf16x8 a, bf16x8 b, f32x4 c) {
  return __builtin_amdgcn_mfma_f32_16x16x32_bf16(a, b, c, 0, 0, 0);
}
__device__ __forceinline__ float bperm(float v, int srclane) {
  return __int_as_float(__builtin_amdgcn_ds_bpermute(srclane << 2, __float_as_int(v)));
}
__device__ __forceinline__ float wave_sum(float v, int lane) {
#pragma unroll
  for (int o = 32; o >= 1; o >>= 1) v += bperm(v, lane ^ o);
  return v;
}

__device__ __forceinline__ int opaque_tid() {
  int t = threadIdx.x;
  asm volatile("" : "+v"(t));
  return t;
}

__device__ __forceinline__ int win_colmap(int np) {
  int tile = np >> 7, r = np & 127;
  if (tile < 32) { int wc = r >> 6, t = (r >> 4) & 3, i = r & 15; return A_OFF + t * 1024 + tile * 32 + wc * 16 + i; }
  if (tile < 40) return B_OFF + (np - 32 * 128);
  if (tile < 52) return B_OFF + 1024 + (np - 40 * 128);
  if (tile < 60) return B_OFF + 2560 + (np - 52 * 128);
  if (tile == 60) return r < 48 ? B_OFF + 3584 + r : -1;
  if (tile < 77) { int tb = tile - 61, wc = r >> 6, t = (r >> 4) & 3, i = r & 15; return C_OFF + ((t & 1) ? 2048 : 0) + tb * 64 + wc * 32 + (t >> 1) * 16 + i; }
  if (tile < 85) return C_OFF + 1024 + (np - 77 * 128);
  return G_OFF + (np - 85 * 128);
}

template <bool WIN>
__device__ __forceinline__ void transpose_tile(const float* __restrict__ src, int ld_src, bf16_t* __restrict__ dst, int Kdim, int n0, int k0, float* sm, int tid) {
  const int tx = tid & 63, ty = tid >> 6;
  const int col = WIN ? win_colmap(n0 + tx) : (n0 + tx);
  __syncthreads();
#pragma unroll
  for (int i = 0; i < 16; ++i) {
    int k = ty * 16 + i;
    float v = (col >= 0) ? src[(size_t)(k0 + k) * ld_src + col] : 0.f;
    sm[k * 65 + tx] = v;
  }
  __syncthreads();
#pragma unroll
  for (int i = 0; i < 16; ++i) {
    int n = ty * 16 + i;
    dst[(size_t)(n0 + n) * Kdim + k0 + tx] = f2bf(sm[tx * 65 + n]);
  }
}

__device__ __forceinline__ void phase0(const Params& p, char* smraw) {
  float* smf = (float*)smraw;
  const int bid = blockIdx.x, nblk = gridDim.x, tid = opaque_tid();
  bf16_t* WinT = (bf16_t*)(p.ws + OFF_WINT);
  bf16_t* WbrT = (bf16_t*)(p.ws + OFF_WBRT);
  bf16_t* WoutT = (bf16_t*)(p.ws + OFF_WOUTT);
  bf16_t* Wc1T = (bf16_t*)(p.ws + OFF_WC1T);
  bf16_t* Wm = (bf16_t*)(p.ws + OFF_WM);
  float* bias1 = (float*)(p.ws + OFF_BIAS1);
  float* mod = (float*)(p.ws + OFF_MOD);
  for (int t = bid; t < DEPTH * 218 * 16; t += nblk) {
    int l = t / (218 * 16), r = t % (218 * 16), nt = r >> 4, kt = r & 15;
    transpose_tile<true>(p.w_in + (size_t)l * D * IN_COLS, IN_COLS, WinT + (size_t)l * NP * D, D, nt * 64, kt * 64, smf, tid);
  }
  for (int t = bid; t < DEPTH * 3 * 256; t += nblk) {
    int li = t >> 8, r = t & 255, nt = r >> 4, kt = r & 15;
    transpose_tile<false>(p.w_br + (size_t)li * D * D, D, WbrT + (size_t)li * D * D, D, nt * 64, kt * 64, smf, tid);
  }
  for (int t = bid; t < DEPTH * 256; t += nblk) {
    int l = t >> 8, r = t & 255, nt = r >> 4, kt = r & 15;
    transpose_tile<false>(p.w_out + (size_t)l * D * D, D, WoutT + (size_t)l * D * D, D, nt * 64, kt * 64, smf, tid);
  }
  for (int t = bid; t < DEPTH * 2 * 64; t += nblk) {
    int lk = t >> 6, r = t & 63, nt = r >> 5, kt = r & 31;
    int l = lk >> 1, kv = lk & 1;
    const float* src = (kv ? p.w_cv1 : p.w_ck1) + (size_t)l * 2048 * 128;
    transpose_tile<false>(src, 128, Wc1T + (size_t)lk * 128 * 2048, 2048, nt * 64, kt * 64, smf, tid);
  }
  for (int e = bid * 256 + tid; e < DEPTH * 8 * 128 * 128; e += nblk * 256) {
    int j = e & 127, i = (e >> 7) & 127;
    Wm[e] = (j <= i) ? f2bf(p.w_s[e]) : (bf16_t)0;
  }
  for (int t = bid - 128; t >= 0 && t < DEPTH * 2 * 8; t += nblk) {
    int lk = t >> 3, ks = t & 7, l = lk >> 1, kv = lk & 1;
    const float* pos = (kv ? p.pos_cv : p.pos_ck) + (size_t)l * 2048;
    const float* w1 = (kv ? p.w_cv1 : p.w_ck1) + (size_t)l * 2048 * 128;
    int n = tid & 127, half = tid >> 7;
    float acc = 0.f;
    const int kb = ks * 256 + half * 128;
#pragma unroll 16
    for (int k = kb; k < kb + 128; ++k) acc += pos[k] * w1[(size_t)k * 128 + n];
    __syncthreads();
    smf[tid] = acc;
    __syncthreads();
    if (tid < 128) bias1[t * 128 + tid] = smf[tid] + smf[tid + 128];
  }
  for (int t = nblk - 1 - bid; t < DEPTH * 48; t += nblk) {
    int l = t / 48, ch = t % 48;
    int tx = tid & 63, ty = tid >> 6;
    int col = ch * 64 + tx;
    __syncthreads();
    for (int i = 0; i < 64; ++i) {
      int e = tid + 256 * i;
      smf[(e & 1023) * 16 + (e >> 10)] = silu_(p.c[e]);
    }
    __syncthreads();
    float acc[16];
#pragma unroll
    for (int b = 0; b < 16; ++b) acc[b] = 0.f;
    const float* w = p.w_ada + (size_t)l * D * 3072 + col;
#pragma unroll 8
    for (int k = ty * 256; k < ty * 256 + 256; ++k) {
      float wv = w[(size_t)k * 3072];
      const f32x4 s0 = *(const f32x4*)(smf + k * 16), s1 = *(const f32x4*)(smf + k * 16 + 4), s2 = *(const f32x4*)(smf + k * 16 + 8), s3 = *(const f32x4*)(smf + k * 16 + 12);
#pragma unroll
      for (int b = 0; b < 4; ++b) { acc[b] += s0[b] * wv; acc[4 + b] += s1[b] * wv; acc[8 + b] += s2[b] * wv; acc[12 + b] += s3[b] * wv; }
    }
    __syncthreads();
#pragma unroll
    for (int b = 0; b < 16; ++b) smf[(ty * 16 + b) * 64 + tx] = acc[b];
    __syncthreads();
    if (ty == 0) {
#pragma unroll
      for (int b = 0; b < 16; ++b) {
        float s_ = smf[b * 64 + tx] + smf[(16 + b) * 64 + tx] + smf[(32 + b) * 64 + tx] + smf[(48 + b) * 64 + tx];
        mod[((size_t)l * 16 + b) * 3072 + col] = s_ + p.b_ada[l * 3072 + col];
      }
    }
  }
}

__device__ __forceinline__ void write_h_row(const f32x4 (&xv)[4], float ss, const float* g_pre, const float* modl_b, bf16_t* hrow, int lane) {
  float rs = rsqrtf(ss * (1.f / 1024.f) + 1e-6f);
#pragma unroll
  for (int i = 0; i < 4; ++i) {
    int c = i * 256 + lane * 4;
    f32x4 g = *(const f32x4*)(g_pre + c);
    f32x4 sh = *(const f32x4*)(modl_b + c);
    f32x4 sc = *(const f32x4*)(modl_b + 1024 + c);
    float h0 = xv[i].x * rs * g.x * (1.f + sc.x) + sh.x;
    float h1 = xv[i].y * rs * g.y * (1.f + sc.y) + sh.y;
    float h2 = xv[i].z * rs * g.z * (1.f + sc.z) + sh.z;
    float h3 = xv[i].w * rs * g.w * (1.f + sc.w) + sh.w;
    u32x2 o; o.x = pack2(h0, h1); o.y = pack2(h2, h3);
    *(u32x2*)(hrow + c) = o;
  }
}

__device__ __forceinline__ void phase_h0(const Params& p, int grp_i) {
  const int tid = opaque_tid(); const int lane = tid & 63, w = tid >> 6;
  bf16_t* H = (bf16_t*)(p.ws + OFF_H);
  const float* mod = (const float*)(p.ws + OFF_MOD);
  for (int r = blockIdx.x * 4 + w; r < R; r += gridDim.x * 4) {
    size_t grow = (size_t)grp_i * R + r;
    int b = (int)(grow >> 12);
    const float* xr = p.x + grow * D;
    f32x4 xv[4]; float ss = 0.f;
#pragma unroll
    for (int i = 0; i < 4; ++i) {
      xv[i] = *(const f32x4*)(xr + i * 256 + lane * 4);
      ss += xv[i].x * xv[i].x + xv[i].y * xv[i].y + xv[i].z * xv[i].z + xv[i].w * xv[i].w;
    }
    ss = wave_sum(ss, lane);
    write_h_row(xv, ss, p.g_pre, mod + (size_t)b * 3072, H + (size_t)r * D, lane);
  }
}

__device__ __forceinline__ void phase_final(const Params& p, int grp_i, int l) {
  const int tid = opaque_tid(); const int lane = tid & 63, w = tid >> 6;
  bf16_t* H = (bf16_t*)(p.ws + OFF_H);
  const bf16_t* OP = (const bf16_t*)(p.ws + OFF_YAPRE);
  const float* mod = (const float*)(p.ws + OFF_MOD);
  const float* xin = (l == 0) ? p.x : p.out;
  for (int r = blockIdx.x * 4 + w; r < R; r += gridDim.x * 4) {
    size_t grow = (size_t)grp_i * R + r;
    int b = (int)(grow >> 12);
    const float* xr = xin + grow * D;
    const bf16_t* orow = OP + (size_t)r * D;
    const float* gate = mod + ((size_t)l * 16 + b) * 3072 + 2048;
    const float* gp = p.g_post + l * D;
    f32x4 xv[4], ov[4]; float ss = 0.f;
#pragma unroll
    for (int i = 0; i < 4; ++i) {
      int c = i * 256 + lane * 4;
      xv[i] = *(const f32x4*)(xr + c);
      u32x2 u = *(const u32x2*)(orow + c);
      ov[i].x = bf2f(u.x & 0xffffu); ov[i].y = bf2f(u.x >> 16); ov[i].z = bf2f(u.y & 0xffffu); ov[i].w = bf2f(u.y >> 16);
      ss += ov[i].x * ov[i].x + ov[i].y * ov[i].y + ov[i].z * ov[i].z + ov[i].w * ov[i].w;
    }
    ss = wave_sum(ss, lane);
    float rs = rsqrtf(ss * (1.f / 1024.f) + 1e-6f);
    float ss2 = 0.f;
#pragma unroll
    for (int i = 0; i < 4; ++i) {
      int c = i * 256 + lane * 4;
      f32x4 g = *(const f32x4*)(gp + c);
      f32x4 ga = *(const f32x4*)(gate + c);
      xv[i].x += ga.x * (ov[i].x * rs * g.x);
      xv[i].y += ga.y * (ov[i].y * rs * g.y);
      xv[i].z += ga.z * (ov[i].z * rs * g.z);
      xv[i].w += ga.w * (ov[i].w * rs * g.w);
      *(f32x4*)(p.out + grow * D + c) = xv[i];
      ss2 += xv[i].x * xv[i].x + xv[i].y * xv[i].y + xv[i].z * xv[i].z + xv[i].w * xv[i].w;
    }
    if (l == 0) {
      ss2 = wave_sum(ss2, lane);
      write_h_row(xv, ss2, p.g_pre + D, mod + ((size_t)16 + b) * 3072, H + (size_t)r * D, lane);
    }
  }
}

struct StdLoader {
  const bf16_t* base;
  int soff;
  u32x4 r0, r1;
  __device__ __forceinline__ void init(const bf16_t* tile_base, size_t ld, int tid) {
    base = tile_base + (size_t)(tid >> 1) * ld + (tid & 1) * 16;
    soff = (tid >> 1) * LDK + (tid & 1) * 16;
  }
  __device__ __forceinline__ void load(int kt) {
    const bf16_t* q = base + kt * 32;
    r0 = *(const u32x4*)q; r1 = *(const u32x4*)(q + 8);
  }
  __device__ __forceinline__ void store(bf16_t* tile) {
    bf16_t* q = tile + soff;
    *(u32x4*)q = r0; *(u32x4*)(q + 8) = r1;
  }
};

template <class AL, class BL>
__device__ __forceinline__ void gemm_core(f32x4 (&acc)[4][4], AL& al, BL& bl, int nk, bf16_t* sm, int tid) {
  const int lane = tid & 63, w = tid >> 6, wr = w >> 1, wc = w & 1, l15 = lane & 15, grp = lane >> 4;
  al.load(0); bl.load(0);
  __syncthreads();
  al.store(sm); bl.store(sm + 2 * 128 * LDK);
  __syncthreads();
  for (int kt = 0; kt < nk; ++kt) {
    const bf16_t* Ab = sm + (kt & 1) * 128 * LDK;
    const bf16_t* Bb = sm + (2 + (kt & 1)) * 128 * LDK;
    if (kt + 1 < nk) { al.load(kt + 1); bl.load(kt + 1); }
    bf16x8 a[4], b[4];
#pragma unroll
    for (int m = 0; m < 4; ++m) a[m] = *(const bf16x8*)(Ab + (wr * 64 + m * 16 + l15) * LDK + grp * 8);
#pragma unroll
    for (int n = 0; n < 4; ++n) b[n] = *(const bf16x8*)(Bb + (wc * 64 + n * 16 + l15) * LDK + grp * 8);
#pragma unroll
    for (int m = 0; m < 4; ++m)
#pragma unroll
      for (int n = 0; n < 4; ++n) acc[m][n] = mfma16(a[m], b[n], acc[m][n]);
    if (kt + 1 < nk) {
      al.store(sm + ((kt + 1) & 1) * 128 * LDK);
      bl.store(sm + (2 + ((kt + 1) & 1)) * 128 * LDK);
    }
    __syncthreads();
  }
}

struct Regs4 { u32x4 r0, r1, r2, r3; };
struct StdLoader64 {
  typedef Regs4 Regs;
  const bf16_t* base;
  size_t ld32;
  int soff;
  __device__ __forceinline__ void init(const bf16_t* tile_base, size_t ld, int tid) {
    base = tile_base + (size_t)(tid >> 3) * ld + (tid & 7) * 8;
    ld32 = ld * 32;
    soff = (tid >> 3) * 64 + (((tid & 7) ^ ((tid >> 4) & 7)) * 8);
  }
  __device__ __forceinline__ void load(int kt, Regs& r) const {
    const bf16_t* q = base + kt * 64;
    r.r0 = *(const u32x4*)q; r.r1 = *(const u32x4*)(q + ld32); r.r2 = *(const u32x4*)(q + 2 * ld32); r.r3 = *(const u32x4*)(q + 3 * ld32);
  }
  __device__ __forceinline__ void store(bf16_t* tile, const Regs& r) const {
    bf16_t* q = tile + soff;
    *(u32x4*)q = r.r0; *(u32x4*)(q + 2048) = r.r1; *(u32x4*)(q + 4096) = r.r2; *(u32x4*)(q + 6144) = r.r3;
  }
};

template <int NST, class AL, class BL>
__device__ __forceinline__ void gemm_core64(f32x4 (&acc)[4][4], const AL& al, const BL& bl, int nk, bf16_t* sm, int tid) {
  const int lane = tid & 63, w = tid >> 6, wr = w >> 1, wc = w & 1, l15 = lane & 15, grp = lane >> 4;
  constexpr int TILE = 128 * 64;
  const int sw = (l15 >> 1) & 7;
  const int fo0 = l15 * 64 + ((grp ^ sw) * 8), fo1 = l15 * 64 + (((4 + grp) ^ sw) * 8);
  typename AL::Regs ra[NST];
  typename BL::Regs rb[NST];
#pragma unroll
  for (int s_ = 0; s_ < NST; ++s_) { al.load(s_, ra[s_]); bl.load(s_, rb[s_]); }
  __syncthreads();
  al.store(sm, ra[0]); bl.store(sm + 2 * TILE, rb[0]);
  { const int k2 = NST < nk ? NST : nk - 1; al.load(k2, ra[0]); bl.load(k2, rb[0]); }
  __syncthreads();
  for (int kt0 = 0; kt0 < nk; kt0 += NST) {
#pragma unroll
    for (int u = 0; u < NST; ++u) {
      const int kt = kt0 + u;
      const bf16_t* Ab = sm + (kt & 1) * TILE + wr * 64 * 64;
      const bf16_t* Bb = sm + (2 + (kt & 1)) * TILE + wc * 64 * 64;
#pragma unroll
      for (int ks = 0; ks < 2; ++ks) {
        const int fo = ks ? fo1 : fo0;
        bf16x8 a[4], b[4];
#pragma unroll
        for (int m = 0; m < 4; ++m) a[m] = *(const bf16x8*)(Ab + m * 16 * 64 + fo);
#pragma unroll
        for (int n = 0; n < 4; ++n) b[n] = *(const bf16x8*)(Bb + n * 16 * 64 + fo);
#pragma unroll
        for (int m = 0; m < 4; ++m)
#pragma unroll
          for (int n = 0; n < 4; ++n) acc[m][n] = mfma16(b[n], a[m], acc[m][n]);
      }
      al.store(sm + ((kt + 1) & 1) * TILE, ra[(u + 1) % NST]);
      bl.store(sm + (2 + ((kt + 1) & 1)) * TILE, rb[(u + 1) % NST]);
      {
        int k2 = kt + 1 + NST;
        k2 = k2 < nk ? k2 : nk - 1;
        al.load(k2, ra[(u + 1) % NST]); bl.load(k2, rb[(u + 1) % NST]);
      }
      __syncthreads();
    }
  }
}

__device__ __forceinline__ void glds_prefetch0(const bf16_t* Atile, size_t lda, const bf16_t* Btile, size_t ldb, bf16_t* sm, int tid) {
  constexpr int TILE = 128 * 64;
  const int gch = ((tid & 7) ^ ((tid >> 4) & 7)) * 8;
  const bf16_t* ga = Atile + (size_t)(tid >> 3) * lda + gch;
  const bf16_t* gb = Btile + (size_t)(tid >> 3) * ldb + gch;
  const size_t a32 = lda * 32, b32 = ldb * 32;
  bf16_t* lbase = sm + tid * 8;
#pragma unroll
  for (int i_ = 0; i_ < 4; ++i_) {
    __builtin_amdgcn_global_load_lds((const unsigned*)(ga + i_ * a32), (unsigned*)(lbase + i_ * 2048), 16, 0, 0);
    __builtin_amdgcn_global_load_lds((const unsigned*)(gb + i_ * b32), (unsigned*)(lbase + 2 * TILE + i_ * 2048), 16, 0, 0);
  }
}

#define DSR1(dst, base, OFF) asm volatile("ds_read_b128 %0, %1 offset:" #OFF : "=v"(dst) : "v"(base) : "memory")
#define DSR4(arr, base) do { DSR1(arr[0], base, 0); DSR1(arr[1], base, 2048); DSR1(arr[2], base, 4096); DSR1(arr[3], base, 6144); } while (0)
template <bool HOIST>
__device__ __forceinline__ void gemm_core_glds(f32x4 (&acc)[4][4], const bf16_t* Atile, size_t lda, const bf16_t* Btile, size_t ldb,
                                               int nk, bf16_t* sm, int tid) {
  const int lane = tid & 63, w = tid >> 6, wr = w >> 1, wc = w & 1, l15 = lane & 15, grp = lane >> 4;
  constexpr int TILE = 128 * 64;
  const int sw = (l15 >> 1) & 7;
  const int fo0 = l15 * 64 + ((grp ^ sw) * 8), fo1 = l15 * 64 + (((4 + grp) ^ sw) * 8);
  const int gch = ((tid & 7) ^ ((tid >> 4) & 7)) * 8;
  const bf16_t* ga = Atile + (size_t)(tid >> 3) * lda + gch;
  const bf16_t* gb = Btile + (size_t)(tid >> 3) * ldb + gch;
  const size_t a32 = lda * 32, b32 = ldb * 32;
  bf16_t* lbase = sm + tid * 8;
#define GLDS_ISSUE(KT, BUF)                                                                                                            \
  do {                                                                                                                                 \
    _Pragma("unroll") for (int i_ = 0; i_ < 4; ++i_) {                                                                                 \
      __builtin_amdgcn_global_load_lds((const unsigned*)(ga + i_ * a32 + (KT) * 64), (unsigned*)(lbase + (BUF) * TILE + i_ * 2048), 16, 0, 0);       \
      __builtin_amdgcn_global_load_lds((const unsigned*)(gb + i_ * b32 + (KT) * 64), (unsigned*)(lbase + (2 + (BUF)) * TILE + i_ * 2048), 16, 0, 0); \
    }                                                                                                                                  \
  } while (0)
#define GLDS_COMPUTE(BUF)                                                                             \
  do {                                                                                                \
    const bf16_t* Ab = sm + (BUF) * TILE + wr * 64 * 64;                                              \
    const bf16_t* Bb = sm + (2 + (BUF)) * TILE + wc * 64 * 64;                                        \
    if (HOIST) {                                                                                      \
        \
      bf16x8 a0[4], b0[4], a1[4], b1[4];                                                              \
      const unsigned pa0 = (unsigned)(size_t)(Ab + fo0), pb0 = (unsigned)(size_t)(Bb + fo0);          \
      const unsigned pa1 = (unsigned)(size_t)(Ab + fo1), pb1 = (unsigned)(size_t)(Bb + fo1);          \
      DSR4(a0, pa0); DSR4(b0, pb0); DSR4(a1, pa1); DSR4(b1, pb1);                                     \
      asm volatile("s_waitcnt lgkmcnt(8)" : "+v"(a0[0]), "+v"(a0[1]), "+v"(a0[2]), "+v"(a0[3]), "+v"(b0[0]), "+v"(b0[1]), "+v"(b0[2]), "+v"(b0[3]) :: "memory"); \
      _Pragma("unroll") for (int m = 0; m < 4; ++m)                                                   \
        _Pragma("unroll") for (int n = 0; n < 4; ++n) acc[m][n] = mfma16(b0[n], a0[m], acc[m][n]);    \
      __builtin_amdgcn_sched_barrier(0);             \
      asm volatile("s_waitcnt lgkmcnt(0)" : "+v"(a1[0]), "+v"(a1[1]), "+v"(a1[2]), "+v"(a1[3]), "+v"(b1[0]), "+v"(b1[1]), "+v"(b1[2]), "+v"(b1[3]) :: "memory"); \
      _Pragma("unroll") for (int m = 0; m < 4; ++m)                                                   \
        _Pragma("unroll") for (int n = 0; n < 4; ++n) acc[m][n] = mfma16(b1[n], a1[m], acc[m][n]);    \
      __builtin_amdgcn_sched_barrier(0);             \
    } else {                                                                                          \
      _Pragma("unroll") for (int ks = 0; ks < 2; ++ks) {                                              \
        const int fo = ks ? fo1 : fo0;                                                                \
        bf16x8 a[4], b[4];                                                                            \
        _Pragma("unroll") for (int m = 0; m < 4; ++m) a[m] = *(const bf16x8*)(Ab + m * 16 * 64 + fo); \
        _Pragma("unroll") for (int n = 0; n < 4; ++n) b[n] = *(const bf16x8*)(Bb + n * 16 * 64 + fo); \
        _Pragma("unroll") for (int m = 0; m < 4; ++m)                                                 \
          _Pragma("unroll") for (int n = 0; n < 4; ++n) acc[m][n] = mfma16(b[n], a[m], acc[m][n]);     \
      }                                                                                               \
    }                                                                                                 \
  } while (0)
  asm volatile("s_waitcnt vmcnt(0)" ::: "memory");
  __syncthreads();
  for (int kt = 0; kt < nk; kt += 2) {
    GLDS_ISSUE(kt + 1, 1);
    GLDS_COMPUTE(0);
    asm volatile("s_waitcnt vmcnt(0)" ::: "memory");
    __syncthreads();
    if (kt + 2 < nk) GLDS_ISSUE(kt + 2, 0);
    GLDS_COMPUTE(1);
    asm volatile("s_waitcnt vmcnt(0)" ::: "memory");
    __syncthreads();
  }
#undef GLDS_ISSUE
#undef GLDS_COMPUTE
}

__device__ __forceinline__ void gemm_core_glds_cmp(f32x4 (&acc)[4][4], const bf16_t* colptr, int r0, const bf16_t* Btile, size_t ldb,
                                                   int nk, bf16_t* sm, int tid) {
  const int lane = tid & 63, w = tid >> 6, wr = w >> 1, wc = w & 1, l15 = lane & 15, grp = lane >> 4;
  constexpr int TILE = 128 * 64;
  const int sw = (l15 >> 1) & 7;
  const int fo0 = l15 * 64 + ((grp ^ sw) * 8), fo1 = l15 * 64 + (((4 + grp) ^ sw) * 8);
  const int gch = ((tid & 7) ^ ((tid >> 4) & 7)) * 8;
  const bf16_t* gb = Btile + (size_t)(tid >> 3) * ldb + gch;
  const size_t b32 = ldb * 32;
  bf16_t* lbase = sm + tid * 8;
#define CMP_ISSUE(KT, BUF)                                                                                                             \
  do {                                                                                                                                 \
    _Pragma("unroll") for (int i_ = 0; i_ < 4; ++i_) {                                                                                 \
      int tok_ = 16 * (r0 + 32 * i_) + (KT);                                                                                           \
      tok_ = tok_ > (SEQ - 1) ? (SEQ - 1) : tok_;                                                                                      \
      __builtin_amdgcn_global_load_lds((const unsigned*)(colptr + (size_t)tok_ * 1536), (unsigned*)(lbase + (BUF) * TILE + i_ * 2048), 16, 0, 0);     \
      __builtin_amdgcn_global_load_lds((const unsigned*)(gb + i_ * b32 + (KT) * 64), (unsigned*)(lbase + (2 + (BUF)) * TILE + i_ * 2048), 16, 0, 0); \
    }                                                                                                                                  \
  } while (0)
#define CMP_COMPUTE(BUF)                                                                              \
  do {                                                                                                \
    const bf16_t* Ab = sm + (BUF) * TILE + wr * 64 * 64;                                              \
    const bf16_t* Bb = sm + (2 + (BUF)) * TILE + wc * 64 * 64;                                        \
    _Pragma("unroll") for (int ks = 0; ks < 2; ++ks) {                                                \
      const int fo = ks ? fo1 : fo0;                                                                  \
      bf16x8 a[4], b[4];                                                                              \
      _Pragma("unroll") for (int m = 0; m < 4; ++m) a[m] = *(const bf16x8*)(Ab + m * 16 * 64 + fo);   \
      _Pragma("unroll") for (int n = 0; n < 4; ++n) b[n] = *(const bf16x8*)(Bb + n * 16 * 64 + fo);   \
      _Pragma("unroll") for (int m = 0; m < 4; ++m)                                                   \
        _Pragma("unroll") for (int n = 0; n < 4; ++n) acc[m][n] = mfma16(b[n], a[m], acc[m][n]);     \
    }                                                                                                 \
  } while (0)
  __syncthreads();
  CMP_ISSUE(0, 0);
  asm volatile("s_waitcnt vmcnt(0)" ::: "memory");
  __syncthreads();
  for (int kt = 0; kt < nk; kt += 2) {
    CMP_ISSUE(kt + 1, 1);
    CMP_COMPUTE(0);
    asm volatile("s_waitcnt vmcnt(0)" ::: "memory");
    __syncthreads();
    if (kt + 2 < nk) CMP_ISSUE(kt + 2, 0);
    CMP_COMPUTE(1);
    asm volatile("s_waitcnt vmcnt(0)" ::: "memory");
    __syncthreads();
  }
#undef CMP_ISSUE
#undef CMP_COMPUTE
}

__device__ __forceinline__ void zero_acc(f32x4 (&acc)[4][4]) {
#pragma unroll
  for (int m = 0; m < 4; ++m)
#pragma unroll
    for (int n = 0; n < 4; ++n) acc[m][n] = f32x4{0.f, 0.f, 0.f, 0.f};
}

__device__ __forceinline__ void phase_inproj(const Params& p, int l, char* smraw) {
  bf16_t* sm = (bf16_t*)smraw;
  const bf16_t* H = (const bf16_t*)(p.ws + OFF_H);
  const bf16_t* W = (const bf16_t*)(p.ws + OFF_WINT) + (size_t)l * NP * D;
  bf16_t* yApre = (bf16_t*)(p.ws + OFF_YAPRE);
  bf16_t* bzA = (bf16_t*)(p.ws + OFF_BZA);
  bf16_t* qb = (bf16_t*)(p.ws + OFF_Q);
  bf16_t* zb = (bf16_t*)(p.ws + OFF_ZB);
  bf16_t* uz = (bf16_t*)(p.ws + OFF_UZ);
  bf16_t* gv = (bf16_t*)(p.ws + OFF_GV);
  bf16_t* kvb = (bf16_t*)(p.ws + OFF_KV);
  float* glb = (float*)(p.ws + OFF_GL);
  bf16_t* gates = (bf16_t*)(p.ws + OFF_GATES);
  const int tid = opaque_tid(); const int lane = tid & 63, w = tid >> 6, wr = w >> 1, wc = w & 1, l15 = lane & 15, grp = lane >> 4;
  constexpr int MT = R / 128;
  constexpr int NC = (NT_IN + 7) / 8;
  const int nx = gridDim.x >> 3;
  constexpr int CJ_END = (MT / 8) * NC * 64;
  auto cj_valid = [&](int c) { return c < CJ_END && ((c >> 6) % NC) * 8 + ((c & 63) >> 3) < NT_IN; };
  auto cj_next = [&](int c) {
    do { c = ((c & 63) + nx < 64) ? (c + nx) : (((c >> 6) + 8) * 64 + (int)(blockIdx.x >> 3)); } while (c < CJ_END && !cj_valid(c));
    return c;
  };
  int cj = (blockIdx.x & 7) * 64 + (blockIdx.x >> 3);
  if (!cj_valid(cj)) cj = cj_next(cj);
  __syncthreads();
  if (cj < CJ_END) {
    const int cell = cj >> 6, jj = cj & 63;
    glds_prefetch0(H + (size_t)((cell / NC) * 8 + (jj & 7)) * 128 * D, D, W + (size_t)((cell % NC) * 8 + (jj >> 3)) * 128 * D, D, sm, tid);
  }
  while (cj < CJ_END) {
    const int cell = cj >> 6, jj = cj & 63;
    const int nt = (cell % NC) * 8 + (jj >> 3), mt = (cell / NC) * 8 + (jj & 7);
    f32x4 acc[4][4];
    zero_acc(acc);
    gemm_core_glds<true>(acc, H + (size_t)mt * 128 * D, D, W + (size_t)nt * 128 * D, D, D / 64, sm, tid);
    cj = cj_next(cj);
    if (cj < CJ_END) {
      const int cell2 = cj >> 6, jj2 = cj & 63;
      glds_prefetch0(H + (size_t)((cell2 / NC) * 8 + (jj2 & 7)) * 128 * D, D, W + (size_t)((cell2 % NC) * 8 + (jj2 >> 3)) * 128 * D, D, sm, tid);
    }
    const int rbase = mt * 128 + wr * 64 + l15;
    const int c4 = 4 * grp;
#define ST4(PTR, V0, V1, V2, V3) *(u32x2*)(PTR) = u32x2{pack2((V0), (V1)), pack2((V2), (V3))}
    if (nt < 32) {
      const int ch = nt * 32 + wc * 16 + c4;
#pragma unroll
      for (int m = 0; m < 4; ++m) {
        const size_t row = rbase + m * 16;
        ST4(yApre + row * 1024 + ch, acc[m][1][0] * acc[m][2][0], acc[m][1][1] * acc[m][2][1], acc[m][1][2] * acc[m][2][2], acc[m][1][3] * acc[m][2][3]);
        ST4(bzA + row * 1024 + ch, acc[m][0][0] * silu_(acc[m][3][0]), acc[m][0][1] * silu_(acc[m][3][1]), acc[m][0][2] * silu_(acc[m][3][2]), acc[m][0][3] * silu_(acc[m][3][3]));
      }
    } else if (nt < 40) {
      const int cb = (nt - 32) * 128 + wc * 64 + c4;
      const float qs = 0.125f * 1.44269504f;
#pragma unroll
      for (int m = 0; m < 4; ++m)
#pragma unroll
        for (int n = 0; n < 4; ++n)
          ST4(qb + (size_t)(rbase + m * 16) * 1024 + cb + n * 16, acc[m][n][0] * qs, acc[m][n][1] * qs, acc[m][n][2] * qs, acc[m][n][3] * qs);
    } else if (nt < 52) {
      const int cb = (nt - 40) * 128 + wc * 64 + c4;
#pragma unroll
      for (int m = 0; m < 4; ++m)
#pragma unroll
        for (int n = 0; n < 4; ++n)
          ST4(kvb + (size_t)(rbase + m * 16) * 1536 + cb + n * 16, acc[m][n][0], acc[m][n][1], acc[m][n][2], acc[m][n][3]);
    } else if (nt < 60) {
      const int cb = (nt - 52) * 128 + wc * 64 + c4;
#pragma unroll
      for (int m = 0; m < 4; ++m)
#pragma unroll
        for (int n = 0; n < 4; ++n)
          ST4(zb + (size_t)(rbase + m * 16) * 1024 + cb + n * 16, silu_(acc[m][n][0]), silu_(acc[m][n][1]), silu_(acc[m][n][2]), silu_(acc[m][n][3]));
    } else if (nt == 60) {
      if (wc == 0) {
#pragma unroll
        for (int m = 0; m < 4; ++m)
#pragma unroll
          for (int n = 0; n < 3; ++n)
            *(f32x4*)(glb + (size_t)(rbase + m * 16) * 48 + n * 16 + c4) =
                f32x4{sigmoid_(acc[m][n][0]), sigmoid_(acc[m][n][1]), sigmoid_(acc[m][n][2]), sigmoid_(acc[m][n][3])};
      }
    } else if (nt < 77) {
      const int chb = (nt - 61) * 64 + wc * 32 + c4;
#pragma unroll
      for (int m = 0; m < 4; ++m)
#pragma unroll
        for (int pr = 0; pr < 2; ++pr)
          ST4(uz + (size_t)(rbase + m * 16) * 1024 + chb + pr * 16,
              gelu_(acc[m][2 * pr][0]) * silu_(acc[m][2 * pr + 1][0]), gelu_(acc[m][2 * pr][1]) * silu_(acc[m][2 * pr + 1][1]),
              gelu_(acc[m][2 * pr][2]) * silu_(acc[m][2 * pr + 1][2]), gelu_(acc[m][2 * pr][3]) * silu_(acc[m][2 * pr + 1][3]));
    } else if (nt < 85) {
      const int cb = (nt - 77) * 128 + wc * 64 + c4;
#pragma unroll
      for (int m = 0; m < 4; ++m)
#pragma unroll
        for (int n = 0; n < 4; ++n)
          ST4(gv + (size_t)(rbase + m * 16) * 1024 + cb + n * 16, gelu_(acc[m][n][0]), gelu_(acc[m][n][1]), gelu_(acc[m][n][2]), gelu_(acc[m][n][3]));
    } else {
      const int cb = (nt - 85) * 128 + wc * 64 + c4;
#pragma unroll
      for (int m = 0; m < 4; ++m)
#pragma unroll
        for (int n = 0; n < 4; ++n)
          ST4(gates + (size_t)(rbase + m * 16) * 3072 + cb + n * 16, sigmoid_(acc[m][n][0]), sigmoid_(acc[m][n][1]), sigmoid_(acc[m][n][2]), sigmoid_(acc[m][n][3]));
    }
#undef ST4
  }
}

struct CmpALoader {
  const bf16_t* rowptr;
  int r, soff;
  u32x4 r0, r1;
  __device__ __forceinline__ void load(int kt) {
    int tok = 16 * r + (kt >> 1);
    tok = tok > (SEQ - 1) ? (SEQ - 1) : tok;
    const bf16_t* q = rowptr + (size_t)tok * 1536 + (kt & 1) * 32;
    r0 = *(const u32x4*)q; r1 = *(const u32x4*)(q + 8);
  }
  __device__ __forceinline__ void store(bf16_t* tile) {
    bf16_t* q = tile + soff;
    *(u32x4*)q = r0; *(u32x4*)(q + 8) = r1;
  }
};

__device__ __forceinline__ void phase_mix1(const Params& p, int l, char* smraw) {
  const int tid = opaque_tid(); const int lane = tid & 63, w = tid >> 6, l15 = lane & 15, grp = lane >> 4;
  const bf16_t* gv = (const bf16_t*)(p.ws + OFF_GV);
  float* stats = (float*)(p.ws + OFF_STATS);
  constexpr int NCB = 2 * (NB * 4 * 256 / 128);
  const bool split = (int)gridDim.x >= 2 * NCB;
  const int eb = split ? (int)blockIdx.x - NCB : (int)blockIdx.x;
  const int neb = split ? (int)gridDim.x - NCB : (int)gridDim.x;
  for (int r = eb * 4 + w; eb >= 0 && r < R; r += neb * 4) {
    const bf16_t* row = gv + (size_t)r * 1024;
    float v[16]; float s = 0.f;
#pragma unroll
    for (int i = 0; i < 2; ++i) {
      u32x4 u = *(const u32x4*)(row + i * 512 + lane * 8);
      v[i * 8 + 0] = bf2f(u.x & 0xffffu); v[i * 8 + 1] = bf2f(u.x >> 16);
      v[i * 8 + 2] = bf2f(u.y & 0xffffu); v[i * 8 + 3] = bf2f(u.y >> 16);
      v[i * 8 + 4] = bf2f(u.z & 0xffffu); v[i * 8 + 5] = bf2f(u.z >> 16);
      v[i * 8 + 6] = bf2f(u.w & 0xffffu); v[i * 8 + 7] = bf2f(u.w >> 16);
    }
#pragma unroll
    for (int i = 0; i < 16; ++i) s += v[i];
    s = wave_sum(s, lane);
    float mu = s * (1.f / 1024.f);
    float q = 0.f;
#pragma unroll
    for (int i = 0; i < 16; ++i) { float d = v[i] - mu; q += d * d; }
    q = wave_sum(q, lane);
    if (lane == 0) { stats[r * 2] = mu; stats[r * 2 + 1] = rsqrtf(q * (1.f / 1024.f) + 1e-6f); }
  }
  {
    const bf16_t* yApre = (const bf16_t*)(p.ws + OFF_YAPRE);
    const bf16_t* bzA = (const bf16_t*)(p.ws + OFF_BZA);
    bf16_t* yA = (bf16_t*)(p.ws + OFF_YA);
    const float* cw = p.conv_w + (size_t)l * 3 * 1024;
    const float* cb = p.conv_b + (size_t)l * 1024;
    for (int e = eb * 256 + tid; eb >= 0 && e < R * 128; e += neb * 256) {
      int row = e >> 7, c8 = (e & 127) * 8;
      int t = row & (SEQ - 1);
      u32x4 y2 = *(const u32x4*)(yApre + (size_t)row * 1024 + c8);
      u32x4 y1 = (t >= 1) ? *(const u32x4*)(yApre + (size_t)(row - 1) * 1024 + c8) : u32x4{0, 0, 0, 0};
      u32x4 y0 = (t >= 2) ? *(const u32x4*)(yApre + (size_t)(row - 2) * 1024 + c8) : u32x4{0, 0, 0, 0};
      u32x4 bz = *(const u32x4*)(bzA + (size_t)row * 1024 + c8);
      u32x4 o;
#pragma unroll
      for (int i = 0; i < 4; ++i) {
        int c = c8 + i * 2;
        float r0 = cb[c] + cw[c] * bf2f(y0[i] & 0xffffu) + cw[1024 + c] * bf2f(y1[i] & 0xffffu) + cw[2048 + c] * bf2f(y2[i] & 0xffffu);
        float r1 = cb[c + 1] + cw[c + 1] * bf2f(y0[i] >> 16) + cw[1024 + c + 1] * bf2f(y1[i] >> 16) + cw[2048 + c + 1] * bf2f(y2[i] >> 16);
        o[i] = pack2(bf2f(bz[i] & 0xffffu) * r0, bf2f(bz[i] >> 16) * r1);
      }
      *(u32x4*)(yA + (size_t)row * 1024 + c8) = o;
    }
  }
  {
    bf16_t* sm = (bf16_t*)smraw;
    const bf16_t* kvb = (const bf16_t*)(p.ws + OFF_KV);
    const bf16_t* Wc1T = (const bf16_t*)(p.ws + OFF_WC1T);
    const float* bias1 = (const float*)(p.ws + OFF_BIAS1);
    const int wr = w >> 1, wc = w & 1;
    constexpr int MTC = NB * 4 * 256 / 128;
    for (int t = blockIdx.x; t < 2 * MTC; t += gridDim.x) {
      int kv = t / MTC, mt = t % MTC;
      f32x4 acc[4][4];
      zero_acc(acc);
      {
        const int rr = mt * 128 + (tid >> 3);
        const int bl = rr >> 10, g = (rr >> 8) & 3;
        const int gch = ((tid & 7) ^ ((tid >> 4) & 7)) * 8;
        gemm_core_glds_cmp(acc, kvb + (size_t)bl * SEQ * 1536 + kv * 256 + g * 64 + gch, rr & 255,
                           Wc1T + (size_t)(l * 2 + kv) * 128 * 2048, 2048, 2048 / 64, sm, tid);
      }
      bf16_t* Hs = sm;
      bf16_t* W2s = sm + 128 * HS_LD;
      const float* b1 = bias1 + (l * 2 + kv) * 8 * 128;
#pragma unroll
      for (int n = 0; n < 4; ++n) {
        const int col = wc * 64 + n * 16 + 4 * grp;
        f32x4 bb = f32x4{0.f, 0.f, 0.f, 0.f};
#pragma unroll
        for (int ks = 0; ks < 8; ++ks) bb += *(const f32x4*)(b1 + ks * 128 + col);
#pragma unroll
        for (int m = 0; m < 4; ++m)
          *(u32x2*)(Hs + (wr * 64 + m * 16 + l15) * HS_LD + col) =
              u32x2{pack2(silu_(acc[m][n][0] + bb[0]), silu_(acc[m][n][1] + bb[1])), pack2(silu_(acc[m][n][2] + bb[2]), silu_(acc[m][n][3] + bb[3]))};
      }
      const float* w2 = (kv ? p.w_cv2 : p.w_ck2) + (size_t)l * 128 * 64;
      for (int i = 0; i < 32; ++i) {
        int e = tid + 256 * i;
        int j = e >> 6, d = e & 63;
        W2s[d * HS_LD + j] = f2bf(w2[e]);
      }
      __syncthreads();
      f32x4 a2[2][4];
#pragma unroll
      for (int mm = 0; mm < 2; ++mm)
#pragma unroll
        for (int nn = 0; nn < 4; ++nn) a2[mm][nn] = f32x4{0.f, 0.f, 0.f, 0.f};
#pragma unroll
      for (int ks = 0; ks < 4; ++ks) {
        bf16x8 af[2], bfr[4];
#pragma unroll
        for (int mm = 0; mm < 2; ++mm) af[mm] = *(const bf16x8*)(Hs + (w * 32 + mm * 16 + l15) * HS_LD + ks * 32 + grp * 8);
#pragma unroll
        for (int nn = 0; nn < 4; ++nn) bfr[nn] = *(const bf16x8*)(W2s + (nn * 16 + l15) * HS_LD + ks * 32 + grp * 8);
#pragma unroll
        for (int mm = 0; mm < 2; ++mm)
#pragma unroll
          for (int nn = 0; nn < 4; ++nn) a2[mm][nn] = mfma16(af[mm], bfr[nn], a2[mm][nn]);
      }
      bf16_t* outp = (bf16_t*)(p.ws + (kv ? OFF_VCMP : OFF_KCMP));
#pragma unroll
      for (int mm = 0; mm < 2; ++mm)
#pragma unroll
        for (int nn = 0; nn < 4; ++nn)
#pragma unroll
          for (int j = 0; j < 4; ++j) {
            int row = mt * 128 + w * 32 + mm * 16 + 4 * grp + j;
            outp[(size_t)row * 64 + nn * 16 + l15] = f2bf(a2[mm][nn][j]);
          }
      __syncthreads();
    }
  }
}

struct KVRegs { u32x4 k0, k1, v0, v1; };

__device__ __forceinline__ void kv_issue(KVRegs& r, const bf16_t* kbase, const bf16_t* vbase, size_t ld, bool wantV, int tid) {
  const uint32_t row = (uint32_t)tid >> 3, c = ((uint32_t)tid & 7u) * 8u;
  const uint32_t ldu = (ld == 64 ? 64u : 1536u);
  const uint32_t off = row * ldu + c;
  const bf16_t* kp = kbase + off;
  r.k0 = *(const u32x4*)kp; r.k1 = *(const u32x4*)(kp + 32u * ldu);
  if (wantV) {
    const bf16_t* vp = vbase + off;
    r.v0 = *(const u32x4*)vp; r.v1 = *(const u32x4*)(vp + 32u * ldu);
  }
}
__device__ __forceinline__ void kv_commit(const KVRegs& r, bf16_t* Ks, bf16_t* Vs, bool wantV, int tid) {
  int row = tid >> 3, c = (tid & 7) * 8;
  *(u32x4*)(Ks + row * KS_LD + c) = r.k0;
  *(u32x4*)(Ks + (row + 32) * KS_LD + c) = r.k1;
  if (wantV) {
    *(u32x4*)(Vs + row * KS_LD + c) = r.v0;
    *(u32x4*)(Vs + (row + 32) * KS_LD + c) = r.v1;
  }
}

typedef short s16x4 __attribute__((ext_vector_type(4)));
__device__ __forceinline__ s16x4 tr_read(const bf16_t* ptr) {
  return __builtin_amdgcn_ds_read_tr16_b64_v4i16((s16x4 __attribute__((address_space(3)))*)ptr);
}

#define ADSR(dst, base, OFF) asm volatile("ds_read_b128 %0, %1 offset:" #OFF : "=v"(dst) : "v"(base) : "memory")
#define ATRR(dst, base, OFF) asm volatile("ds_read_b64_tr_b16 %0, %1 offset:" #OFF : "=v"(dst) : "v"(base) : "memory")
template <bool MASKED, int KPSTRIDE>
__device__ __forceinline__ void attn_block64(const bf16_t* Ks, const bf16_t* Vs, bf16x8 q0, bf16x8 q1, int tq, int kp0, int kpstride_unused,
                                             int maxdist, bool extra_ok, float slope, float& m, f32x4& lsum, f32x4 (&o)[4], int l15, int grp,
                                             const f32x4 (&tb)[4]) {
  constexpr int kpstride = KPSTRIDE;
  const int d0 = tq - kp0 - 4 * grp * kpstride;
  const float base = -slope * (float)d0;
  const unsigned kaddr = (unsigned)(size_t)(Ks + l15 * KS_LD + grp * 8);
  const unsigned vaddr = (unsigned)(size_t)(Vs + (4 * grp + (l15 >> 2)) * KS_LD + 4 * (l15 & 3));
  bf16x8 kf[8];
  ADSR(kf[0], kaddr, 0);    ADSR(kf[1], kaddr, 64);   ADSR(kf[2], kaddr, 2560); ADSR(kf[3], kaddr, 2624);
  ADSR(kf[4], kaddr, 5120); ADSR(kf[5], kaddr, 5184); ADSR(kf[6], kaddr, 7680); ADSR(kf[7], kaddr, 7744);
  f32x4 s[4];
  asm volatile("s_waitcnt lgkmcnt(6)" : "+v"(kf[0]), "+v"(kf[1]) :: "memory");
  const f32x4 b0 = (KPSTRIDE == 1) ? tb[0] : tb[0] * (float)KPSTRIDE, b1 = (KPSTRIDE == 1) ? tb[1] : tb[1] * (float)KPSTRIDE;
  const f32x4 b2 = (KPSTRIDE == 1) ? tb[2] : tb[2] * (float)KPSTRIDE, b3 = (KPSTRIDE == 1) ? tb[3] : tb[3] * (float)KPSTRIDE;
  s[0] = mfma16(kf[1], q1, mfma16(kf[0], q0, b0));
  asm volatile("s_waitcnt lgkmcnt(4)" : "+v"(kf[2]), "+v"(kf[3]) :: "memory");
  s[1] = mfma16(kf[3], q1, mfma16(kf[2], q0, b1));
  asm volatile("s_waitcnt lgkmcnt(2)" : "+v"(kf[4]), "+v"(kf[5]) :: "memory");
  s[2] = mfma16(kf[5], q1, mfma16(kf[4], q0, b2));
  asm volatile("s_waitcnt lgkmcnt(0)" : "+v"(kf[6]), "+v"(kf[7]) :: "memory");
  s[3] = mfma16(kf[7], q1, mfma16(kf[6], q0, b3));
  s16x4 vt[16];
  ATRR(vt[0], vaddr, 0);     ATRR(vt[1], vaddr, 2560);  ATRR(vt[2], vaddr, 32);    ATRR(vt[3], vaddr, 2592);
  ATRR(vt[4], vaddr, 64);    ATRR(vt[5], vaddr, 2624);  ATRR(vt[6], vaddr, 96);    ATRR(vt[7], vaddr, 2656);
  ATRR(vt[8], vaddr, 5120);  ATRR(vt[9], vaddr, 7680);  ATRR(vt[10], vaddr, 5152); ATRR(vt[11], vaddr, 7712);
  ATRR(vt[12], vaddr, 5184); ATRR(vt[13], vaddr, 7744); ATRR(vt[14], vaddr, 5216); ATRR(vt[15], vaddr, 7776);
  float cmax = -1e30f;
#pragma unroll
  for (int t = 0; t < 4; ++t)
#pragma unroll
    for (int j = 0; j < 4; ++j) {
      const int ci = t * 16 + j;
      float v = s[t][j];
      if (MASKED) {
        const int dist = d0 - ci * kpstride;
        const bool valid = extra_ok && ((unsigned)dist < (unsigned)maxdist);
        v = valid ? v : -1e30f;
      }
      s[t][j] = v;
      cmax = fmaxf(cmax, v);
    }
  if (!MASKED) cmax = extra_ok ? cmax : -1e30f;
  if (__ballot(cmax + base > m + 40.f) != 0ull) {
    cmax = (cmax > -1e29f) ? cmax + base : -1e30f;
    cmax = fmaxf(cmax, bperm(cmax, (l15 + 16 * grp) ^ 16));
    cmax = fmaxf(cmax, bperm(cmax, (l15 + 16 * grp) ^ 32));
    const float mnew = fmaxf(m, cmax);
    const float alpha = __builtin_amdgcn_exp2f(m - mnew);
    lsum *= alpha;
#pragma unroll
    for (int dt = 0; dt < 4; ++dt) o[dt] *= alpha;
    m = mnew;
  }
  const float mb = m - base;
#pragma unroll
  for (int t = 0; t < 4; ++t)
#pragma unroll
    for (int j = 0; j < 4; ++j) {
      const float v = s[t][j];
      float pe = __builtin_amdgcn_exp2f(v - mb);
      if (MASKED) pe = (v > -1e29f) ? pe : 0.f;
      s[t][j] = pe;
    }
  const bf16x8 ones = {0x3F80, 0x3F80, 0x3F80, 0x3F80, 0x3F80, 0x3F80, 0x3F80, 0x3F80};
  const uint32_t rowm = (MASKED || extra_ok) ? 0xffffffffu : 0u;
  asm volatile("s_waitcnt lgkmcnt(0)"
               : "+v"(vt[0]), "+v"(vt[1]), "+v"(vt[2]), "+v"(vt[3]), "+v"(vt[4]), "+v"(vt[5]), "+v"(vt[6]), "+v"(vt[7]),
                 "+v"(vt[8]), "+v"(vt[9]), "+v"(vt[10]), "+v"(vt[11]), "+v"(vt[12]), "+v"(vt[13]), "+v"(vt[14]), "+v"(vt[15])
               :: "memory");
#pragma unroll
  for (int sc = 0; sc < 2; ++sc) {
    const bf16x8 pb = __builtin_bit_cast(bf16x8, u32x4{pack2(s[2 * sc][0], s[2 * sc][1]) & rowm, pack2(s[2 * sc][2], s[2 * sc][3]) & rowm,
                                                       pack2(s[2 * sc + 1][0], s[2 * sc + 1][1]) & rowm, pack2(s[2 * sc + 1][2], s[2 * sc + 1][3]) & rowm});
    lsum = mfma16(ones, pb, lsum);
#pragma unroll
    for (int dt = 0; dt < 4; ++dt) {
      const s16x4 vlo = vt[sc * 8 + dt * 2], vhi = vt[sc * 8 + dt * 2 + 1];
      const bf16x8 vf = {vlo[0], vlo[1], vlo[2], vlo[3], vhi[0], vhi[1], vhi[2], vhi[3]};
      o[dt] = mfma16(vf, pb, o[dt]);
    }
  }
}

constexpr int ATT_TILE = 64 * KS_LD * 2;
constexpr int ATT_BUF = 2 * ATT_TILE;

template <class DescF, class ProcF>
__device__ __forceinline__ void kv_stream_run(int n, DescF desc, ProcF proc, char* smraw, int tid, KVRegs& r0, KVRegs& r1) {
  const bf16_t *kp, *vp; size_t ld;
  __syncthreads();
  kv_commit(r0, (bf16_t*)smraw, (bf16_t*)(smraw + ATT_TILE), true, tid);
  desc(2 < n ? 2 : n - 1, kp, vp, ld); kv_issue(r0, kp, vp, ld, true, tid);
  __syncthreads();
  for (int e0 = 0; e0 < n; e0 += 2) {
    {
      const int e = e0;
      proc(e, (const bf16_t*)smraw, (const bf16_t*)(smraw + ATT_TILE));
      kv_commit(r1, (bf16_t*)(smraw + ATT_BUF), (bf16_t*)(smraw + ATT_BUF + ATT_TILE), true, tid);
      desc(e + 3 < n ? e + 3 : n - 1, kp, vp, ld); kv_issue(r1, kp, vp, ld, true, tid);
      __syncthreads();
    }
    {
      const int e = e0 + 1;
      if (e < n) proc(e, (const bf16_t*)(smraw + ATT_BUF), (const bf16_t*)(smraw + ATT_BUF + ATT_TILE));
      kv_commit(r0, (bf16_t*)smraw, (bf16_t*)(smraw + ATT_TILE), true, tid);
      desc(e + 3 < n ? e + 3 : n - 1, kp, vp, ld); kv_issue(r0, kp, vp, ld, true, tid);
      __syncthreads();
    }
  }
}

template <class DescF, class ProcF>
__device__ __forceinline__ void kv_stream(int n, DescF desc, ProcF proc, char* smraw, int tid) {
  if (n <= 0) return;
  KVRegs r0, r1;
  const bf16_t *kp, *vp; size_t ld;
  desc(0, kp, vp, ld); kv_issue(r0, kp, vp, ld, true, tid);
  desc(1 < n ? 1 : n - 1, kp, vp, ld); kv_issue(r1, kp, vp, ld, true, tid);
  kv_stream_run(n, desc, proc, smraw, tid, r0, r1);
}

__device__ __forceinline__ void attn_unit(const Params& p, char* smraw, int bl, int g, int qb) {
  float* impbuf = (float*)(smraw + 2 * ATT_BUF);
  unsigned long long* selmask = (unsigned long long*)(smraw + 2 * ATT_BUF + 16640);
  int* sellist = (int*)(smraw + 2 * ATT_BUF + 16640 + 128);
  const bf16_t* qbuf = (const bf16_t*)(p.ws + OFF_Q);
  const bf16_t* zbuf = (const bf16_t*)(p.ws + OFF_ZB);
  const bf16_t* kvb = (const bf16_t*)(p.ws + OFF_KV);
  const float* glb = (const float*)(p.ws + OFF_GL);
  bf16_t* yB = (bf16_t*)(p.ws + OFF_YB);
  const int tid = opaque_tid(); const int lane = tid & 63, n = tid >> 6, l15 = lane & 15, grp = lane >> 4;
  const int h = g * 4 + n, t0 = qb * 16, tq = t0 + l15;
  const float slope = exp2f(-0.5f * (float)(h + 1)) * 1.44269504f;
  f32x4 tb[4];
#pragma unroll
  for (int t = 0; t < 4; ++t) tb[t] = f32x4{slope * (float)(16 * t), slope * (float)(16 * t + 1), slope * (float)(16 * t + 2), slope * (float)(16 * t + 3)};
  const size_t rowq = (size_t)bl * SEQ + tq;
  bf16x8 q0, q1;
  {
    const bf16_t* qp = qbuf + rowq * 1024 + h * 64 + grp * 8;
    q0 = *(const bf16x8*)qp; q1 = *(const bf16x8*)(qp + 32);
  }
  const float g0 = glb[rowq * 48 + h * 3 + 0], g1 = glb[rowq * 48 + h * 3 + 1], g2 = glb[rowq * 48 + h * 3 + 2];
  f32x4 otot[4];
#pragma unroll
  for (int dt = 0; dt < 4; ++dt) otot[dt] = f32x4{0.f, 0.f, 0.f, 0.f};
  const size_t seqbase = (size_t)bl * SEQ * 1536 + g * 64;
  const int BIG = 1 << 30;
  const bf16_t* kcb = (const bf16_t*)(p.ws + OFF_KCMP) + (size_t)(bl * 4 + g) * 256 * 64;
  const bf16_t* vcb = (const bf16_t*)(p.ws + OFF_VCMP) + (size_t)(bl * 4 + g) * 256 * 64;
  const bf16_t* kwb = kvb + seqbase + 1024;
  const bf16_t* vwb = kvb + seqbase + 1280;
  const bf16_t* ksb = kvb + seqbase + 512;
  const bf16_t* vsb = kvb + seqbase + 768;

  float m = -1e30f;
  f32x4 lsum = f32x4{0.f, 0.f, 0.f, 0.f};
  f32x4 o[4];
#pragma unroll
  for (int dt = 0; dt < 4; ++dt) o[dt] = f32x4{0.f, 0.f, 0.f, 0.f};
  float m_c = -1e30f, inv_c = 0.f, prev_rot = 0.f;
  float* myimp = impbuf + n * 1040;
#pragma unroll
  for (int i = 0; i < 16; ++i) myimp[i * 65 + lane] = 0.f;

  int lo = t0 - 511; lo = lo < 0 ? 0 : lo;
  const int wlo = lo >> 6, whi = t0 >> 6, nW = whi - wlo + 1;
  const int nck = (qb + 63) >> 6;
  auto finish = [&](float gate) -> float {
    const float lt = lsum[0];
    const float inv = lt > 0.f ? 1.f / lt : 0.f;
    const float sc_ = gate * inv;
#pragma unroll
    for (int dt = 0; dt < 4; ++dt) { otot[dt] += o[dt] * sc_; o[dt] = f32x4{0.f, 0.f, 0.f, 0.f}; }
    lsum = f32x4{0.f, 0.f, 0.f, 0.f};
    return inv;
  };
  kv_stream(nW + 2 * nck,
    [&](int e, const bf16_t*& kp, const bf16_t*& vp, size_t& ld) {
      if (e < nW) { const size_t off = (size_t)(whi - e) * 64 * 1536; kp = kwb + off; vp = vwb + off; ld = 1536; }
      else { const int c = (e < nW + nck) ? (nW + nck - 1 - e) : (e - nW - nck); kp = kcb + c * 4096; vp = vcb + c * 4096; ld = 64; }
    },
    [&](int e, const bf16_t* Ks, const bf16_t* Vt) {
      if (e < nW) {
        const int wb = whi - e;
        if (wb < whi && wb * 64 >= t0 - 496) attn_block64<false, 1>(Ks, Vt, q0, q1, tq, wb * 64, 1, 512, true, slope, m, lsum, o, l15, grp, tb);
        else attn_block64<true, 1>(Ks, Vt, q0, q1, tq, wb * 64, 1, 512, true, slope, m, lsum, o, l15, grp, tb);
        if (e == nW - 1) { (void)finish(g2); m = -1e30f; }
      } else if (e < nW + nck) {
        const int c = nW + nck - 1 - e;
        if (16 * (64 * c + 63) + 31 <= t0) attn_block64<false, 16>(Ks, Vt, q0, q1, tq, 1024 * c + 31, 16, BIG, true, slope, m, lsum, o, l15, grp, tb);
        else attn_block64<true, 16>(Ks, Vt, q0, q1, tq, 1024 * c + 31, 16, BIG, true, slope, m, lsum, o, l15, grp, tb);
        if (e == nW + nck - 1) { inv_c = finish(g0); m_c = m; m = -1e30f; }
      } else {
        const int c = e - nW - nck;
#pragma unroll
        for (int tt = 0; tt < 4; ++tt) {
          const bf16_t* krp = Ks + (tt * 16 + l15) * KS_LD + grp * 8;
          bf16x8 k0 = *(const bf16x8*)krp, k1 = *(const bf16x8*)(krp + 32);
          f32x4 z = tb[tt] * 16.f;
          z = mfma16(k0, q0, z);
          z = mfma16(k1, q1, z);
          float sum4 = 0.f, p3 = 0.f;
          const int dist0 = tq - (16 * (c * 64 + 4 * grp) + 31);
          const float mref = m_c + slope * (float)dist0;
#pragma unroll
          for (int j = 0; j < 4; ++j) {
            int dist = dist0 - 16 * (tt * 16 + j);
            float pe = (dist >= 0) ? __builtin_amdgcn_exp2f(z[j] - mref) * inv_c : 0.f;
            sum4 += pe;
            if (j == 3) p3 = pe;
          }
          float rot = bperm(p3, (lane + 48) & 63);
          float extra = (grp == 0) ? prev_rot : rot;
          myimp[l15 * 65 + (c * 4 + tt) * 4 + grp] = sum4 + extra;
          prev_rot = rot;
        }
      }
    }, smraw, tid);
  KVRegs sr0, sr1;
  {
    const int b0 = whi, b1 = whi > 0 ? whi - 1 : 0;
    kv_issue(sr0, ksb + (size_t)b0 * 64 * 1536, vsb + (size_t)b0 * 64 * 1536, 1536, true, tid);
    kv_issue(sr1, ksb + (size_t)b1 * 64 * 1536, vsb + (size_t)b1 * 64 * 1536, 1536, true, tid);
  }
  if (nck < 4 && grp == 0) myimp[l15 * 65 + nck * 16] = prev_rot;
  __syncthreads();
#pragma unroll 1
  for (int i = 0; i < 4; ++i) {
    int qi = n * 4 + i;
    const int cur = t0 >> 6, s = lane;
    float imp = impbuf[qi * 65 + s] + impbuf[1040 + qi * 65 + s] + impbuf[2080 + qi * 65 + s] + impbuf[3120 + qi * 65 + s];
    bool forced = (s == 0) || (s == cur) || (s == cur - 1);
    bool valid = s <= cur;
    float score = forced ? __builtin_inff() : (valid ? imp : -__builtin_inff());
    unsigned long long mk;
    if (cur < 16) {
      mk = __ballot(valid);
    } else {
      const int key = (int)(((forced ? 0x7F800000u : __float_as_uint(imp)) & 0xFFFFFFC0u) | (unsigned)(63 - s));
      int rank = 0;
#pragma unroll 8
      for (int sp = 0; sp <= cur; ++sp)
        rank += (__builtin_amdgcn_readlane(key, sp) > key) ? 1 : 0;
      mk = __ballot((rank < 16) && valid);
    }
    if (lane == 0) selmask[qi] = mk;
  }
  __syncthreads();
  const unsigned long long mymask = selmask[l15];
  unsigned long long U = 0, Uand = ~0ull;
#pragma unroll
  for (int i = 0; i < 16; ++i) { const unsigned long long mk = selmask[i]; U |= mk; Uand &= mk; }
  {
    uint32_t ulo = __builtin_amdgcn_readfirstlane((uint32_t)U), uhi = __builtin_amdgcn_readfirstlane((uint32_t)(U >> 32));
    U = ((unsigned long long)uhi << 32) | ulo;
    ulo = __builtin_amdgcn_readfirstlane((uint32_t)Uand); uhi = __builtin_amdgcn_readfirstlane((uint32_t)(Uand >> 32));
    Uand = ((unsigned long long)uhi << 32) | ulo;
  }
  const int nsel = __popcll(U);
  if (n == 0) {
    if ((U >> lane) & 1ull) sellist[__popcll(U >> lane) - 1] = lane;
  }
  __syncthreads();
  kv_stream_run(nsel,
    [&](int e, const bf16_t*& kp, const bf16_t*& vp, size_t& ld) {
      const int s = __builtin_amdgcn_readfirstlane(sellist[e]);
      const size_t off = (size_t)s * 64 * 1536; kp = ksb + off; vp = vsb + off; ld = 1536;
    },
    [&](int e, const bf16_t* Ks, const bf16_t* Vt) {
      const int s = __builtin_amdgcn_readfirstlane(sellist[e]);
      const bool ok = (mymask >> s) & 1ull;
      if (s < whi) attn_block64<false, 1>(Ks, Vt, q0, q1, tq, s * 64, 1, BIG, ok, slope, m, lsum, o, l15, grp, tb);
      else attn_block64<true, 1>(Ks, Vt, q0, q1, tq, s * 64, 1, BIG, ok, slope, m, lsum, o, l15, grp, tb);
    }, smraw, tid, sr0, sr1);
  (void)finish(g1);
#pragma unroll
  for (int dt = 0; dt < 4; ++dt) {
    size_t off = rowq * 1024 + h * 64 + dt * 16 + 4 * grp;
    u32x2 zz = *(const u32x2*)(zbuf + off);
    u32x2 ov;
    ov.x = pack2(otot[dt][0] * bf2f(zz.x & 0xffffu), otot[dt][1] * bf2f(zz.x >> 16));
    ov.y = pack2(otot[dt][2] * bf2f(zz.y & 0xffffu), otot[dt][3] * bf2f(zz.y >> 16));
    *(u32x2*)(yB + off) = ov;
  }
}

struct GmlpBLoader {
  const bf16_t* gvbase;
  const float* stats;
  const float* lg; const float* lb;
  int tid;
  u32x4 r[2]; f32x2 st[2];
  __device__ __forceinline__ void load(int kt) {
#pragma unroll
    for (int i = 0; i < 2; ++i) {
      int v = tid + 256 * i;
      int j = kt * 32 + (v >> 4), c8 = (v & 15) * 8;
      r[i] = *(const u32x4*)(gvbase + (size_t)j * 1024 + c8);
      st[i] = *(const f32x2*)(stats + j * 2);
    }
  }
  __device__ __forceinline__ void store(bf16_t* tile) {
#pragma unroll
    for (int i = 0; i < 2; ++i) {
      int v = tid + 256 * i;
      int jl = v >> 4, c8 = (v & 15) * 8;
      const u32x4 u = r[i];
#pragma unroll
      for (int e = 0; e < 4; ++e) {
        int c = c8 + 2 * e;
        float a = (bf2f(u[e] & 0xffffu) - st[i].x) * st[i].y * lg[c] + lb[c];
        float b = (bf2f(u[e] >> 16) - st[i].x) * st[i].y * lg[c + 1] + lb[c + 1];
        tile[c * LDK + jl] = f2bf(a);
        tile[(c + 1) * LDK + jl] = f2bf(b);
      }
    }
  }
};

__device__ __forceinline__ void gmlp_unit(const Params& p, int l, char* smraw, int bl, int chunk, int g) {
  bf16_t* sm = (bf16_t*)smraw;
  const int tid = opaque_tid(); const int lane = tid & 63, w = tid >> 6, wr = w >> 1, wc = w & 1, l15 = lane & 15, grp = lane >> 4;
  const size_t row0 = (size_t)bl * SEQ + chunk * 128;
  f32x4 acc[4][4];
  zero_acc(acc);
  StdLoader al;
  al.init((const bf16_t*)(p.ws + OFF_WM) + (size_t)(l * 8 + g) * 128 * 128, 128, tid);
  GmlpBLoader bl_;
  bl_.tid = tid;
  bl_.gvbase = (const bf16_t*)(p.ws + OFF_GV) + row0 * 1024 + g * 128;
  bl_.stats = (const float*)(p.ws + OFF_STATS) + row0 * 2;
  bl_.lg = p.ln_g + l * 1024 + g * 128;
  bl_.lb = p.ln_b + l * 1024 + g * 128;
  gemm_core(acc, al, bl_, 4, sm, tid);
  const bf16_t* uz = (const bf16_t*)(p.ws + OFF_UZ);
  bf16_t* yC = (bf16_t*)(p.ws + OFF_YC);
  const float* bs = p.b_s + (size_t)(l * 8 + g) * 128;
#pragma unroll
  for (int m = 0; m < 4; ++m)
#pragma unroll
    for (int j = 0; j < 4; ++j) {
      int i = wr * 64 + m * 16 + 4 * grp + j;
      float bb = bs[i];
#pragma unroll
      for (int n = 0; n < 4; ++n) {
        size_t off = (row0 + i) * 1024 + g * 128 + wc * 64 + n * 16 + l15;
        yC[off] = f2bf(bf2f(uz[off]) * (acc[m][n][j] + bb));
      }
    }
}

__device__ __forceinline__ void phase_mix2(const Params& p, int l, char* smraw) {
  constexpr int NATT = NB * 4 * 256, NGM = NB * 32 * 8;
  for (int u = blockIdx.x; u < NATT + NGM; u += gridDim.x) {
    if (u < NATT) {
      int qb = 255 - (u / (NB * 4)), r = u % (NB * 4);
      attn_unit(p, smraw, r >> 2, r & 3, qb);
    } else {
      int v = u - NATT;
      gmlp_unit(p, l, smraw, v >> 8, (v >> 3) & 31, v & 7);
    }
  }
}

__device__ __forceinline__ void phase_merge(const Params& p, int l, char* smraw) {
  bf16_t* sm = (bf16_t*)smraw;
  const bf16_t* WbrT = (const bf16_t*)(p.ws + OFF_WBRT) + (size_t)l * 3 * D * D;
  const bf16_t* gates = (const bf16_t*)(p.ws + OFF_GATES);
  bf16_t* merged = (bf16_t*)(p.ws + OFF_H);
  const int tid = opaque_tid(); const int lane = tid & 63, w = tid >> 6, wr = w >> 1, wc = w & 1, l15 = lane & 15, grp = lane >> 4;
  const int nx = gridDim.x >> 3;
  constexpr int CJ_END = (R / 1024) * 64;
  auto cj_next = [&](int c) { return ((c & 63) + nx < 64) ? (c + nx) : (((c >> 6) + 8) * 64 + (int)(blockIdx.x >> 3)); };
  auto ybuf = [&](int i) { return (const bf16_t*)(p.ws + (i == 0 ? OFF_YA : (i == 1 ? OFF_YB : OFF_YC))); };
  int cj = (blockIdx.x & 7) * 64 + (blockIdx.x >> 3);
  __syncthreads();
  if (cj < CJ_END) glds_prefetch0(ybuf(0) + (size_t)((cj >> 6) * 8 + (cj & 7)) * 128 * D, D, WbrT + (size_t)((cj & 63) >> 3) * 128 * D, D, sm, tid);
  for (; cj < CJ_END; cj = cj_next(cj)) {
    const int nt = (cj & 63) >> 3, mt = (cj >> 6) * 8 + (cj & 7);
    const int rbase = mt * 128 + wr * 64 + l15, cbase = nt * 128 + wc * 64 + 4 * grp;
    f32x4 tot[4][4];
    zero_acc(tot);
#pragma unroll 1
    for (int i = 0; i < 3; ++i) {
      f32x4 acc[4][4];
      zero_acc(acc);
      const bf16_t* Y = ybuf(i);
      gemm_core_glds<false>(acc, Y + (size_t)mt * 128 * D, D, WbrT + (size_t)i * D * D + (size_t)nt * 128 * D, D, D / 64, sm, tid);
      if (i < 2) {
        glds_prefetch0(ybuf(i + 1) + (size_t)mt * 128 * D, D, WbrT + (size_t)(i + 1) * D * D + (size_t)nt * 128 * D, D, sm, tid);
      } else {
        const int c2 = cj_next(cj);
        if (c2 < CJ_END) glds_prefetch0(ybuf(0) + (size_t)((c2 >> 6) * 8 + (c2 & 7)) * 128 * D, D, WbrT + (size_t)((c2 & 63) >> 3) * 128 * D, D, sm, tid);
      }
#pragma unroll
      for (int m = 0; m < 4; ++m)
#pragma unroll
        for (int n = 0; n < 4; ++n) {
          const u32x2 gt = *(const u32x2*)(gates + (size_t)(rbase + m * 16) * 3072 + i * 1024 + cbase + n * 16);
          tot[m][n][0] += bf2f(gt.x & 0xffffu) * acc[m][n][0];
          tot[m][n][1] += bf2f(gt.x >> 16) * acc[m][n][1];
          tot[m][n][2] += bf2f(gt.y & 0xffffu) * acc[m][n][2];
          tot[m][n][3] += bf2f(gt.y >> 16) * acc[m][n][3];
        }
    }
#pragma unroll
    for (int m = 0; m < 4; ++m)
#pragma unroll
      for (int n = 0; n < 4; ++n)
        *(u32x2*)(merged + (size_t)(rbase + m * 16) * 1024 + cbase + n * 16) = u32x2{pack2(tot[m][n][0], tot[m][n][1]), pack2(tot[m][n][2], tot[m][n][3])};
  }
}

__device__ __forceinline__ void phase_outproj(const Params& p, int l, char* smraw) {
  bf16_t* sm = (bf16_t*)smraw;
  const bf16_t* WoutT = (const bf16_t*)(p.ws + OFF_WOUTT) + (size_t)l * D * D;
  const bf16_t* merged = (const bf16_t*)(p.ws + OFF_H);
  bf16_t* opre = (bf16_t*)(p.ws + OFF_YAPRE);
  const int tid = opaque_tid(); const int lane = tid & 63, w = tid >> 6, wr = w >> 1, wc = w & 1, l15 = lane & 15, grp = lane >> 4;
  const int nx = gridDim.x >> 3;
  constexpr int CJ_END = (R / 1024) * 64;
  auto cj_next = [&](int c) { return ((c & 63) + nx < 64) ? (c + nx) : (((c >> 6) + 8) * 64 + (int)(blockIdx.x >> 3)); };
  int cj = (blockIdx.x & 7) * 64 + (blockIdx.x >> 3);
  __syncthreads();
  if (cj < CJ_END) glds_prefetch0(merged + (size_t)((cj >> 6) * 8 + (cj & 7)) * 128 * D, D, WoutT + (size_t)((cj & 63) >> 3) * 128 * D, D, sm, tid);
  for (; cj < CJ_END; cj = cj_next(cj)) {
    const int nt = (cj & 63) >> 3, mt = (cj >> 6) * 8 + (cj & 7);
    f32x4 acc[4][4];
    zero_acc(acc);
    gemm_core_glds<true>(acc, merged + (size_t)mt * 128 * D, D, WoutT + (size_t)nt * 128 * D, D, D / 64, sm, tid);
    {
      const int c2 = cj_next(cj);
      if (c2 < CJ_END) glds_prefetch0(merged + (size_t)((c2 >> 6) * 8 + (c2 & 7)) * 128 * D, D, WoutT + (size_t)((c2 & 63) >> 3) * 128 * D, D, sm, tid);
    }
    const int rbase = mt * 128 + wr * 64 + l15, cbase = nt * 128 + wc * 64 + 4 * grp;
#pragma unroll
    for (int m = 0; m < 4; ++m)
#pragma unroll
      for (int n = 0; n < 4; ++n)
        *(u32x2*)(opre + (size_t)(rbase + m * 16) * 1024 + cbase + n * 16) = u32x2{pack2(acc[m][n][0], acc[m][n][1]), pack2(acc[m][n][2], acc[m][n][3])};
  }
}

#define XB_TMO      128
#define XB_XCNT(j)  (256  + 64 * (j))
#define XB_XSUB(j)  (1280 + 64 * (j))
#define XB_XGEN(j)  (2304 + 64 * (j))
#define XB_TOP      3328
#define XB_TOPGEN   3392
#define XCD_BAR_WORDS 3456
#define XB_SPIN_CAP (1u << 18)
#define LAS __attribute__((address_space(3)))

__device__ __forceinline__ unsigned xb_ld(unsigned* p)              { return __hip_atomic_load(p, __ATOMIC_RELAXED, __HIP_MEMORY_SCOPE_AGENT); }
__device__ __forceinline__ unsigned xb_add(unsigned* p, unsigned v) { return __hip_atomic_fetch_add(p, v, __ATOMIC_RELAXED, __HIP_MEMORY_SCOPE_AGENT); }
__device__ __forceinline__ unsigned xb_xcc_id() { return (unsigned)__builtin_amdgcn_s_getreg((3 << 11) | 20) & 0xFu; }
#define XB_SPIN(cond, bar) do { unsigned _sp = 0; while (cond) { __builtin_amdgcn_s_sleep(1); \
    if ((++_sp & 255u) == 0u) { if (xb_ld(&(bar)[XB_TMO])) break; if (_sp > XB_SPIN_CAP) { atomicAdd(&(bar)[XB_TMO], 1u); break; } } } } while (0)

struct XcdBarrier {
    unsigned* bar; unsigned x;
    volatile LAS unsigned* st;
};

__device__ __forceinline__ XcdBarrier xcd_barrier_post(unsigned* bar, volatile LAS unsigned* st) {
    XcdBarrier b; b.bar = bar; b.x = xb_xcc_id(); b.st = st;
    if (threadIdx.x == 0) (void)xb_add(&bar[XB_XCNT(b.x)], 1u);
    return b;
}
__device__ __forceinline__ void xcd_barrier_complete(unsigned* bar, unsigned x, unsigned& nloc, unsigned& nx) {
    const unsigned G = gridDim.x * gridDim.y * gridDim.z;
    unsigned sum, cnt, mine, sp = 0u;
    for (;;) {
        sum = 0u; cnt = 0u; mine = 0u;
#pragma unroll
        for (unsigned j = 0; j < 16; ++j) { const unsigned c = xb_ld(&bar[XB_XCNT(j)]); sum += c; cnt += (c > 0u) ? 1u : 0u; mine = (j == x) ? c : mine; }
        if (sum == G) break;
        __builtin_amdgcn_s_sleep(1);
        if ((++sp & 255u) == 0u) { if (xb_ld(&bar[XB_TMO])) break; if (sp > XB_SPIN_CAP) { atomicAdd(&bar[XB_TMO], 1u); break; } }
    }
    nloc = mine > 0u ? mine : 1u; nx = cnt > 0u ? cnt : 1u;
}
__device__ __forceinline__ void xcd_barrier(const XcdBarrier& b) {
    asm volatile("s_waitcnt vmcnt(0)" ::: "memory");
    __syncthreads();
    if (threadIdx.x == 0) {
        unsigned* bar = b.bar;
        __builtin_amdgcn_s_waitcnt(0);
        unsigned nloc = b.st[0], nx = b.st[1];
        if (nloc == 0u) { xcd_barrier_complete(bar, b.x, nloc, nx); b.st[0] = nloc; b.st[1] = nx; }
        const unsigned old = xb_add(&bar[XB_XSUB(b.x)], 1u);
        const unsigned gen = old / nloc;
        if (old + 1u == (gen + 1u) * nloc) {
            __builtin_amdgcn_fence(__ATOMIC_RELEASE, "agent");
            asm volatile("s_waitcnt vmcnt(0)" ::: "memory");
            const unsigned og = xb_add(&bar[XB_TOP], 1u);
            const unsigned tg = og / nx;
            if (og + 1u == (tg + 1u) * nx) xb_add(&bar[XB_TOPGEN], 1u);
            else XB_SPIN(xb_ld(&bar[XB_TOPGEN]) == tg, bar);
            __builtin_amdgcn_fence(__ATOMIC_ACQUIRE, "agent");
            xb_add(&bar[XB_XGEN(b.x)], 1u);
            asm volatile("s_waitcnt vmcnt(0)" ::: "memory");
        } else {
            XB_SPIN(xb_ld(&bar[XB_XGEN(b.x)]) == gen, bar);
            __builtin_amdgcn_fence(__ATOMIC_ACQUIRE, "agent");
            asm volatile("s_waitcnt vmcnt(0)" ::: "memory");
        }
    }
    __syncthreads();
}

__global__ void __launch_bounds__(256, 2) hybrid_fwd(Params p) {
  __shared__ __attribute__((aligned(16))) char smraw[SMEM_BYTES];
  cg::grid_group grid = cg::this_grid();
  if (threadIdx.x == 0) *(u32x4*)(smraw + 65536) = u32x4{0u, 0u, 0u, 0u};
  __syncthreads();
  const XcdBarrier xb = xcd_barrier_post((unsigned*)(p.ws + OFF_BAR), (volatile LAS unsigned*)(smraw + 65536));
  phase0(p, smraw);
  grid.sync();
  for (int gi = 0; gi < NGRP; ++gi) {
    phase_h0(p, gi);
    xcd_barrier(xb);
    for (int l = 0; l < DEPTH; ++l) {
      phase_inproj(p, l, smraw);
      xcd_barrier(xb);
      phase_mix1(p, l, smraw);
      xcd_barrier(xb);
      phase_mix2(p, l, smraw);
      xcd_barrier(xb);
      phase_merge(p, l, smraw);
      xcd_barrier(xb);
      phase_outproj(p, l, smraw);
      xcd_barrier(xb);
      phase_final(p, gi, l);
      xcd_barrier(xb);
    }
  }
}

extern "C" void kernel_launch(void* const* d_in, const int* in_sizes, int n_in, void* d_out, int out_size, void* d_ws,
                              size_t ws_size, hipStream_t stream) {
  static int grid_blocks = 0;
  if (!grid_blocks) {
    int dev = 0, cus = 0, per_cu = 0;
    hipGetDevice(&dev);
    hipDeviceGetAttribute(&cus, hipDeviceAttributeMultiprocessorCount, dev);
    hipOccupancyMaxActiveBlocksPerMultiprocessor(&per_cu, hybrid_fwd, 256, 0);
    if (per_cu < 1) per_cu = 1;
    if (per_cu > 2) per_cu = 2;
    grid_blocks = cus * per_cu;
    if (ws_size < WS_END) fprintf(stderr, "kernel_launch: workspace too small: %zu < %zu\n", ws_size, (size_t)WS_END);
  }
  Params p{};
  const float** pp = (const float**)&p;
  for (int i = 0; i < 21; ++i) pp[i] = (const float*)d_in[i];
  p.out = (float*)d_out;
  p.ws = (unsigned char*)d_ws;
  (void)hipMemsetAsync((char*)d_ws + OFF_BAR, 0, 3456 * 4, stream);
  void* args[] = {&p};
  hipError_t e = hipLaunchCooperativeKernel((void*)hybrid_fwd, dim3(grid_blocks), dim3(256), args, 0, stream);
  if (e != hipSuccess) fprintf(stderr, "cooperative launch failed: %s (grid %d)\n", hipGetErrorString(e), grid_blocks);
}
```
